# Optimizing an MI355X kernel written in HIP

```python
import math
import jax
import jax.numpy as jnp
from jax import lax
import numpy as np

D_MODEL = 1024
BATCH = 2
SEQ = 8192
DEPTH = 4

D_MIX = D_MODEL
W_GROUP = D_MIX // 4
D_FF = 2816
NORM_EPS = 1e-6
GROUP_NORM_EPS = 1e-5
CONV_W = 4

GLA_HEADS = 4
GLA_DK = W_GROUP // 2
GLA_DV = W_GROUP
GLA_HK = GLA_DK // GLA_HEADS
GLA_HV = GLA_DV // GLA_HEADS
GLA_RANK = 16
GLA_GATE_NORM = 16.0
GLA_CHUNK = 64
GLA_COLS = 2 * GLA_DK + 2 * GLA_DV + GLA_RANK

LRU_WIDTH = W_GROUP
LRU_BLOCKS = 4
LRU_BS = LRU_WIDTH // LRU_BLOCKS
LRU_C = 8.0
LRU_COLS = 2 * LRU_WIDTH

RW_WIDTH = W_GROUP
RW_HEADS = 4
RW_HS = RW_WIDTH // RW_HEADS
RW_W_RANK = 16
RW_A_RANK = 16
RW_V_RANK = 8
RW_G_RANK = 32
RW_DECAY_SCALE = math.exp(-0.5)
RW_GN_EPS = 64e-5
RW_COLS = 3 * RW_WIDTH + RW_W_RANK + RW_A_RANK + RW_G_RANK

SSD_DINNER = W_GROUP
SSD_HEADDIM = 64
SSD_HEADS = SSD_DINNER // SSD_HEADDIM
SSD_GROUPS = 2
SSD_DSTATE = 128
SSD_CHUNK = 128
SSD_CONV_DIM = SSD_DINNER + 2 * SSD_GROUPS * SSD_DSTATE
SSD_COLS = SSD_DINNER + SSD_CONV_DIM + SSD_HEADS

N_IN = GLA_COLS + LRU_COLS + RW_COLS + SSD_COLS

kernel_name = "hybrid_parallel_groups_gla_rglru_rwkv7_ssd_macaron"


def split_cols(p, widths):
    offsets = [int(o) for o in np.cumsum(widths)[:-1]]
    return jnp.split(p, offsets, axis=-1)


def rmsnorm(x, w, eps=NORM_EPS):
    xf = x.astype(jnp.float32)
    y = xf * lax.rsqrt(jnp.mean(xf * xf, axis=-1, keepdims=True) + eps)
    return (y * w.astype(jnp.float32)).astype(x.dtype)


def swiglu(x, w_gate, w_up, w_down):
    return (jax.nn.silu(x @ w_gate) * (x @ w_up)) @ w_down


def causal_conv(x, w, b):
    k_w, ch = w.shape
    y = lax.conv_general_dilated(
        x, w[:, None, :].astype(x.dtype), window_strides=(1,), padding=[(k_w - 1, 0)],
        dimension_numbers=("NWC", "WIO", "NWC"), feature_group_count=ch)
    return y + b.astype(x.dtype)


def token_shift(x):
    return jnp.pad(x[:, :-1], ((0, 0), (1, 0), (0, 0)))


def gla_chunked(q, k, v, log_a):
    bsz, seq, heads, dk = q.shape
    dv = v.shape[-1]
    n_chunks = seq // GLA_CHUNK

    def chunks(t):
        return t.astype(jnp.float32).reshape(bsz, n_chunks, GLA_CHUNK, heads, t.shape[-1])

    q, k, v, log_a = chunks(q), chunks(k), chunks(v), chunks(log_a)
    b = jnp.cumsum(log_a, axis=2)
    b_last = b[:, :, -1:]
    q_dec = q * jnp.exp(b)
    k_dec = k * jnp.exp(-b)
    causal = jnp.tril(jnp.ones((GLA_CHUNK, GLA_CHUNK), dtype=bool))
    scores = jnp.where(causal, jnp.einsum("bnihd,bnjhd->bnhij", q_dec, k_dec), 0.0)
    o_intra = jnp.einsum("bnhij,bnjhv->bnihv", scores, v)
    kv_chunk = jnp.einsum("bnjhd,bnjhv->nbhdv", k * jnp.exp(b_last - b), v)
    decay_chunk = jnp.exp(jnp.moveaxis(b_last[:, :, 0], 1, 0))

    def step(state, inp):
        dec, kv = inp
        return dec[..., None] * state + kv, state

    _, s_prev = lax.scan(step, jnp.zeros((bsz, heads, dk, dv), jnp.float32), (decay_chunk, kv_chunk))
    o_inter = jnp.einsum("bnihd,nbhdv->bnihv", q_dec, s_prev)
    return (o_intra + o_inter).reshape(bsz, seq, heads, dv)


def gla_group(p, alpha_up, alpha_bias, norm_w):
    bsz, seq, _ = p.shape
    q, k, v, g, stem = split_cols(p, (GLA_DK, GLA_DK, GLA_DV, GLA_DV, GLA_RANK))
    log_a = jax.nn.log_sigmoid((stem @ alpha_up + alpha_bias).astype(jnp.float32)) / GLA_GATE_NORM
    heads_k = lambda t: t.reshape(bsz, seq, GLA_HEADS, GLA_HK)
    o = gla_chunked(heads_k(q) * (GLA_HK ** -0.5), heads_k(k),
                    v.reshape(bsz, seq, GLA_HEADS, GLA_HV), heads_k(log_a))
    o = rmsnorm(o, norm_w, GROUP_NORM_EPS).reshape(bsz, seq, GLA_DV).astype(p.dtype)
    return o * jax.nn.silu(g)


def _linear_recurrence_combine(left, right):
    a_l, b_l = left
    a_r, b_r = right
    return a_l * a_r, a_r * b_l + b_r


def rglru_group(p, conv_w, conv_b, w_a, b_a, w_x, b_x, lam):
    bsz, seq, _ = p.shape
    xb, gate = split_cols(p, (LRU_WIDTH, LRU_WIDTH))
    xb = causal_conv(xb, conv_w, conv_b)
    xblk = xb.reshape(bsz, seq, LRU_BLOCKS, LRU_BS)
    r = jax.nn.sigmoid(jnp.einsum("bsnk,nkj->bsnj", xblk, w_a).reshape(bsz, seq, LRU_WIDTH) + b_a)
    i = jax.nn.sigmoid(jnp.einsum("bsnk,nkj->bsnj", xblk, w_x).reshape(bsz, seq, LRU_WIDTH) + b_x)
    log_a = -LRU_C * r.astype(jnp.float32) * jax.nn.softplus(-lam.astype(jnp.float32))
    a = jnp.exp(log_a)
    u = jnp.sqrt(-jnp.expm1(2.0 * log_a)) * (i * xb).astype(jnp.float32)
    _, h = lax.associative_scan(_linear_recurrence_combine, (a, u), axis=1)
    return h.astype(p.dtype) * jax.nn.gelu(gate)


def rwkv7_scan(r, w, k, v, a, b):
    bsz, _, heads, n = r.shape
    xs = tuple(jnp.moveaxis(t, 1, 0) for t in (r, w, k, v, a, b))

    def step(state, inp):
        r_t, w_t, k_t, v_t, a_t, b_t = inp
        sa = jnp.einsum("bhvk,bhk->bhv", state, a_t)
        state = (state * w_t[:, :, None, :] + sa[..., None] * b_t[:, :, None, :]
                 + v_t[..., None] * k_t[:, :, None, :])
        return state, jnp.einsum("bhvk,bhk->bhv", state, r_t)

    _, y = lax.scan(step, jnp.zeros((bsz, heads, n, n), jnp.float32), xs)
    return jnp.moveaxis(y, 0, 1)


def rwkv7_group(p, mu, w0, w2, a0, a2, g2, k_k, k_a, r_k, gn_w, gn_b, v_first, v_mix):
    bsz, seq, _ = p.shape
    p = p + (token_shift(p) - p) * mu
    r, k, v, s_w, s_a, s_g = split_cols(p, (RW_WIDTH, RW_WIDTH, RW_WIDTH, RW_W_RANK, RW_A_RANK, RW_G_RANK))
    log_w = -RW_DECAY_SCALE * jax.nn.sigmoid((w0 + jnp.tanh(s_w) @ w2).astype(jnp.float32))
    a = jax.nn.sigmoid(a0 + s_a @ a2)
    g = jax.nn.sigmoid(s_g) @ g2
    if v_mix is not None:
        v0, v1, v2 = v_mix
        v = v + (v_first - v) * jax.nn.sigmoid(v0 + (v @ v1) @ v2)
    heads = lambda t: t.astype(jnp.float32).reshape(bsz, seq, RW_HEADS, RW_HS)
    kk = heads(k * k_k)
    kk = kk / jnp.maximum(jnp.sqrt(jnp.sum(kk * kk, axis=-1, keepdims=True)), 1e-12)
    k = k * (1.0 + (a - 1.0) * k_a)
    rh, kh, vh, ah = heads(r), heads(k), heads(v), heads(a)
    y = rwkv7_scan(rh, heads(jnp.exp(log_w)), kh, vh, -kk, kk * ah)
    mean = jnp.mean(y, axis=-1, keepdims=True)
    var = jnp.mean(jnp.square(y - mean), axis=-1, keepdims=True)
    y = ((y - mean) * lax.rsqrt(var + RW_GN_EPS)).reshape(bsz, seq, RW_WIDTH) * gn_w + gn_b
    bonus = jnp.sum(rh * kh * r_k.astype(jnp.float32), axis=-1, keepdims=True) * vh
    y = (y + bonus.reshape(bsz, seq, RW_WIDTH)).astype(p.dtype) * g
    return y, v


def ssd_chunked(x, d_a, b_in, c_in):
    bsz, seq, heads, hp = x.shape
    groups, n = b_in.shape[2], b_in.shape[3]
    rep = heads // groups
    nc = seq // SSD_CHUNK
    x = x.reshape(bsz, nc, SSD_CHUNK, groups, rep, hp)
    d_a = d_a.reshape(bsz, nc, SSD_CHUNK, groups, rep)
    b_in = b_in.astype(jnp.float32).reshape(bsz, nc, SSD_CHUNK, groups, n)
    c_in = c_in.astype(jnp.float32).reshape(bsz, nc, SSD_CHUNK, groups, n)
    cs = jnp.cumsum(d_a, axis=2)
    seg = cs[:, :, :, None] - cs[:, :, None, :]
    causal = jnp.tril(jnp.ones((SSD_CHUNK, SSD_CHUNK), dtype=bool))[:, :, None, None]
    decay = jnp.exp(jnp.where(causal, seg, -jnp.inf))
    cb = jnp.einsum("bclgn,bcsgn->bclsg", c_in, b_in)
    y_diag = jnp.einsum("bclsgr,bcsgrp->bclgrp", cb[..., None] * decay, x)
    cs_last = cs[:, :, -1]
    x_to_end = x * jnp.exp(cs_last[:, :, None] - cs)[..., None]
    states = jnp.einsum("bcsgn,bcsgrp->cbgrpn", b_in, x_to_end)

    def step(h, inp):
        dec, st = inp
        return dec[..., None, None] * h + st, h

    _, h_prev = lax.scan(step, jnp.zeros((bsz, groups, rep, hp, n), jnp.float32),
                         (jnp.moveaxis(jnp.exp(cs_last), 1, 0), states))
    y_off = jnp.einsum("bclgn,cbgrpn->bclgrp", c_in, h_prev) * jnp.exp(cs)[..., None]
    return (y_diag + y_off).reshape(bsz, seq, heads, hp)


def mamba2_group(p, conv_w, conv_b, dt_bias, a_log, d_skip, norm_w):
    bsz, seq, _ = p.shape
    z, xbc, dt = split_cols(p, (SSD_DINNER, SSD_CONV_DIM, SSD_HEADS))
    xbc = jax.nn.silu(causal_conv(xbc, conv_w, conv_b))
    xs, b_in, c_in = split_cols(xbc, (SSD_DINNER, SSD_GROUPS * SSD_DSTATE, SSD_GROUPS * SSD_DSTATE))
    dt = jax.nn.softplus(dt.astype(jnp.float32) + dt_bias.astype(jnp.float32))
    a = -jnp.exp(a_log.astype(jnp.float32))
    xh = xs.astype(jnp.float32).reshape(bsz, seq, SSD_HEADS, SSD_HEADDIM)
    grp = lambda t: t.reshape(bsz, seq, SSD_GROUPS, SSD_DSTATE)
    y = ssd_chunked(xh * dt[..., None], dt * a, grp(b_in), grp(c_in))
    y = y + d_skip.astype(jnp.float32)[:, None] * xh
    y = y.reshape(bsz, seq, SSD_DINNER) * jax.nn.silu(z.astype(jnp.float32))
    gsz = SSD_DINNER // SSD_GROUPS
    y = rmsnorm(y.reshape(bsz, seq, SSD_GROUPS, gsz), norm_w.reshape(SSD_GROUPS, gsz), GROUP_NORM_EPS)
    return y.reshape(bsz, seq, SSD_DINNER).astype(p.dtype)


def setup_inputs(seed: int = 0) -> dict:
    key = jax.random.key(seed)
    keys = jax.random.split(key, 64)
    counter = [0]

    def nk():
        k = keys[counter[0]]
        counter[0] += 1
        return k

    def nrm(shape, scale):
        return jax.random.normal(nk(), shape, jnp.float32) * scale

    def gain(shape):
        return 1.0 + nrm(shape, 0.02)

    def unif(shape, lo, hi):
        return jax.random.uniform(nk(), shape, jnp.float32, lo, hi)

    L = DEPTH
    lru_s = unif((L, LRU_WIDTH), 0.9, 0.999) ** (1.0 / LRU_C)
    dt0 = jnp.exp(unif((L, SSD_HEADS), math.log(1e-3), math.log(1e-1)))
    return {
        "x": nrm((BATCH, SEQ, D_MODEL), 1.0),
        "ffn1_norm": gain((L, D_MODEL)),
        "ffn1_w_gate": nrm((L, D_MODEL, D_FF), D_MODEL ** -0.5),
        "ffn1_w_up": nrm((L, D_MODEL, D_FF), D_MODEL ** -0.5),
        "ffn1_w_down": nrm((L, D_FF, D_MODEL), D_FF ** -0.5),
        "mix_norm": gain((L, D_MODEL)),
        "w_in": nrm((L, D_MODEL, N_IN), D_MODEL ** -0.5),
        "w_out": nrm((L, D_MIX, D_MODEL), D_MIX ** -0.5),
        "gla_alpha_up": nrm((L, GLA_RANK, GLA_DK), GLA_RANK ** -0.5),
        "gla_alpha_bias": nrm((L, GLA_DK), 0.1),
        "gla_norm": gain((L, GLA_HV)),
        "lru_conv_w": nrm((L, CONV_W, LRU_WIDTH), CONV_W ** -0.5),
        "lru_conv_b": nrm((L, LRU_WIDTH), 0.02),
        "lru_w_a": nrm((L, LRU_BLOCKS, LRU_BS, LRU_BS), LRU_BS ** -0.5),
        "lru_b_a": nrm((L, LRU_WIDTH), 0.02),
        "lru_w_x": nrm((L, LRU_BLOCKS, LRU_BS, LRU_BS), LRU_BS ** -0.5),
        "lru_b_x": nrm((L, LRU_WIDTH), 0.02),
        "lru_lambda": jnp.log(lru_s) - jnp.log1p(-lru_s),
        "rw_mu": unif((L, RW_COLS), 0.0, 1.0),
        "rw_w0": nrm((L, RW_WIDTH), 1.0),
        "rw_w2": nrm((L, RW_W_RANK, RW_WIDTH), RW_W_RANK ** -0.5),
        "rw_a0": nrm((L, RW_WIDTH), 0.1),
        "rw_a2": nrm((L, RW_A_RANK, RW_WIDTH), RW_A_RANK ** -0.5),
        "rw_g2": nrm((L, RW_G_RANK, RW_WIDTH), RW_G_RANK ** -0.5),
        "rw_v0": nrm((L - 1, RW_WIDTH), 0.1),
        "rw_v1": nrm((L - 1, RW_WIDTH, RW_V_RANK), RW_WIDTH ** -0.5),
        "rw_v2": nrm((L - 1, RW_V_RANK, RW_WIDTH), RW_V_RANK ** -0.5),
        "rw_k_k": 0.85 + nrm((L, RW_WIDTH), 0.02),
        "rw_k_a": gain((L, RW_WIDTH)),
        "rw_r_k": nrm((L, RW_HEADS, RW_HS), 0.1),
        "rw_gn_w": gain((L, RW_WIDTH)),
        "rw_gn_b": nrm((L, RW_WIDTH), 0.02),
        "ssd_conv_w": nrm((L, CONV_W, SSD_CONV_DIM), CONV_W ** -0.5),
        "ssd_conv_b": nrm((L, SSD_CONV_DIM), 0.02),
        "ssd_dt_bias": dt0 + jnp.log(-jnp.expm1(-dt0)),
        "ssd_a_log": jnp.log(unif((L, SSD_HEADS), 1.0, 16.0)),
        "ssd_d": gain((L, SSD_HEADS)),
        "ssd_norm": gain((L, SSD_DINNER)),
        "ffn2_norm": gain((L, D_MODEL)),
        "ffn2_w_gate": nrm((L, D_MODEL, D_FF), D_MODEL ** -0.5),
        "ffn2_w_up": nrm((L, D_MODEL, D_FF), D_MODEL ** -0.5),
        "ffn2_w_down": nrm((L, D_FF, D_MODEL), D_FF ** -0.5),
        "final_norm": gain((D_MODEL,)),
    }


def reference(x, ffn1_norm, ffn1_w_gate, ffn1_w_up, ffn1_w_down, mix_norm, w_in, w_out,
              gla_alpha_up, gla_alpha_bias, gla_norm,
              lru_conv_w, lru_conv_b, lru_w_a, lru_b_a, lru_w_x, lru_b_x, lru_lambda,
              rw_mu, rw_w0, rw_w2, rw_a0, rw_a2, rw_g2, rw_v0, rw_v1, rw_v2,
              rw_k_k, rw_k_a, rw_r_k, rw_gn_w, rw_gn_b,
              ssd_conv_w, ssd_conv_b, ssd_dt_bias, ssd_a_log, ssd_d, ssd_norm,
              ffn2_norm, ffn2_w_gate, ffn2_w_up, ffn2_w_down, final_norm):
    v_first = None
    for l in range(DEPTH):
        x = x + 0.5 * swiglu(rmsnorm(x, ffn1_norm[l]), ffn1_w_gate[l], ffn1_w_up[l], ffn1_w_down[l])
        proj = rmsnorm(x, mix_norm[l]) @ w_in[l]
        p_gla, p_lru, p_rw, p_ssd = split_cols(proj, (GLA_COLS, LRU_COLS, RW_COLS, SSD_COLS))
        y_gla = gla_group(p_gla, gla_alpha_up[l], gla_alpha_bias[l], gla_norm[l])
        y_lru = rglru_group(p_lru, lru_conv_w[l], lru_conv_b[l], lru_w_a[l], lru_b_a[l],
                            lru_w_x[l], lru_b_x[l], lru_lambda[l])
        v_mix = None if l == 0 else (rw_v0[l - 1], rw_v1[l - 1], rw_v2[l - 1])
        y_rw, v_rw = rwkv7_group(p_rw, rw_mu[l], rw_w0[l], rw_w2[l], rw_a0[l], rw_a2[l], rw_g2[l],
                                 rw_k_k[l], rw_k_a[l], rw_r_k[l], rw_gn_w[l], rw_gn_b[l], v_first, v_mix)
        if l == 0:
            v_first = v_rw
        y_ssd = mamba2_group(p_ssd, ssd_conv_w[l], ssd_conv_b[l], ssd_dt_bias[l], ssd_a_log[l],
                             ssd_d[l], ssd_norm[l])
        y = jnp.concatenate([y_gla, y_lru, y_rw, y_ssd], axis=-1)
        x = x + y @ w_out[l]
        x = x + 0.5 * swiglu(rmsnorm(x, ffn2_norm[l]), ffn2_w_gate[l], ffn2_w_up[l], ffn2_w_down[l])
    return rmsnorm(x, final_norm)
```

```cpp
#include <hip/hip_runtime.h>
#include <hip/hip_cooperative_groups.h>
#include <cstdio>
#include <cstdint>
namespace cg = cooperative_groups;
namespace pg8 {
#define PG8_LAS __attribute__((address_space(3)))
typedef unsigned short bf16_t;
typedef short bf16x8 __attribute__((ext_vector_type(8)));
typedef float f32x4 __attribute__((ext_vector_type(4)));
typedef unsigned u32x4 __attribute__((ext_vector_type(4)));
constexpr int BM = 256, BK = 64, HALF = 128, HTB = HALF * BK * 2  , STAGE_BYTES = 8 * HTB, NXCD = 8, WGM = 8;

__host__ __device__ __forceinline__ int lds_byte(int r, int c) { const int st = (r >> 4) * 2 + (c >> 5), rr = r & 15, cc = c & 31, ob = rr * 64 + cc * 2; return st * 1024 + (ob ^ (((ob >> 9) & 1) << 5)); }
__host__ __device__ __forceinline__ void stage_rc(int b, int& R, int& C) { const int st = b / 1024, sb = b % 1024, swz = sb ^ (((sb >> 9) & 1) << 5); R = (st >> 1) * 16 + swz / 64; C = (st & 1) * 32 + (swz % 64) / 2; }
__host__ __device__ __forceinline__ int perm32(int rho) { const int n = rho >> 4, i = rho & 15; return 8 * (i >> 2) + 4 * n + (i & 3); }

struct Unit { int pm, pn; };
struct Gemm { const bf16_t* A; const bf16_t* Bt; int M, N, K; };

struct StaticOrder {
    int nM, nN, nwg, G, c;
    __host__ __device__ void init(int M, int N, int G_, int c_) { nM = M / BM; nN = N / BM; nwg = nM * nN; G = G_; c = c_; }
    __host__ __device__ bool next(int i, Unit& u) const {
        const long L = (long)i * G + c; if (L >= nwg) return false;
        int wgid = (int)L; { const int q = nwg / NXCD, r = nwg % NXCD, xcd = wgid % NXCD, off = wgid / NXCD; wgid = (xcd < r ? xcd * (q + 1) : r * (q + 1) + (xcd - r) * q) + off; }
        const int nig = WGM * nN, gid = wgid / nig, fm = gid * WGM, gsz = (nM - fm) < WGM ? (nM - fm) : WGM;
        u.pm = fm + ((wgid % nig) % gsz); u.pn = (wgid % nig) / gsz; return true;
    }
    __device__ __forceinline__ void a_ready(const Unit&) const {}
    __device__ __forceinline__ void done(const Unit&) const {}
};

__device__ __forceinline__ unsigned cvt_pk_bf16(float lo, float hi) { unsigned r; asm volatile("v_cvt_pk_bf16_f32 %0, %1, %2" : "=v"(r) : "v"(lo), "v"(hi)); return r; }
typedef float f32x2 __attribute__((ext_vector_type(2)));
template <class Epi, class Sched, bool ALIGN_EPI = false, bool SP2 = false>
__device__ __forceinline__ void gemm_phase(PG8_LAS unsigned char* lds, const Gemm g, const Sched& S, const Epi& E) {
    int tid_ = threadIdx.x; asm volatile("" : "+v"(tid_));
    const int tid = tid_, wid = __builtin_amdgcn_readfirstlane(tid >> 6), lane = tid & 63, wr = wid >> 2, wc = wid & 3, fr = lane & 15, fq = lane >> 4;
    const int K = g.K, nt = K / BK;
    unsigned voffA[2], voffB[2];
#pragma unroll
    for (int i = 0; i < 2; ++i) { int R, C; stage_rc(tid * 16 + i * 8192, R, C); const int Rb = Epi::PERM ? ((R & ~31) + perm32(R & 31)) : R;
        voffA[i] = (unsigned)(R * K + C) * 2u; voffB[i] = (unsigned)(Rb * K + C) * 2u; }
    const size_t kstep = (size_t)(BK * 2);
    const size_t hstep = (size_t)HALF * K * 2;
    const size_t tstep = 2 * hstep;
    const unsigned ldsw = (unsigned)wid * 1024u;
    const int aoff = lds_byte(wr * 64 + fr, fq * 8), boff = lds_byte(wc * 32 + fr, fq * 8);
#define PG8_SA(b, h) (((b) * 2 + (h)) * HTB)
#define PG8_SB(b, h) ((4 + (b) * 2 + (h)) * HTB)
#define PG8_STAGE(bufoff, gbase, voff) do { _Pragma("unroll") for (int _i = 0; _i < 2; ++_i) \
        __builtin_amdgcn_global_load_lds((const unsigned*)((const char*)(gbase) + (voff)[_i]), (PG8_LAS unsigned*)(lds + (bufoff) + ldsw + _i * 8192), 16, 0, 0); } while (0)
#define PG8_LDA(dst, b, h) do { _Pragma("unroll") for (int m = 0; m < 4; ++m) _Pragma("unroll") for (int k = 0; k < 2; ++k) dst[m][k] = *(const PG8_LAS bf16x8*)(lds + PG8_SA(b, h) + aoff + m * 2048 + k * 1024); } while (0)
#define PG8_LDB(dst, b, h) do { _Pragma("unroll") for (int n = 0; n < 2; ++n) _Pragma("unroll") for (int k = 0; k < 2; ++k) dst[n][k] = *(const PG8_LAS bf16x8*)(lds + PG8_SB(b, h) + boff + n * 2048 + k * 1024); } while (0)
#define PG8_MMA(ai, bj, At, Bt) do { __builtin_amdgcn_s_setprio(1); _Pragma("unroll") for (int m = 0; m < 4; ++m) _Pragma("unroll") for (int n = 0; n < 2; ++n) _Pragma("unroll") for (int k = 0; k < 2; ++k) \
        acc[ai][bj][m][n] = __builtin_amdgcn_mfma_f32_16x16x32_bf16(Bt[n][k], At[m][k], acc[ai][bj][m][n], 0, 0, 0); __builtin_amdgcn_s_setprio(0); } while (0)
#define PG8_WAIT_V(n) asm volatile("s_waitcnt vmcnt(" #n ")" ::: "memory")
#define PG8_WAIT_L(n) asm volatile("s_waitcnt lgkmcnt(" #n ")" ::: "memory")
#define PG8_BAR __builtin_amdgcn_s_barrier()
#define PG8_SCHED __builtin_amdgcn_sched_barrier(0)
    Unit cur, nxt; int ui = 0;
    if (!S.next(0, cur)) return;
    f32x4 acc[2][2][4][2];
#pragma unroll
    for (int a = 0; a < 2; ++a)
#pragma unroll
        for (int b = 0; b < 2; ++b)
#pragma unroll
            for (int m = 0; m < 4; ++m)
#pragma unroll
                for (int n = 0; n < 2; ++n) acc[a][b][m][n] = (f32x4){0.f, 0.f, 0.f, 0.f};
    bf16x8 At[4][2], B0[2][2], B1[2][2];
    const char* cA = (const char*)g.A + (size_t)cur.pm * tstep; const char* cB = (const char*)g.Bt + (size_t)cur.pn * tstep;
    S.a_ready(cur);
    if constexpr (SP2) {
        PG8_STAGE(PG8_SB(0, 0), cB, voffB); PG8_STAGE(PG8_SB(0, 1), cB + hstep, voffB); PG8_STAGE(PG8_SA(0, 0), cA, voffA); PG8_STAGE(PG8_SA(0, 1), cA + hstep, voffA);
        if (wr == 1) PG8_BAR;
        PG8_WAIT_V(2); PG8_BAR;
        PG8_STAGE(PG8_SB(1, 0), cB + kstep, voffB); PG8_STAGE(PG8_SA(1, 0), cA + kstep, voffA); PG8_STAGE(PG8_SB(1, 1), cB + hstep + kstep, voffB);
        PG8_WAIT_V(6); PG8_BAR;
    } else {
        PG8_STAGE(PG8_SB(0, 0), cB, voffB); PG8_STAGE(PG8_SA(0, 0), cA, voffA); PG8_STAGE(PG8_SB(0, 1), cB + hstep, voffB); PG8_STAGE(PG8_SA(0, 1), cA + hstep, voffA);
        if (wr == 1) PG8_BAR;
        PG8_WAIT_V(4); PG8_BAR;
        PG8_STAGE(PG8_SB(1, 0), cB + kstep, voffB); PG8_STAGE(PG8_SA(1, 0), cA + kstep, voffA); PG8_STAGE(PG8_SB(1, 1), cB + hstep + kstep, voffB);
        PG8_WAIT_V(6); PG8_BAR;
    }
    for (;;) {
        const bool has_next = S.next(ui + 1, nxt);
        const char* nA = has_next ? (const char*)g.A + (size_t)nxt.pm * tstep : cA; const char* nB = has_next ? (const char*)g.Bt + (size_t)nxt.pn * tstep : cB;
        for (int t = 0; t < nt; t += 2) {
            const bool last = (t == nt - 2);
            const char* a1 = cA + (size_t)(t + 1) * kstep;
            const char* a2 = last ? nA : cA + (size_t)(t + 2) * kstep; const char* b2 = last ? nB : cB + (size_t)(t + 2) * kstep;
            const char* a3 = a2 + kstep; const char* b3 = b2 + kstep;
            if (last && has_next) S.a_ready(nxt);
            if constexpr (SP2) {
            PG8_LDB(B0, 0, 0); PG8_LDB(B1, 0, 1); PG8_SCHED; PG8_LDA(At, 0, 0); PG8_STAGE(PG8_SA(1, 1), a1 + hstep, voffA);
            PG8_WAIT_V(8); PG8_WAIT_L(0); PG8_BAR; PG8_MMA(0, 0, At, B0); PG8_MMA(0, 1, At, B1); PG8_BAR; PG8_SCHED;
            PG8_LDA(At, 0, 1); PG8_STAGE(PG8_SB(0, 0), b2, voffB); PG8_STAGE(PG8_SB(0, 1), b2 + hstep, voffB); PG8_STAGE(PG8_SA(0, 0), a2, voffA);
            PG8_WAIT_V(8); PG8_WAIT_L(0); PG8_BAR; PG8_MMA(1, 0, At, B0); PG8_MMA(1, 1, At, B1); PG8_BAR; PG8_SCHED;
            PG8_LDB(B0, 1, 0); PG8_LDB(B1, 1, 1); PG8_SCHED; PG8_LDA(At, 1, 0); PG8_STAGE(PG8_SA(0, 1), a2 + hstep, voffA);
            PG8_WAIT_V(8); PG8_WAIT_L(0); PG8_BAR; PG8_MMA(0, 0, At, B0); PG8_MMA(0, 1, At, B1); PG8_BAR; PG8_SCHED;
            PG8_LDA(At, 1, 1); PG8_STAGE(PG8_SB(1, 0), b3, voffB); PG8_STAGE(PG8_SB(1, 1), b3 + hstep, voffB); PG8_STAGE(PG8_SA(1, 0), a3, voffA);
            PG8_WAIT_V(8); PG8_WAIT_L(0); PG8_BAR; PG8_MMA(1, 0, At, B0); PG8_MMA(1, 1, At, B1); PG8_BAR; PG8_SCHED;
            } else {
            PG8_LDB(B0, 0, 0); PG8_SCHED; PG8_LDA(At, 0, 0); PG8_STAGE(PG8_SA(1, 1), a1 + hstep, voffA);
            PG8_WAIT_L(8); PG8_BAR; PG8_WAIT_L(0); PG8_MMA(0, 0, At, B0); PG8_BAR; PG8_SCHED;
            PG8_LDB(B1, 0, 1); PG8_STAGE(PG8_SB(0, 0), b2, voffB);
            PG8_BAR; PG8_WAIT_L(0); PG8_MMA(0, 1, At, B1); PG8_BAR;
            PG8_LDA(At, 0, 1); PG8_STAGE(PG8_SA(0, 0), a2, voffA);
            PG8_BAR; PG8_WAIT_L(0); PG8_MMA(1, 0, At, B0); PG8_BAR; PG8_SCHED;
            PG8_STAGE(PG8_SB(0, 1), b2 + hstep, voffB);
            PG8_WAIT_V(6); PG8_BAR; PG8_MMA(1, 1, At, B1); PG8_BAR;
            PG8_LDB(B0, 1, 0); PG8_SCHED; PG8_LDA(At, 1, 0); PG8_STAGE(PG8_SA(0, 1), a2 + hstep, voffA);
            PG8_WAIT_L(8); PG8_BAR; PG8_WAIT_L(0); PG8_MMA(0, 0, At, B0); PG8_BAR; PG8_SCHED;
            PG8_LDB(B1, 1, 1); PG8_STAGE(PG8_SB(1, 0), b3, voffB);
            PG8_BAR; PG8_WAIT_L(0); PG8_MMA(0, 1, At, B1); PG8_BAR;
            PG8_LDA(At, 1, 1); PG8_STAGE(PG8_SA(1, 0), a3, voffA);
            PG8_BAR; PG8_WAIT_L(0); PG8_MMA(1, 0, At, B0); PG8_BAR; PG8_SCHED;
            PG8_STAGE(PG8_SB(1, 1), b3 + hstep, voffB);
            PG8_WAIT_V(6); PG8_BAR; PG8_MMA(1, 1, At, B1); PG8_BAR;
            }
        }
        if constexpr (ALIGN_EPI) { if (wr == 0) PG8_BAR; }
        if constexpr (!Epi::AFTER_DRAIN) { E(acc, cur, wr, wc, fr, fq); S.done(cur); }
        if (!has_next) break;
#pragma unroll
        for (int a = 0; a < 2; ++a)
#pragma unroll
            for (int b = 0; b < 2; ++b)
#pragma unroll
                for (int m = 0; m < 4; ++m)
#pragma unroll
                    for (int n = 0; n < 2; ++n) acc[a][b][m][n] = (f32x4){0.f, 0.f, 0.f, 0.f};
        cur = nxt; cA = nA; cB = nB; ++ui;
        if constexpr (ALIGN_EPI) { if (wr == 1) PG8_BAR; }
    }
    PG8_WAIT_V(0);
    if constexpr (!ALIGN_EPI) { if (wr == 0) PG8_BAR; }
    PG8_BAR;
    if constexpr (Epi::AFTER_DRAIN) { E.fused(acc, cur, wr, wc, fr, fq, lds, wid, lane); S.done(cur); }
#undef PG8_SA
#undef PG8_SB
#undef PG8_STAGE
#undef PG8_LDA
#undef PG8_LDB
#undef PG8_MMA
#undef PG8_WAIT_V
#undef PG8_WAIT_L
#undef PG8_BAR
#undef PG8_SCHED
}
}
#define LAS __attribute__((address_space(3)))
typedef unsigned short bf16;
typedef float f4 __attribute__((ext_vector_type(4)));
typedef unsigned u2 __attribute__((ext_vector_type(2)));
typedef unsigned u4 __attribute__((ext_vector_type(4)));
using pg8::f32x4;

constexpr int M = 16384, D = 1024, FF = 2816, NIN = 3156, NINP = 3328, NL = 4, SEQ = 8192;
constexpr int LDS_BYTES = 147456;
constexpr size_t HM = 524288;
constexpr size_t WS_WGU1 = 0, WS_WD1 = 22 * HM, WS_WIN = 33 * HM, WS_WOUT = 46 * HM, WS_WGU2 = 50 * HM, WS_WD2 = 72 * HM;
constexpr size_t MiB = 1048576;
constexpr size_t WS_XB = 42 * MiB;
constexpr size_t WS_OGLA = WS_XB, WS_YRW = WS_XB + 8 * MiB, WS_YSSD = WS_XB + 16 * MiB;
constexpr size_t WS_Y = 74 * MiB;
constexpr size_t WS_PROJ = 106 * MiB;
constexpr size_t WS_VFIRST = 210 * MiB;
constexpr size_t WS_SS = 226 * MiB;
constexpr size_t WS_RWR = 227 * MiB, WS_RWK = 235 * MiB, WS_RWV = 243 * MiB, WS_RWKK = 251 * MiB, WS_RWB = 259 * MiB;
constexpr size_t WS_RWW = 267 * MiB;
constexpr size_t WS_RWG = 283 * MiB;
constexpr size_t WS_RWBON = 291 * MiB;
constexpr size_t WS_XBC = 292 * MiB;
constexpr size_t WS_DT = 316 * MiB, WS_DEC = 317 * MiB;
constexpr size_t WS_LRA = 318 * MiB, WS_LRH = 334 * MiB;
constexpr size_t WS_SEGA = 350 * MiB, WS_SEGH = 351 * MiB, WS_CARRY = 352 * MiB;
constexpr size_t WS_END = 353 * MiB;

constexpr int PC_GQ = 0, PC_GK = 128, PC_GV = 256, PC_GG = 512, PC_GSTEM = 768, PC_LX = 784, PC_LG = 1040, PC_RW = 1296, PC_SZ = 2128, PC_SXBC = 2384, PC_SDT = 3152;

__device__ __forceinline__ float bf2f(bf16 v) { return __uint_as_float((unsigned)v << 16); }
__device__ __forceinline__ float bflo(unsigned w) { return __uint_as_float(w << 16); }
__device__ __forceinline__ float bfhi(unsigned w) { return __uint_as_float(w & 0xffff0000u); }
__device__ __forceinline__ unsigned pk2(float lo, float hi) { return pg8::cvt_pk_bf16(lo, hi); }
__device__ __forceinline__ float sigmoidf_(float x) { return 1.f / (1.f + __expf(-x)); }
__device__ __forceinline__ float siluf_(float x) { return x / (1.f + __expf(-x)); }
__device__ __forceinline__ float tanhf_(float x) { return 1.f - 2.f / (1.f + __expf(2.f * x)); }
__device__ __forceinline__ float softplusf_(float x) { return fmaxf(x, 0.f) + log1pf(__expf(-fabsf(x))); }
__device__ __forceinline__ float gelu_tanh(float x) { const float u = 0.7978845608028654f * (x + 0.044715f * x * x * x); return 0.5f * x * (1.f + tanhf_(u)); }
__device__ __forceinline__ float wave_sum(float v) {
#pragma unroll
    for (int o = 1; o < 64; o <<= 1) v += __shfl_xor(v, o);
    return v;
}
__device__ __forceinline__ float red8(float x) { x += __shfl_xor(x, 1); x += __shfl_xor(x, 2); x += __shfl_xor(x, 4); return x; }
__device__ __forceinline__ float rstd_row(const float* ss, int row) { const f4 p = *(const f4*)(ss + (size_t)row * 4); return rsqrtf(((p.x + p.y) + (p.z + p.w)) * (1.f / 1024.f) + 1e-6f); }

struct EpiGU {
    static constexpr bool PERM = true, AFTER_DRAIN = true;
    bf16* H; const float* ss;
    __device__ __forceinline__ void fused(f32x4 (&acc)[2][2][4][2], const pg8::Unit& u, int wr, int wc, int fr, int fq, LAS unsigned char* lds, int wid, int lane) const {
#pragma unroll
        for (int ai = 0; ai < 2; ++ai)
#pragma unroll
            for (int m = 0; m < 4; ++m) {
                const int row = u.pm * 256 + ai * 128 + wr * 64 + m * 16 + fr; const float rs = rstd_row(ss, row);
                float hv[8];
#pragma unroll
                for (int n = 0; n < 2; ++n)
#pragma unroll
                    for (int e = 0; e < 4; ++e) { const float g = acc[ai][0][m][n][e] * rs, up = acc[ai][1][m][n][e] * rs; hv[n * 4 + e] = siluf_(g) * up; }
                u4 w; w.x = pk2(hv[0], hv[1]); w.y = pk2(hv[2], hv[3]); w.z = pk2(hv[4], hv[5]); w.w = pk2(hv[6], hv[7]);
                *(u4*)(H + (size_t)row * FF + u.pn * 128 + wc * 32 + 8 * fq) = w;
                asm volatile("" ::: "memory");
            }
    }
};
struct EpiProj {
    static constexpr bool PERM = true, AFTER_DRAIN = true;
    bf16* O; const float* ss;
    __device__ __forceinline__ void fused(f32x4 (&acc)[2][2][4][2], const pg8::Unit& u, int wr, int wc, int fr, int fq, LAS unsigned char* lds, int wid, int lane) const {
#pragma unroll
        for (int ai = 0; ai < 2; ++ai)
#pragma unroll
            for (int m = 0; m < 4; ++m) {
                const int row = u.pm * 256 + ai * 128 + wr * 64 + m * 16 + fr; const float rs = rstd_row(ss, row);
#pragma unroll
                for (int bj = 0; bj < 2; ++bj) { const f32x4 v0 = acc[ai][bj][m][0] * rs, v1 = acc[ai][bj][m][1] * rs;
                    u4 w; w.x = pk2(v0[0], v0[1]); w.y = pk2(v0[2], v0[3]); w.z = pk2(v1[0], v1[1]); w.w = pk2(v1[2], v1[3]);
                    *(u4*)(O + (size_t)row * NINP + u.pn * 256 + bj * 128 + wc * 32 + 8 * fq) = w; }
                asm volatile("" ::: "memory");
            }
    }
};
struct EpiResid {
    static constexpr bool PERM = true, AFTER_DRAIN = true;
    const float* xin; float* xout; bf16* xb; float* ss; float scale;
    __device__ __forceinline__ void fused(f32x4 (&acc)[2][2][4][2], const pg8::Unit& u, int wr, int wc, int fr, int fq, LAS unsigned char* lds, int wid, int lane) const {
        LAS float* P = (LAS float*)lds;
#pragma unroll
        for (int ai = 0; ai < 2; ++ai)
#pragma unroll
            for (int m = 0; m < 4; ++m) {
                const int rt = ai * 128 + wr * 64 + m * 16 + fr; const size_t row = (size_t)u.pm * 256 + rt; float sq = 0.f;
#pragma unroll
                for (int bj = 0; bj < 2; ++bj) { const size_t off = row * D + u.pn * 256 + bj * 128 + wc * 32 + 8 * fq;
                    f32x4 x0 = *(const f32x4*)(xin + off), x1 = *(const f32x4*)(xin + off + 4);
                    x0 += acc[ai][bj][m][0] * scale; x1 += acc[ai][bj][m][1] * scale;
                    *(f32x4*)(xout + off) = x0; *(f32x4*)(xout + off + 4) = x1;
                    u4 w; w.x = pk2(x0[0], x0[1]); w.y = pk2(x0[2], x0[3]); w.z = pk2(x1[0], x1[1]); w.w = pk2(x1[2], x1[3]);
                    *(u4*)(xb + off) = w;
                    sq += (x0[0] * x0[0] + x0[1] * x0[1]) + (x0[2] * x0[2] + x0[3] * x0[3]) + (x1[0] * x1[0] + x1[1] * x1[1]) + (x1[2] * x1[2] + x1[3] * x1[3]); }
                sq += __shfl_xor(sq, 16); sq += __shfl_xor(sq, 32);
                if (fq == 0) P[rt * 4 + wc] = sq;
            }
        __syncthreads();
        const int tid = wid * 64 + lane;
        if (tid < 256) ss[(size_t)(u.pm * 256 + tid) * 4 + u.pn] = (P[tid * 4 + 0] + P[tid * 4 + 1]) + (P[tid * 4 + 2] + P[tid * 4 + 3]);
        __syncthreads();
    }
};
struct OneUnit { pg8::StaticOrder b; int r;
    __device__ __forceinline__ bool next(int i, pg8::Unit& u) const { return i == 0 && b.next(r, u); }
    __device__ __forceinline__ void a_ready(const pg8::Unit&) const {}
    __device__ __forceinline__ void done(const pg8::Unit&) const {} };

__device__ __forceinline__ void tr_item(const float* W, int ldn, int nvalid, int col0, const float* sc, bf16* WT, int K, int row0, int k0, LAS float* scr, int lane) {
    const int c = col0 + (lane & 31);
#pragma unroll 8
    for (int i = 0; i < 32; ++i) { const int kk = 2 * i + (lane >> 5); float v = (c < nvalid) ? W[(size_t)(k0 + kk) * ldn + c] : 0.f; if (sc) v *= sc[k0 + kk]; scr[kk * 33 + (lane & 31)] = v; }
    asm volatile("s_waitcnt lgkmcnt(0)" ::: "memory");
    const int c8 = lane & 7;
#pragma unroll
    for (int j = 0; j < 4; ++j) { const int n = (lane >> 3) + 8 * j; const LAS float* s = scr + (8 * c8) * 33 + n;
        u4 o; o.x = pk2(s[0 * 33], s[1 * 33]); o.y = pk2(s[2 * 33], s[3 * 33]); o.z = pk2(s[4 * 33], s[5 * 33]); o.w = pk2(s[6 * 33], s[7 * 33]);
        *(u4*)(WT + (size_t)(row0 + n) * K + k0 + 8 * c8) = o; }
    asm volatile("s_waitcnt lgkmcnt(0)" ::: "memory");
}
__device__ __forceinline__ void tr_gu(const float* Wg, const float* Wu, const float* nw, bf16* WT, int it, LAS float* scr, int lane) {
    const int kb = it / 176, nb = it % 176, row0 = nb * 32, pn = row0 >> 8, half = (row0 >> 7) & 1, i0 = row0 & 127;
    tr_item(half ? Wu : Wg, FF, FF, pn * 128 + i0, nw, WT, D, row0, kb * 64, scr, lane);
}
__device__ __forceinline__ void phase_convert(const float* const* in, unsigned char* ws, int l, LAS unsigned char* lds, int gw, int NGW, int wave, int lane) {
    LAS float* scr = (LAS float*)(lds + wave * 16384);
    const size_t oFF = (size_t)l * D * FF;
    constexpr int I_GU = 2816, I_D = 1408, I_IN = 1664, I_OUT = 512, NIT = 2 * I_GU + 2 * I_D + I_IN + I_OUT;
    for (int it = gw; it < NIT; it += NGW) {
        int r = it;
        if (r < I_GU) { tr_gu(in[2] + oFF, in[3] + oFF, in[1] + l * D, (bf16*)(ws + WS_WGU1), r, scr, lane); continue; } r -= I_GU;
        if (r < I_D) { tr_item(in[4] + oFF, D, D, (r % 32) * 32, nullptr, (bf16*)(ws + WS_WD1), FF, (r % 32) * 32, (r / 32) * 64, scr, lane); continue; } r -= I_D;
        if (r < I_IN) { tr_item(in[6] + (size_t)l * D * NIN, NIN, NIN, (r % 104) * 32, in[5] + l * D, (bf16*)(ws + WS_WIN), D, (r % 104) * 32, (r / 104) * 64, scr, lane); continue; } r -= I_IN;
        if (r < I_OUT) { tr_item(in[7] + (size_t)l * D * D, D, D, (r % 32) * 32, nullptr, (bf16*)(ws + WS_WOUT), D, (r % 32) * 32, (r / 32) * 64, scr, lane); continue; } r -= I_OUT;
        if (r < I_GU) { tr_gu(in[39] + oFF, in[40] + oFF, in[38] + l * D, (bf16*)(ws + WS_WGU2), r, scr, lane); continue; } r -= I_GU;
        tr_item(in[41] + oFF, D, D, (r % 32) * 32, nullptr, (bf16*)(ws + WS_WD2), FF, (r % 32) * 32, (r / 32) * 64, scr, lane);
    }
}
__device__ __forceinline__ void phase_init_rows(const float* x, bf16* xb, float* ss, int gw, int NGW, int lane) {
    for (int m = gw; m < M; m += NGW) {
        const f4* xr = (const f4*)(x + (size_t)m * D) + lane; float s = 0.f; u2* o = (u2*)(xb + (size_t)m * D) + lane;
#pragma unroll
        for (int j = 0; j < 4; ++j) { const f4 v = xr[64 * j]; s += (v.x * v.x + v.y * v.y) + (v.z * v.z + v.w * v.w); u2 w; w.x = pk2(v.x, v.y); w.y = pk2(v.z, v.w); o[64 * j] = w; }
        s = wave_sum(s);
        if (lane < 4) ss[(size_t)m * 4 + lane] = lane == 0 ? s : 0.f;
    }
}
__device__ __forceinline__ void phase_final(float* x, const float* fw, int gw, int NGW, int lane) {
    for (int m = gw; m < M; m += NGW) {
        f4* xr = (f4*)(x + (size_t)m * D) + lane; f4 v[4]; float s = 0.f;
#pragma unroll
        for (int j = 0; j < 4; ++j) { v[j] = xr[64 * j]; s += (v[j].x * v[j].x + v[j].y * v[j].y) + (v[j].z * v[j].z + v[j].w * v[j].w); }
        const float rs = rsqrtf(wave_sum(s) * (1.f / 1024.f) + 1e-6f);
#pragma unroll
        for (int j = 0; j < 4; ++j) { const f4 w = ((const f4*)fw)[lane + 64 * j]; xr[64 * j] = v[j] * rs * w; }
    }
}
__device__ __forceinline__ void prep_lru(const float* const* in, unsigned char* ws, int l, int item, LAS unsigned char* lds, int tid) {
    const bf16* PROJ = (const bf16*)(ws + WS_PROJ); LAS float* X = (LAS float*)lds; LAS float* G = X + 32 * 256;
    const int t0 = item * 32; const float* cw = in[11] + l * 4 * 256; const float* cb = in[12] + l * 256;
#pragma unroll 1
    for (int idx = tid; idx < 32 * 256; idx += 512) { const int t = idx >> 8, c = idx & 255, tok = t0 + t, pos = tok & (SEQ - 1); float acc = cb[c];
#pragma unroll
        for (int k = 0; k < 4; ++k) { const int tp = pos - 3 + k; if (tp >= 0) acc += cw[k * 256 + c] * bf2f(PROJ[(size_t)(tok - 3 + k) * NINP + PC_LX + c]); }
        X[idx] = acc; }
    __syncthreads();
    const int gsel = tid >> 8, c = tid & 255, blk = c >> 6, j = c & 63;
    { const float* pw = (gsel ? in[15] : in[13]) + (size_t)l * 16384 + blk * 4096 + j; const float bias = (gsel ? in[16] : in[14])[l * 256 + c];
#pragma unroll 1
      for (int kh = 0; kh < 2; ++kh) { float wv[32];
#pragma unroll
          for (int k = 0; k < 32; ++k) wv[k] = pw[(kh * 32 + k) * 64];
#pragma unroll 1
          for (int t = 0; t < 32; ++t) { const LAS f4* xr = (const LAS f4*)(X + t * 256 + blk * 64 + kh * 32); float d0 = 0.f, d1 = 0.f;
#pragma unroll
              for (int k4 = 0; k4 < 8; k4 += 2) { const f4 v = xr[k4], w = xr[k4 + 1];
                  d0 += v.x * wv[4 * k4] + v.y * wv[4 * k4 + 1] + v.z * wv[4 * k4 + 2] + v.w * wv[4 * k4 + 3];
                  d1 += w.x * wv[4 * k4 + 4] + w.y * wv[4 * k4 + 5] + w.z * wv[4 * k4 + 6] + w.w * wv[4 * k4 + 7]; }
              LAS float* gp = G + (gsel * 32 + t) * 256 + c;
              if (kh == 0) *gp = d0 + d1; else *gp = sigmoidf_(*gp + d0 + d1 + bias); } } }
    __syncthreads();
    if (tid < 256) { const float sp = softplusf_(-in[17][l * 256 + c]); float h = 0.f, A = 1.f; float* LRA = (float*)(ws + WS_LRA); float* LRH = (float*)(ws + WS_LRH);
#pragma unroll 1
        for (int t = 0; t < 32; ++t) { const float r = G[t * 256 + c], ig = G[(32 + t) * 256 + c], la = -8.f * r * sp, av = __expf(la), u = sqrtf(fmaxf(-expm1f(2.f * la), 0.f)) * (ig * X[t * 256 + c]);
            h = av * h + u; A *= av; const size_t o = (size_t)(t0 + t) * 256 + c; LRA[o] = A; LRH[o] = h; }
        ((float*)(ws + WS_SEGA))[item * 256 + c] = A; ((float*)(ws + WS_SEGH))[item * 256 + c] = h; }
    __syncthreads();
}
__device__ __forceinline__ void prep_ssd(const float* const* in, unsigned char* ws, int l, int item, int tid) {
    const bf16* PROJ = (const bf16*)(ws + WS_PROJ); unsigned* XBC = (unsigned*)(ws + WS_XBC);
    const int t0 = item * 32; const float* cw = in[32] + l * 4 * 768; const float* cb = in[33] + l * 768;
    for (int idx = tid; idx < 32 * 384; idx += 512) { const int t = idx / 384, c = (idx % 384) * 2, tok = t0 + t, pos = tok & (SEQ - 1); float a0 = cb[c], a1 = cb[c + 1];
#pragma unroll
        for (int k = 0; k < 4; ++k) { const int tp = pos - 3 + k; if (tp >= 0) { const unsigned w = *(const unsigned*)(PROJ + (size_t)(tok - 3 + k) * NINP + PC_SXBC + c); a0 += cw[k * 768 + c] * bflo(w); a1 += cw[k * 768 + c + 1] * bfhi(w); } }
        XBC[((size_t)tok * 768 + c) >> 1] = pk2(siluf_(a0), siluf_(a1)); }
    if (tid < 128) { const int t = tid >> 2, hh = tid & 3, tok = t0 + t; const float dt = softplusf_(bf2f(PROJ[(size_t)tok * NINP + PC_SDT + hh]) + in[34][l * 4 + hh]);
        ((float*)(ws + WS_DT))[tok * 4 + hh] = dt; ((float*)(ws + WS_DEC))[tok * 4 + hh] = __expf(-dt * __expf(in[35][l * 4 + hh])); }
}
__device__ __forceinline__ void prep_rw(const float* const* in, unsigned char* ws, int l, int item, LAS unsigned char* lds, int tid) {
    const bf16* PROJ = (const bf16*)(ws + WS_PROJ); LAS float* P = (LAS float*)lds; LAS float* VV = (LAS float*)(lds + 32 * 832 * 4);
    const int t0 = item * 32; const float* mu = in[18] + l * 832;
#pragma unroll 1
    for (int idx = tid; idx < 32 * 832; idx += 512) { const int t = idx / 832, col = idx % 832, tok = t0 + t;
        const float cur = bf2f(PROJ[(size_t)tok * NINP + PC_RW + col]), prev = (tok & (SEQ - 1)) ? bf2f(PROJ[(size_t)(tok - 1) * NINP + PC_RW + col]) : 0.f;
        float p = cur + (prev - cur) * mu[col];
        if (col >= 768 && col < 784) p = tanhf_(p); else if (col >= 800) p = sigmoidf_(p);
        P[idx] = p; }
    __syncthreads();
    if (l > 0 && tid < 256) { const int t = tid >> 3, j = tid & 7; const float* v1 = in[25] + (size_t)(l - 1) * 2048 + j; float s = 0.f;
#pragma unroll 4
        for (int c = 0; c < 256; ++c) s += P[t * 832 + 512 + c] * v1[c * 8];
        VV[t * 8 + j] = s; }
    __syncthreads();
    const int half = tid >> 8, c = tid & 255, hh = c >> 6, lane = tid & 63;
    float zw[16], za[16], gg[16], zv[16];
    { const float w0 = in[19][l * 256 + c], a0 = in[21][l * 256 + c], v0 = l > 0 ? in[24][(l - 1) * 256 + c] : 0.f;
#pragma unroll
      for (int tt = 0; tt < 16; ++tt) { zw[tt] = w0; za[tt] = a0; gg[tt] = 0.f; zv[tt] = v0; } }
    const LAS float* ph = P + half * 16 * 832;
    { const float* w2p = in[20] + (size_t)l * 4096 + c; const float* a2p = in[22] + (size_t)l * 4096 + c;
#pragma unroll 1
      for (int j4 = 0; j4 < 4; ++j4) { const float wa = w2p[(4 * j4) * 256], wb = w2p[(4 * j4 + 1) * 256], wc_ = w2p[(4 * j4 + 2) * 256], wd_ = w2p[(4 * j4 + 3) * 256];
          const float aa = a2p[(4 * j4) * 256], ab = a2p[(4 * j4 + 1) * 256], ac = a2p[(4 * j4 + 2) * 256], ad = a2p[(4 * j4 + 3) * 256];
#pragma unroll
          for (int tt = 0; tt < 16; ++tt) { const f4 sw = *(const LAS f4*)(ph + tt * 832 + 768 + 4 * j4), sa = *(const LAS f4*)(ph + tt * 832 + 784 + 4 * j4);
              zw[tt] += sw.x * wa + sw.y * wb + sw.z * wc_ + sw.w * wd_; za[tt] += sa.x * aa + sa.y * ab + sa.z * ac + sa.w * ad; } } }
    { const float* g2p = in[23] + (size_t)l * 8192 + c;
#pragma unroll 1
      for (int j4 = 0; j4 < 8; ++j4) { const float ga = g2p[(4 * j4) * 256], gb = g2p[(4 * j4 + 1) * 256], gc = g2p[(4 * j4 + 2) * 256], gd = g2p[(4 * j4 + 3) * 256];
#pragma unroll
          for (int tt = 0; tt < 16; ++tt) { const f4 sg = *(const LAS f4*)(ph + tt * 832 + 800 + 4 * j4); gg[tt] += sg.x * ga + sg.y * gb + sg.z * gc + sg.w * gd; } } }
    if (l > 0) { const float* v2p = in[26] + (size_t)(l - 1) * 2048 + c;
#pragma unroll 1
      for (int j4 = 0; j4 < 2; ++j4) { const float va = v2p[(4 * j4) * 256], vb = v2p[(4 * j4 + 1) * 256], vc = v2p[(4 * j4 + 2) * 256], vd = v2p[(4 * j4 + 3) * 256];
#pragma unroll
          for (int tt = 0; tt < 16; ++tt) { const f4 sv = *(const LAS f4*)(VV + (half * 16 + tt) * 8 + 4 * j4); zv[tt] += sv.x * va + sv.y * vb + sv.z * vc + sv.w * vd; } } }
    const float kkw = in[27][l * 256 + c], kaw = in[28][l * 256 + c], rkw = in[29][l * 256 + c];
    float* VF = (float*)(ws + WS_VFIRST);
#pragma unroll
    for (int tt = 0; tt < 16; ++tt) { const int t = half * 16 + tt; const size_t o = (size_t)(t0 + t) * 256 + c; const LAS float* pr = P + t * 832;
        const float r = pr[c], k = pr[256 + c]; float v = pr[512 + c];
        const float wd = __expf(-0.6065306597126334f * sigmoidf_(zw[tt])), av = sigmoidf_(za[tt]), g = gg[tt];
        if (l > 0) v = v + (VF[o] - v) * sigmoidf_(zv[tt]); else VF[o] = v;
        float kk = k * kkw; const float nrm = sqrtf(wave_sum(kk * kk)); kk = kk / fmaxf(nrm, 1e-12f);
        const float k2 = k * (1.f + (av - 1.f) * kaw);
        const float bon = wave_sum(r * k2 * rkw);
        ((bf16*)(ws + WS_RWR))[o] = (bf16)pk2(r, 0.f); ((bf16*)(ws + WS_RWK))[o] = (bf16)pk2(k2, 0.f); ((bf16*)(ws + WS_RWV))[o] = (bf16)pk2(v, 0.f);
        ((bf16*)(ws + WS_RWKK))[o] = (bf16)pk2(kk, 0.f); ((bf16*)(ws + WS_RWB))[o] = (bf16)pk2(kk * av, 0.f); ((bf16*)(ws + WS_RWG))[o] = (bf16)pk2(g, 0.f);
        ((float*)(ws + WS_RWW))[o] = wd;
        if (lane == 0) ((float*)(ws + WS_RWBON))[(t0 + t) * 4 + hh] = bon;
        asm volatile("" ::: "memory"); }
    __syncthreads();
}
__device__ __forceinline__ void phase_prep(const float* const* in, unsigned char* ws, int l, LAS unsigned char* lds, int tid) {
    constexpr int N_L = 512, N_R = 512, N_S = 512;
    for (int it = blockIdx.x; it < N_L + N_R + N_S; it += gridDim.x) {
        if (it < N_L) {
#ifndef SKIP_PL
            prep_lru(in, ws, l, it, lds, tid);
#endif
        } else if (it < N_L + N_R) {
#ifndef SKIP_PR
            prep_rw(in, ws, l, it - N_L, lds, tid);
#endif
        } else {
#ifndef SKIP_PS
            prep_ssd(in, ws, l, it - N_L - N_R, tid);
#endif
        }
    }
}

__device__ __forceinline__ void scan_rw(unsigned char* ws, int b, int hh, int tokb, int nsub, LAS unsigned char* lds, int tid) {
    LAS float* LW = (LAS float*)lds; LAS float* LKK = LW + 2048; LAS float* LB = LW + 4096; LAS float* LK = LW + 6144; LAS float* LR = LW + 8192; LAS float* LV = LW + 10240; LAS float* LY = LW + 12288;
    const int st = tid >> 4, sc4 = (tid & 15) * 4, row = tid >> 3, sl = tid & 7;
    const bf16* gR = (const bf16*)(ws + WS_RWR); const bf16* gK = (const bf16*)(ws + WS_RWK); const bf16* gV = (const bf16*)(ws + WS_RWV); const bf16* gKK = (const bf16*)(ws + WS_RWKK); const bf16* gB = (const bf16*)(ws + WS_RWB);
    const float* gW = (const float*)(ws + WS_RWW); bf16* gY = (bf16*)(ws + WS_YRW);
    float s[8];
#pragma unroll
    for (int i = 0; i < 8; ++i) s[i] = 0.f;
    u2 pr, pk, pv, pkk, pb; f4 pw;
    { const size_t o = (size_t)(tokb + st) * 256 + hh * 64 + sc4; pr = *(const u2*)(gR + o); pk = *(const u2*)(gK + o); pv = *(const u2*)(gV + o); pkk = *(const u2*)(gKK + o); pb = *(const u2*)(gB + o); pw = *(const f4*)(gW + o); }
    for (int sub = 0; sub < nsub; ++sub) {
        const int so = st * 64 + sc4;
        *(LAS f4*)(LW + so) = pw; *(LAS f4*)(LR + so) = (f4){bflo(pr.x), bfhi(pr.x), bflo(pr.y), bfhi(pr.y)}; *(LAS f4*)(LK + so) = (f4){bflo(pk.x), bfhi(pk.x), bflo(pk.y), bfhi(pk.y)};
        *(LAS f4*)(LV + so) = (f4){bflo(pv.x), bfhi(pv.x), bflo(pv.y), bfhi(pv.y)}; *(LAS f4*)(LKK + so) = (f4){bflo(pkk.x), bfhi(pkk.x), bflo(pkk.y), bfhi(pkk.y)}; *(LAS f4*)(LB + so) = (f4){bflo(pb.x), bfhi(pb.x), bflo(pb.y), bfhi(pb.y)};
        __syncthreads();
        if (sub + 1 < nsub) { const size_t o = (size_t)(tokb + (sub + 1) * 32 + st) * 256 + hh * 64 + sc4; pr = *(const u2*)(gR + o); pk = *(const u2*)(gK + o); pv = *(const u2*)(gV + o); pkk = *(const u2*)(gKK + o); pb = *(const u2*)(gB + o); pw = *(const f4*)(gW + o); }
        for (int t = 0; t < 32; ++t) { const int o = t * 64 + sl * 8;
            const f4 w0 = *(const LAS f4*)(LW + o), w1 = *(const LAS f4*)(LW + o + 4), a0 = *(const LAS f4*)(LKK + o), a1 = *(const LAS f4*)(LKK + o + 4), b0 = *(const LAS f4*)(LB + o), b1 = *(const LAS f4*)(LB + o + 4);
            const f4 k0 = *(const LAS f4*)(LK + o), k1 = *(const LAS f4*)(LK + o + 4), r0 = *(const LAS f4*)(LR + o), r1 = *(const LAS f4*)(LR + o + 4); const float vv = LV[t * 64 + row];
            float dot = (s[0] * a0.x + s[1] * a0.y) + (s[2] * a0.z + s[3] * a0.w) + (s[4] * a1.x + s[5] * a1.y) + (s[6] * a1.z + s[7] * a1.w);
            const float sa = -red8(dot);
            s[0] = s[0] * w0.x + sa * b0.x + vv * k0.x; s[1] = s[1] * w0.y + sa * b0.y + vv * k0.y; s[2] = s[2] * w0.z + sa * b0.z + vv * k0.z; s[3] = s[3] * w0.w + sa * b0.w + vv * k0.w;
            s[4] = s[4] * w1.x + sa * b1.x + vv * k1.x; s[5] = s[5] * w1.y + sa * b1.y + vv * k1.y; s[6] = s[6] * w1.z + sa * b1.z + vv * k1.z; s[7] = s[7] * w1.w + sa * b1.w + vv * k1.w;
            float y = (s[0] * r0.x + s[1] * r0.y) + (s[2] * r0.z + s[3] * r0.w) + (s[4] * r1.x + s[5] * r1.y) + (s[6] * r1.z + s[7] * r1.w);
            y = red8(y);
            if (sl == 0) LY[t * 64 + row] = y; }
        __syncthreads();
        { const f4 y = *(const LAS f4*)(LY + so); u2 w; w.x = pk2(y.x, y.y); w.y = pk2(y.z, y.w); *(u2*)(gY + (size_t)(tokb + sub * 32 + st) * 256 + hh * 64 + sc4) = w; }
    }
    __syncthreads();
}
__device__ __forceinline__ void scan_gla(const float* const* in, unsigned char* ws, int l, int b, int hh, int tokb, int nsub, LAS unsigned char* lds, int tid) {
    LAS float* LA = (LAS float*)lds; LAS float* LK = LA + 1024; LAS float* LQ = LA + 2048; LAS float* LV = LA + 3072; LAS float* LO = LA + 5120;
    const bf16* PROJ = (const bf16*)(ws + WS_PROJ); bf16* gO = (bf16*)(ws + WS_OGLA);
    const int st = tid >> 4, si = tid & 15, vcol = tid >> 3, sl = tid & 7;
    float up0[16], up1[16];
#pragma unroll
    for (int r = 0; r < 16; ++r) { up0[r] = in[8][(l * 16 + r) * 128 + hh * 32 + 2 * si]; up1[r] = in[8][(l * 16 + r) * 128 + hh * 32 + 2 * si + 1]; }
    const float bi0 = in[9][l * 128 + hh * 32 + 2 * si], bi1 = in[9][l * 128 + hh * 32 + 2 * si + 1];
    float s[4] = {0.f, 0.f, 0.f, 0.f};
    u4 ps0, ps1; unsigned pq, pk; u2 pv;
    { const bf16* p = PROJ + (size_t)(tokb + st) * NINP; ps0 = *(const u4*)(p + PC_GSTEM); ps1 = *(const u4*)(p + PC_GSTEM + 8); pq = *(const unsigned*)(p + PC_GQ + hh * 32 + 2 * si); pk = *(const unsigned*)(p + PC_GK + hh * 32 + 2 * si); pv = *(const u2*)(p + PC_GV + hh * 64 + 4 * si); }
    for (int sub = 0; sub < nsub; ++sub) {
        { const unsigned sw[8] = {ps0.x, ps0.y, ps0.z, ps0.w, ps1.x, ps1.y, ps1.z, ps1.w}; float z0 = bi0, z1 = bi1;
#pragma unroll
          for (int r = 0; r < 8; ++r) { const float e0 = bflo(sw[r]), e1 = bfhi(sw[r]); z0 += e0 * up0[2 * r] + e1 * up0[2 * r + 1]; z1 += e0 * up1[2 * r] + e1 * up1[2 * r + 1]; }
          const float l0 = fminf(z0, 0.f) - log1pf(__expf(-fabsf(z0))), l1 = fminf(z1, 0.f) - log1pf(__expf(-fabsf(z1)));
          const int o = st * 32 + 2 * si; LA[o] = __expf(l0 * 0.0625f); LA[o + 1] = __expf(l1 * 0.0625f); LK[o] = bflo(pk); LK[o + 1] = bfhi(pk); LQ[o] = bflo(pq); LQ[o + 1] = bfhi(pq);
          *(LAS f4*)(LV + st * 64 + 4 * si) = (f4){bflo(pv.x), bfhi(pv.x), bflo(pv.y), bfhi(pv.y)}; }
        __syncthreads();
        if (sub + 1 < nsub) { const bf16* p = PROJ + (size_t)(tokb + (sub + 1) * 32 + st) * NINP; ps0 = *(const u4*)(p + PC_GSTEM); ps1 = *(const u4*)(p + PC_GSTEM + 8); pq = *(const unsigned*)(p + PC_GQ + hh * 32 + 2 * si); pk = *(const unsigned*)(p + PC_GK + hh * 32 + 2 * si); pv = *(const u2*)(p + PC_GV + hh * 64 + 4 * si); }
        for (int t = 0; t < 32; ++t) { const f4 al = *(const LAS f4*)(LA + t * 32 + 4 * sl), kk = *(const LAS f4*)(LK + t * 32 + 4 * sl), qq = *(const LAS f4*)(LQ + t * 32 + 4 * sl); const float vv = LV[t * 64 + vcol];
            s[0] = s[0] * al.x + kk.x * vv; s[1] = s[1] * al.y + kk.y * vv; s[2] = s[2] * al.z + kk.z * vv; s[3] = s[3] * al.w + kk.w * vv;
            float o = (s[0] * qq.x + s[1] * qq.y) + (s[2] * qq.z + s[3] * qq.w); o = red8(o);
            if (sl == 0) LO[t * 64 + vcol] = o * 0.17677669529663687f; }
        __syncthreads();
        { const f4 y = *(const LAS f4*)(LO + st * 64 + 4 * si); u2 w; w.x = pk2(y.x, y.y); w.y = pk2(y.z, y.w); *(u2*)(gO + (size_t)(tokb + sub * 32 + st) * 256 + hh * 64 + 4 * si) = w; }
    }
    __syncthreads();
}
__device__ __forceinline__ void scan_ssd(unsigned char* ws, int b, int hh, int tokb, int nsub, LAS unsigned char* lds, int tid) {
    LAS float* LB = (LAS float*)lds; LAS float* LC = LB + 4096; LAS float* LX = LB + 8192; LAS float* LD = LB + 10240; LAS float* LY = LB + 10304;
    const bf16* XBC = (const bf16*)(ws + WS_XBC); const float* DT = (const float*)(ws + WS_DT); const float* DEC = (const float*)(ws + WS_DEC); bf16* gY = (bf16*)(ws + WS_YSSD);
    const int st = tid >> 4, si = tid & 15, p = tid >> 3, sl = tid & 7, g = hh >> 1;
    float s[16];
#pragma unroll
    for (int i = 0; i < 16; ++i) s[i] = 0.f;
    u4 pb, pc; u2 px; float pdt, pdec;
    { const size_t tok = tokb + st; const bf16* q = XBC + tok * 768; pb = *(const u4*)(q + 256 + g * 128 + 8 * si); pc = *(const u4*)(q + 512 + g * 128 + 8 * si); px = *(const u2*)(q + hh * 64 + 4 * si); pdt = DT[tok * 4 + hh]; pdec = DEC[tok * 4 + hh]; }
    for (int sub = 0; sub < nsub; ++sub) {
        { const int o = st * 128 + 8 * si;
          *(LAS f4*)(LB + o) = (f4){bflo(pb.x), bfhi(pb.x), bflo(pb.y), bfhi(pb.y)}; *(LAS f4*)(LB + o + 4) = (f4){bflo(pb.z), bfhi(pb.z), bflo(pb.w), bfhi(pb.w)};
          *(LAS f4*)(LC + o) = (f4){bflo(pc.x), bfhi(pc.x), bflo(pc.y), bfhi(pc.y)}; *(LAS f4*)(LC + o + 4) = (f4){bflo(pc.z), bfhi(pc.z), bflo(pc.w), bfhi(pc.w)};
          *(LAS f4*)(LX + st * 64 + 4 * si) = (f4){bflo(px.x) * pdt, bfhi(px.x) * pdt, bflo(px.y) * pdt, bfhi(px.y) * pdt};
          if (si == 0) LD[st] = pdec; }
        __syncthreads();
        if (sub + 1 < nsub) { const size_t tok = tokb + (sub + 1) * 32 + st; const bf16* q = XBC + tok * 768; pb = *(const u4*)(q + 256 + g * 128 + 8 * si); pc = *(const u4*)(q + 512 + g * 128 + 8 * si); px = *(const u2*)(q + hh * 64 + 4 * si); pdt = DT[tok * 4 + hh]; pdec = DEC[tok * 4 + hh]; }
        for (int t = 0; t < 32; ++t) { const float xv = LX[t * 64 + p], dc = LD[t]; float y = 0.f;
#pragma unroll
            for (int q4 = 0; q4 < 4; ++q4) { const f4 bb = *(const LAS f4*)(LB + t * 128 + 16 * sl + 4 * q4), cc = *(const LAS f4*)(LC + t * 128 + 16 * sl + 4 * q4);
                s[4 * q4] = s[4 * q4] * dc + bb.x * xv; s[4 * q4 + 1] = s[4 * q4 + 1] * dc + bb.y * xv; s[4 * q4 + 2] = s[4 * q4 + 2] * dc + bb.z * xv; s[4 * q4 + 3] = s[4 * q4 + 3] * dc + bb.w * xv;
                y += (s[4 * q4] * cc.x + s[4 * q4 + 1] * cc.y) + (s[4 * q4 + 2] * cc.z + s[4 * q4 + 3] * cc.w); }
            y = red8(y);
            if (sl == 0) LY[t * 64 + p] = y; }
        __syncthreads();
        { const f4 y = *(const LAS f4*)(LY + st * 64 + 4 * si); u2 w; w.x = pk2(y.x, y.y); w.y = pk2(y.z, y.w); *(u2*)(gY + (size_t)(tokb + sub * 32 + st) * 256 + hh * 64 + 4 * si) = w; }
    }
    __syncthreads();
}
__device__ __forceinline__ void scan_lru_carry(unsigned char* ws, int tid) {
    const float* SA = (const float*)(ws + WS_SEGA); const float* SH = (const float*)(ws + WS_SEGH); float* CY = (float*)(ws + WS_CARRY);
    const int b = tid >> 8, c = tid & 255; float h = 0.f;
    for (int sg = 0; sg < 256; ++sg) { const int o = (b * 256 + sg) * 256 + c; CY[o] = h; h = SA[o] * h + SH[o]; }
}
__device__ __forceinline__ void phase_scan(const float* const* in, unsigned char* ws, int l, LAS unsigned char* lds, int tid) {
    for (int it = blockIdx.x; it < 25; it += gridDim.x) {
        const int w = it & 7, b = w >> 2, hh = w & 3;
        if (it < 8) scan_ssd(ws, b, hh, b * SEQ, SEQ / 32, lds, tid);
        else if (it < 16) scan_rw(ws, b, hh, b * SEQ, SEQ / 32, lds, tid);
        else if (it < 24) scan_gla(in, ws, l, b, hh, b * SEQ, SEQ / 32, lds, tid);
        else scan_lru_carry(ws, tid);
    }
}
__device__ __forceinline__ float red16(float x) { x += __shfl_xor(x, 1); x += __shfl_xor(x, 2); x += __shfl_xor(x, 4); x += __shfl_xor(x, 8); return x; }
__device__ __forceinline__ void phase_post(const float* const* in, unsigned char* ws, int l, int gw, int NGW, int lane) {
    const bf16* PROJ = (const bf16*)(ws + WS_PROJ); bf16* Y = (bf16*)(ws + WS_Y); const int c = 4 * lane, hh = lane >> 4;
    const f4 gnorm = *(const f4*)(in[10] + l * 64 + (c & 63)), gnw = *(const f4*)(in[30] + l * 256 + c), gnb = *(const f4*)(in[31] + l * 256 + c), snw = *(const f4*)(in[37] + l * 256 + c);
    const float dsk = in[36][l * 4 + hh];
    for (int tok = gw; tok < M; tok += NGW) { const bf16* pp = PROJ + (size_t)tok * NINP; const size_t o = (size_t)tok * 256 + c; bf16* yo = Y + (size_t)tok * D + c;
        { const u2 ov = *(const u2*)((const bf16*)(ws + WS_OGLA) + o), gv = *(const u2*)(pp + PC_GG + c);
          const float o0 = bflo(ov.x), o1 = bfhi(ov.x), o2 = bflo(ov.y), o3 = bfhi(ov.y);
          const float rs = rsqrtf(red16((o0 * o0 + o1 * o1) + (o2 * o2 + o3 * o3)) * (1.f / 64.f) + 1e-5f);
          u2 w; w.x = pk2(o0 * rs * gnorm.x * siluf_(bflo(gv.x)), o1 * rs * gnorm.y * siluf_(bfhi(gv.x))); w.y = pk2(o2 * rs * gnorm.z * siluf_(bflo(gv.y)), o3 * rs * gnorm.w * siluf_(bfhi(gv.y))); *(u2*)(yo) = w; }
        { const f4 A = *(const f4*)((const float*)(ws + WS_LRA) + o), H = *(const f4*)((const float*)(ws + WS_LRH) + o), cy = *(const f4*)((const float*)(ws + WS_CARRY) + (size_t)(tok >> 5) * 256 + c);
          const u2 gv = *(const u2*)(pp + PC_LG + c);
          u2 w; w.x = pk2((H.x + A.x * cy.x) * gelu_tanh(bflo(gv.x)), (H.y + A.y * cy.y) * gelu_tanh(bfhi(gv.x))); w.y = pk2((H.z + A.z * cy.z) * gelu_tanh(bflo(gv.y)), (H.w + A.w * cy.w) * gelu_tanh(bfhi(gv.y))); *(u2*)(yo + 256) = w; }
        { const u2 yv = *(const u2*)((const bf16*)(ws + WS_YRW) + o), vv = *(const u2*)((const bf16*)(ws + WS_RWV) + o), gv = *(const u2*)((const bf16*)(ws + WS_RWG) + o);
          const float bon = ((const float*)(ws + WS_RWBON))[tok * 4 + hh];
          float y0 = bflo(yv.x), y1 = bfhi(yv.x), y2 = bflo(yv.y), y3 = bfhi(yv.y);
          const float mean = red16((y0 + y1) + (y2 + y3)) * (1.f / 64.f); y0 -= mean; y1 -= mean; y2 -= mean; y3 -= mean;
          const float rs = rsqrtf(red16((y0 * y0 + y1 * y1) + (y2 * y2 + y3 * y3)) * (1.f / 64.f) + 64e-5f);
          u2 w; w.x = pk2((y0 * rs * gnw.x + gnb.x + bon * bflo(vv.x)) * bflo(gv.x), (y1 * rs * gnw.y + gnb.y + bon * bfhi(vv.x)) * bfhi(gv.x));
          w.y = pk2((y2 * rs * gnw.z + gnb.z + bon * bflo(vv.y)) * bflo(gv.y), (y3 * rs * gnw.w + gnb.w + bon * bfhi(vv.y)) * bfhi(gv.y)); *(u2*)(yo + 512) = w; }
        { const u2 yv = *(const u2*)((const bf16*)(ws + WS_YSSD) + o), xv = *(const u2*)((const bf16*)(ws + WS_XBC) + (size_t)tok * 768 + c), zv = *(const u2*)(pp + PC_SZ + c);
          const float y0 = (bflo(yv.x) + dsk * bflo(xv.x)) * siluf_(bflo(zv.x)), y1 = (bfhi(yv.x) + dsk * bfhi(xv.x)) * siluf_(bfhi(zv.x)), y2 = (bflo(yv.y) + dsk * bflo(xv.y)) * siluf_(bflo(zv.y)), y3 = (bfhi(yv.y) + dsk * bfhi(xv.y)) * siluf_(bfhi(zv.y));
          float q = red16((y0 * y0 + y1 * y1) + (y2 * y2 + y3 * y3)); q += __shfl_xor(q, 16);
          const float rs = rsqrtf(q * (1.f / 128.f) + 1e-5f);
          u2 w; w.x = pk2(y0 * rs * snw.x, y1 * rs * snw.y); w.y = pk2(y2 * rs * snw.z, y3 * rs * snw.w); *(u2*)(yo + 768) = w; }
    }
}
struct Args { const float* in[43]; float* out; unsigned char* ws; };
template <class Epi> __device__ __forceinline__ void gemm_multi(LAS unsigned char* lds, const pg8::Gemm& g, const Epi& E) {
    pg8::StaticOrder S; S.init(g.M, g.N, (int)gridDim.x, (int)blockIdx.x);
    pg8::gemm_phase<Epi, pg8::StaticOrder, true, true>(lds, g, S, E);
}
template <class Epi> __device__ __forceinline__ void gemm_single(LAS unsigned char* lds, const pg8::Gemm& g, const Epi& E) {
    pg8::StaticOrder S; S.init(g.M, g.N, (int)gridDim.x, (int)blockIdx.x);
    for (int r = 0;; ++r) { pg8::Unit u; if (!S.next(r, u)) break; OneUnit O{S, r}; pg8::gemm_phase<Epi, OneUnit, false, true>(lds, g, O, E); }
}
__global__ void __launch_bounds__(512, 2) fwd(Args a) {
    extern __shared__ __attribute__((aligned(16))) unsigned char lds_raw[];
    LAS unsigned char* lds = (LAS unsigned char*)lds_raw;
    cg::grid_group grid = cg::this_grid();
#define TIDS int tid = threadIdx.x; asm volatile("" : "+v"(tid)); const int lane = tid & 63, wave = __builtin_amdgcn_readfirstlane(tid >> 6), gw = blockIdx.x * 8 + wave, NGW = gridDim.x * 8; (void)lane; (void)gw; (void)NGW;
    unsigned char* ws = a.ws; const float* const* in = a.in; float* X = a.out;
    bf16* XB = (bf16*)(ws + WS_XB); bf16* Y = (bf16*)(ws + WS_Y); bf16* H = (bf16*)(ws + WS_PROJ); bf16* PROJ = (bf16*)(ws + WS_PROJ); float* SS = (float*)(ws + WS_SS);
#pragma unroll 1
    for (int l = 0; l < NL; ++l) {
        { TIDS
#ifndef SKIP_CONV
        phase_convert(in, ws, l, lds, gw, NGW, wave, lane);
#endif
        if (l == 0) phase_init_rows(in[0], XB, SS, gw, NGW, lane); }
        grid.sync();
#ifndef SKIP_G1
        { pg8::Gemm g{XB, (const bf16*)(ws + WS_WGU1), M, 2 * FF, D}; EpiGU E{H, SS}; gemm_single(lds, g, E); }
#endif
        grid.sync();
#ifndef SKIP_G2
        { pg8::Gemm g{H, (const bf16*)(ws + WS_WD1), M, D, FF}; EpiResid E{l == 0 ? in[0] : X, X, XB, SS, 0.5f}; gemm_single(lds, g, E); }
#endif
        grid.sync();
#ifndef SKIP_G3
        { pg8::Gemm g{XB, (const bf16*)(ws + WS_WIN), M, NINP, D}; EpiProj E{PROJ, SS}; gemm_single(lds, g, E); }
#endif
        grid.sync();
#ifndef SKIP_PREP
        { TIDS phase_prep(in, ws, l, lds, tid); }
#endif
        grid.sync();
#ifndef SKIP_SCAN
        { TIDS phase_scan(in, ws, l, lds, tid); }
#endif
        grid.sync();
#ifndef SKIP_POST
        { TIDS phase_post(in, ws, l, gw, NGW, lane); }
#endif
        grid.sync();
#ifndef SKIP_G4
        { pg8::Gemm g{Y, (const bf16*)(ws + WS_WOUT), M, D, D}; EpiResid E{X, X, XB, SS, 1.0f}; gemm_single(lds, g, E); }
#endif
        grid.sync();
#ifndef SKIP_G5
        { pg8::Gemm g{XB, (const bf16*)(ws + WS_WGU2), M, 2 * FF, D}; EpiGU E{H, SS}; gemm_single(lds, g, E); }
#endif
        grid.sync();
#ifndef SKIP_G6
        { pg8::Gemm g{H, (const bf16*)(ws + WS_WD2), M, D, FF}; EpiResid E{X, X, XB, SS, 0.5f}; gemm_single(lds, g, E); }
#endif
        grid.sync();
    }
    { TIDS phase_final(X, in[42], gw, NGW, lane); }
}

extern "C" void kernel_launch(void* const* d_in, const int* in_sizes, int n_in, void* d_out, int out_size, void* d_ws, size_t ws_size, hipStream_t stream) {
    static int grid = 0;
    if (grid == 0) {
        int dev = 0, cus = 0, per_cu = 0;
        (void)hipGetDevice(&dev);
        (void)hipDeviceGetAttribute(&cus, hipDeviceAttributeMultiprocessorCount, dev);
        (void)hipFuncSetAttribute((const void*)fwd, hipFuncAttributeMaxDynamicSharedMemorySize, LDS_BYTES);
        (void)hipOccupancyMaxActiveBlocksPerMultiprocessor(&per_cu, (const void*)fwd, 512, LDS_BYTES);
        if (per_cu < 1) per_cu = 1;
        grid = cus * per_cu;
        if (n_in != 43 || out_size != M * D || ws_size < WS_END) fprintf(stderr, "kernel_launch: unexpected sizes n_in %d out %d ws %zu (need %zu)\n", n_in, out_size, ws_size, (size_t)WS_END);
    }
    Args a{};
    for (int i = 0; i < 43 && i < n_in; ++i) a.in[i] = (const float*)d_in[i];
    a.out = (float*)d_out; a.ws = (unsigned char*)d_ws;
    void* args[] = {&a};
    hipError_t e = hipLaunchCooperativeKernel((const void*)fwd, dim3(grid), dim3(512), args, LDS_BYTES, stream);
    if (e != hipSuccess) fprintf(stderr, "cooperative launch failed: %s (grid %d)\n", hipGetErrorString(e), grid);
}
```

```cpp
#include <hip/hip_runtime.h>
#include <hip/hip_cooperative_groups.h>
#include <cstdio>
#include <cstdint>
namespace cg = cooperative_groups;
namespace pg8 {
#define PG8_LAS __attribute__((address_space(3)))
typedef unsigned short bf16_t;
typedef short bf16x8 __attribute__((ext_vector_type(8)));
typedef float f32x4 __attribute__((ext_vector_type(4)));
typedef unsigned u32x4 __attribute__((ext_vector_type(4)));
constexpr int BM = 256, BK = 64, HALF = 128, HTB = HALF * BK * 2  , STAGE_BYTES = 8 * HTB, NXCD = 8, WGM = 8;

__host__ __device__ __forceinline__ int lds_byte(int r, int c) { const int st = (r >> 4) * 2 + (c >> 5), rr = r & 15, cc = c & 31, ob = rr * 64 + cc * 2; return st * 1024 + (ob ^ (((ob >> 9) & 1) << 5)); }
__host__ __device__ __forceinline__ void stage_rc(int b, int& R, int& C) { const int st = b / 1024, sb = b % 1024, swz = sb ^ (((sb >> 9) & 1) << 5); R = (st >> 1) * 16 + swz / 64; C = (st & 1) * 32 + (swz % 64) / 2; }
__host__ __device__ __forceinline__ int perm32(int rho) { const int n = rho >> 4, i = rho & 15; return 8 * (i >> 2) + 4 * n + (i & 3); }

struct Unit { int pm, pn; };
struct Gemm { const bf16_t* A; const bf16_t* Bt; int M, N, K; };

struct StaticOrder {
    int nM, nN, nwg, G, c;
    __host__ __device__ void init(int M, int N, int G_, int c_) { nM = M / BM; nN = N / BM; nwg = nM * nN; G = G_; c = c_; }
    __host__ __device__ bool next(int i, Unit& u) const {
        const long L = (long)i * G + c; if (L >= nwg) return false;
        int wgid = (int)L; { const int q = nwg / NXCD, r = nwg % NXCD, xcd = wgid % NXCD, off = wgid / NXCD; wgid = (xcd < r ? xcd * (q + 1) : r * (q + 1) + (xcd - r) * q) + off; }
        const int nig = WGM * nN, gid = wgid / nig, fm = gid * WGM, gsz = (nM - fm) < WGM ? (nM - fm) : WGM;
        u.pm = fm + ((wgid % nig) % gsz); u.pn = (wgid % nig) / gsz; return true;
    }
    __device__ __forceinline__ void a_ready(const Unit&) const {}
    __device__ __forceinline__ void done(const Unit&) const {}
};

__device__ __forceinline__ unsigned cvt_pk_bf16(float lo, float hi) { unsigned r; asm volatile("v_cvt_pk_bf16_f32 %0, %1, %2" : "=v"(r) : "v"(lo), "v"(hi)); return r; }
typedef float f32x2 __attribute__((ext_vector_type(2)));
template <class Epi, class Sched, bool ALIGN_EPI = false, bool SP2 = false>
__device__ __forceinline__ void gemm_phase(PG8_LAS unsigned char* lds, const Gemm g, const Sched& S, const Epi& E) {
    int tid_ = threadIdx.x; asm volatile("" : "+v"(tid_));
    const int tid = tid_, wid = __builtin_amdgcn_readfirstlane(tid >> 6), lane = tid & 63, wr = wid >> 2, wc = wid & 3, fr = lane & 15, fq = lane >> 4;
    const int K = g.K, nt = K / BK;
    unsigned voffA[2], voffB[2];
#pragma unroll
    for (int i = 0; i < 2; ++i) { int R, C; stage_rc(tid * 16 + i * 8192, R, C); const int Rb = Epi::PERM ? ((R & ~31) + perm32(R & 31)) : R;
        voffA[i] = (unsigned)(R * K + C) * 2u; voffB[i] = (unsigned)(Rb * K + C) * 2u; }
    const size_t kstep = (size_t)(BK * 2);
    const size_t hstep = (size_t)HALF * K * 2;
    const size_t tstep = 2 * hstep;
    const unsigned ldsw = (unsigned)wid * 1024u;
    const int aoff = lds_byte(wr * 64 + fr, fq * 8), boff = lds_byte(wc * 32 + fr, fq * 8);
#define PG8_SA(b, h) (((b) * 2 + (h)) * HTB)
#define PG8_SB(b, h) ((4 + (b) * 2 + (h)) * HTB)
#define PG8_STAGE(bufoff, gbase, voff) do { _Pragma("unroll") for (int _i = 0; _i < 2; ++_i) \
        __builtin_amdgcn_global_load_lds((const unsigned*)((const char*)(gbase) + (voff)[_i]), (PG8_LAS unsigned*)(lds + (bufoff) + ldsw + _i * 8192), 16, 0, 0); } while (0)
#define PG8_LDA(dst, b, h) do { _Pragma("unroll") for (int m = 0; m < 4; ++m) _Pragma("unroll") for (int k = 0; k < 2; ++k) dst[m][k] = *(const PG8_LAS bf16x8*)(lds + PG8_SA(b, h) + aoff + m * 2048 + k * 1024); } while (0)
#define PG8_LDB(dst, b, h) do { _Pragma("unroll") for (int n = 0; n < 2; ++n) _Pragma("unroll") for (int k = 0; k < 2; ++k) dst[n][k] = *(const PG8_LAS bf16x8*)(lds + PG8_SB(b, h) + boff + n * 2048 + k * 1024); } while (0)
#define PG8_MMA(ai, bj, At, Bt) do { __builtin_amdgcn_s_setprio(1); _Pragma("unroll") for (int m = 0; m < 4; ++m) _Pragma("unroll") for (int n = 0; n < 2; ++n) _Pragma("unroll") for (int k = 0; k < 2; ++k) \
        acc[ai][bj][m][n] = __builtin_amdgcn_mfma_f32_16x16x32_bf16(Bt[n][k], At[m][k], acc[ai][bj][m][n], 0, 0, 0); __builtin_amdgcn_s_setprio(0); } while (0)
#define PG8_WAIT_V(n) asm volatile("s_waitcnt vmcnt(" #n ")" ::: "memory")
#define PG8_WAIT_L(n) asm volatile("s_waitcnt lgkmcnt(" #n ")" ::: "memory")
#define PG8_BAR __builtin_amdgcn_s_barrier()
#define PG8_SCHED __builtin_amdgcn_sched_barrier(0)
    Unit cur, nxt; int ui = 0;
    if (!S.next(0, cur)) return;
    f32x4 acc[2][2][4][2];
#pragma unroll
    for (int a = 0; a < 2; ++a)
#pragma unroll
        for (int b = 0; b < 2; ++b)
#pragma unroll
            for (int m = 0; m < 4; ++m)
#pragma unroll
                for (int n = 0; n < 2; ++n) acc[a][b][m][n] = (f32x4){0.f, 0.f, 0.f, 0.f};
    bf16x8 At[4][2], B0[2][2], B1[2][2];
    const char* cA = (const char*)g.A + (size_t)cur.pm * tstep; const char* cB = (const char*)g.Bt + (size_t)cur.pn * tstep;
    S.a_ready(cur);
    if constexpr (SP2) {
        PG8_STAGE(PG8_SB(0, 0), cB, voffB); PG8_STAGE(PG8_SB(0, 1), cB + hstep, voffB); PG8_STAGE(PG8_SA(0, 0), cA, voffA); PG8_STAGE(PG8_SA(0, 1), cA + hstep, voffA);
        if (wr == 1) PG8_BAR;
        PG8_WAIT_V(2); PG8_BAR;
        PG8_STAGE(PG8_SB(1, 0), cB + kstep, voffB); PG8_STAGE(PG8_SA(1, 0), cA + kstep, voffA); PG8_STAGE(PG8_SB(1, 1), cB + hstep + kstep, voffB);
        PG8_WAIT_V(6); PG8_BAR;
    } else {
        PG8_STAGE(PG8_SB(0, 0), cB, voffB); PG8_STAGE(PG8_SA(0, 0), cA, voffA); PG8_STAGE(PG8_SB(0, 1), cB + hstep, voffB); PG8_STAGE(PG8_SA(0, 1), cA + hstep, voffA);
        if (wr == 1) PG8_BAR;
        PG8_WAIT_V(4); PG8_BAR;
        PG8_STAGE(PG8_SB(1, 0), cB + kstep, voffB); PG8_STAGE(PG8_SA(1, 0), cA + kstep, voffA); PG8_STAGE(PG8_SB(1, 1), cB + hstep + kstep, voffB);
        PG8_WAIT_V(6); PG8_BAR;
    }
    for (;;) {
        const bool has_next = S.next(ui + 1, nxt);
        const char* nA = has_next ? (const char*)g.A + (size_t)nxt.pm * tstep : cA; const char* nB = has_next ? (const char*)g.Bt + (size_t)nxt.pn * tstep : cB;
        for (int t = 0; t < nt; t += 2) {
            const bool last = (t == nt - 2);
            const char* a1 = cA + (size_t)(t + 1) * kstep;
            const char* a2 = last ? nA : cA + (size_t)(t + 2) * kstep; const char* b2 = last ? nB : cB + (size_t)(t + 2) * kstep;
            const char* a3 = a2 + kstep; const char* b3 = b2 + kstep;
            if (last && has_next) S.a_ready(nxt);
            if constexpr (SP2) {
            PG8_LDB(B0, 0, 0); PG8_LDB(B1, 0, 1); PG8_SCHED; PG8_LDA(At, 0, 0); PG8_STAGE(PG8_SA(1, 1), a1 + hstep, voffA);
            PG8_WAIT_V(8); PG8_WAIT_L(0); PG8_BAR; PG8_MMA(0, 0, At, B0); PG8_MMA(0, 1, At, B1); PG8_BAR; PG8_SCHED;
            PG8_LDA(At, 0, 1); PG8_STAGE(PG8_SB(0, 0), b2, voffB); PG8_STAGE(PG8_SB(0, 1), b2 + hstep, voffB); PG8_STAGE(PG8_SA(0, 0), a2, voffA);
            PG8_WAIT_V(8); PG8_WAIT_L(0); PG8_BAR; PG8_MMA(1, 0, At, B0); PG8_MMA(1, 1, At, B1); PG8_BAR; PG8_SCHED;
            PG8_LDB(B0, 1, 0); PG8_LDB(B1, 1, 1); PG8_SCHED; PG8_LDA(At, 1, 0); PG8_STAGE(PG8_SA(0, 1), a2 + hstep, voffA);
            PG8_WAIT_V(8); PG8_WAIT_L(0); PG8_BAR; PG8_MMA(0, 0, At, B0); PG8_MMA(0, 1, At, B1); PG8_BAR; PG8_SCHED;
            PG8_LDA(At, 1, 1); PG8_STAGE(PG8_SB(1, 0), b3, voffB); PG8_STAGE(PG8_SB(1, 1), b3 + hstep, voffB); PG8_STAGE(PG8_SA(1, 0), a3, voffA);
            PG8_WAIT_V(8); PG8_WAIT_L(0); PG8_BAR; PG8_MMA(1, 0, At, B0); PG8_MMA(1, 1, At, B1); PG8_BAR; PG8_SCHED;
            } else {
            PG8_LDB(B0, 0, 0); PG8_SCHED; PG8_LDA(At, 0, 0); PG8_STAGE(PG8_SA(1, 1), a1 + hstep, voffA);
            PG8_WAIT_L(8); PG8_BAR; PG8_WAIT_L(0); PG8_MMA(0, 0, At, B0); PG8_BAR; PG8_SCHED;
            PG8_LDB(B1, 0, 1); PG8_STAGE(PG8_SB(0, 0), b2, voffB);
            PG8_BAR; PG8_WAIT_L(0); PG8_MMA(0, 1, At, B1); PG8_BAR;
            PG8_LDA(At, 0, 1); PG8_STAGE(PG8_SA(0, 0), a2, voffA);
            PG8_BAR; PG8_WAIT_L(0); PG8_MMA(1, 0, At, B0); PG8_BAR; PG8_SCHED;
            PG8_STAGE(PG8_SB(0, 1), b2 + hstep, voffB);
            PG8_WAIT_V(6); PG8_BAR; PG8_MMA(1, 1, At, B1); PG8_BAR;
            PG8_LDB(B0, 1, 0); PG8_SCHED; PG8_LDA(At, 1, 0); PG8_STAGE(PG8_SA(0, 1), a2 + hstep, voffA);
            PG8_WAIT_L(8); PG8_BAR; PG8_WAIT_L(0); PG8_MMA(0, 0, At, B0); PG8_BAR; PG8_SCHED;
            PG8_LDB(B1, 1, 1); PG8_STAGE(PG8_SB(1, 0), b3, voffB);
            PG8_BAR; PG8_WAIT_L(0); PG8_MMA(0, 1, At, B1); PG8_BAR;
            PG8_LDA(At, 1, 1); PG8_STAGE(PG8_SA(1, 0), a3, voffA);
            PG8_BAR; PG8_WAIT_L(0); PG8_MMA(1, 0, At, B0); PG8_BAR; PG8_SCHED;
            PG8_STAGE(PG8_SB(1, 1), b3 + hstep, voffB);
            PG8_WAIT_V(6); PG8_BAR; PG8_MMA(1, 1, At, B1); PG8_BAR;
            }
        }
        if constexpr (ALIGN_EPI) { if (wr == 0) PG8_BAR; }
        if constexpr (!Epi::AFTER_DRAIN) { E(acc, cur, wr, wc, fr, fq); S.done(cur); }
        if (!has_next) break;
#pragma unroll
        for (int a = 0; a < 2; ++a)
#pragma unroll
            for (int b = 0; b < 2; ++b)
#pragma unroll
                for (int m = 0; m < 4; ++m)
#pragma unroll
                    for (int n = 0; n < 2; ++n) acc[a][b][m][n] = (f32x4){0.f, 0.f, 0.f, 0.f};
        cur = nxt; cA = nA; cB = nB; ++ui;
        if constexpr (ALIGN_EPI) { if (wr == 1) PG8_BAR; }
    }
    PG8_WAIT_V(0);
    if constexpr (!ALIGN_EPI) { if (wr == 0) PG8_BAR; }
    PG8_BAR;
    if constexpr (Epi::AFTER_DRAIN) { E.fused(acc, cur, wr, wc, fr, fq, lds, wid, lane); S.done(cur); }
#undef PG8_SA
#undef PG8_SB
#undef PG8_STAGE
#undef PG8_LDA
#undef PG8_LDB
#undef PG8_MMA
#undef PG8_WAIT_V
#undef PG8_WAIT_L
#undef PG8_BAR
#undef PG8_SCHED
}
}
#define LAS __attribute__((address_space(3)))
typedef unsigned short bf16;
typedef float f4 __attribute__((ext_vector_type(4)));
typedef unsigned u2 __attribute__((ext_vector_type(2)));
typedef unsigned u4 __attribute__((ext_vector_type(4)));
using pg8::f32x4;

constexpr int M = 16384, D = 1024, FF = 2816, NIN = 3156, NINP = 3328, NL = 4, SEQ = 8192;
constexpr int LDS_BYTES = 147456;
constexpr size_t HM = 524288;
constexpr size_t WS_WGU1 = 0, WS_WD1 = 22 * HM, WS_WIN = 33 * HM, WS_WOUT = 46 * HM, WS_WGU2 = 50 * HM, WS_WD2 = 72 * HM;
constexpr size_t MiB = 1048576;
constexpr size_t WS_XB = 42 * MiB;
constexpr size_t WS_OGLA = WS_XB, WS_YRW = WS_XB + 8 * MiB, WS_YSSD = WS_XB + 16 * MiB;
constexpr size_t WS_Y = 74 * MiB;
constexpr size_t WS_PROJ = 106 * MiB;
constexpr size_t WS_VFIRST = 210 * MiB;
constexpr size_t WS_SS = 226 * MiB;
constexpr size_t WS_RWR = 227 * MiB, WS_RWK = 235 * MiB, WS_RWV = 243 * MiB, WS_RWKK = 251 * MiB, WS_RWB = 259 * MiB;
constexpr size_t WS_RWW = 267 * MiB;
constexpr size_t WS_RWG = 283 * MiB;
constexpr size_t WS_RWBON = 291 * MiB;
constexpr size_t WS_XBC = 292 * MiB;
constexpr size_t WS_DT = 316 * MiB, WS_DEC = 317 * MiB;
constexpr size_t WS_LRA = 318 * MiB, WS_LRH = 334 * MiB;
constexpr size_t WS_SEGA = 350 * MiB, WS_SEGH = 351 * MiB, WS_CARRY = 352 * MiB;
constexpr int NCH = 32, CHL = SEQ / NCH;
constexpr size_t WS_RWP = 353 * MiB, WS_RWU = 357 * MiB;
constexpr size_t WS_GLU = 361 * MiB, WS_GLD = 363 * MiB;
constexpr size_t WS_SSU = 364 * MiB, WS_SSD = 372 * MiB;
constexpr size_t WS_END = 373 * MiB;

constexpr int PC_GQ = 0, PC_GK = 128, PC_GV = 256, PC_GG = 512, PC_GSTEM = 768, PC_LX = 784, PC_LG = 1040, PC_RW = 1296, PC_SZ = 2128, PC_SXBC = 2384, PC_SDT = 3152;

__device__ __forceinline__ float bf2f(bf16 v) { return __uint_as_float((unsigned)v << 16); }
__device__ __forceinline__ float bflo(unsigned w) { return __uint_as_float(w << 16); }
__device__ __forceinline__ float bfhi(unsigned w) { return __uint_as_float(w & 0xffff0000u); }
__device__ __forceinline__ unsigned pk2(float lo, float hi) { return pg8::cvt_pk_bf16(lo, hi); }
__device__ __forceinline__ float sigmoidf_(float x) { return 1.f / (1.f + __expf(-x)); }
__device__ __forceinline__ float siluf_(float x) { return x / (1.f + __expf(-x)); }
__device__ __forceinline__ float tanhf_(float x) { return 1.f - 2.f / (1.f + __expf(2.f * x)); }
__device__ __forceinline__ float softplusf_(float x) { return fmaxf(x, 0.f) + log1pf(__expf(-fabsf(x))); }
__device__ __forceinline__ float gelu_tanh(float x) { const float u = 0.7978845608028654f * (x + 0.044715f * x * x * x); return 0.5f * x * (1.f + tanhf_(u)); }
__device__ __forceinline__ float wave_sum(float v) {
#pragma unroll
    for (int o = 1; o < 64; o <<= 1) v += __shfl_xor(v, o);
    return v;
}
__device__ __forceinline__ float red8(float x) { x += __shfl_xor(x, 1); x += __shfl_xor(x, 2); x += __shfl_xor(x, 4); return x; }
__device__ __forceinline__ float rstd_row(const float* ss, int row) { const f4 p = *(const f4*)(ss + (size_t)row * 4); return rsqrtf(((p.x + p.y) + (p.z + p.w)) * (1.f / 1024.f) + 1e-6f); }

struct EpiGU {
    static constexpr bool PERM = true, AFTER_DRAIN = true;
    bf16* H; const float* ss;
    __device__ __forceinline__ void fused(f32x4 (&acc)[2][2][4][2], const pg8::Unit& u, int wr, int wc, int fr, int fq, LAS unsigned char* lds, int wid, int lane) const {
#pragma unroll
        for (int ai = 0; ai < 2; ++ai)
#pragma unroll
            for (int m = 0; m < 4; ++m) {
                const int row = u.pm * 256 + ai * 128 + wr * 64 + m * 16 + fr; const float rs = rstd_row(ss, row);
                float hv[8];
#pragma unroll
                for (int n = 0; n < 2; ++n)
#pragma unroll
                    for (int e = 0; e < 4; ++e) { const float g = acc[ai][0][m][n][e] * rs, up = acc[ai][1][m][n][e] * rs; hv[n * 4 + e] = siluf_(g) * up; }
                u4 w; w.x = pk2(hv[0], hv[1]); w.y = pk2(hv[2], hv[3]); w.z = pk2(hv[4], hv[5]); w.w = pk2(hv[6], hv[7]);
                *(u4*)(H + (size_t)row * FF + u.pn * 128 + wc * 32 + 8 * fq) = w;
                asm volatile("" ::: "memory");
            }
    }
};
struct EpiProj {
    static constexpr bool PERM = true, AFTER_DRAIN = true;
    bf16* O; const float* ss;
    __device__ __forceinline__ void fused(f32x4 (&acc)[2][2][4][2], const pg8::Unit& u, int wr, int wc, int fr, int fq, LAS unsigned char* lds, int wid, int lane) const {
#pragma unroll
        for (int ai = 0; ai < 2; ++ai)
#pragma unroll
            for (int m = 0; m < 4; ++m) {
                const int row = u.pm * 256 + ai * 128 + wr * 64 + m * 16 + fr; const float rs = rstd_row(ss, row);
#pragma unroll
                for (int bj = 0; bj < 2; ++bj) { const f32x4 v0 = acc[ai][bj][m][0] * rs, v1 = acc[ai][bj][m][1] * rs;
                    u4 w; w.x = pk2(v0[0], v0[1]); w.y = pk2(v0[2], v0[3]); w.z = pk2(v1[0], v1[1]); w.w = pk2(v1[2], v1[3]);
                    *(u4*)(O + (size_t)row * NINP + u.pn * 256 + bj * 128 + wc * 32 + 8 * fq) = w; }
                asm volatile("" ::: "memory");
            }
    }
};
struct EpiResid {
    static constexpr bool PERM = true, AFTER_DRAIN = true;
    const float* xin; float* xout; bf16* xb; float* ss; float scale;
    __device__ __forceinline__ void fused(f32x4 (&acc)[2][2][4][2], const pg8::Unit& u, int wr, int wc, int fr, int fq, LAS unsigned char* lds, int wid, int lane) const {
        LAS float* P = (LAS float*)lds;
#pragma unroll
        for (int ai = 0; ai < 2; ++ai)
#pragma unroll
            for (int m = 0; m < 4; ++m) {
                const int rt = ai * 128 + wr * 64 + m * 16 + fr; const size_t row = (size_t)u.pm * 256 + rt; float sq = 0.f;
#pragma unroll
                for (int bj = 0; bj < 2; ++bj) { const size_t off = row * D + u.pn * 256 + bj * 128 + wc * 32 + 8 * fq;
                    f32x4 x0 = *(const f32x4*)(xin + off), x1 = *(const f32x4*)(xin + off + 4);
                    x0 += acc[ai][bj][m][0] * scale; x1 += acc[ai][bj][m][1] * scale;
                    *(f32x4*)(xout + off) = x0; *(f32x4*)(xout + off + 4) = x1;
                    u4 w; w.x = pk2(x0[0], x0[1]); w.y = pk2(x0[2], x0[3]); w.z = pk2(x1[0], x1[1]); w.w = pk2(x1[2], x1[3]);
                    *(u4*)(xb + off) = w;
                    sq += (x0[0] * x0[0] + x0[1] * x0[1]) + (x0[2] * x0[2] + x0[3] * x0[3]) + (x1[0] * x1[0] + x1[1] * x1[1]) + (x1[2] * x1[2] + x1[3] * x1[3]); }
                sq += __shfl_xor(sq, 16); sq += __shfl_xor(sq, 32);
                if (fq == 0) P[rt * 4 + wc] = sq;
            }
        __syncthreads();
        const int tid = wid * 64 + lane;
        if (tid < 256) ss[(size_t)(u.pm * 256 + tid) * 4 + u.pn] = (P[tid * 4 + 0] + P[tid * 4 + 1]) + (P[tid * 4 + 2] + P[tid * 4 + 3]);
        __syncthreads();
    }
};
struct OneUnit { pg8::StaticOrder b; int r;
    __device__ __forceinline__ bool next(int i, pg8::Unit& u) const { return i == 0 && b.next(r, u); }
    __device__ __forceinline__ void a_ready(const pg8::Unit&) const {}
    __device__ __forceinline__ void done(const pg8::Unit&) const {} };

__device__ __forceinline__ void tr_item(const float* W, int ldn, int nvalid, int col0, const float* sc, bf16* WT, int K, int row0, int k0, LAS float* scr, int lane) {
    const int c = col0 + (lane & 31);
#pragma unroll 8
    for (int i = 0; i < 32; ++i) { const int kk = 2 * i + (lane >> 5); float v = (c < nvalid) ? W[(size_t)(k0 + kk) * ldn + c] : 0.f; if (sc) v *= sc[k0 + kk]; scr[kk * 33 + (lane & 31)] = v; }
    asm volatile("s_waitcnt lgkmcnt(0)" ::: "memory");
    const int c8 = lane & 7;
#pragma unroll
    for (int j = 0; j < 4; ++j) { const int n = (lane >> 3) + 8 * j; const LAS float* s = scr + (8 * c8) * 33 + n;
        u4 o; o.x = pk2(s[0 * 33], s[1 * 33]); o.y = pk2(s[2 * 33], s[3 * 33]); o.z = pk2(s[4 * 33], s[5 * 33]); o.w = pk2(s[6 * 33], s[7 * 33]);
        *(u4*)(WT + (size_t)(row0 + n) * K + k0 + 8 * c8) = o; }
    asm volatile("s_waitcnt lgkmcnt(0)" ::: "memory");
}
__device__ __forceinline__ void tr_gu(const float* Wg, const float* Wu, const float* nw, bf16* WT, int it, LAS float* scr, int lane) {
    const int kb = it / 176, nb = it % 176, row0 = nb * 32, pn = row0 >> 8, half = (row0 >> 7) & 1, i0 = row0 & 127;
    tr_item(half ? Wu : Wg, FF, FF, pn * 128 + i0, nw, WT, D, row0, kb * 64, scr, lane);
}
__device__ __forceinline__ void phase_convert(const float* const* in, unsigned char* ws, int l, LAS unsigned char* lds, int gw, int NGW, int wave, int lane) {
    LAS float* scr = (LAS float*)(lds + wave * 16384);
    const size_t oFF = (size_t)l * D * FF;
    constexpr int I_GU = 2816, I_D = 1408, I_IN = 1664, I_OUT = 512, NIT = 2 * I_GU + 2 * I_D + I_IN + I_OUT;
    for (int it = gw; it < NIT; it += NGW) {
        int r = it;
        if (r < I_GU) { tr_gu(in[2] + oFF, in[3] + oFF, in[1] + l * D, (bf16*)(ws + WS_WGU1), r, scr, lane); continue; } r -= I_GU;
        if (r < I_D) { tr_item(in[4] + oFF, D, D, (r % 32) * 32, nullptr, (bf16*)(ws + WS_WD1), FF, (r % 32) * 32, (r / 32) * 64, scr, lane); continue; } r -= I_D;
        if (r < I_IN) { tr_item(in[6] + (size_t)l * D * NIN, NIN, NIN, (r % 104) * 32, in[5] + l * D, (bf16*)(ws + WS_WIN), D, (r % 104) * 32, (r / 104) * 64, scr, lane); continue; } r -= I_IN;
        if (r < I_OUT) { tr_item(in[7] + (size_t)l * D * D, D, D, (r % 32) * 32, nullptr, (bf16*)(ws + WS_WOUT), D, (r % 32) * 32, (r / 32) * 64, scr, lane); continue; } r -= I_OUT;
        if (r < I_GU) { tr_gu(in[39] + oFF, in[40] + oFF, in[38] + l * D, (bf16*)(ws + WS_WGU2), r, scr, lane); continue; } r -= I_GU;
        tr_item(in[41] + oFF, D, D, (r % 32) * 32, nullptr, (bf16*)(ws + WS_WD2), FF, (r % 32) * 32, (r / 32) * 64, scr, lane);
    }
}
__device__ __forceinline__ void phase_init_rows(const float* x, bf16* xb, float* ss, int gw, int NGW, int lane) {
    for (int m = gw; m < M; m += NGW) {
        const f4* xr = (const f4*)(x + (size_t)m * D) + lane; float s = 0.f; u2* o = (u2*)(xb + (size_t)m * D) + lane;
#pragma unroll
        for (int j = 0; j < 4; ++j) { const f4 v = xr[64 * j]; s += (v.x * v.x + v.y * v.y) + (v.z * v.z + v.w * v.w); u2 w; w.x = pk2(v.x, v.y); w.y = pk2(v.z, v.w); o[64 * j] = w; }
        s = wave_sum(s);
        if (lane < 4) ss[(size_t)m * 4 + lane] = lane == 0 ? s : 0.f;
    }
}
__device__ __forceinline__ void phase_final(float* x, const float* fw, int gw, int NGW, int lane) {
    for (int m = gw; m < M; m += NGW) {
        f4* xr = (f4*)(x + (size_t)m * D) + lane; f4 v[4]; float s = 0.f;
#pragma unroll
        for (int j = 0; j < 4; ++j) { v[j] = xr[64 * j]; s += (v[j].x * v[j].x + v[j].y * v[j].y) + (v[j].z * v[j].z + v[j].w * v[j].w); }
        const float rs = rsqrtf(wave_sum(s) * (1.f / 1024.f) + 1e-6f);
#pragma unroll
        for (int j = 0; j < 4; ++j) { const f4 w = ((const f4*)fw)[lane + 64 * j]; xr[64 * j] = v[j] * rs * w; }
    }
}
__device__ __forceinline__ void prep_lru(const float* const* in, unsigned char* ws, int l, int item, LAS unsigned char* lds, int tid) {
    const bf16* PROJ = (const bf16*)(ws + WS_PROJ); LAS float* X = (LAS float*)lds; LAS float* G = X + 32 * 256;
    const int t0 = item * 32; const float* cw = in[11] + l * 4 * 256; const float* cb = in[12] + l * 256;
#pragma unroll 1
    for (int idx = tid; idx < 32 * 256; idx += 512) { const int t = idx >> 8, c = idx & 255, tok = t0 + t, pos = tok & (SEQ - 1); float acc = cb[c];
#pragma unroll
        for (int k = 0; k < 4; ++k) { const int tp = pos - 3 + k; if (tp >= 0) acc += cw[k * 256 + c] * bf2f(PROJ[(size_t)(tok - 3 + k) * NINP + PC_LX + c]); }
        X[idx] = acc; }
    __syncthreads();
    const int gsel = tid >> 8, c = tid & 255, blk = c >> 6, j = c & 63;
    { const float* pw = (gsel ? in[15] : in[13]) + (size_t)l * 16384 + blk * 4096 + j; const float bias = (gsel ? in[16] : in[14])[l * 256 + c];
#pragma unroll 1
      for (int kh = 0; kh < 2; ++kh) { float wv[32];
#pragma unroll
          for (int k = 0; k < 32; ++k) wv[k] = pw[(kh * 32 + k) * 64];
#pragma unroll 1
          for (int t = 0; t < 32; ++t) { const LAS f4* xr = (const LAS f4*)(X + t * 256 + blk * 64 + kh * 32); float d0 = 0.f, d1 = 0.f;
#pragma unroll
              for (int k4 = 0; k4 < 8; k4 += 2) { const f4 v = xr[k4], w = xr[k4 + 1];
                  d0 += v.x * wv[4 * k4] + v.y * wv[4 * k4 + 1] + v.z * wv[4 * k4 + 2] + v.w * wv[4 * k4 + 3];
                  d1 += w.x * wv[4 * k4 + 4] + w.y * wv[4 * k4 + 5] + w.z * wv[4 * k4 + 6] + w.w * wv[4 * k4 + 7]; }
              LAS float* gp = G + (gsel * 32 + t) * 256 + c;
              if (kh == 0) *gp = d0 + d1; else *gp = sigmoidf_(*gp + d0 + d1 + bias); } } }
    __syncthreads();
    if (tid < 256) { const float sp = softplusf_(-in[17][l * 256 + c]); float h = 0.f, A = 1.f; float* LRA = (float*)(ws + WS_LRA); float* LRH = (float*)(ws + WS_LRH);
#pragma unroll 1
        for (int t = 0; t < 32; ++t) { const float r = G[t * 256 + c], ig = G[(32 + t) * 256 + c], la = -8.f * r * sp, av = __expf(la), u = sqrtf(fmaxf(-expm1f(2.f * la), 0.f)) * (ig * X[t * 256 + c]);
            h = av * h + u; A *= av; const size_t o = (size_t)(t0 + t) * 256 + c; LRA[o] = A; LRH[o] = h; }
        ((float*)(ws + WS_SEGA))[item * 256 + c] = A; ((float*)(ws + WS_SEGH))[item * 256 + c] = h; }
    __syncthreads();
}
__device__ __forceinline__ void prep_ssd(const float* const* in, unsigned char* ws, int l, int item, int tid) {
    const bf16* PROJ = (const bf16*)(ws + WS_PROJ); unsigned* XBC = (unsigned*)(ws + WS_XBC);
    const int t0 = item * 32; const float* cw = in[32] + l * 4 * 768; const float* cb = in[33] + l * 768;
    for (int idx = tid; idx < 32 * 384; idx += 512) { const int t = idx / 384, c = (idx % 384) * 2, tok = t0 + t, pos = tok & (SEQ - 1); float a0 = cb[c], a1 = cb[c + 1];
#pragma unroll
        for (int k = 0; k < 4; ++k) { const int tp = pos - 3 + k; if (tp >= 0) { const unsigned w = *(const unsigned*)(PROJ + (size_t)(tok - 3 + k) * NINP + PC_SXBC + c); a0 += cw[k * 768 + c] * bflo(w); a1 += cw[k * 768 + c + 1] * bfhi(w); } }
        XBC[((size_t)tok * 768 + c) >> 1] = pk2(siluf_(a0), siluf_(a1)); }
    if (tid < 128) { const int t = tid >> 2, hh = tid & 3, tok = t0 + t; const float dt = softplusf_(bf2f(PROJ[(size_t)tok * NINP + PC_SDT + hh]) + in[34][l * 4 + hh]);
        ((float*)(ws + WS_DT))[tok * 4 + hh] = dt; ((float*)(ws + WS_DEC))[tok * 4 + hh] = __expf(-dt * __expf(in[35][l * 4 + hh])); }
}
__device__ __forceinline__ void prep_rw(const float* const* in, unsigned char* ws, int l, int item, LAS unsigned char* lds, int tid) {
    const bf16* PROJ = (const bf16*)(ws + WS_PROJ); LAS float* P = (LAS float*)lds; LAS float* VV = (LAS float*)(lds + 32 * 832 * 4);
    const int t0 = item * 32; const float* mu = in[18] + l * 832;
#pragma unroll 1
    for (int idx = tid; idx < 32 * 832; idx += 512) { const int t = idx / 832, col = idx % 832, tok = t0 + t;
        const float cur = bf2f(PROJ[(size_t)tok * NINP + PC_RW + col]), prev = (tok & (SEQ - 1)) ? bf2f(PROJ[(size_t)(tok - 1) * NINP + PC_RW + col]) : 0.f;
        float p = cur + (prev - cur) * mu[col];
        if (col >= 768 && col < 784) p = tanhf_(p); else if (col >= 800) p = sigmoidf_(p);
        P[idx] = p; }
    __syncthreads();
    if (l > 0 && tid < 256) { const int t = tid >> 3, j = tid & 7; const float* v1 = in[25] + (size_t)(l - 1) * 2048 + j; float s = 0.f;
#pragma unroll 4
        for (int c = 0; c < 256; ++c) s += P[t * 832 + 512 + c] * v1[c * 8];
        VV[t * 8 + j] = s; }
    __syncthreads();
    const int half = tid >> 8, c = tid & 255, hh = c >> 6, lane = tid & 63;
    float zw[16], za[16], gg[16], zv[16];
    { const float w0 = in[19][l * 256 + c], a0 = in[21][l * 256 + c], v0 = l > 0 ? in[24][(l - 1) * 256 + c] : 0.f;
#pragma unroll
      for (int tt = 0; tt < 16; ++tt) { zw[tt] = w0; za[tt] = a0; gg[tt] = 0.f; zv[tt] = v0; } }
    const LAS float* ph = P + half * 16 * 832;
    { const float* w2p = in[20] + (size_t)l * 4096 + c; const float* a2p = in[22] + (size_t)l * 4096 + c;
#pragma unroll 1
      for (int j4 = 0; j4 < 4; ++j4) { const float wa = w2p[(4 * j4) * 256], wb = w2p[(4 * j4 + 1) * 256], wc_ = w2p[(4 * j4 + 2) * 256], wd_ = w2p[(4 * j4 + 3) * 256];
          const float aa = a2p[(4 * j4) * 256], ab = a2p[(4 * j4 + 1) * 256], ac = a2p[(4 * j4 + 2) * 256], ad = a2p[(4 * j4 + 3) * 256];
#pragma unroll
          for (int tt = 0; tt < 16; ++tt) { const f4 sw = *(const LAS f4*)(ph + tt * 832 + 768 + 4 * j4), sa = *(const LAS f4*)(ph + tt * 832 + 784 + 4 * j4);
              zw[tt] += sw.x * wa + sw.y * wb + sw.z * wc_ + sw.w * wd_; za[tt] += sa.x * aa + sa.y * ab + sa.z * ac + sa.w * ad; } } }
    { const float* g2p = in[23] + (size_t)l * 8192 + c;
#pragma unroll 1
      for (int j4 = 0; j4 < 8; ++j4) { const float ga = g2p[(4 * j4) * 256], gb = g2p[(4 * j4 + 1) * 256], gc = g2p[(4 * j4 + 2) * 256], gd = g2p[(4 * j4 + 3) * 256];
#pragma unroll
          for (int tt = 0; tt < 16; ++tt) { const f4 sg = *(const LAS f4*)(ph + tt * 832 + 800 + 4 * j4); gg[tt] += sg.x * ga + sg.y * gb + sg.z * gc + sg.w * gd; } } }
    if (l > 0) { const float* v2p = in[26] + (size_t)(l - 1) * 2048 + c;
#pragma unroll 1
      for (int j4 = 0; j4 < 2; ++j4) { const float va = v2p[(4 * j4) * 256], vb = v2p[(4 * j4 + 1) * 256], vc = v2p[(4 * j4 + 2) * 256], vd = v2p[(4 * j4 + 3) * 256];
#pragma unroll
          for (int tt = 0; tt < 16; ++tt) { const f4 sv = *(const LAS f4*)(VV + (half * 16 + tt) * 8 + 4 * j4); zv[tt] += sv.x * va + sv.y * vb + sv.z * vc + sv.w * vd; } } }
    const float kkw = in[27][l * 256 + c], kaw = in[28][l * 256 + c], rkw = in[29][l * 256 + c];
    float* VF = (float*)(ws + WS_VFIRST);
#pragma unroll
    for (int tt = 0; tt < 16; ++tt) { const int t = half * 16 + tt; const size_t o = (size_t)(t0 + t) * 256 + c; const LAS float* pr = P + t * 832;
        const float r = pr[c], k = pr[256 + c]; float v = pr[512 + c];
        const float wd = __expf(-0.6065306597126334f * sigmoidf_(zw[tt])), av = sigmoidf_(za[tt]), g = gg[tt];
        if (l > 0) v = v + (VF[o] - v) * sigmoidf_(zv[tt]); else VF[o] = v;
        float kk = k * kkw; const float nrm = sqrtf(wave_sum(kk * kk)); kk = kk / fmaxf(nrm, 1e-12f);
        const float k2 = k * (1.f + (av - 1.f) * kaw);
        const float bon = wave_sum(r * k2 * rkw);
        ((bf16*)(ws + WS_RWR))[o] = (bf16)pk2(r, 0.f); ((bf16*)(ws + WS_RWK))[o] = (bf16)pk2(k2, 0.f); ((bf16*)(ws + WS_RWV))[o] = (bf16)pk2(v, 0.f);
        ((bf16*)(ws + WS_RWKK))[o] = (bf16)pk2(kk, 0.f); ((bf16*)(ws + WS_RWB))[o] = (bf16)pk2(kk * av, 0.f); ((bf16*)(ws + WS_RWG))[o] = (bf16)pk2(g, 0.f);
        ((float*)(ws + WS_RWW))[o] = wd;
        if (lane == 0) ((float*)(ws + WS_RWBON))[(t0 + t) * 4 + hh] = bon;
        asm volatile("" ::: "memory"); }
    __syncthreads();
}
__device__ __forceinline__ void phase_prep(const float* const* in, unsigned char* ws, int l, LAS unsigned char* lds, int tid) {
    constexpr int N_L = 512, N_R = 512, N_S = 512;
    for (int it = blockIdx.x; it < N_L + N_R + N_S; it += gridDim.x) {
        if (it < N_L) {
#ifndef SKIP_PL
            prep_lru(in, ws, l, it, lds, tid);
#endif
        } else if (it < N_L + N_R) {
#ifndef SKIP_PR
            prep_rw(in, ws, l, it - N_L, lds, tid);
#endif
        } else {
#ifndef SKIP_PS
            prep_ssd(in, ws, l, it - N_L - N_R, tid);
#endif
        }
    }
}

template <int MODE> __device__ __forceinline__ void scan_rw(unsigned char* ws, int item, LAS unsigned char* lds, int tid) {
    LAS float* LW = (LAS float*)lds; LAS float* LKK = LW + 2048; LAS float* LB = LW + 4096; LAS float* LK = LW + 6144; LAS float* LR = LW + 8192; LAS float* LV = LW + 10240; LAS float* LY = LW + 12288;
    const int bh = item / NCH, ch = item % NCH, hh = bh & 3, tokb = (bh >> 2) * SEQ + ch * CHL, nsub = CHL / 32;
    const int st = tid >> 4, sc4 = (tid & 15) * 4, row = tid >> 3, sl = tid & 7;
    const bf16* gR = (const bf16*)(ws + WS_RWR); const bf16* gK = (const bf16*)(ws + WS_RWK); const bf16* gV = (const bf16*)(ws + WS_RWV); const bf16* gKK = (const bf16*)(ws + WS_RWKK); const bf16* gB = (const bf16*)(ws + WS_RWB);
    const float* gW = (const float*)(ws + WS_RWW); bf16* gY = (bf16*)(ws + WS_YRW);
    float* gU = (float*)(ws + WS_RWU) + (size_t)item * 4096 + row * 64 + sl * 8; float* gP = (float*)(ws + WS_RWP) + (size_t)item * 4096 + row * 64 + sl * 8;
    float s[8], p[8];
    if (MODE == 1) { const f4 a = *(const f4*)gU, c = *(const f4*)(gU + 4); s[0] = a.x; s[1] = a.y; s[2] = a.z; s[3] = a.w; s[4] = c.x; s[5] = c.y; s[6] = c.z; s[7] = c.w; }
    else {
#pragma unroll
        for (int i = 0; i < 8; ++i) { s[i] = 0.f; p[i] = (sl * 8 + i == row) ? 1.f : 0.f; } }
    u2 pr, pk, pv, pkk, pb; f4 pw;
    { const size_t o = (size_t)(tokb + st) * 256 + hh * 64 + sc4; if (MODE == 1) pr = *(const u2*)(gR + o); pk = *(const u2*)(gK + o); pv = *(const u2*)(gV + o); pkk = *(const u2*)(gKK + o); pb = *(const u2*)(gB + o); pw = *(const f4*)(gW + o); }
    for (int sub = 0; sub < nsub; ++sub) {
        const int so = st * 64 + sc4;
        *(LAS f4*)(LW + so) = pw; if (MODE == 1) *(LAS f4*)(LR + so) = (f4){bflo(pr.x), bfhi(pr.x), bflo(pr.y), bfhi(pr.y)}; *(LAS f4*)(LK + so) = (f4){bflo(pk.x), bfhi(pk.x), bflo(pk.y), bfhi(pk.y)};
        *(LAS f4*)(LV + so) = (f4){bflo(pv.x), bfhi(pv.x), bflo(pv.y), bfhi(pv.y)}; *(LAS f4*)(LKK + so) = (f4){bflo(pkk.x), bfhi(pkk.x), bflo(pkk.y), bfhi(pkk.y)}; *(LAS f4*)(LB + so) = (f4){bflo(pb.x), bfhi(pb.x), bflo(pb.y), bfhi(pb.y)};
        __syncthreads();
        if (sub + 1 < nsub) { const size_t o = (size_t)(tokb + (sub + 1) * 32 + st) * 256 + hh * 64 + sc4; if (MODE == 1) pr = *(const u2*)(gR + o); pk = *(const u2*)(gK + o); pv = *(const u2*)(gV + o); pkk = *(const u2*)(gKK + o); pb = *(const u2*)(gB + o); pw = *(const f4*)(gW + o); }
        for (int t = 0; t < 32; ++t) { const int o = t * 64 + sl * 8;
            const f4 w0 = *(const LAS f4*)(LW + o), w1 = *(const LAS f4*)(LW + o + 4), a0 = *(const LAS f4*)(LKK + o), a1 = *(const LAS f4*)(LKK + o + 4), b0 = *(const LAS f4*)(LB + o), b1 = *(const LAS f4*)(LB + o + 4);
            const f4 k0 = *(const LAS f4*)(LK + o), k1 = *(const LAS f4*)(LK + o + 4); const float vv = LV[t * 64 + row];
            float dot = (s[0] * a0.x + s[1] * a0.y) + (s[2] * a0.z + s[3] * a0.w) + (s[4] * a1.x + s[5] * a1.y) + (s[6] * a1.z + s[7] * a1.w);
            if (MODE == 0) { float dp = (p[0] * a0.x + p[1] * a0.y) + (p[2] * a0.z + p[3] * a0.w) + (p[4] * a1.x + p[5] * a1.y) + (p[6] * a1.z + p[7] * a1.w);
                const float sp = -red8(dp);
                p[0] = p[0] * w0.x + sp * b0.x; p[1] = p[1] * w0.y + sp * b0.y; p[2] = p[2] * w0.z + sp * b0.z; p[3] = p[3] * w0.w + sp * b0.w;
                p[4] = p[4] * w1.x + sp * b1.x; p[5] = p[5] * w1.y + sp * b1.y; p[6] = p[6] * w1.z + sp * b1.z; p[7] = p[7] * w1.w + sp * b1.w; }
            const float sa = -red8(dot);
            s[0] = s[0] * w0.x + sa * b0.x + vv * k0.x; s[1] = s[1] * w0.y + sa * b0.y + vv * k0.y; s[2] = s[2] * w0.z + sa * b0.z + vv * k0.z; s[3] = s[3] * w0.w + sa * b0.w + vv * k0.w;
            s[4] = s[4] * w1.x + sa * b1.x + vv * k1.x; s[5] = s[5] * w1.y + sa * b1.y + vv * k1.y; s[6] = s[6] * w1.z + sa * b1.z + vv * k1.z; s[7] = s[7] * w1.w + sa * b1.w + vv * k1.w;
            if (MODE == 1) { const f4 r0 = *(const LAS f4*)(LR + o), r1 = *(const LAS f4*)(LR + o + 4);
                float y = (s[0] * r0.x + s[1] * r0.y) + (s[2] * r0.z + s[3] * r0.w) + (s[4] * r1.x + s[5] * r1.y) + (s[6] * r1.z + s[7] * r1.w);
                y = red8(y);
                if (sl == 0) LY[t * 64 + row] = y; } }
        __syncthreads();
        if (MODE == 1) { const f4 y = *(const LAS f4*)(LY + so); u2 w; w.x = pk2(y.x, y.y); w.y = pk2(y.z, y.w); *(u2*)(gY + (size_t)(tokb + sub * 32 + st) * 256 + hh * 64 + sc4) = w; }
    }
    if (MODE == 0) { *(f4*)gU = (f4){s[0], s[1], s[2], s[3]}; *(f4*)(gU + 4) = (f4){s[4], s[5], s[6], s[7]}; *(f4*)gP = (f4){p[0], p[1], p[2], p[3]}; *(f4*)(gP + 4) = (f4){p[4], p[5], p[6], p[7]}; }
    __syncthreads();
}
__device__ __forceinline__ void combine_rw(unsigned char* ws, int bh, LAS unsigned char* lds, int tid) {
    LAS float* LP = (LAS float*)lds; LAS float* LS = LP + 4096;
    const int row = tid >> 3, sl = tid & 7; float s[8];
#pragma unroll
    for (int i = 0; i < 8; ++i) s[i] = 0.f;
    const float* gP = (const float*)(ws + WS_RWP) + (size_t)bh * NCH * 4096; float* gU = (float*)(ws + WS_RWU) + (size_t)bh * NCH * 4096 + row * 64 + sl * 8;
    f4 q0 = *(const f4*)(gP + tid * 8), q1 = *(const f4*)(gP + tid * 8 + 4), u0 = *(const f4*)gU, u1 = *(const f4*)(gU + 4);
    for (int c = 0; c < NCH; ++c) {
        *(LAS f4*)(LP + tid * 8) = q0; *(LAS f4*)(LP + tid * 8 + 4) = q1;
        *(LAS f4*)(LS + row * 68 + sl * 8) = (f4){s[0], s[1], s[2], s[3]}; *(LAS f4*)(LS + row * 68 + sl * 8 + 4) = (f4){s[4], s[5], s[6], s[7]};
        *(f4*)(gU + (size_t)c * 4096) = (f4){s[0], s[1], s[2], s[3]}; *(f4*)(gU + (size_t)c * 4096 + 4) = (f4){s[4], s[5], s[6], s[7]};
        float n[8] = {u0.x, u0.y, u0.z, u0.w, u1.x, u1.y, u1.z, u1.w};
        __syncthreads();
        if (c + 1 < NCH) { q0 = *(const f4*)(gP + (size_t)(c + 1) * 4096 + tid * 8); q1 = *(const f4*)(gP + (size_t)(c + 1) * 4096 + tid * 8 + 4); u0 = *(const f4*)(gU + (size_t)(c + 1) * 4096); u1 = *(const f4*)(gU + (size_t)(c + 1) * 4096 + 4); }
#pragma unroll 4
        for (int i4 = 0; i4 < 16; ++i4) { const f4 sv = *(const LAS f4*)(LS + row * 68 + 4 * i4); const float se[4] = {sv.x, sv.y, sv.z, sv.w};
#pragma unroll
            for (int e = 0; e < 4; ++e) { const f4 pa = *(const LAS f4*)(LP + (4 * i4 + e) * 64 + sl * 8), pb = *(const LAS f4*)(LP + (4 * i4 + e) * 64 + sl * 8 + 4);
                n[0] += se[e] * pa.x; n[1] += se[e] * pa.y; n[2] += se[e] * pa.z; n[3] += se[e] * pa.w; n[4] += se[e] * pb.x; n[5] += se[e] * pb.y; n[6] += se[e] * pb.z; n[7] += se[e] * pb.w; } }
#pragma unroll
        for (int i = 0; i < 8; ++i) s[i] = n[i];
        __syncthreads();
    }
}
template <int MODE> __device__ __forceinline__ void scan_gla(const float* const* in, unsigned char* ws, int l, int item, LAS unsigned char* lds, int tid) {
    LAS float* LA = (LAS float*)lds; LAS float* LK = LA + 1024; LAS float* LQ = LA + 2048; LAS float* LV = LA + 3072; LAS float* LO = LA + 5120;
    const bf16* PROJ = (const bf16*)(ws + WS_PROJ); bf16* gO = (bf16*)(ws + WS_OGLA);
    const int bh = item / NCH, ch = item % NCH, hh = bh & 3, tokb = (bh >> 2) * SEQ + ch * CHL, nsub = CHL / 32;
    const int st = tid >> 4, si = tid & 15, vcol = tid >> 3, sl = tid & 7;
    float up0[16], up1[16];
#pragma unroll
    for (int r = 0; r < 16; ++r) { up0[r] = in[8][(l * 16 + r) * 128 + hh * 32 + 2 * si]; up1[r] = in[8][(l * 16 + r) * 128 + hh * 32 + 2 * si + 1]; }
    const float bi0 = in[9][l * 128 + hh * 32 + 2 * si], bi1 = in[9][l * 128 + hh * 32 + 2 * si + 1];
    float* gU = (float*)(ws + WS_GLU) + (size_t)item * 2048 + vcol * 32 + 4 * sl;
    float s[4] = {0.f, 0.f, 0.f, 0.f}, dp[4] = {1.f, 1.f, 1.f, 1.f};
    if (MODE == 1) { const f4 a = *(const f4*)gU; s[0] = a.x; s[1] = a.y; s[2] = a.z; s[3] = a.w; }
    u4 ps0, ps1; unsigned pq = 0, pk; u2 pv;
    { const bf16* p = PROJ + (size_t)(tokb + st) * NINP; ps0 = *(const u4*)(p + PC_GSTEM); ps1 = *(const u4*)(p + PC_GSTEM + 8); if (MODE == 1) pq = *(const unsigned*)(p + PC_GQ + hh * 32 + 2 * si); pk = *(const unsigned*)(p + PC_GK + hh * 32 + 2 * si); pv = *(const u2*)(p + PC_GV + hh * 64 + 4 * si); }
    for (int sub = 0; sub < nsub; ++sub) {
        { const unsigned sw[8] = {ps0.x, ps0.y, ps0.z, ps0.w, ps1.x, ps1.y, ps1.z, ps1.w}; float z0 = bi0, z1 = bi1;
#pragma unroll
          for (int r = 0; r < 8; ++r) { const float e0 = bflo(sw[r]), e1 = bfhi(sw[r]); z0 += e0 * up0[2 * r] + e1 * up0[2 * r + 1]; z1 += e0 * up1[2 * r] + e1 * up1[2 * r + 1]; }
          const float l0 = fminf(z0, 0.f) - log1pf(__expf(-fabsf(z0))), l1 = fminf(z1, 0.f) - log1pf(__expf(-fabsf(z1)));
          const int o = st * 32 + 2 * si; LA[o] = __expf(l0 * 0.0625f); LA[o + 1] = __expf(l1 * 0.0625f); LK[o] = bflo(pk); LK[o + 1] = bfhi(pk); if (MODE == 1) { LQ[o] = bflo(pq); LQ[o + 1] = bfhi(pq); }
          *(LAS f4*)(LV + st * 64 + 4 * si) = (f4){bflo(pv.x), bfhi(pv.x), bflo(pv.y), bfhi(pv.y)}; }
        __syncthreads();
        if (sub + 1 < nsub) { const bf16* p = PROJ + (size_t)(tokb + (sub + 1) * 32 + st) * NINP; ps0 = *(const u4*)(p + PC_GSTEM); ps1 = *(const u4*)(p + PC_GSTEM + 8); if (MODE == 1) pq = *(const unsigned*)(p + PC_GQ + hh * 32 + 2 * si); pk = *(const unsigned*)(p + PC_GK + hh * 32 + 2 * si); pv = *(const u2*)(p + PC_GV + hh * 64 + 4 * si); }
        for (int t = 0; t < 32; ++t) { const f4 al = *(const LAS f4*)(LA + t * 32 + 4 * sl), kk = *(const LAS f4*)(LK + t * 32 + 4 * sl); const float vv = LV[t * 64 + vcol];
            s[0] = s[0] * al.x + kk.x * vv; s[1] = s[1] * al.y + kk.y * vv; s[2] = s[2] * al.z + kk.z * vv; s[3] = s[3] * al.w + kk.w * vv;
            if (MODE == 0) { dp[0] *= al.x; dp[1] *= al.y; dp[2] *= al.z; dp[3] *= al.w; }
            else { const f4 qq = *(const LAS f4*)(LQ + t * 32 + 4 * sl); float o = (s[0] * qq.x + s[1] * qq.y) + (s[2] * qq.z + s[3] * qq.w); o = red8(o);
                if (sl == 0) LO[t * 64 + vcol] = o * 0.17677669529663687f; } }
        __syncthreads();
        if (MODE == 1) { const f4 y = *(const LAS f4*)(LO + st * 64 + 4 * si); u2 w; w.x = pk2(y.x, y.y); w.y = pk2(y.z, y.w); *(u2*)(gO + (size_t)(tokb + sub * 32 + st) * 256 + hh * 64 + 4 * si) = w; }
    }
    if (MODE == 0) { *(f4*)gU = (f4){s[0], s[1], s[2], s[3]}; if (vcol == 0) *(f4*)((float*)(ws + WS_GLD) + item * 32 + 4 * sl) = (f4){dp[0], dp[1], dp[2], dp[3]}; }
    __syncthreads();
}
template <int MODE> __device__ __forceinline__ void scan_ssd(unsigned char* ws, int item, LAS unsigned char* lds, int tid) {
    LAS float* LB = (LAS float*)lds; LAS float* LC = LB + 4096; LAS float* LX = LB + 8192; LAS float* LD = LB + 10240; LAS float* LY = LB + 10304;
    const bf16* XBC = (const bf16*)(ws + WS_XBC); const float* DT = (const float*)(ws + WS_DT); const float* DEC = (const float*)(ws + WS_DEC); bf16* gY = (bf16*)(ws + WS_YSSD);
    const int bh = item / NCH, ch = item % NCH, hh = bh & 3, tokb = (bh >> 2) * SEQ + ch * CHL, nsub = CHL / 32;
    const int st = tid >> 4, si = tid & 15, p = tid >> 3, sl = tid & 7, g = hh >> 1;
    float* gU = (float*)(ws + WS_SSU) + (size_t)item * 8192 + p * 128 + 16 * sl;
    float s[16]; float dprod = 1.f;
#pragma unroll
    for (int i = 0; i < 4; ++i) { f4 a = (f4){0.f, 0.f, 0.f, 0.f}; if (MODE == 1) a = *(const f4*)(gU + 4 * i); s[4 * i] = a.x; s[4 * i + 1] = a.y; s[4 * i + 2] = a.z; s[4 * i + 3] = a.w; }
    u4 pb, pc = (u4){0u, 0u, 0u, 0u}; u2 px; float pdt, pdec;
    { const size_t tok = tokb + st; const bf16* q = XBC + tok * 768; pb = *(const u4*)(q + 256 + g * 128 + 8 * si); if (MODE == 1) pc = *(const u4*)(q + 512 + g * 128 + 8 * si); px = *(const u2*)(q + hh * 64 + 4 * si); pdt = DT[tok * 4 + hh]; pdec = DEC[tok * 4 + hh]; }
    for (int sub = 0; sub < nsub; ++sub) {
        { const int o = st * 128 + 8 * si;
          *(LAS f4*)(LB + o) = (f4){bflo(pb.x), bfhi(pb.x), bflo(pb.y), bfhi(pb.y)}; *(LAS f4*)(LB + o + 4) = (f4){bflo(pb.z), bfhi(pb.z), bflo(pb.w), bfhi(pb.w)};
          if (MODE == 1) { *(LAS f4*)(LC + o) = (f4){bflo(pc.x), bfhi(pc.x), bflo(pc.y), bfhi(pc.y)}; *(LAS f4*)(LC + o + 4) = (f4){bflo(pc.z), bfhi(pc.z), bflo(pc.w), bfhi(pc.w)}; }
          *(LAS f4*)(LX + st * 64 + 4 * si) = (f4){bflo(px.x) * pdt, bfhi(px.x) * pdt, bflo(px.y) * pdt, bfhi(px.y) * pdt};
          if (si == 0) LD[st] = pdec; }
        __syncthreads();
        if (sub + 1 < nsub) { const size_t tok = tokb + (sub + 1) * 32 + st; const bf16* q = XBC + tok * 768; pb = *(const u4*)(q + 256 + g * 128 + 8 * si); if (MODE == 1) pc = *(const u4*)(q + 512 + g * 128 + 8 * si); px = *(const u2*)(q + hh * 64 + 4 * si); pdt = DT[tok * 4 + hh]; pdec = DEC[tok * 4 + hh]; }
        for (int t = 0; t < 32; ++t) { const float xv = LX[t * 64 + p], dc = LD[t]; float y = 0.f;
            if (MODE == 0) dprod *= dc;
#pragma unroll
            for (int q4 = 0; q4 < 4; ++q4) { const f4 bb = *(const LAS f4*)(LB + t * 128 + 16 * sl + 4 * q4);
                s[4 * q4] = s[4 * q4] * dc + bb.x * xv; s[4 * q4 + 1] = s[4 * q4 + 1] * dc + bb.y * xv; s[4 * q4 + 2] = s[4 * q4 + 2] * dc + bb.z * xv; s[4 * q4 + 3] = s[4 * q4 + 3] * dc + bb.w * xv;
                if (MODE == 1) { const f4 cc = *(const LAS f4*)(LC + t * 128 + 16 * sl + 4 * q4); y += (s[4 * q4] * cc.x + s[4 * q4 + 1] * cc.y) + (s[4 * q4 + 2] * cc.z + s[4 * q4 + 3] * cc.w); } }
            if (MODE == 1) { y = red8(y); if (sl == 0) LY[t * 64 + p] = y; } }
        __syncthreads();
        if (MODE == 1) { const f4 y = *(const LAS f4*)(LY + st * 64 + 4 * si); u2 w; w.x = pk2(y.x, y.y); w.y = pk2(y.z, y.w); *(u2*)(gY + (size_t)(tokb + sub * 32 + st) * 256 + hh * 64 + 4 * si) = w; }
    }
    if (MODE == 0) {
#pragma unroll
        for (int i = 0; i < 4; ++i) *(f4*)(gU + 4 * i) = (f4){s[4 * i], s[4 * i + 1], s[4 * i + 2], s[4 * i + 3]};
        if (tid == 0) ((float*)(ws + WS_SSD))[item] = dprod; }
    __syncthreads();
}
__device__ __forceinline__ void scan_lru_carry(unsigned char* ws, int tid) {
    const float* SA = (const float*)(ws + WS_SEGA); const float* SH = (const float*)(ws + WS_SEGH); float* CY = (float*)(ws + WS_CARRY);
    const int b = tid >> 8, c = tid & 255; float h = 0.f;
#pragma unroll 8
    for (int sg = 0; sg < 256; ++sg) { const int o = (b * 256 + sg) * 256 + c; CY[o] = h; h = SA[o] * h + SH[o]; }
}
__device__ __forceinline__ void combine_gla(unsigned char* ws, int bh, int tid) {
    float* gU = (float*)(ws + WS_GLU) + (size_t)bh * NCH * 2048 + tid * 4; const float* gD = (const float*)(ws + WS_GLD) + bh * NCH * 32 + (tid & 7) * 4; f4 s = (f4){0.f, 0.f, 0.f, 0.f};
#pragma unroll 4
    for (int c = 0; c < NCH; ++c) { const f4 u = *(const f4*)(gU + (size_t)c * 2048), d = *(const f4*)(gD + c * 32); *(f4*)(gU + (size_t)c * 2048) = s; s = s * d + u; }
}
__device__ __forceinline__ void combine_ssd(unsigned char* ws, int q, int tid) {
    const int bh = q >> 2; float* gU = (float*)(ws + WS_SSU) + (size_t)bh * NCH * 8192 + (q & 3) * 2048 + tid * 4; const float* gD = (const float*)(ws + WS_SSD) + bh * NCH; f4 s = (f4){0.f, 0.f, 0.f, 0.f};
#pragma unroll 4
    for (int c = 0; c < NCH; ++c) { const f4 u = *(const f4*)(gU + (size_t)c * 8192); const float d = gD[c]; *(f4*)(gU + (size_t)c * 8192) = s; s = s * d + u; }
}
template <int MODE> __device__ __forceinline__ void phase_scan(const float* const* in, unsigned char* ws, int l, LAS unsigned char* lds, int tid) {
    constexpr int NI = 8 * NCH;
    for (int it = blockIdx.x; it < 3 * NI + (MODE == 0 ? 1 : 0); it += gridDim.x) {
        if (it < NI) scan_rw<MODE>(ws, it, lds, tid);
        else if (it < 2 * NI) scan_ssd<MODE>(ws, it - NI, lds, tid);
        else if (it < 3 * NI) scan_gla<MODE>(in, ws, l, it - 2 * NI, lds, tid);
        else scan_lru_carry(ws, tid);
    }
}
__device__ __forceinline__ void phase_combine(unsigned char* ws, LAS unsigned char* lds, int tid) {
    for (int it = blockIdx.x; it < 48; it += gridDim.x) {
        if (it < 8) combine_rw(ws, it, lds, tid);
        else if (it < 16) combine_gla(ws, it - 8, tid);
        else combine_ssd(ws, it - 16, tid);
    }
}
__device__ __forceinline__ float red16(float x) { x += __shfl_xor(x, 1); x += __shfl_xor(x, 2); x += __shfl_xor(x, 4); x += __shfl_xor(x, 8); return x; }
__device__ __forceinline__ void phase_post(const float* const* in, unsigned char* ws, int l, int gw, int NGW, int lane) {
    const bf16* PROJ = (const bf16*)(ws + WS_PROJ); bf16* Y = (bf16*)(ws + WS_Y); const int c = 4 * lane, hh = lane >> 4;
    const f4 gnorm = *(const f4*)(in[10] + l * 64 + (c & 63)), gnw = *(const f4*)(in[30] + l * 256 + c), gnb = *(const f4*)(in[31] + l * 256 + c), snw = *(const f4*)(in[37] + l * 256 + c);
    const float dsk = in[36][l * 4 + hh];
    for (int tok = gw; tok < M; tok += NGW) { const bf16* pp = PROJ + (size_t)tok * NINP; const size_t o = (size_t)tok * 256 + c; bf16* yo = Y + (size_t)tok * D + c;
        { const u2 ov = *(const u2*)((const bf16*)(ws + WS_OGLA) + o), gv = *(const u2*)(pp + PC_GG + c);
          const float o0 = bflo(ov.x), o1 = bfhi(ov.x), o2 = bflo(ov.y), o3 = bfhi(ov.y);
          const float rs = rsqrtf(red16((o0 * o0 + o1 * o1) + (o2 * o2 + o3 * o3)) * (1.f / 64.f) + 1e-5f);
          u2 w; w.x = pk2(o0 * rs * gnorm.x * siluf_(bflo(gv.x)), o1 * rs * gnorm.y * siluf_(bfhi(gv.x))); w.y = pk2(o2 * rs * gnorm.z * siluf_(bflo(gv.y)), o3 * rs * gnorm.w * siluf_(bfhi(gv.y))); *(u2*)(yo) = w; }
        { const f4 A = *(const f4*)((const float*)(ws + WS_LRA) + o), H = *(const f4*)((const float*)(ws + WS_LRH) + o), cy = *(const f4*)((const float*)(ws + WS_CARRY) + (size_t)(tok >> 5) * 256 + c);
          const u2 gv = *(const u2*)(pp + PC_LG + c);
          u2 w; w.x = pk2((H.x + A.x * cy.x) * gelu_tanh(bflo(gv.x)), (H.y + A.y * cy.y) * gelu_tanh(bfhi(gv.x))); w.y = pk2((H.z + A.z * cy.z) * gelu_tanh(bflo(gv.y)), (H.w + A.w * cy.w) * gelu_tanh(bfhi(gv.y))); *(u2*)(yo + 256) = w; }
        { const u2 yv = *(const u2*)((const bf16*)(ws + WS_YRW) + o), vv = *(const u2*)((const bf16*)(ws + WS_RWV) + o), gv = *(const u2*)((const bf16*)(ws + WS_RWG) + o);
          const float bon = ((const float*)(ws + WS_RWBON))[tok * 4 + hh];
          float y0 = bflo(yv.x), y1 = bfhi(yv.x), y2 = bflo(yv.y), y3 = bfhi(yv.y);
          const float mean = red16((y0 + y1) + (y2 + y3)) * (1.f / 64.f); y0 -= mean; y1 -= mean; y2 -= mean; y3 -= mean;
          const float rs = rsqrtf(red16((y0 * y0 + y1 * y1) + (y2 * y2 + y3 * y3)) * (1.f / 64.f) + 64e-5f);
          u2 w; w.x = pk2((y0 * rs * gnw.x + gnb.x + bon * bflo(vv.x)) * bflo(gv.x), (y1 * rs * gnw.y + gnb.y + bon * bfhi(vv.x)) * bfhi(gv.x));
          w.y = pk2((y2 * rs * gnw.z + gnb.z + bon * bflo(vv.y)) * bflo(gv.y), (y3 * rs * gnw.w + gnb.w + bon * bfhi(vv.y)) * bfhi(gv.y)); *(u2*)(yo + 512) = w; }
        { const u2 yv = *(const u2*)((const bf16*)(ws + WS_YSSD) + o), xv = *(const u2*)((const bf16*)(ws + WS_XBC) + (size_t)tok * 768 + c), zv = *(const u2*)(pp + PC_SZ + c);
          const float y0 = (bflo(yv.x) + dsk * bflo(xv.x)) * siluf_(bflo(zv.x)), y1 = (bfhi(yv.x) + dsk * bfhi(xv.x)) * siluf_(bfhi(zv.x)), y2 = (bflo(yv.y) + dsk * bflo(xv.y)) * siluf_(bflo(zv.y)), y3 = (bfhi(yv.y) + dsk * bfhi(xv.y)) * siluf_(bfhi(zv.y));
          float q = red16((y0 * y0 + y1 * y1) + (y2 * y2 + y3 * y3)); q += __shfl_xor(q, 16);
          const float rs = rsqrtf(q * (1.f / 128.f) + 1e-5f);
          u2 w; w.x = pk2(y0 * rs * snw.x, y1 * rs * snw.y); w.y = pk2(y2 * rs * snw.z, y3 * rs * snw.w); *(u2*)(yo + 768) = w; }
    }
}
struct Args { const float* in[43]; float* out; unsigned char* ws; };
template <class Epi> __device__ __forceinline__ void gemm_multi(LAS unsigned char* lds, const pg8::Gemm& g, const Epi& E) {
    pg8::StaticOrder S; S.init(g.M, g.N, (int)gridDim.x, (int)blockIdx.x);
    pg8::gemm_phase<Epi, pg8::StaticOrder, true, true>(lds, g, S, E);
}
template <class Epi> __device__ __forceinline__ void gemm_single(LAS unsigned char* lds, const pg8::Gemm& g, const Epi& E) {
    pg8::StaticOrder S; S.init(g.M, g.N, (int)gridDim.x, (int)blockIdx.x);
    for (int r = 0;; ++r) { pg8::Unit u; if (!S.next(r, u)) break; OneUnit O{S, r}; pg8::gemm_phase<Epi, OneUnit, false, true>(lds, g, O, E); }
}
__global__ void __launch_bounds__(512, 2) fwd(Args a) {
    extern __shared__ __attribute__((aligned(16))) unsigned char lds_raw[];
    LAS unsigned char* lds = (LAS unsigned char*)lds_raw;
    cg::grid_group grid = cg::this_grid();
#define TIDS int tid = threadIdx.x; asm volatile("" : "+v"(tid)); const int lane = tid & 63, wave = __builtin_amdgcn_readfirstlane(tid >> 6), gw = blockIdx.x * 8 + wave, NGW = gridDim.x * 8; (void)lane; (void)gw; (void)NGW;
    unsigned char* ws = a.ws; const float* const* in = a.in; float* X = a.out;
    bf16* XB = (bf16*)(ws + WS_XB); bf16* Y = (bf16*)(ws + WS_Y); bf16* H = (bf16*)(ws + WS_PROJ); bf16* PROJ = (bf16*)(ws + WS_PROJ); float* SS = (float*)(ws + WS_SS);
#pragma unroll 1
    for (int l = 0; l < NL; ++l) {
        { TIDS
#ifndef SKIP_CONV
        phase_convert(in, ws, l, lds, gw, NGW, wave, lane);
#endif
        if (l == 0) phase_init_rows(in[0], XB, SS, gw, NGW, lane); }
        grid.sync();
#ifndef SKIP_G1
        { pg8::Gemm g{XB, (const bf16*)(ws + WS_WGU1), M, 2 * FF, D}; EpiGU E{H, SS}; gemm_single(lds, g, E); }
#endif
        grid.sync();
#ifndef SKIP_G2
        { pg8::Gemm g{H, (const bf16*)(ws + WS_WD1), M, D, FF}; EpiResid E{l == 0 ? in[0] : X, X, XB, SS, 0.5f}; gemm_single(lds, g, E); }
#endif
        grid.sync();
#ifndef SKIP_G3
        { pg8::Gemm g{XB, (const bf16*)(ws + WS_WIN), M, NINP, D}; EpiProj E{PROJ, SS}; gemm_single(lds, g, E); }
#endif
        grid.sync();
#ifndef SKIP_PREP
        { TIDS phase_prep(in, ws, l, lds, tid); }
#endif
        grid.sync();
#ifndef SKIP_SCAN
        { TIDS phase_scan<0>(in, ws, l, lds, tid); }
        grid.sync();
        { TIDS phase_combine(ws, lds, tid); }
        grid.sync();
        { TIDS phase_scan<1>(in, ws, l, lds, tid); }
#endif
        grid.sync();
#ifndef SKIP_POST
        { TIDS phase_post(in, ws, l, gw, NGW, lane); }
#endif
        grid.sync();
#ifndef SKIP_G4
        { pg8::Gemm g{Y, (const bf16*)(ws + WS_WOUT), M, D, D}; EpiResid E{X, X, XB, SS, 1.0f}; gemm_single(lds, g, E); }
#endif
        grid.sync();
#ifndef SKIP_G5
        { pg8::Gemm g{XB, (const bf16*)(ws + WS_WGU2), M, 2 * FF, D}; EpiGU E{H, SS}; gemm_single(lds, g, E); }
#endif
        grid.sync();
#ifndef SKIP_G6
        { pg8::Gemm g{H, (const bf16*)(ws + WS_WD2), M, D, FF}; EpiResid E{X, X, XB, SS, 0.5f}; gemm_single(lds, g, E); }
#endif
        grid.sync();
    }
    { TIDS phase_final(X, in[42], gw, NGW, lane); }
}

extern "C" void kernel_launch(void* const* d_in, const int* in_sizes, int n_in, void* d_out, int out_size, void* d_ws, size_t ws_size, hipStream_t stream) {
    static int grid = 0;
    if (grid == 0) {
        int dev = 0, cus = 0, per_cu = 0;
        (void)hipGetDevice(&dev);
        (void)hipDeviceGetAttribute(&cus, hipDeviceAttributeMultiprocessorCount, dev);
        (void)hipFuncSetAttribute((const void*)fwd, hipFuncAttributeMaxDynamicSharedMemorySize, LDS_BYTES);
        (void)hipOccupancyMaxActiveBlocksPerMultiprocessor(&per_cu, (const void*)fwd, 512, LDS_BYTES);
        if (per_cu < 1) per_cu = 1;
        grid = cus * per_cu;
        if (n_in != 43 || out_size != M * D || ws_size < WS_END) fprintf(stderr, "kernel_launch: unexpected sizes n_in %d out %d ws %zu (need %zu)\n", n_in, out_size, ws_size, (size_t)WS_END);
    }
    Args a{};
    for (int i = 0; i < 43 && i < n_in; ++i) a.in[i] = (const float*)d_in[i];
    a.out = (float*)d_out; a.ws = (unsigned char*)d_ws;
    void* args[] = {&a};
    hipError_t e = hipLaunchCooperativeKernel((const void*)fwd, dim3(grid), dim3(512), args, LDS_BYTES, stream);
    if (e != hipSuccess) fprintf(stderr, "cooperative launch failed: %s (grid %d)\n", hipGetErrorString(e), grid);
}
```

```cpp
#include <hip/hip_runtime.h>
#include <hip/hip_cooperative_groups.h>
#include <cstdio>
#include <cstdint>
namespace cg = cooperative_groups;
namespace pg8 {
#define PG8_LAS __attribute__((address_space(3)))
typedef unsigned short bf16_t;
typedef short bf16x8 __attribute__((ext_vector_type(8)));
typedef float f32x4 __attribute__((ext_vector_type(4)));
typedef unsigned u32x4 __attribute__((ext_vector_type(4)));
constexpr int BM = 256, BK = 64, HALF = 128, HTB = HALF * BK * 2  , STAGE_BYTES = 8 * HTB, NXCD = 8, WGM = 8;

__host__ __device__ __forceinline__ int lds_byte(int r, int c) { const int st = (r >> 4) * 2 + (c >> 5), rr = r & 15, cc = c & 31, ob = rr * 64 + cc * 2; return st * 1024 + (ob ^ (((ob >> 9) & 1) << 5)); }
__host__ __device__ __forceinline__ void stage_rc(int b, int& R, int& C) { const int st = b / 1024, sb = b % 1024, swz = sb ^ (((sb >> 9) & 1) << 5); R = (st >> 1) * 16 + swz / 64; C = (st & 1) * 32 + (swz % 64) / 2; }
__host__ __device__ __forceinline__ int perm32(int rho) { const int n = rho >> 4, i = rho & 15; return 8 * (i >> 2) + 4 * n + (i & 3); }

struct Unit { int pm, pn; };
struct Gemm { const bf16_t* A; const bf16_t* Bt; int M, N, K; };

struct StaticOrder {
    int nM, nN, nwg, G, c;
    __host__ __device__ void init(int M, int N, int G_, int c_) { nM = M / BM; nN = N / BM; nwg = nM * nN; G = G_; c = c_; }
    __host__ __device__ bool next(int i, Unit& u) const {
        const long L = (long)i * G + c; if (L >= nwg) return false;
        int wgid = (int)L; { const int q = nwg / NXCD, r = nwg % NXCD, xcd = wgid % NXCD, off = wgid / NXCD; wgid = (xcd < r ? xcd * (q + 1) : r * (q + 1) + (xcd - r) * q) + off; }
        const int nig = WGM * nN, gid = wgid / nig, fm = gid * WGM, gsz = (nM - fm) < WGM ? (nM - fm) : WGM;
        u.pm = fm + ((wgid % nig) % gsz); u.pn = (wgid % nig) / gsz; return true;
    }
    __device__ __forceinline__ void a_ready(const Unit&) const {}
    __device__ __forceinline__ void done(const Unit&) const {}
};

__device__ __forceinline__ unsigned cvt_pk_bf16(float lo, float hi) { unsigned r; asm volatile("v_cvt_pk_bf16_f32 %0, %1, %2" : "=v"(r) : "v"(lo), "v"(hi)); return r; }
typedef float f32x2 __attribute__((ext_vector_type(2)));
template <class Epi, class Sched, bool ALIGN_EPI = false, bool SP2 = false>
__device__ __forceinline__ void gemm_phase(PG8_LAS unsigned char* lds, const Gemm g, const Sched& S, const Epi& E) {
    int tid_ = threadIdx.x; asm volatile("" : "+v"(tid_));
    const int tid = tid_, wid = __builtin_amdgcn_readfirstlane(tid >> 6), lane = tid & 63, wr = wid >> 2, wc = wid & 3, fr = lane & 15, fq = lane >> 4;
    const int K = g.K, nt = K / BK;
    unsigned voffA[2], voffB[2];
#pragma unroll
    for (int i = 0; i < 2; ++i) { int R, C; stage_rc(tid * 16 + i * 8192, R, C); const int Rb = Epi::PERM ? ((R & ~31) + perm32(R & 31)) : R;
        voffA[i] = (unsigned)(R * K + C) * 2u; voffB[i] = (unsigned)(Rb * K + C) * 2u; }
    const size_t kstep = (size_t)(BK * 2);
    const size_t hstep = (size_t)HALF * K * 2;
    const size_t tstep = 2 * hstep;
    const unsigned ldsw = (unsigned)wid * 1024u;
    const int aoff = lds_byte(wr * 64 + fr, fq * 8), boff = lds_byte(wc * 32 + fr, fq * 8);
#define PG8_SA(b, h) (((b) * 2 + (h)) * HTB)
#define PG8_SB(b, h) ((4 + (b) * 2 + (h)) * HTB)
#define PG8_STAGE(bufoff, gbase, voff) do { _Pragma("unroll") for (int _i = 0; _i < 2; ++_i) \
        __builtin_amdgcn_global_load_lds((const unsigned*)((const char*)(gbase) + (voff)[_i]), (PG8_LAS unsigned*)(lds + (bufoff) + ldsw + _i * 8192), 16, 0, 0); } while (0)
#define PG8_LDA(dst, b, h) do { _Pragma("unroll") for (int m = 0; m < 4; ++m) _Pragma("unroll") for (int k = 0; k < 2; ++k) dst[m][k] = *(const PG8_LAS bf16x8*)(lds + PG8_SA(b, h) + aoff + m * 2048 + k * 1024); } while (0)
#define PG8_LDB(dst, b, h) do { _Pragma("unroll") for (int n = 0; n < 2; ++n) _Pragma("unroll") for (int k = 0; k < 2; ++k) dst[n][k] = *(const PG8_LAS bf16x8*)(lds + PG8_SB(b, h) + boff + n * 2048 + k * 1024); } while (0)
#define PG8_MMA(ai, bj, At, Bt) do { __builtin_amdgcn_s_setprio(1); _Pragma("unroll") for (int m = 0; m < 4; ++m) _Pragma("unroll") for (int n = 0; n < 2; ++n) _Pragma("unroll") for (int k = 0; k < 2; ++k) \
        acc[ai][bj][m][n] = __builtin_amdgcn_mfma_f32_16x16x32_bf16(Bt[n][k], At[m][k], acc[ai][bj][m][n], 0, 0, 0); __builtin_amdgcn_s_setprio(0); } while (0)
#define PG8_WAIT_V(n) asm volatile("s_waitcnt vmcnt(" #n ")" ::: "memory")
#define PG8_WAIT_L(n) asm volatile("s_waitcnt lgkmcnt(" #n ")" ::: "memory")
#define PG8_BAR __builtin_amdgcn_s_barrier()
#define PG8_SCHED __builtin_amdgcn_sched_barrier(0)
    Unit cur, nxt; int ui = 0;
    if (!S.next(0, cur)) return;
    f32x4 acc[2][2][4][2];
#pragma unroll
    for (int a = 0; a < 2; ++a)
#pragma unroll
        for (int b = 0; b < 2; ++b)
#pragma unroll
            for (int m = 0; m < 4; ++m)
#pragma unroll
                for (int n = 0; n < 2; ++n) acc[a][b][m][n] = (f32x4){0.f, 0.f, 0.f, 0.f};
    bf16x8 At[4][2], B0[2][2], B1[2][2];
    const char* cA = (const char*)g.A + (size_t)cur.pm * tstep; const char* cB = (const char*)g.Bt + (size_t)cur.pn * tstep;
    S.a_ready(cur);
    if constexpr (SP2) {
        PG8_STAGE(PG8_SB(0, 0), cB, voffB); PG8_STAGE(PG8_SB(0, 1), cB + hstep, voffB); PG8_STAGE(PG8_SA(0, 0), cA, voffA); PG8_STAGE(PG8_SA(0, 1), cA + hstep, voffA);
        if (wr == 1) PG8_BAR;
        PG8_WAIT_V(2); PG8_BAR;
        PG8_STAGE(PG8_SB(1, 0), cB + kstep, voffB); PG8_STAGE(PG8_SA(1, 0), cA + kstep, voffA); PG8_STAGE(PG8_SB(1, 1), cB + hstep + kstep, voffB);
        PG8_WAIT_V(6); PG8_BAR;
    } else {
        PG8_STAGE(PG8_SB(0, 0), cB, voffB); PG8_STAGE(PG8_SA(0, 0), cA, voffA); PG8_STAGE(PG8_SB(0, 1), cB + hstep, voffB); PG8_STAGE(PG8_SA(0, 1), cA + hstep, voffA);
        if (wr == 1) PG8_BAR;
        PG8_WAIT_V(4); PG8_BAR;
        PG8_STAGE(PG8_SB(1, 0), cB + kstep, voffB); PG8_STAGE(PG8_SA(1, 0), cA + kstep, voffA); PG8_STAGE(PG8_SB(1, 1), cB + hstep + kstep, voffB);
        PG8_WAIT_V(6); PG8_BAR;
    }
    for (;;) {
        const bool has_next = S.next(ui + 1, nxt);
        const char* nA = has_next ? (const char*)g.A + (size_t)nxt.pm * tstep : cA; const char* nB = has_next ? (const char*)g.Bt + (size_t)nxt.pn * tstep : cB;
        for (int t = 0; t < nt; t += 2) {
            const bool last = (t == nt - 2);
            const char* a1 = cA + (size_t)(t + 1) * kstep;
            const char* a2 = last ? nA : cA + (size_t)(t + 2) * kstep; const char* b2 = last ? nB : cB + (size_t)(t + 2) * kstep;
            const char* a3 = a2 + kstep; const char* b3 = b2 + kstep;
            if (last && has_next) S.a_ready(nxt);
            if constexpr (SP2) {
            PG8_LDB(B0, 0, 0); PG8_LDB(B1, 0, 1); PG8_SCHED; PG8_LDA(At, 0, 0); PG8_STAGE(PG8_SA(1, 1), a1 + hstep, voffA);
            PG8_WAIT_V(8); PG8_WAIT_L(0); PG8_BAR; PG8_MMA(0, 0, At, B0); PG8_MMA(0, 1, At, B1); PG8_BAR; PG8_SCHED;
            PG8_LDA(At, 0, 1); PG8_STAGE(PG8_SB(0, 0), b2, voffB); PG8_STAGE(PG8_SB(0, 1), b2 + hstep, voffB); PG8_STAGE(PG8_SA(0, 0), a2, voffA);
            PG8_WAIT_V(8); PG8_WAIT_L(0); PG8_BAR; PG8_MMA(1, 0, At, B0); PG8_MMA(1, 1, At, B1); PG8_BAR; PG8_SCHED;
            PG8_LDB(B0, 1, 0); PG8_LDB(B1, 1, 1); PG8_SCHED; PG8_LDA(At, 1, 0); PG8_STAGE(PG8_SA(0, 1), a2 + hstep, voffA);
            PG8_WAIT_V(8); PG8_WAIT_L(0); PG8_BAR; PG8_MMA(0, 0, At, B0); PG8_MMA(0, 1, At, B1); PG8_BAR; PG8_SCHED;
            PG8_LDA(At, 1, 1); PG8_STAGE(PG8_SB(1, 0), b3, voffB); PG8_STAGE(PG8_SB(1, 1), b3 + hstep, voffB); PG8_STAGE(PG8_SA(1, 0), a3, voffA);
            PG8_WAIT_V(8); PG8_WAIT_L(0); PG8_BAR; PG8_MMA(1, 0, At, B0); PG8_MMA(1, 1, At, B1); PG8_BAR; PG8_SCHED;
            } else {
            PG8_LDB(B0, 0, 0); PG8_SCHED; PG8_LDA(At, 0, 0); PG8_STAGE(PG8_SA(1, 1), a1 + hstep, voffA);
            PG8_WAIT_L(8); PG8_BAR; PG8_WAIT_L(0); PG8_MMA(0, 0, At, B0); PG8_BAR; PG8_SCHED;
            PG8_LDB(B1, 0, 1); PG8_STAGE(PG8_SB(0, 0), b2, voffB);
            PG8_BAR; PG8_WAIT_L(0); PG8_MMA(0, 1, At, B1); PG8_BAR;
            PG8_LDA(At, 0, 1); PG8_STAGE(PG8_SA(0, 0), a2, voffA);
            PG8_BAR; PG8_WAIT_L(0); PG8_MMA(1, 0, At, B0); PG8_BAR; PG8_SCHED;
            PG8_STAGE(PG8_SB(0, 1), b2 + hstep, voffB);
            PG8_WAIT_V(6); PG8_BAR; PG8_MMA(1, 1, At, B1); PG8_BAR;
            PG8_LDB(B0, 1, 0); PG8_SCHED; PG8_LDA(At, 1, 0); PG8_STAGE(PG8_SA(0, 1), a2 + hstep, voffA);
            PG8_WAIT_L(8); PG8_BAR; PG8_WAIT_L(0); PG8_MMA(0, 0, At, B0); PG8_BAR; PG8_SCHED;
            PG8_LDB(B1, 1, 1); PG8_STAGE(PG8_SB(1, 0), b3, voffB);
            PG8_BAR; PG8_WAIT_L(0); PG8_MMA(0, 1, At, B1); PG8_BAR;
            PG8_LDA(At, 1, 1); PG8_STAGE(PG8_SA(1, 0), a3, voffA);
            PG8_BAR; PG8_WAIT_L(0); PG8_MMA(1, 0, At, B0); PG8_BAR; PG8_SCHED;
            PG8_STAGE(PG8_SB(1, 1), b3 + hstep, voffB);
            PG8_WAIT_V(6); PG8_BAR; PG8_MMA(1, 1, At, B1); PG8_BAR;
            }
        }
        if constexpr (ALIGN_EPI) { if (wr == 0) PG8_BAR; }
        if constexpr (!Epi::AFTER_DRAIN) { E(acc, cur, wr, wc, fr, fq); S.done(cur); }
        if (!has_next) break;
#pragma unroll
        for (int a = 0; a < 2; ++a)
#pragma unroll
            for (int b = 0; b < 2; ++b)
#pragma unroll
                for (int m = 0; m < 4; ++m)
#pragma unroll
                    for (int n = 0; n < 2; ++n) acc[a][b][m][n] = (f32x4){0.f, 0.f, 0.f, 0.f};
        cur = nxt; cA = nA; cB = nB; ++ui;
        if constexpr (ALIGN_EPI) { if (wr == 1) PG8_BAR; }
    }
    PG8_WAIT_V(0);
    if constexpr (!ALIGN_EPI) { if (wr == 0) PG8_BAR; }
    PG8_BAR;
    if constexpr (Epi::AFTER_DRAIN) { E.fused(acc, cur, wr, wc, fr, fq, lds, wid, lane); S.done(cur); }
#undef PG8_SA
#undef PG8_SB
#undef PG8_STAGE
#undef PG8_LDA
#undef PG8_LDB
#undef PG8_MMA
#undef PG8_WAIT_V
#undef PG8_WAIT_L
#undef PG8_BAR
#undef PG8_SCHED
}
}
#define LAS __attribute__((address_space(3)))
typedef unsigned short bf16;
typedef float f4 __attribute__((ext_vector_type(4)));
typedef unsigned u2 __attribute__((ext_vector_type(2)));
typedef unsigned u4 __attribute__((ext_vector_type(4)));
using pg8::f32x4;

constexpr int M = 16384, D = 1024, FF = 2816, NIN = 3156, NINP = 3328, NL = 4, SEQ = 8192;
constexpr int LDS_BYTES = 147456;
constexpr size_t HM = 524288;
constexpr size_t WS_WGU1 = 0, WS_WD1 = 22 * HM, WS_WIN = 33 * HM, WS_WOUT = 46 * HM, WS_WGU2 = 50 * HM, WS_WD2 = 72 * HM;
constexpr size_t MiB = 1048576;
constexpr size_t WS_XB = 42 * MiB;
constexpr size_t WS_OGLA = WS_XB, WS_YRW = WS_XB + 8 * MiB, WS_YSSD = WS_XB + 16 * MiB;
constexpr size_t WS_Y = 74 * MiB;
constexpr size_t WS_PROJ = 106 * MiB;
constexpr size_t WS_VFIRST = 210 * MiB;
constexpr size_t WS_SS = 226 * MiB;
constexpr size_t WS_RWR = 227 * MiB, WS_RWK = 235 * MiB, WS_RWV = 243 * MiB, WS_RWKK = 251 * MiB, WS_RWB = 259 * MiB;
constexpr size_t WS_RWW = 267 * MiB;
constexpr size_t WS_RWG = 283 * MiB;
constexpr size_t WS_RWBON = 291 * MiB;
constexpr size_t WS_XBC = 292 * MiB;
constexpr size_t WS_DT = 316 * MiB, WS_DEC = 317 * MiB;
constexpr size_t WS_LRA = 318 * MiB, WS_LRH = 334 * MiB;
constexpr size_t WS_SEGA = 350 * MiB, WS_SEGH = 351 * MiB, WS_CARRY = 352 * MiB;
constexpr int NCH = 32, CHL = SEQ / NCH;
constexpr size_t WS_RWP = 353 * MiB, WS_RWU = 357 * MiB;
constexpr size_t WS_GLU = 361 * MiB, WS_GLD = 363 * MiB;
constexpr size_t WS_SSU = 364 * MiB, WS_SSD = 372 * MiB;
constexpr size_t WS_CTL = 373 * MiB;
constexpr size_t WS_END = 374 * MiB;

constexpr int PC_GQ = 0, PC_GK = 128, PC_GV = 256, PC_GG = 512, PC_GSTEM = 768, PC_LX = 784, PC_LG = 1040, PC_RW = 1296, PC_SZ = 2128, PC_SXBC = 2384, PC_SDT = 3152;

__device__ __forceinline__ float bf2f(bf16 v) { return __uint_as_float((unsigned)v << 16); }
__device__ __forceinline__ float bflo(unsigned w) { return __uint_as_float(w << 16); }
__device__ __forceinline__ float bfhi(unsigned w) { return __uint_as_float(w & 0xffff0000u); }
__device__ __forceinline__ unsigned pk2(float lo, float hi) { return pg8::cvt_pk_bf16(lo, hi); }
__device__ __forceinline__ float sigmoidf_(float x) { return 1.f / (1.f + __expf(-x)); }
__device__ __forceinline__ float siluf_(float x) { return x / (1.f + __expf(-x)); }
__device__ __forceinline__ float tanhf_(float x) { return 1.f - 2.f / (1.f + __expf(2.f * x)); }
__device__ __forceinline__ float softplusf_(float x) { return fmaxf(x, 0.f) + log1pf(__expf(-fabsf(x))); }
__device__ __forceinline__ float gelu_tanh(float x) { const float u = 0.7978845608028654f * (x + 0.044715f * x * x * x); return 0.5f * x * (1.f + tanhf_(u)); }
__device__ __forceinline__ float wave_sum(float v) {
#pragma unroll
    for (int o = 1; o < 64; o <<= 1) v += __shfl_xor(v, o);
    return v;
}
__device__ __forceinline__ float red8(float x) { x += __shfl_xor(x, 1); x += __shfl_xor(x, 2); x += __shfl_xor(x, 4); return x; }
__device__ __forceinline__ float rstd_row(const float* ss, int row) { const f4 p = *(const f4*)(ss + (size_t)row * 4); return rsqrtf(((p.x + p.y) + (p.z + p.w)) * (1.f / 1024.f) + 1e-6f); }

struct EpiGU {
    static constexpr bool PERM = true, AFTER_DRAIN = true;
    bf16* H; const float* ss;
    __device__ __forceinline__ void fused(f32x4 (&acc)[2][2][4][2], const pg8::Unit& u, int wr, int wc, int fr, int fq, LAS unsigned char* lds, int wid, int lane) const {
#pragma unroll
        for (int ai = 0; ai < 2; ++ai)
#pragma unroll
            for (int m = 0; m < 4; ++m) {
                const int row = u.pm * 256 + ai * 128 + wr * 64 + m * 16 + fr; const float rs = rstd_row(ss, row);
                float hv[8];
#pragma unroll
                for (int n = 0; n < 2; ++n)
#pragma unroll
                    for (int e = 0; e < 4; ++e) { const float g = acc[ai][0][m][n][e] * rs, up = acc[ai][1][m][n][e] * rs; hv[n * 4 + e] = siluf_(g) * up; }
                u4 w; w.x = pk2(hv[0], hv[1]); w.y = pk2(hv[2], hv[3]); w.z = pk2(hv[4], hv[5]); w.w = pk2(hv[6], hv[7]);
                *(u4*)(H + (size_t)row * FF + u.pn * 128 + wc * 32 + 8 * fq) = w;
                asm volatile("" ::: "memory");
            }
    }
};
struct EpiProj {
    static constexpr bool PERM = true, AFTER_DRAIN = true;
    bf16* O; const float* ss;
    __device__ __forceinline__ void fused(f32x4 (&acc)[2][2][4][2], const pg8::Unit& u, int wr, int wc, int fr, int fq, LAS unsigned char* lds, int wid, int lane) const {
#pragma unroll
        for (int ai = 0; ai < 2; ++ai)
#pragma unroll
            for (int m = 0; m < 4; ++m) {
                const int row = u.pm * 256 + ai * 128 + wr * 64 + m * 16 + fr; const float rs = rstd_row(ss, row);
#pragma unroll
                for (int bj = 0; bj < 2; ++bj) { const f32x4 v0 = acc[ai][bj][m][0] * rs, v1 = acc[ai][bj][m][1] * rs;
                    u4 w; w.x = pk2(v0[0], v0[1]); w.y = pk2(v0[2], v0[3]); w.z = pk2(v1[0], v1[1]); w.w = pk2(v1[2], v1[3]);
                    *(u4*)(O + (size_t)row * NINP + u.pn * 256 + bj * 128 + wc * 32 + 8 * fq) = w; }
                asm volatile("" ::: "memory");
            }
    }
};
struct EpiResid {
    static constexpr bool PERM = true, AFTER_DRAIN = true;
    const float* xin; float* xout; bf16* xb; float* ss; float scale;
    __device__ __forceinline__ void fused(f32x4 (&acc)[2][2][4][2], const pg8::Unit& u, int wr, int wc, int fr, int fq, LAS unsigned char* lds, int wid, int lane) const {
        LAS float* P = (LAS float*)lds;
#pragma unroll
        for (int ai = 0; ai < 2; ++ai)
#pragma unroll
            for (int m = 0; m < 4; ++m) {
                const int rt = ai * 128 + wr * 64 + m * 16 + fr; const size_t row = (size_t)u.pm * 256 + rt; float sq = 0.f;
#pragma unroll
                for (int bj = 0; bj < 2; ++bj) { const size_t off = row * D + u.pn * 256 + bj * 128 + wc * 32 + 8 * fq;
                    f32x4 x0 = *(const f32x4*)(xin + off), x1 = *(const f32x4*)(xin + off + 4);
                    x0 += acc[ai][bj][m][0] * scale; x1 += acc[ai][bj][m][1] * scale;
                    *(f32x4*)(xout + off) = x0; *(f32x4*)(xout + off + 4) = x1;
                    u4 w; w.x = pk2(x0[0], x0[1]); w.y = pk2(x0[2], x0[3]); w.z = pk2(x1[0], x1[1]); w.w = pk2(x1[2], x1[3]);
                    *(u4*)(xb + off) = w;
                    sq += (x0[0] * x0[0] + x0[1] * x0[1]) + (x0[2] * x0[2] + x0[3] * x0[3]) + (x1[0] * x1[0] + x1[1] * x1[1]) + (x1[2] * x1[2] + x1[3] * x1[3]); }
                sq += __shfl_xor(sq, 16); sq += __shfl_xor(sq, 32);
                if (fq == 0) P[rt * 4 + wc] = sq;
            }
        __syncthreads();
        const int tid = wid * 64 + lane;
        if (tid < 256) ss[(size_t)(u.pm * 256 + tid) * 4 + u.pn] = (P[tid * 4 + 0] + P[tid * 4 + 1]) + (P[tid * 4 + 2] + P[tid * 4 + 3]);
        __syncthreads();
    }
};
struct OneUnit { pg8::StaticOrder b; int r;
    __device__ __forceinline__ bool next(int i, pg8::Unit& u) const { return i == 0 && b.next(r, u); }
    __device__ __forceinline__ void a_ready(const pg8::Unit&) const {}
    __device__ __forceinline__ void done(const pg8::Unit&) const {} };

__device__ __forceinline__ void tr_item(const float* W, int ldn, int nvalid, int col0, const float* sc, bf16* WT, int K, int row0, int k0, LAS float* scr, int lane) {
    const int c = col0 + (lane & 31);
#pragma unroll 8
    for (int i = 0; i < 32; ++i) { const int kk = 2 * i + (lane >> 5); float v = (c < nvalid) ? W[(size_t)(k0 + kk) * ldn + c] : 0.f; if (sc) v *= sc[k0 + kk]; scr[kk * 33 + (lane & 31)] = v; }
    asm volatile("s_waitcnt lgkmcnt(0)" ::: "memory");
    const int c8 = lane & 7;
#pragma unroll
    for (int j = 0; j < 4; ++j) { const int n = (lane >> 3) + 8 * j; const LAS float* s = scr + (8 * c8) * 33 + n;
        u4 o; o.x = pk2(s[0 * 33], s[1 * 33]); o.y = pk2(s[2 * 33], s[3 * 33]); o.z = pk2(s[4 * 33], s[5 * 33]); o.w = pk2(s[6 * 33], s[7 * 33]);
        *(u4*)(WT + (size_t)(row0 + n) * K + k0 + 8 * c8) = o; }
    asm volatile("s_waitcnt lgkmcnt(0)" ::: "memory");
}
__device__ __forceinline__ void tr_gu(const float* Wg, const float* Wu, const float* nw, bf16* WT, int it, LAS float* scr, int lane) {
    const int kb = it / 176, nb = it % 176, row0 = nb * 32, pn = row0 >> 8, half = (row0 >> 7) & 1, i0 = row0 & 127;
    tr_item(half ? Wu : Wg, FF, FF, pn * 128 + i0, nw, WT, D, row0, kb * 64, scr, lane);
}
__device__ __forceinline__ void phase_convert(const float* const* in, unsigned char* ws, int l, LAS unsigned char* lds, int gw, int NGW, int wave, int lane) {
    LAS float* scr = (LAS float*)(lds + wave * 16384);
    const size_t oFF = (size_t)l * D * FF;
    constexpr int I_GU = 2816, I_D = 1408, I_IN = 1664, I_OUT = 512, NIT = 2 * I_GU + 2 * I_D + I_IN + I_OUT;
    for (int it = gw; it < NIT; it += NGW) {
        int r = it;
        if (r < I_GU) { tr_gu(in[2] + oFF, in[3] + oFF, in[1] + l * D, (bf16*)(ws + WS_WGU1), r, scr, lane); continue; } r -= I_GU;
        if (r < I_D) { tr_item(in[4] + oFF, D, D, (r % 32) * 32, nullptr, (bf16*)(ws + WS_WD1), FF, (r % 32) * 32, (r / 32) * 64, scr, lane); continue; } r -= I_D;
        if (r < I_IN) { tr_item(in[6] + (size_t)l * D * NIN, NIN, NIN, (r % 104) * 32, in[5] + l * D, (bf16*)(ws + WS_WIN), D, (r % 104) * 32, (r / 104) * 64, scr, lane); continue; } r -= I_IN;
        if (r < I_OUT) { tr_item(in[7] + (size_t)l * D * D, D, D, (r % 32) * 32, nullptr, (bf16*)(ws + WS_WOUT), D, (r % 32) * 32, (r / 32) * 64, scr, lane); continue; } r -= I_OUT;
        if (r < I_GU) { tr_gu(in[39] + oFF, in[40] + oFF, in[38] + l * D, (bf16*)(ws + WS_WGU2), r, scr, lane); continue; } r -= I_GU;
        tr_item(in[41] + oFF, D, D, (r % 32) * 32, nullptr, (bf16*)(ws + WS_WD2), FF, (r % 32) * 32, (r / 32) * 64, scr, lane);
    }
}
__device__ __forceinline__ void phase_init_rows(const float* x, bf16* xb, float* ss, int gw, int NGW, int lane) {
    for (int m = gw; m < M; m += NGW) {
        const f4* xr = (const f4*)(x + (size_t)m * D) + lane; float s = 0.f; u2* o = (u2*)(xb + (size_t)m * D) + lane;
#pragma unroll
        for (int j = 0; j < 4; ++j) { const f4 v = xr[64 * j]; s += (v.x * v.x + v.y * v.y) + (v.z * v.z + v.w * v.w); u2 w; w.x = pk2(v.x, v.y); w.y = pk2(v.z, v.w); o[64 * j] = w; }
        s = wave_sum(s);
        if (lane < 4) ss[(size_t)m * 4 + lane] = lane == 0 ? s : 0.f;
    }
}
__device__ __forceinline__ void phase_final(float* x, const float* fw, int gw, int NGW, int lane) {
    for (int m = gw; m < M; m += NGW) {
        f4* xr = (f4*)(x + (size_t)m * D) + lane; f4 v[4]; float s = 0.f;
#pragma unroll
        for (int j = 0; j < 4; ++j) { v[j] = xr[64 * j]; s += (v[j].x * v[j].x + v[j].y * v[j].y) + (v[j].z * v[j].z + v[j].w * v[j].w); }
        const float rs = rsqrtf(wave_sum(s) * (1.f / 1024.f) + 1e-6f);
#pragma unroll
        for (int j = 0; j < 4; ++j) { const f4 w = ((const f4*)fw)[lane + 64 * j]; xr[64 * j] = v[j] * rs * w; }
    }
}
#define XB_TMO      128
#define XB_XCNT(j)  (256  + 64 * (j))
#define XB_XSUB(j)  (1280 + 64 * (j))
#define XB_XGEN(j)  (2304 + 64 * (j))
#define XB_TOP      3328
#define XB_TOPGEN   3392
#define XCD_BAR_WORDS 3456
#define XB_SPIN_CAP (1u << 18)

__device__ __forceinline__ unsigned xb_ld(unsigned* p)              { return __hip_atomic_load(p, __ATOMIC_RELAXED, __HIP_MEMORY_SCOPE_AGENT); }
__device__ __forceinline__ unsigned xb_add(unsigned* p, unsigned v) { return __hip_atomic_fetch_add(p, v, __ATOMIC_RELAXED, __HIP_MEMORY_SCOPE_AGENT); }
__device__ __forceinline__ unsigned xb_xcc_id() { return (unsigned)__builtin_amdgcn_s_getreg((3 << 11) | 20) & 0xFu; }
#define XB_SPIN(cond, bar) do { unsigned _sp = 0; while (cond) { __builtin_amdgcn_s_sleep(1); \
    if ((++_sp & 255u) == 0u) { if (xb_ld(&(bar)[XB_TMO])) break; if (_sp > XB_SPIN_CAP) { atomicAdd(&(bar)[XB_TMO], 1u); break; } } } } while (0)

struct XcdBarrier {
    unsigned* bar; unsigned x;
    volatile LAS unsigned* st;
};

__device__ __forceinline__ XcdBarrier xcd_barrier_post(unsigned* bar, volatile LAS unsigned* st) {
    XcdBarrier b; b.bar = bar; b.x = xb_xcc_id(); b.st = st;
    if (threadIdx.x == 0) (void)xb_add(&bar[XB_XCNT(b.x)], 1u);
    return b;
}
__device__ __forceinline__ void xcd_barrier_complete(unsigned* bar, unsigned x, unsigned& nloc, unsigned& nx) {
    const unsigned G = gridDim.x * gridDim.y * gridDim.z;
    unsigned sum, cnt, mine, sp = 0u;
    for (;;) {
        sum = 0u; cnt = 0u; mine = 0u;
#pragma unroll
        for (unsigned j = 0; j < 16; ++j) { const unsigned c = xb_ld(&bar[XB_XCNT(j)]); sum += c; cnt += (c > 0u) ? 1u : 0u; mine = (j == x) ? c : mine; }
        if (sum == G) break;
        __builtin_amdgcn_s_sleep(1);
        if ((++sp & 255u) == 0u) { if (xb_ld(&bar[XB_TMO])) break; if (sp > XB_SPIN_CAP) { atomicAdd(&bar[XB_TMO], 1u); break; } }
    }
    nloc = mine > 0u ? mine : 1u; nx = cnt > 0u ? cnt : 1u;
}

__device__ __forceinline__ void xcd_barrier(const XcdBarrier& b) {
    asm volatile("s_waitcnt vmcnt(0)" ::: "memory");
    __syncthreads();
    if (threadIdx.x == 0) {
        unsigned* bar = b.bar;
        __builtin_amdgcn_s_waitcnt(0);
        unsigned nloc = b.st[0], nx = b.st[1];
        if (nloc == 0u) { xcd_barrier_complete(bar, b.x, nloc, nx); b.st[0] = nloc; b.st[1] = nx; }
        const unsigned old = xb_add(&bar[XB_XSUB(b.x)], 1u);
        const unsigned gen = old / nloc;
        if (old + 1u == (gen + 1u) * nloc) {
            __builtin_amdgcn_fence(__ATOMIC_RELEASE, "agent");
            asm volatile("s_waitcnt vmcnt(0)" ::: "memory");
            const unsigned og = xb_add(&bar[XB_TOP], 1u);
            const unsigned tg = og / nx;
            if (og + 1u == (tg + 1u) * nx) xb_add(&bar[XB_TOPGEN], 1u);
            else XB_SPIN(xb_ld(&bar[XB_TOPGEN]) == tg, bar);
            __builtin_amdgcn_fence(__ATOMIC_ACQUIRE, "agent");
            xb_add(&bar[XB_XGEN(b.x)], 1u);
            asm volatile("s_waitcnt vmcnt(0)" ::: "memory");
        } else {
            XB_SPIN(xb_ld(&bar[XB_XGEN(b.x)]) == gen, bar);
            __builtin_amdgcn_fence(__ATOMIC_ACQUIRE, "agent");
            asm volatile("s_waitcnt vmcnt(0)" ::: "memory");
        }
    }
    __syncthreads();
}
__device__ __forceinline__ void prep_lru(const float* const* in, unsigned char* ws, int l, int item, LAS unsigned char* lds, int tid) {
    const bf16* PROJ = (const bf16*)(ws + WS_PROJ); LAS float* X = (LAS float*)lds; LAS float* G = X + 32 * 256;
    const int t0 = item * 32; const float* cw = in[11] + l * 4 * 256; const float* cb = in[12] + l * 256;
#pragma unroll 1
    for (int idx = tid; idx < 32 * 256; idx += 512) { const int t = idx >> 8, c = idx & 255, tok = t0 + t, pos = tok & (SEQ - 1); float acc = cb[c];
#pragma unroll
        for (int k = 0; k < 4; ++k) { const int tp = pos - 3 + k; if (tp >= 0) acc += cw[k * 256 + c] * bf2f(PROJ[(size_t)(tok - 3 + k) * NINP + PC_LX + c]); }
        X[idx] = acc; }
    __syncthreads();
    const int gsel = tid >> 8, c = tid & 255, blk = c >> 6, j = c & 63;
    { const float* pw = (gsel ? in[15] : in[13]) + (size_t)l * 16384 + blk * 4096 + j; const float bias = (gsel ? in[16] : in[14])[l * 256 + c];
#pragma unroll 1
      for (int kh = 0; kh < 2; ++kh) { float wv[32];
#pragma unroll
          for (int k = 0; k < 32; ++k) wv[k] = pw[(kh * 32 + k) * 64];
#pragma unroll 1
          for (int t = 0; t < 32; ++t) { const LAS f4* xr = (const LAS f4*)(X + t * 256 + blk * 64 + kh * 32); float d0 = 0.f, d1 = 0.f;
#pragma unroll
              for (int k4 = 0; k4 < 8; k4 += 2) { const f4 v = xr[k4], w = xr[k4 + 1];
                  d0 += v.x * wv[4 * k4] + v.y * wv[4 * k4 + 1] + v.z * wv[4 * k4 + 2] + v.w * wv[4 * k4 + 3];
                  d1 += w.x * wv[4 * k4 + 4] + w.y * wv[4 * k4 + 5] + w.z * wv[4 * k4 + 6] + w.w * wv[4 * k4 + 7]; }
              LAS float* gp = G + (gsel * 32 + t) * 256 + c;
              if (kh == 0) *gp = d0 + d1; else *gp = sigmoidf_(*gp + d0 + d1 + bias); } } }
    __syncthreads();
    if (tid < 256) { const float sp = softplusf_(-in[17][l * 256 + c]); float h = 0.f, A = 1.f; float* LRA = (float*)(ws + WS_LRA); float* LRH = (float*)(ws + WS_LRH);
#pragma unroll 1
        for (int t = 0; t < 32; ++t) { const float r = G[t * 256 + c], ig = G[(32 + t) * 256 + c], la = -8.f * r * sp, av = __expf(la), u = sqrtf(fmaxf(-expm1f(2.f * la), 0.f)) * (ig * X[t * 256 + c]);
            h = av * h + u; A *= av; const size_t o = (size_t)(t0 + t) * 256 + c; LRA[o] = A; LRH[o] = h; }
        ((float*)(ws + WS_SEGA))[item * 256 + c] = A; ((float*)(ws + WS_SEGH))[item * 256 + c] = h; }
    __syncthreads();
}
__device__ __forceinline__ void prep_ssd(const float* const* in, unsigned char* ws, int l, int item, int tid) {
    const bf16* PROJ = (const bf16*)(ws + WS_PROJ); unsigned* XBC = (unsigned*)(ws + WS_XBC);
    const int t0 = item * 32; const float* cw = in[32] + l * 4 * 768; const float* cb = in[33] + l * 768;
    for (int idx = tid; idx < 32 * 384; idx += 512) { const int t = idx / 384, c = (idx % 384) * 2, tok = t0 + t, pos = tok & (SEQ - 1); float a0 = cb[c], a1 = cb[c + 1];
#pragma unroll
        for (int k = 0; k < 4; ++k) { const int tp = pos - 3 + k; if (tp >= 0) { const unsigned w = *(const unsigned*)(PROJ + (size_t)(tok - 3 + k) * NINP + PC_SXBC + c); a0 += cw[k * 768 + c] * bflo(w); a1 += cw[k * 768 + c + 1] * bfhi(w); } }
        XBC[((size_t)tok * 768 + c) >> 1] = pk2(siluf_(a0), siluf_(a1)); }
    if (tid < 128) { const int t = tid >> 2, hh = tid & 3, tok = t0 + t; const float dt = softplusf_(bf2f(PROJ[(size_t)tok * NINP + PC_SDT + hh]) + in[34][l * 4 + hh]);
        ((float*)(ws + WS_DT))[tok * 4 + hh] = dt; ((float*)(ws + WS_DEC))[tok * 4 + hh] = __expf(-dt * __expf(in[35][l * 4 + hh])); }
}
__device__ __forceinline__ void prep_rw(const float* const* in, unsigned char* ws, int l, int item, LAS unsigned char* lds, int tid) {
    const bf16* PROJ = (const bf16*)(ws + WS_PROJ); LAS float* P = (LAS float*)lds; LAS float* VV = (LAS float*)(lds + 32 * 832 * 4);
    const int t0 = item * 32; const float* mu = in[18] + l * 832;
#pragma unroll 1
    for (int idx = tid; idx < 32 * 832; idx += 512) { const int t = idx / 832, col = idx % 832, tok = t0 + t;
        const float cur = bf2f(PROJ[(size_t)tok * NINP + PC_RW + col]), prev = (tok & (SEQ - 1)) ? bf2f(PROJ[(size_t)(tok - 1) * NINP + PC_RW + col]) : 0.f;
        float p = cur + (prev - cur) * mu[col];
        if (col >= 768 && col < 784) p = tanhf_(p); else if (col >= 800) p = sigmoidf_(p);
        P[idx] = p; }
    __syncthreads();
    if (l > 0 && tid < 256) { const int t = tid >> 3, j = tid & 7; const float* v1 = in[25] + (size_t)(l - 1) * 2048 + j; float s = 0.f;
#pragma unroll 4
        for (int c = 0; c < 256; ++c) s += P[t * 832 + 512 + c] * v1[c * 8];
        VV[t * 8 + j] = s; }
    __syncthreads();
    const int half = tid >> 8, c = tid & 255, hh = c >> 6, lane = tid & 63;
    float zw[16], za[16], gg[16], zv[16];
    { const float w0 = in[19][l * 256 + c], a0 = in[21][l * 256 + c], v0 = l > 0 ? in[24][(l - 1) * 256 + c] : 0.f;
#pragma unroll
      for (int tt = 0; tt < 16; ++tt) { zw[tt] = w0; za[tt] = a0; gg[tt] = 0.f; zv[tt] = v0; } }
    const LAS float* ph = P + half * 16 * 832;
    { const float* w2p = in[20] + (size_t)l * 4096 + c; const float* a2p = in[22] + (size_t)l * 4096 + c;
#pragma unroll 1
      for (int j4 = 0; j4 < 4; ++j4) { const float wa = w2p[(4 * j4) * 256], wb = w2p[(4 * j4 + 1) * 256], wc_ = w2p[(4 * j4 + 2) * 256], wd_ = w2p[(4 * j4 + 3) * 256];
          const float aa = a2p[(4 * j4) * 256], ab = a2p[(4 * j4 + 1) * 256], ac = a2p[(4 * j4 + 2) * 256], ad = a2p[(4 * j4 + 3) * 256];
#pragma unroll
          for (int tt = 0; tt < 16; ++tt) { const f4 sw = *(const LAS f4*)(ph + tt * 832 + 768 + 4 * j4), sa = *(const LAS f4*)(ph + tt * 832 + 784 + 4 * j4);
              zw[tt] += sw.x * wa + sw.y * wb + sw.z * wc_ + sw.w * wd_; za[tt] += sa.x * aa + sa.y * ab + sa.z * ac + sa.w * ad; } } }
    { const float* g2p = in[23] + (size_t)l * 8192 + c;
#pragma unroll 1
      for (int j4 = 0; j4 < 8; ++j4) { const float ga = g2p[(4 * j4) * 256], gb = g2p[(4 * j4 + 1) * 256], gc = g2p[(4 * j4 + 2) * 256], gd = g2p[(4 * j4 + 3) * 256];
#pragma unroll
          for (int tt = 0; tt < 16; ++tt) { const f4 sg = *(const LAS f4*)(ph + tt * 832 + 800 + 4 * j4); gg[tt] += sg.x * ga + sg.y * gb + sg.z * gc + sg.w * gd; } } }
    if (l > 0) { const float* v2p = in[26] + (size_t)(l - 1) * 2048 + c;
#pragma unroll 1
      for (int j4 = 0; j4 < 2; ++j4) { const float va = v2p[(4 * j4) * 256], vb = v2p[(4 * j4 + 1) * 256], vc = v2p[(4 * j4 + 2) * 256], vd = v2p[(4 * j4 + 3) * 256];
#pragma unroll
          for (int tt = 0; tt < 16; ++tt) { const f4 sv = *(const LAS f4*)(VV + (half * 16 + tt) * 8 + 4 * j4); zv[tt] += sv.x * va + sv.y * vb + sv.z * vc + sv.w * vd; } } }
    const float kkw = in[27][l * 256 + c], kaw = in[28][l * 256 + c], rkw = in[29][l * 256 + c];
    float* VF = (float*)(ws + WS_VFIRST);
#pragma unroll
    for (int tt = 0; tt < 16; ++tt) { const int t = half * 16 + tt; const size_t o = (size_t)(t0 + t) * 256 + c; const LAS float* pr = P + t * 832;
        const float r = pr[c], k = pr[256 + c]; float v = pr[512 + c];
        const float wd = __expf(-0.6065306597126334f * sigmoidf_(zw[tt])), av = sigmoidf_(za[tt]), g = gg[tt];
        if (l > 0) v = v + (VF[o] - v) * sigmoidf_(zv[tt]); else VF[o] = v;
        float kk = k * kkw; const float nrm = sqrtf(wave_sum(kk * kk)); kk = kk / fmaxf(nrm, 1e-12f);
        const float k2 = k * (1.f + (av - 1.f) * kaw);
        const float bon = wave_sum(r * k2 * rkw);
        ((bf16*)(ws + WS_RWR))[o] = (bf16)pk2(r, 0.f); ((bf16*)(ws + WS_RWK))[o] = (bf16)pk2(k2, 0.f); ((bf16*)(ws + WS_RWV))[o] = (bf16)pk2(v, 0.f);
        ((bf16*)(ws + WS_RWKK))[o] = (bf16)pk2(kk, 0.f); ((bf16*)(ws + WS_RWB))[o] = (bf16)pk2(kk * av, 0.f); ((bf16*)(ws + WS_RWG))[o] = (bf16)pk2(g, 0.f);
        ((float*)(ws + WS_RWW))[o] = wd;
        if (lane == 0) ((float*)(ws + WS_RWBON))[(t0 + t) * 4 + hh] = bon;
        asm volatile("" ::: "memory"); }
    __syncthreads();
}
__device__ __forceinline__ void phase_prep(const float* const* in, unsigned char* ws, int l, LAS unsigned char* lds, int tid) {
    constexpr int N_L = 512, N_R = 512, N_S = 512;
    for (int it = blockIdx.x; it < N_L + N_R + N_S; it += gridDim.x) {
        if (it < N_L) {
#ifndef SKIP_PL
            prep_lru(in, ws, l, it, lds, tid);
#endif
        } else if (it < N_L + N_R) {
#ifndef SKIP_PR
            prep_rw(in, ws, l, it - N_L, lds, tid);
#endif
        } else {
#ifndef SKIP_PS
            prep_ssd(in, ws, l, it - N_L - N_R, tid);
#endif
        }
    }
}

template <int MODE> __device__ __forceinline__ void scan_rw(unsigned char* ws, int item, LAS unsigned char* lds, int tid) {
    LAS float* LW = (LAS float*)lds; LAS float* LKK = LW + 2048; LAS float* LB = LW + 4096; LAS float* LK = LW + 6144; LAS float* LR = LW + 8192; LAS float* LV = LW + 10240; LAS float* LY = LW + 12288;
    const int bh = item / NCH, ch = item % NCH, hh = bh & 3, tokb = (bh >> 2) * SEQ + ch * CHL, nsub = CHL / 32;
    const int st = tid >> 4, sc4 = (tid & 15) * 4, row = tid >> 3, sl = tid & 7;
    const bf16* gR = (const bf16*)(ws + WS_RWR); const bf16* gK = (const bf16*)(ws + WS_RWK); const bf16* gV = (const bf16*)(ws + WS_RWV); const bf16* gKK = (const bf16*)(ws + WS_RWKK); const bf16* gB = (const bf16*)(ws + WS_RWB);
    const float* gW = (const float*)(ws + WS_RWW); bf16* gY = (bf16*)(ws + WS_YRW);
    float* gU = (float*)(ws + WS_RWU) + (size_t)item * 4096 + row * 64 + sl * 8; float* gP = (float*)(ws + WS_RWP) + (size_t)item * 4096 + row * 64 + sl * 8;
    float s[8], p[8];
    if (MODE == 1) { const f4 a = *(const f4*)gU, c = *(const f4*)(gU + 4); s[0] = a.x; s[1] = a.y; s[2] = a.z; s[3] = a.w; s[4] = c.x; s[5] = c.y; s[6] = c.z; s[7] = c.w; }
    else {
#pragma unroll
        for (int i = 0; i < 8; ++i) { s[i] = 0.f; p[i] = (sl * 8 + i == row) ? 1.f : 0.f; } }
    u2 pr, pk, pv, pkk, pb; f4 pw;
    { const size_t o = (size_t)(tokb + st) * 256 + hh * 64 + sc4; if (MODE == 1) pr = *(const u2*)(gR + o); pk = *(const u2*)(gK + o); pv = *(const u2*)(gV + o); pkk = *(const u2*)(gKK + o); pb = *(const u2*)(gB + o); pw = *(const f4*)(gW + o); }
    for (int sub = 0; sub < nsub; ++sub) {
        const int so = st * 64 + sc4;
        *(LAS f4*)(LW + so) = pw; if (MODE == 1) *(LAS f4*)(LR + so) = (f4){bflo(pr.x), bfhi(pr.x), bflo(pr.y), bfhi(pr.y)}; *(LAS f4*)(LK + so) = (f4){bflo(pk.x), bfhi(pk.x), bflo(pk.y), bfhi(pk.y)};
        *(LAS f4*)(LV + so) = (f4){bflo(pv.x), bfhi(pv.x), bflo(pv.y), bfhi(pv.y)}; *(LAS f4*)(LKK + so) = (f4){bflo(pkk.x), bfhi(pkk.x), bflo(pkk.y), bfhi(pkk.y)}; *(LAS f4*)(LB + so) = (f4){bflo(pb.x), bfhi(pb.x), bflo(pb.y), bfhi(pb.y)};
        __syncthreads();
        if (sub + 1 < nsub) { const size_t o = (size_t)(tokb + (sub + 1) * 32 + st) * 256 + hh * 64 + sc4; if (MODE == 1) pr = *(const u2*)(gR + o); pk = *(const u2*)(gK + o); pv = *(const u2*)(gV + o); pkk = *(const u2*)(gKK + o); pb = *(const u2*)(gB + o); pw = *(const f4*)(gW + o); }
        for (int t = 0; t < 32; ++t) { const int o = t * 64 + sl * 8;
            const f4 w0 = *(const LAS f4*)(LW + o), w1 = *(const LAS f4*)(LW + o + 4), a0 = *(const LAS f4*)(LKK + o), a1 = *(const LAS f4*)(LKK + o + 4), b0 = *(const LAS f4*)(LB + o), b1 = *(const LAS f4*)(LB + o + 4);
            const f4 k0 = *(const LAS f4*)(LK + o), k1 = *(const LAS f4*)(LK + o + 4); const float vv = LV[t * 64 + row];
            float dot = (s[0] * a0.x + s[1] * a0.y) + (s[2] * a0.z + s[3] * a0.w) + (s[4] * a1.x + s[5] * a1.y) + (s[6] * a1.z + s[7] * a1.w);
            if (MODE == 0) { float dp = (p[0] * a0.x + p[1] * a0.y) + (p[2] * a0.z + p[3] * a0.w) + (p[4] * a1.x + p[5] * a1.y) + (p[6] * a1.z + p[7] * a1.w);
                const float sp = -red8(dp);
                p[0] = p[0] * w0.x + sp * b0.x; p[1] = p[1] * w0.y + sp * b0.y; p[2] = p[2] * w0.z + sp * b0.z; p[3] = p[3] * w0.w + sp * b0.w;
                p[4] = p[4] * w1.x + sp * b1.x; p[5] = p[5] * w1.y + sp * b1.y; p[6] = p[6] * w1.z + sp * b1.z; p[7] = p[7] * w1.w + sp * b1.w; }
            const float sa = -red8(dot);
            s[0] = s[0] * w0.x + sa * b0.x + vv * k0.x; s[1] = s[1] * w0.y + sa * b0.y + vv * k0.y; s[2] = s[2] * w0.z + sa * b0.z + vv * k0.z; s[3] = s[3] * w0.w + sa * b0.w + vv * k0.w;
            s[4] = s[4] * w1.x + sa * b1.x + vv * k1.x; s[5] = s[5] * w1.y + sa * b1.y + vv * k1.y; s[6] = s[6] * w1.z + sa * b1.z + vv * k1.z; s[7] = s[7] * w1.w + sa * b1.w + vv * k1.w;
            if (MODE == 1) { const f4 r0 = *(const LAS f4*)(LR + o), r1 = *(const LAS f4*)(LR + o + 4);
                float y = (s[0] * r0.x + s[1] * r0.y) + (s[2] * r0.z + s[3] * r0.w) + (s[4] * r1.x + s[5] * r1.y) + (s[6] * r1.z + s[7] * r1.w);
                y = red8(y);
                if (sl == 0) LY[t * 64 + row] = y; } }
        __syncthreads();
        if (MODE == 1) { const f4 y = *(const LAS f4*)(LY + so); u2 w; w.x = pk2(y.x, y.y); w.y = pk2(y.z, y.w); *(u2*)(gY + (size_t)(tokb + sub * 32 + st) * 256 + hh * 64 + sc4) = w; }
    }
    if (MODE == 0) { *(f4*)gU = (f4){s[0], s[1], s[2], s[3]}; *(f4*)(gU + 4) = (f4){s[4], s[5], s[6], s[7]}; *(f4*)gP = (f4){p[0], p[1], p[2], p[3]}; *(f4*)(gP + 4) = (f4){p[4], p[5], p[6], p[7]}; }
    __syncthreads();
}
__device__ __forceinline__ void combine_rw(unsigned char* ws, int bh, LAS unsigned char* lds, int tid) {
    LAS float* LP = (LAS float*)lds; LAS float* LS = LP + 4096;
    const int row = tid >> 3, sl = tid & 7; float s[8];
#pragma unroll
    for (int i = 0; i < 8; ++i) s[i] = 0.f;
    const float* gP = (const float*)(ws + WS_RWP) + (size_t)bh * NCH * 4096; float* gU = (float*)(ws + WS_RWU) + (size_t)bh * NCH * 4096 + row * 64 + sl * 8;
    f4 q0 = *(const f4*)(gP + tid * 8), q1 = *(const f4*)(gP + tid * 8 + 4), u0 = *(const f4*)gU, u1 = *(const f4*)(gU + 4);
    for (int c = 0; c < NCH; ++c) {
        *(LAS f4*)(LP + tid * 8) = q0; *(LAS f4*)(LP + tid * 8 + 4) = q1;
        *(LAS f4*)(LS + row * 68 + sl * 8) = (f4){s[0], s[1], s[2], s[3]}; *(LAS f4*)(LS + row * 68 + sl * 8 + 4) = (f4){s[4], s[5], s[6], s[7]};
        *(f4*)(gU + (size_t)c * 4096) = (f4){s[0], s[1], s[2], s[3]}; *(f4*)(gU + (size_t)c * 4096 + 4) = (f4){s[4], s[5], s[6], s[7]};
        float n[8] = {u0.x, u0.y, u0.z, u0.w, u1.x, u1.y, u1.z, u1.w};
        __syncthreads();
        if (c + 1 < NCH) { q0 = *(const f4*)(gP + (size_t)(c + 1) * 4096 + tid * 8); q1 = *(const f4*)(gP + (size_t)(c + 1) * 4096 + tid * 8 + 4); u0 = *(const f4*)(gU + (size_t)(c + 1) * 4096); u1 = *(const f4*)(gU + (size_t)(c + 1) * 4096 + 4); }
#pragma unroll 4
        for (int i4 = 0; i4 < 16; ++i4) { const f4 sv = *(const LAS f4*)(LS + row * 68 + 4 * i4); const float se[4] = {sv.x, sv.y, sv.z, sv.w};
#pragma unroll
            for (int e = 0; e < 4; ++e) { const f4 pa = *(const LAS f4*)(LP + (4 * i4 + e) * 64 + sl * 8), pb = *(const LAS f4*)(LP + (4 * i4 + e) * 64 + sl * 8 + 4);
                n[0] += se[e] * pa.x; n[1] += se[e] * pa.y; n[2] += se[e] * pa.z; n[3] += se[e] * pa.w; n[4] += se[e] * pb.x; n[5] += se[e] * pb.y; n[6] += se[e] * pb.z; n[7] += se[e] * pb.w; } }
#pragma unroll
        for (int i = 0; i < 8; ++i) s[i] = n[i];
        __syncthreads();
    }
}
template <int MODE> __device__ __forceinline__ void scan_gla(const float* const* in, unsigned char* ws, int l, int item, LAS unsigned char* lds, int tid) {
    LAS float* LA = (LAS float*)lds; LAS float* LK = LA + 1024; LAS float* LQ = LA + 2048; LAS float* LV = LA + 3072; LAS float* LO = LA + 5120;
    const bf16* PROJ = (const bf16*)(ws + WS_PROJ); bf16* gO = (bf16*)(ws + WS_OGLA);
    const int bh = item / NCH, ch = item % NCH, hh = bh & 3, tokb = (bh >> 2) * SEQ + ch * CHL, nsub = CHL / 32;
    const int st = tid >> 4, si = tid & 15, vcol = tid >> 3, sl = tid & 7;
    float up0[16], up1[16];
#pragma unroll
    for (int r = 0; r < 16; ++r) { up0[r] = in[8][(l * 16 + r) * 128 + hh * 32 + 2 * si]; up1[r] = in[8][(l * 16 + r) * 128 + hh * 32 + 2 * si + 1]; }
    const float bi0 = in[9][l * 128 + hh * 32 + 2 * si], bi1 = in[9][l * 128 + hh * 32 + 2 * si + 1];
    float* gU = (float*)(ws + WS_GLU) + (size_t)item * 2048 + vcol * 32 + 4 * sl;
    float s[4] = {0.f, 0.f, 0.f, 0.f}, dp[4] = {1.f, 1.f, 1.f, 1.f};
    if (MODE == 1) { const f4 a = *(const f4*)gU; s[0] = a.x; s[1] = a.y; s[2] = a.z; s[3] = a.w; }
    u4 ps0, ps1; unsigned pq = 0, pk; u2 pv;
    { const bf16* p = PROJ + (size_t)(tokb + st) * NINP; ps0 = *(const u4*)(p + PC_GSTEM); ps1 = *(const u4*)(p + PC_GSTEM + 8); if (MODE == 1) pq = *(const unsigned*)(p + PC_GQ + hh * 32 + 2 * si); pk = *(const unsigned*)(p + PC_GK + hh * 32 + 2 * si); pv = *(const u2*)(p + PC_GV + hh * 64 + 4 * si); }
    for (int sub = 0; sub < nsub; ++sub) {
        { const unsigned sw[8] = {ps0.x, ps0.y, ps0.z, ps0.w, ps1.x, ps1.y, ps1.z, ps1.w}; float z0 = bi0, z1 = bi1;
#pragma unroll
          for (int r = 0; r < 8; ++r) { const float e0 = bflo(sw[r]), e1 = bfhi(sw[r]); z0 += e0 * up0[2 * r] + e1 * up0[2 * r + 1]; z1 += e0 * up1[2 * r] + e1 * up1[2 * r + 1]; }
          const float l0 = fminf(z0, 0.f) - log1pf(__expf(-fabsf(z0))), l1 = fminf(z1, 0.f) - log1pf(__expf(-fabsf(z1)));
          const int o = st * 32 + 2 * si; LA[o] = __expf(l0 * 0.0625f); LA[o + 1] = __expf(l1 * 0.0625f); LK[o] = bflo(pk); LK[o + 1] = bfhi(pk); if (MODE == 1) { LQ[o] = bflo(pq); LQ[o + 1] = bfhi(pq); }
          *(LAS f4*)(LV + st * 64 + 4 * si) = (f4){bflo(pv.x), bfhi(pv.x), bflo(pv.y), bfhi(pv.y)}; }
        __syncthreads();
        if (sub + 1 < nsub) { const bf16* p = PROJ + (size_t)(tokb + (sub + 1) * 32 + st) * NINP; ps0 = *(const u4*)(p + PC_GSTEM); ps1 = *(const u4*)(p + PC_GSTEM + 8); if (MODE == 1) pq = *(const unsigned*)(p + PC_GQ + hh * 32 + 2 * si); pk = *(const unsigned*)(p + PC_GK + hh * 32 + 2 * si); pv = *(const u2*)(p + PC_GV + hh * 64 + 4 * si); }
        for (int t = 0; t < 32; ++t) { const f4 al = *(const LAS f4*)(LA + t * 32 + 4 * sl), kk = *(const LAS f4*)(LK + t * 32 + 4 * sl); const float vv = LV[t * 64 + vcol];
            s[0] = s[0] * al.x + kk.x * vv; s[1] = s[1] * al.y + kk.y * vv; s[2] = s[2] * al.z + kk.z * vv; s[3] = s[3] * al.w + kk.w * vv;
            if (MODE == 0) { dp[0] *= al.x; dp[1] *= al.y; dp[2] *= al.z; dp[3] *= al.w; }
            else { const f4 qq = *(const LAS f4*)(LQ + t * 32 + 4 * sl); float o = (s[0] * qq.x + s[1] * qq.y) + (s[2] * qq.z + s[3] * qq.w); o = red8(o);
                if (sl == 0) LO[t * 64 + vcol] = o * 0.17677669529663687f; } }
        __syncthreads();
        if (MODE == 1) { const f4 y = *(const LAS f4*)(LO + st * 64 + 4 * si); u2 w; w.x = pk2(y.x, y.y); w.y = pk2(y.z, y.w); *(u2*)(gO + (size_t)(tokb + sub * 32 + st) * 256 + hh * 64 + 4 * si) = w; }
    }
    if (MODE == 0) { *(f4*)gU = (f4){s[0], s[1], s[2], s[3]}; if (vcol == 0) *(f4*)((float*)(ws + WS_GLD) + item * 32 + 4 * sl) = (f4){dp[0], dp[1], dp[2], dp[3]}; }
    __syncthreads();
}
template <int MODE> __device__ __forceinline__ void scan_ssd(unsigned char* ws, int item, LAS unsigned char* lds, int tid) {
    LAS float* LB = (LAS float*)lds; LAS float* LC = LB + 4096; LAS float* LX = LB + 8192; LAS float* LD = LB + 10240; LAS float* LY = LB + 10304;
    const bf16* XBC = (const bf16*)(ws + WS_XBC); const float* DT = (const float*)(ws + WS_DT); const float* DEC = (const float*)(ws + WS_DEC); bf16* gY = (bf16*)(ws + WS_YSSD);
    const int bh = item / NCH, ch = item % NCH, hh = bh & 3, tokb = (bh >> 2) * SEQ + ch * CHL, nsub = CHL / 32;
    const int st = tid >> 4, si = tid & 15, p = tid >> 3, sl = tid & 7, g = hh >> 1;
    float* gU = (float*)(ws + WS_SSU) + (size_t)item * 8192 + p * 128 + 16 * sl;
    float s[16]; float dprod = 1.f;
#pragma unroll
    for (int i = 0; i < 4; ++i) { f4 a = (f4){0.f, 0.f, 0.f, 0.f}; if (MODE == 1) a = *(const f4*)(gU + 4 * i); s[4 * i] = a.x; s[4 * i + 1] = a.y; s[4 * i + 2] = a.z; s[4 * i + 3] = a.w; }
    u4 pb, pc = (u4){0u, 0u, 0u, 0u}; u2 px; float pdt, pdec;
    { const size_t tok = tokb + st; const bf16* q = XBC + tok * 768; pb = *(const u4*)(q + 256 + g * 128 + 8 * si); if (MODE == 1) pc = *(const u4*)(q + 512 + g * 128 + 8 * si); px = *(const u2*)(q + hh * 64 + 4 * si); pdt = DT[tok * 4 + hh]; pdec = DEC[tok * 4 + hh]; }
    for (int sub = 0; sub < nsub; ++sub) {
        { const int o = st * 128 + 8 * si;
          *(LAS f4*)(LB + o) = (f4){bflo(pb.x), bfhi(pb.x), bflo(pb.y), bfhi(pb.y)}; *(LAS f4*)(LB + o + 4) = (f4){bflo(pb.z), bfhi(pb.z), bflo(pb.w), bfhi(pb.w)};
          if (MODE == 1) { *(LAS f4*)(LC + o) = (f4){bflo(pc.x), bfhi(pc.x), bflo(pc.y), bfhi(pc.y)}; *(LAS f4*)(LC + o + 4) = (f4){bflo(pc.z), bfhi(pc.z), bflo(pc.w), bfhi(pc.w)}; }
          *(LAS f4*)(LX + st * 64 + 4 * si) = (f4){bflo(px.x) * pdt, bfhi(px.x) * pdt, bflo(px.y) * pdt, bfhi(px.y) * pdt};
          if (si == 0) LD[st] = pdec; }
        __syncthreads();
        if (sub + 1 < nsub) { const size_t tok = tokb + (sub + 1) * 32 + st; const bf16* q = XBC + tok * 768; pb = *(const u4*)(q + 256 + g * 128 + 8 * si); if (MODE == 1) pc = *(const u4*)(q + 512 + g * 128 + 8 * si); px = *(const u2*)(q + hh * 64 + 4 * si); pdt = DT[tok * 4 + hh]; pdec = DEC[tok * 4 + hh]; }
        for (int t = 0; t < 32; ++t) { const float xv = LX[t * 64 + p], dc = LD[t]; float y = 0.f;
            if (MODE == 0) dprod *= dc;
#pragma unroll
            for (int q4 = 0; q4 < 4; ++q4) { const f4 bb = *(const LAS f4*)(LB + t * 128 + 16 * sl + 4 * q4);
                s[4 * q4] = s[4 * q4] * dc + bb.x * xv; s[4 * q4 + 1] = s[4 * q4 + 1] * dc + bb.y * xv; s[4 * q4 + 2] = s[4 * q4 + 2] * dc + bb.z * xv; s[4 * q4 + 3] = s[4 * q4 + 3] * dc + bb.w * xv;
                if (MODE == 1) { const f4 cc = *(const LAS f4*)(LC + t * 128 + 16 * sl + 4 * q4); y += (s[4 * q4] * cc.x + s[4 * q4 + 1] * cc.y) + (s[4 * q4 + 2] * cc.z + s[4 * q4 + 3] * cc.w); } }
            if (MODE == 1) { y = red8(y); if (sl == 0) LY[t * 64 + p] = y; } }
        __syncthreads();
        if (MODE == 1) { const f4 y = *(const LAS f4*)(LY + st * 64 + 4 * si); u2 w; w.x = pk2(y.x, y.y); w.y = pk2(y.z, y.w); *(u2*)(gY + (size_t)(tokb + sub * 32 + st) * 256 + hh * 64 + 4 * si) = w; }
    }
    if (MODE == 0) {
#pragma unroll
        for (int i = 0; i < 4; ++i) *(f4*)(gU + 4 * i) = (f4){s[4 * i], s[4 * i + 1], s[4 * i + 2], s[4 * i + 3]};
        if (tid == 0) ((float*)(ws + WS_SSD))[item] = dprod; }
    __syncthreads();
}
__device__ __forceinline__ void scan_lru_carry(unsigned char* ws, int tid) {
    const float* SA = (const float*)(ws + WS_SEGA); const float* SH = (const float*)(ws + WS_SEGH); float* CY = (float*)(ws + WS_CARRY);
    const int b = tid >> 8, c = tid & 255; float h = 0.f;
#pragma unroll 8
    for (int sg = 0; sg < 256; ++sg) { const int o = (b * 256 + sg) * 256 + c; CY[o] = h; h = SA[o] * h + SH[o]; }
}
__device__ __forceinline__ void combine_gla(unsigned char* ws, int bh, int tid) {
    float* gU = (float*)(ws + WS_GLU) + (size_t)bh * NCH * 2048 + tid * 4; const float* gD = (const float*)(ws + WS_GLD) + bh * NCH * 32 + (tid & 7) * 4; f4 s = (f4){0.f, 0.f, 0.f, 0.f};
#pragma unroll 4
    for (int c = 0; c < NCH; ++c) { const f4 u = *(const f4*)(gU + (size_t)c * 2048), d = *(const f4*)(gD + c * 32); *(f4*)(gU + (size_t)c * 2048) = s; s = s * d + u; }
}
__device__ __forceinline__ void combine_ssd(unsigned char* ws, int q, int tid) {
    const int bh = q >> 2; float* gU = (float*)(ws + WS_SSU) + (size_t)bh * NCH * 8192 + (q & 3) * 2048 + tid * 4; const float* gD = (const float*)(ws + WS_SSD) + bh * NCH; f4 s = (f4){0.f, 0.f, 0.f, 0.f};
#pragma unroll 4
    for (int c = 0; c < NCH; ++c) { const f4 u = *(const f4*)(gU + (size_t)c * 8192); const float d = gD[c]; *(f4*)(gU + (size_t)c * 8192) = s; s = s * d + u; }
}
template <int MODE> __device__ __forceinline__ void phase_scan(const float* const* in, unsigned char* ws, int l, LAS unsigned char* lds, int tid) {
    constexpr int NI = 8 * NCH;
    for (int it = blockIdx.x; it < 3 * NI + (MODE == 0 ? 1 : 0); it += gridDim.x) {
        if (it < NI) scan_rw<MODE>(ws, it, lds, tid);
        else if (it < 2 * NI) scan_ssd<MODE>(ws, it - NI, lds, tid);
        else if (it < 3 * NI) scan_gla<MODE>(in, ws, l, it - 2 * NI, lds, tid);
        else scan_lru_carry(ws, tid);
    }
}
__device__ __forceinline__ void phase_combine(unsigned char* ws, LAS unsigned char* lds, int tid) {
    for (int it = blockIdx.x; it < 48; it += gridDim.x) {
        if (it < 8) combine_rw(ws, it, lds, tid);
        else if (it < 16) combine_gla(ws, it - 8, tid);
        else combine_ssd(ws, it - 16, tid);
    }
}
__device__ __forceinline__ float red16(float x) { x += __shfl_xor(x, 1); x += __shfl_xor(x, 2); x += __shfl_xor(x, 4); x += __shfl_xor(x, 8); return x; }
__device__ __forceinline__ void phase_post(const float* const* in, unsigned char* ws, int l, int gw, int NGW, int lane) {
    const bf16* PROJ = (const bf16*)(ws + WS_PROJ); bf16* Y = (bf16*)(ws + WS_Y); const int c = 4 * lane, hh = lane >> 4;
    const f4 gnorm = *(const f4*)(in[10] + l * 64 + (c & 63)), gnw = *(const f4*)(in[30] + l * 256 + c), gnb = *(const f4*)(in[31] + l * 256 + c), snw = *(const f4*)(in[37] + l * 256 + c);
    const float dsk = in[36][l * 4 + hh];
    for (int tok = gw; tok < M; tok += NGW) { const bf16* pp = PROJ + (size_t)tok * NINP; const size_t o = (size_t)tok * 256 + c; bf16* yo = Y + (size_t)tok * D + c;
        { const u2 ov = *(const u2*)((const bf16*)(ws + WS_OGLA) + o), gv = *(const u2*)(pp + PC_GG + c);
          const float o0 = bflo(ov.x), o1 = bfhi(ov.x), o2 = bflo(ov.y), o3 = bfhi(ov.y);
          const float rs = rsqrtf(red16((o0 * o0 + o1 * o1) + (o2 * o2 + o3 * o3)) * (1.f / 64.f) + 1e-5f);
          u2 w; w.x = pk2(o0 * rs * gnorm.x * siluf_(bflo(gv.x)), o1 * rs * gnorm.y * siluf_(bfhi(gv.x))); w.y = pk2(o2 * rs * gnorm.z * siluf_(bflo(gv.y)), o3 * rs * gnorm.w * siluf_(bfhi(gv.y))); *(u2*)(yo) = w; }
        { const f4 A = *(const f4*)((const float*)(ws + WS_LRA) + o), H = *(const f4*)((const float*)(ws + WS_LRH) + o), cy = *(const f4*)((const float*)(ws + WS_CARRY) + (size_t)(tok >> 5) * 256 + c);
          const u2 gv = *(const u2*)(pp + PC_LG + c);
          u2 w; w.x = pk2((H.x + A.x * cy.x) * gelu_tanh(bflo(gv.x)), (H.y + A.y * cy.y) * gelu_tanh(bfhi(gv.x))); w.y = pk2((H.z + A.z * cy.z) * gelu_tanh(bflo(gv.y)), (H.w + A.w * cy.w) * gelu_tanh(bfhi(gv.y))); *(u2*)(yo + 256) = w; }
        { const u2 yv = *(const u2*)((const bf16*)(ws + WS_YRW) + o), vv = *(const u2*)((const bf16*)(ws + WS_RWV) + o), gv = *(const u2*)((const bf16*)(ws + WS_RWG) + o);
          const float bon = ((const float*)(ws + WS_RWBON))[tok * 4 + hh];
          float y0 = bflo(yv.x), y1 = bfhi(yv.x), y2 = bflo(yv.y), y3 = bfhi(yv.y);
          const float mean = red16((y0 + y1) + (y2 + y3)) * (1.f / 64.f); y0 -= mean; y1 -= mean; y2 -= mean; y3 -= mean;
          const float rs = rsqrtf(red16((y0 * y0 + y1 * y1) + (y2 * y2 + y3 * y3)) * (1.f / 64.f) + 64e-5f);
          u2 w; w.x = pk2((y0 * rs * gnw.x + gnb.x + bon * bflo(vv.x)) * bflo(gv.x), (y1 * rs * gnw.y + gnb.y + bon * bfhi(vv.x)) * bfhi(gv.x));
          w.y = pk2((y2 * rs * gnw.z + gnb.z + bon * bflo(vv.y)) * bflo(gv.y), (y3 * rs * gnw.w + gnb.w + bon * bfhi(vv.y)) * bfhi(gv.y)); *(u2*)(yo + 512) = w; }
        { const u2 yv = *(const u2*)((const bf16*)(ws + WS_YSSD) + o), xv = *(const u2*)((const bf16*)(ws + WS_XBC) + (size_t)tok * 768 + c), zv = *(const u2*)(pp + PC_SZ + c);
          const float y0 = (bflo(yv.x) + dsk * bflo(xv.x)) * siluf_(bflo(zv.x)), y1 = (bfhi(yv.x) + dsk * bfhi(xv.x)) * siluf_(bfhi(zv.x)), y2 = (bflo(yv.y) + dsk * bflo(xv.y)) * siluf_(bflo(zv.y)), y3 = (bfhi(yv.y) + dsk * bfhi(xv.y)) * siluf_(bfhi(zv.y));
          float q = red16((y0 * y0 + y1 * y1) + (y2 * y2 + y3 * y3)); q += __shfl_xor(q, 16);
          const float rs = rsqrtf(q * (1.f / 128.f) + 1e-5f);
          u2 w; w.x = pk2(y0 * rs * snw.x, y1 * rs * snw.y); w.y = pk2(y2 * rs * snw.z, y3 * rs * snw.w); *(u2*)(yo + 768) = w; }
    }
}
#ifndef PROBE_GEMM
#define PROBE_GEMM 1
#endif
#ifndef PROBE_SCAN
#define PROBE_SCAN 1
#endif
#ifndef PROBE_MISC
#define PROBE_MISC 1
#endif
struct Args { const float* in[43]; float* out; unsigned char* ws; };
template <class Epi> __device__ __forceinline__ void gemm_multi(LAS unsigned char* lds, const pg8::Gemm& g, const Epi& E) {
    pg8::StaticOrder S; S.init(g.M, g.N, (int)gridDim.x, (int)blockIdx.x);
    pg8::gemm_phase<Epi, pg8::StaticOrder, true, true>(lds, g, S, E);
}
template <class Epi> __device__ __forceinline__ void gemm_single(LAS unsigned char* lds, const pg8::Gemm& g, const Epi& E) {
    pg8::StaticOrder S; S.init(g.M, g.N, (int)gridDim.x, (int)blockIdx.x);
    for (int r = 0;; ++r) { pg8::Unit u; if (!S.next(r, u)) break; OneUnit O{S, r}; pg8::gemm_phase<Epi, OneUnit, false, true>(lds, g, O, E); }
}
__global__ void __launch_bounds__(512, 2) fwd(Args a) {
    extern __shared__ __attribute__((aligned(16))) unsigned char lds_raw[];
    LAS unsigned char* lds = (LAS unsigned char*)lds_raw;
    cg::grid_group grid = cg::this_grid();
    unsigned* ctl = (unsigned*)(a.ws + WS_CTL); volatile LAS unsigned* MISC = (volatile LAS unsigned*)(lds + LDS_BYTES - 64);
    if (blockIdx.x == 0) for (int i = threadIdx.x; i < XCD_BAR_WORDS; i += 512) __hip_atomic_store(ctl + i, 0u, __ATOMIC_RELAXED, __HIP_MEMORY_SCOPE_AGENT);
    if (threadIdx.x < 2) MISC[threadIdx.x] = 0u;
    __threadfence();
    grid.sync();
    const XcdBarrier bar = xcd_barrier_post(ctl, MISC);
#define TIDS int tid = threadIdx.x; asm volatile("" : "+v"(tid)); const int lane = tid & 63, wave = __builtin_amdgcn_readfirstlane(tid >> 6), gw = blockIdx.x * 8 + wave, NGW = gridDim.x * 8; (void)lane; (void)gw; (void)NGW;
    unsigned char* ws = a.ws; const float* const* in = a.in; float* X = a.out;
    bf16* XB = (bf16*)(ws + WS_XB); bf16* Y = (bf16*)(ws + WS_Y); bf16* H = (bf16*)(ws + WS_PROJ); bf16* PROJ = (bf16*)(ws + WS_PROJ); float* SS = (float*)(ws + WS_SS);
#pragma unroll 1
    for (int l = 0; l < NL; ++l) {
        for (int rep = 0; rep < PROBE_MISC; ++rep) { TIDS
#ifndef SKIP_CONV
        phase_convert(in, ws, l, lds, gw, NGW, wave, lane);
#endif
        if (l == 0) phase_init_rows(in[0], XB, SS, gw, NGW, lane); }
        xcd_barrier(bar);
#ifndef SKIP_G1
        for (int rep = 0; rep < PROBE_GEMM; ++rep) { pg8::Gemm g{XB, (const bf16*)(ws + WS_WGU1), M, 2 * FF, D}; EpiGU E{H, SS}; gemm_single(lds, g, E); }
#endif
        xcd_barrier(bar);
#ifndef SKIP_G2
        { pg8::Gemm g{H, (const bf16*)(ws + WS_WD1), M, D, FF}; EpiResid E{l == 0 ? in[0] : X, X, XB, SS, 0.5f}; gemm_single(lds, g, E); }
#endif
        xcd_barrier(bar);
#ifndef SKIP_G3
        for (int rep = 0; rep < PROBE_GEMM; ++rep) { pg8::Gemm g{XB, (const bf16*)(ws + WS_WIN), M, NINP, D}; EpiProj E{PROJ, SS}; gemm_single(lds, g, E); }
#endif
        xcd_barrier(bar);
#ifndef SKIP_PREP
        for (int rep = 0; rep < PROBE_MISC; ++rep) { TIDS phase_prep(in, ws, l, lds, tid); }
#endif
        xcd_barrier(bar);
#ifndef SKIP_SCAN
        for (int rep = 0; rep < PROBE_SCAN; ++rep) { TIDS phase_scan<0>(in, ws, l, lds, tid); }
        xcd_barrier(bar);
        { TIDS phase_combine(ws, lds, tid); }
        xcd_barrier(bar);
        for (int rep = 0; rep < PROBE_SCAN; ++rep) { TIDS phase_scan<1>(in, ws, l, lds, tid); }
#endif
        xcd_barrier(bar);
#ifndef SKIP_POST
        for (int rep = 0; rep < PROBE_MISC; ++rep) { TIDS phase_post(in, ws, l, gw, NGW, lane); }
#endif
        xcd_barrier(bar);
#ifndef SKIP_G4
        { pg8::Gemm g{Y, (const bf16*)(ws + WS_WOUT), M, D, D}; EpiResid E{X, X, XB, SS, 1.0f}; gemm_single(lds, g, E); }
#endif
        xcd_barrier(bar);
#ifndef SKIP_G5
        for (int rep = 0; rep < PROBE_GEMM; ++rep) { pg8::Gemm g{XB, (const bf16*)(ws + WS_WGU2), M, 2 * FF, D}; EpiGU E{H, SS}; gemm_single(lds, g, E); }
#endif
        xcd_barrier(bar);
#ifndef SKIP_G6
        { pg8::Gemm g{H, (const bf16*)(ws + WS_WD2), M, D, FF}; EpiResid E{X, X, XB, SS, 0.5f}; gemm_single(lds, g, E); }
#endif
        xcd_barrier(bar);
    }
    { TIDS phase_final(X, in[42], gw, NGW, lane); }
}

extern "C" void kernel_launch(void* const* d_in, const int* in_sizes, int n_in, void* d_out, int out_size, void* d_ws, size_t ws_size, hipStream_t stream) {
    static int grid = 0;
    if (grid == 0) {
        int dev = 0, cus = 0, per_cu = 0;
        (void)hipGetDevice(&dev);
        (void)hipDeviceGetAttribute(&cus, hipDeviceAttributeMultiprocessorCount, dev);
        (void)hipFuncSetAttribute((const void*)fwd, hipFuncAttributeMaxDynamicSharedMemorySize, LDS_BYTES);
        (void)hipOccupancyMaxActiveBlocksPerMultiprocessor(&per_cu, (const void*)fwd, 512, LDS_BYTES);
        if (per_cu < 1) per_cu = 1;
        grid = cus * per_cu;
        if (n_in != 43 || out_size != M * D || ws_size < WS_END) fprintf(stderr, "kernel_launch: unexpected sizes n_in %d out %d ws %zu (need %zu)\n", n_in, out_size, ws_size, (size_t)WS_END);
    }
    Args a{};
    for (int i = 0; i < 43 && i < n_in; ++i) a.in[i] = (const float*)d_in[i];
    a.out = (float*)d_out; a.ws = (unsigned char*)d_ws;
    void* args[] = {&a};
    hipError_t e = hipLaunchCooperativeKernel((const void*)fwd, dim3(grid), dim3(512), args, LDS_BYTES, stream);
    if (e != hipSuccess) fprintf(stderr, "cooperative launch failed: %s (grid %d)\n", hipGetErrorString(e), grid);
}
```

```cpp
#include <hip/hip_runtime.h>
#include <hip/hip_cooperative_groups.h>
#include <cstdio>
#include <cstdint>
namespace cg = cooperative_groups;
namespace pg8 {
#define PG8_LAS __attribute__((address_space(3)))
typedef unsigned short bf16_t;
typedef short bf16x8 __attribute__((ext_vector_type(8)));
typedef float f32x4 __attribute__((ext_vector_type(4)));
typedef unsigned u32x4 __attribute__((ext_vector_type(4)));
constexpr int BM = 256, BK = 64, HALF = 128, HTB = HALF * BK * 2  , STAGE_BYTES = 8 * HTB, NXCD = 8, WGM = 8;

__host__ __device__ __forceinline__ int lds_byte(int r, int c) { const int st = (r >> 4) * 2 + (c >> 5), rr = r & 15, cc = c & 31, ob = rr * 64 + cc * 2; return st * 1024 + (ob ^ (((ob >> 9) & 1) << 5)); }
__host__ __device__ __forceinline__ void stage_rc(int b, int& R, int& C) { const int st = b / 1024, sb = b % 1024, swz = sb ^ (((sb >> 9) & 1) << 5); R = (st >> 1) * 16 + swz / 64; C = (st & 1) * 32 + (swz % 64) / 2; }
__host__ __device__ __forceinline__ int perm32(int rho) { const int n = rho >> 4, i = rho & 15; return 8 * (i >> 2) + 4 * n + (i & 3); }

struct Unit { int pm, pn; };
struct Gemm { const bf16_t* A; const bf16_t* Bt; int M, N, K; };

struct StaticOrder {
    int nM, nN, nwg, G, c;
    __host__ __device__ void init(int M, int N, int G_, int c_) { nM = M / BM; nN = N / BM; nwg = nM * nN; G = G_; c = c_; }
    __host__ __device__ bool next(int i, Unit& u) const {
        const long L = (long)i * G + c; if (L >= nwg) return false;
        int wgid = (int)L; { const int q = nwg / NXCD, r = nwg % NXCD, xcd = wgid % NXCD, off = wgid / NXCD; wgid = (xcd < r ? xcd * (q + 1) : r * (q + 1) + (xcd - r) * q) + off; }
        const int nig = WGM * nN, gid = wgid / nig, fm = gid * WGM, gsz = (nM - fm) < WGM ? (nM - fm) : WGM;
        u.pm = fm + ((wgid % nig) % gsz); u.pn = (wgid % nig) / gsz; return true;
    }
    __device__ __forceinline__ void a_ready(const Unit&) const {}
    __device__ __forceinline__ void done(const Unit&) const {}
};

__device__ __forceinline__ unsigned cvt_pk_bf16(float lo, float hi) { unsigned r; asm volatile("v_cvt_pk_bf16_f32 %0, %1, %2" : "=v"(r) : "v"(lo), "v"(hi)); return r; }
typedef float f32x2 __attribute__((ext_vector_type(2)));
template <class Epi, class Sched, bool ALIGN_EPI = false, bool SP2 = false>
__device__ __forceinline__ void gemm_phase(PG8_LAS unsigned char* lds, const Gemm g, const Sched& S, const Epi& E) {
    int tid_ = threadIdx.x; asm volatile("" : "+v"(tid_));
    const int tid = tid_, wid = __builtin_amdgcn_readfirstlane(tid >> 6), lane = tid & 63, wr = wid >> 2, wc = wid & 3, fr = lane & 15, fq = lane >> 4;
    const int K = g.K, nt = K / BK;
    unsigned voffA[2], voffB[2];
#pragma unroll
    for (int i = 0; i < 2; ++i) { int R, C; stage_rc(tid * 16 + i * 8192, R, C); const int Rb = Epi::PERM ? ((R & ~31) + perm32(R & 31)) : R;
        voffA[i] = (unsigned)(R * K + C) * 2u; voffB[i] = (unsigned)(Rb * K + C) * 2u; }
    const size_t kstep = (size_t)(BK * 2);
    const size_t hstep = (size_t)HALF * K * 2;
    const size_t tstep = 2 * hstep;
    const unsigned ldsw = (unsigned)wid * 1024u;
    const int aoff = lds_byte(wr * 64 + fr, fq * 8), boff = lds_byte(wc * 32 + fr, fq * 8);
#define PG8_SA(b, h) (((b) * 2 + (h)) * HTB)
#define PG8_SB(b, h) ((4 + (b) * 2 + (h)) * HTB)
#define PG8_STAGE(bufoff, gbase, voff) do { _Pragma("unroll") for (int _i = 0; _i < 2; ++_i) \
        __builtin_amdgcn_global_load_lds((const unsigned*)((const char*)(gbase) + (voff)[_i]), (PG8_LAS unsigned*)(lds + (bufoff) + ldsw + _i * 8192), 16, 0, 0); } while (0)
#define PG8_LDA(dst, b, h) do { _Pragma("unroll") for (int m = 0; m < 4; ++m) _Pragma("unroll") for (int k = 0; k < 2; ++k) dst[m][k] = *(const PG8_LAS bf16x8*)(lds + PG8_SA(b, h) + aoff + m * 2048 + k * 1024); } while (0)
#define PG8_LDB(dst, b, h) do { _Pragma("unroll") for (int n = 0; n < 2; ++n) _Pragma("unroll") for (int k = 0; k < 2; ++k) dst[n][k] = *(const PG8_LAS bf16x8*)(lds + PG8_SB(b, h) + boff + n * 2048 + k * 1024); } while (0)
#define PG8_MMA(ai, bj, At, Bt) do { __builtin_amdgcn_s_setprio(1); _Pragma("unroll") for (int m = 0; m < 4; ++m) _Pragma("unroll") for (int n = 0; n < 2; ++n) _Pragma("unroll") for (int k = 0; k < 2; ++k) \
        acc[ai][bj][m][n] = __builtin_amdgcn_mfma_f32_16x16x32_bf16(Bt[n][k], At[m][k], acc[ai][bj][m][n], 0, 0, 0); __builtin_amdgcn_s_setprio(0); } while (0)
#define PG8_WAIT_V(n) asm volatile("s_waitcnt vmcnt(" #n ")" ::: "memory")
#define PG8_WAIT_L(n) asm volatile("s_waitcnt lgkmcnt(" #n ")" ::: "memory")
#define PG8_BAR __builtin_amdgcn_s_barrier()
#define PG8_SCHED __builtin_amdgcn_sched_barrier(0)
    Unit cur, nxt; int ui = 0;
    if (!S.next(0, cur)) return;
    f32x4 acc[2][2][4][2];
#pragma unroll
    for (int a = 0; a < 2; ++a)
#pragma unroll
        for (int b = 0; b < 2; ++b)
#pragma unroll
            for (int m = 0; m < 4; ++m)
#pragma unroll
                for (int n = 0; n < 2; ++n) acc[a][b][m][n] = (f32x4){0.f, 0.f, 0.f, 0.f};
    bf16x8 At[4][2], B0[2][2], B1[2][2];
    const char* cA = (const char*)g.A + (size_t)cur.pm * tstep; const char* cB = (const char*)g.Bt + (size_t)cur.pn * tstep;
    S.a_ready(cur);
    if constexpr (SP2) {
        PG8_STAGE(PG8_SB(0, 0), cB, voffB); PG8_STAGE(PG8_SB(0, 1), cB + hstep, voffB); PG8_STAGE(PG8_SA(0, 0), cA, voffA); PG8_STAGE(PG8_SA(0, 1), cA + hstep, voffA);
        if (wr == 1) PG8_BAR;
        PG8_WAIT_V(2); PG8_BAR;
        PG8_STAGE(PG8_SB(1, 0), cB + kstep, voffB); PG8_STAGE(PG8_SA(1, 0), cA + kstep, voffA); PG8_STAGE(PG8_SB(1, 1), cB + hstep + kstep, voffB);
        PG8_WAIT_V(6); PG8_BAR;
    } else {
        PG8_STAGE(PG8_SB(0, 0), cB, voffB); PG8_STAGE(PG8_SA(0, 0), cA, voffA); PG8_STAGE(PG8_SB(0, 1), cB + hstep, voffB); PG8_STAGE(PG8_SA(0, 1), cA + hstep, voffA);
        if (wr == 1) PG8_BAR;
        PG8_WAIT_V(4); PG8_BAR;
        PG8_STAGE(PG8_SB(1, 0), cB + kstep, voffB); PG8_STAGE(PG8_SA(1, 0), cA + kstep, voffA); PG8_STAGE(PG8_SB(1, 1), cB + hstep + kstep, voffB);
        PG8_WAIT_V(6); PG8_BAR;
    }
    for (;;) {
        const bool has_next = S.next(ui + 1, nxt);
        const char* nA = has_next ? (const char*)g.A + (size_t)nxt.pm * tstep : cA; const char* nB = has_next ? (const char*)g.Bt + (size_t)nxt.pn * tstep : cB;
        for (int t = 0; t < nt; t += 2) {
            const bool last = (t == nt - 2);
            const char* a1 = cA + (size_t)(t + 1) * kstep;
            const char* a2 = last ? nA : cA + (size_t)(t + 2) * kstep; const char* b2 = last ? nB : cB + (size_t)(t + 2) * kstep;
            const char* a3 = a2 + kstep; const char* b3 = b2 + kstep;
            if (last && has_next) S.a_ready(nxt);
            if constexpr (SP2) {
            PG8_LDB(B0, 0, 0); PG8_LDB(B1, 0, 1); PG8_SCHED; PG8_LDA(At, 0, 0); PG8_STAGE(PG8_SA(1, 1), a1 + hstep, voffA);
            PG8_WAIT_V(8); PG8_WAIT_L(0); PG8_BAR; PG8_MMA(0, 0, At, B0); PG8_MMA(0, 1, At, B1); PG8_BAR; PG8_SCHED;
            PG8_LDA(At, 0, 1); PG8_STAGE(PG8_SB(0, 0), b2, voffB); PG8_STAGE(PG8_SB(0, 1), b2 + hstep, voffB); PG8_STAGE(PG8_SA(0, 0), a2, voffA);
            PG8_WAIT_V(8); PG8_WAIT_L(0); PG8_BAR; PG8_MMA(1, 0, At, B0); PG8_MMA(1, 1, At, B1); PG8_BAR; PG8_SCHED;
            PG8_LDB(B0, 1, 0); PG8_LDB(B1, 1, 1); PG8_SCHED; PG8_LDA(At, 1, 0); PG8_STAGE(PG8_SA(0, 1), a2 + hstep, voffA);
            PG8_WAIT_V(8); PG8_WAIT_L(0); PG8_BAR; PG8_MMA(0, 0, At, B0); PG8_MMA(0, 1, At, B1); PG8_BAR; PG8_SCHED;
            PG8_LDA(At, 1, 1); PG8_STAGE(PG8_SB(1, 0), b3, voffB); PG8_STAGE(PG8_SB(1, 1), b3 + hstep, voffB); PG8_STAGE(PG8_SA(1, 0), a3, voffA);
            PG8_WAIT_V(8); PG8_WAIT_L(0); PG8_BAR; PG8_MMA(1, 0, At, B0); PG8_MMA(1, 1, At, B1); PG8_BAR; PG8_SCHED;
            } else {
            PG8_LDB(B0, 0, 0); PG8_SCHED; PG8_LDA(At, 0, 0); PG8_STAGE(PG8_SA(1, 1), a1 + hstep, voffA);
            PG8_WAIT_L(8); PG8_BAR; PG8_WAIT_L(0); PG8_MMA(0, 0, At, B0); PG8_BAR; PG8_SCHED;
            PG8_LDB(B1, 0, 1); PG8_STAGE(PG8_SB(0, 0), b2, voffB);
            PG8_BAR; PG8_WAIT_L(0); PG8_MMA(0, 1, At, B1); PG8_BAR;
            PG8_LDA(At, 0, 1); PG8_STAGE(PG8_SA(0, 0), a2, voffA);
            PG8_BAR; PG8_WAIT_L(0); PG8_MMA(1, 0, At, B0); PG8_BAR; PG8_SCHED;
            PG8_STAGE(PG8_SB(0, 1), b2 + hstep, voffB);
            PG8_WAIT_V(6); PG8_BAR; PG8_MMA(1, 1, At, B1); PG8_BAR;
            PG8_LDB(B0, 1, 0); PG8_SCHED; PG8_LDA(At, 1, 0); PG8_STAGE(PG8_SA(0, 1), a2 + hstep, voffA);
            PG8_WAIT_L(8); PG8_BAR; PG8_WAIT_L(0); PG8_MMA(0, 0, At, B0); PG8_BAR; PG8_SCHED;
            PG8_LDB(B1, 1, 1); PG8_STAGE(PG8_SB(1, 0), b3, voffB);
            PG8_BAR; PG8_WAIT_L(0); PG8_MMA(0, 1, At, B1); PG8_BAR;
            PG8_LDA(At, 1, 1); PG8_STAGE(PG8_SA(1, 0), a3, voffA);
            PG8_BAR; PG8_WAIT_L(0); PG8_MMA(1, 0, At, B0); PG8_BAR; PG8_SCHED;
            PG8_STAGE(PG8_SB(1, 1), b3 + hstep, voffB);
            PG8_WAIT_V(6); PG8_BAR; PG8_MMA(1, 1, At, B1); PG8_BAR;
            }
        }
        if constexpr (ALIGN_EPI) { if (wr == 0) PG8_BAR; }
        if constexpr (!Epi::AFTER_DRAIN) { E(acc, cur, wr, wc, fr, fq); S.done(cur); }
        if (!has_next) break;
#pragma unroll
        for (int a = 0; a < 2; ++a)
#pragma unroll
            for (int b = 0; b < 2; ++b)
#pragma unroll
                for (int m = 0; m < 4; ++m)
#pragma unroll
                    for (int n = 0; n < 2; ++n) acc[a][b][m][n] = (f32x4){0.f, 0.f, 0.f, 0.f};
        cur = nxt; cA = nA; cB = nB; ++ui;
        if constexpr (ALIGN_EPI) { if (wr == 1) PG8_BAR; }
    }
    PG8_WAIT_V(0);
    if constexpr (!ALIGN_EPI) { if (wr == 0) PG8_BAR; }
    PG8_BAR;
    if constexpr (Epi::AFTER_DRAIN) { E.fused(acc, cur, wr, wc, fr, fq, lds, wid, lane); S.done(cur); }
#undef PG8_SA
#undef PG8_SB
#undef PG8_STAGE
#undef PG8_LDA
#undef PG8_LDB
#undef PG8_MMA
#undef PG8_WAIT_V
#undef PG8_WAIT_L
#undef PG8_BAR
#undef PG8_SCHED
}
}
#define LAS __attribute__((address_space(3)))
typedef unsigned short bf16;
typedef float f4 __attribute__((ext_vector_type(4)));
typedef unsigned u2 __attribute__((ext_vector_type(2)));
typedef unsigned u4 __attribute__((ext_vector_type(4)));
using pg8::f32x4;

constexpr int M = 16384, D = 1024, FF = 2816, NIN = 3156, NINP = 3328, NL = 4, SEQ = 8192;
constexpr int LDS_BYTES = 147456;
constexpr size_t HM = 524288;
constexpr size_t WS_WGU1 = 0, WS_WD1 = 22 * HM, WS_WIN = 33 * HM, WS_WOUT = 46 * HM, WS_WGU2 = 50 * HM, WS_WD2 = 72 * HM;
constexpr size_t MiB = 1048576;
constexpr size_t WS_XB = 42 * MiB;
constexpr size_t WS_OGLA = WS_XB, WS_YRW = WS_XB + 8 * MiB, WS_YSSD = WS_XB + 16 * MiB;
constexpr size_t WS_Y = 74 * MiB;
constexpr size_t WS_PROJ = 106 * MiB;
constexpr size_t WS_VFIRST = 210 * MiB;
constexpr size_t WS_SS = 226 * MiB;
constexpr size_t WS_RWR = 227 * MiB, WS_RWK = 235 * MiB, WS_RWV = 243 * MiB, WS_RWKK = 251 * MiB, WS_RWB = 259 * MiB;
constexpr size_t WS_RWW = 267 * MiB;
constexpr size_t WS_RWG = 283 * MiB;
constexpr size_t WS_RWBON = 291 * MiB;
constexpr size_t WS_XBC = 292 * MiB;
constexpr size_t WS_DT = 316 * MiB, WS_DEC = 317 * MiB;
constexpr size_t WS_LRA = 318 * MiB, WS_LRH = 334 * MiB;
constexpr size_t WS_SEGA = 350 * MiB, WS_SEGH = 351 * MiB, WS_CARRY = 352 * MiB;
constexpr int NCH = 32, CHL = SEQ / NCH;
constexpr size_t WS_RWP = 353 * MiB, WS_RWU = 357 * MiB;
constexpr size_t WS_GLU = 361 * MiB, WS_GLD = 363 * MiB;
constexpr size_t WS_SSU = 364 * MiB, WS_SSD = 372 * MiB;
constexpr size_t WS_CTL = 373 * MiB;
constexpr size_t WS_END = 374 * MiB;

constexpr int PC_GQ = 0, PC_GK = 128, PC_GV = 256, PC_GG = 512, PC_GSTEM = 768, PC_LX = 784, PC_LG = 1040, PC_RW = 1296, PC_SZ = 2128, PC_SXBC = 2384, PC_SDT = 3152;

__device__ __forceinline__ float bf2f(bf16 v) { return __uint_as_float((unsigned)v << 16); }
__device__ __forceinline__ float bflo(unsigned w) { return __uint_as_float(w << 16); }
__device__ __forceinline__ float bfhi(unsigned w) { return __uint_as_float(w & 0xffff0000u); }
__device__ __forceinline__ unsigned pk2(float lo, float hi) { return pg8::cvt_pk_bf16(lo, hi); }
__device__ __forceinline__ float sigmoidf_(float x) { return 1.f / (1.f + __expf(-x)); }
__device__ __forceinline__ float siluf_(float x) { return x / (1.f + __expf(-x)); }
__device__ __forceinline__ float tanhf_(float x) { return 1.f - 2.f / (1.f + __expf(2.f * x)); }
__device__ __forceinline__ float softplusf_(float x) { return fmaxf(x, 0.f) + log1pf(__expf(-fabsf(x))); }
__device__ __forceinline__ float gelu_tanh(float x) { const float u = 0.7978845608028654f * (x + 0.044715f * x * x * x); return 0.5f * x * (1.f + tanhf_(u)); }
__device__ __forceinline__ float wave_sum(float v) {
#pragma unroll
    for (int o = 1; o < 64; o <<= 1) v += __shfl_xor(v, o);
    return v;
}
__device__ __forceinline__ float dpp_mov(float x, const int ctrl_sel) {
    const int v = __builtin_bit_cast(int, x); int r;
    if (ctrl_sel == 0) r = __builtin_amdgcn_update_dpp(0, v, 0xB1, 0xF, 0xF, true);
    else if (ctrl_sel == 1) r = __builtin_amdgcn_update_dpp(0, v, 0x4E, 0xF, 0xF, true);
    else r = __builtin_amdgcn_update_dpp(0, v, 0x141, 0xF, 0xF, true);
    return __builtin_bit_cast(float, r);
}
__device__ __forceinline__ float red8(float x) { x += dpp_mov(x, 0); x += dpp_mov(x, 1); x += dpp_mov(x, 2); return x; }
__device__ __forceinline__ float rstd_row(const float* ss, int row) { const f4 p = *(const f4*)(ss + (size_t)row * 4); return rsqrtf(((p.x + p.y) + (p.z + p.w)) * (1.f / 1024.f) + 1e-6f); }

struct EpiGU {
    static constexpr bool PERM = true, AFTER_DRAIN = true;
    bf16* H; const float* ss;
    __device__ __forceinline__ void fused(f32x4 (&acc)[2][2][4][2], const pg8::Unit& u, int wr, int wc, int fr, int fq, LAS unsigned char* lds, int wid, int lane) const {
#pragma unroll
        for (int ai = 0; ai < 2; ++ai)
#pragma unroll
            for (int m = 0; m < 4; ++m) {
                const int row = u.pm * 256 + ai * 128 + wr * 64 + m * 16 + fr; const float rs = rstd_row(ss, row);
                float hv[8];
#pragma unroll
                for (int n = 0; n < 2; ++n)
#pragma unroll
                    for (int e = 0; e < 4; ++e) { const float g = acc[ai][0][m][n][e] * rs, up = acc[ai][1][m][n][e] * rs; hv[n * 4 + e] = siluf_(g) * up; }
                u4 w; w.x = pk2(hv[0], hv[1]); w.y = pk2(hv[2], hv[3]); w.z = pk2(hv[4], hv[5]); w.w = pk2(hv[6], hv[7]);
                *(u4*)(H + (size_t)row * FF + u.pn * 128 + wc * 32 + 8 * fq) = w;
                asm volatile("" ::: "memory");
            }
    }
};
struct EpiProj {
    static constexpr bool PERM = true, AFTER_DRAIN = true;
    bf16* O; const float* ss;
    __device__ __forceinline__ void fused(f32x4 (&acc)[2][2][4][2], const pg8::Unit& u, int wr, int wc, int fr, int fq, LAS unsigned char* lds, int wid, int lane) const {
#pragma unroll
        for (int ai = 0; ai < 2; ++ai)
#pragma unroll
            for (int m = 0; m < 4; ++m) {
                const int row = u.pm * 256 + ai * 128 + wr * 64 + m * 16 + fr; const float rs = rstd_row(ss, row);
#pragma unroll
                for (int bj = 0; bj < 2; ++bj) { const f32x4 v0 = acc[ai][bj][m][0] * rs, v1 = acc[ai][bj][m][1] * rs;
                    u4 w; w.x = pk2(v0[0], v0[1]); w.y = pk2(v0[2], v0[3]); w.z = pk2(v1[0], v1[1]); w.w = pk2(v1[2], v1[3]);
                    *(u4*)(O + (size_t)row * NINP + u.pn * 256 + bj * 128 + wc * 32 + 8 * fq) = w; }
                asm volatile("" ::: "memory");
            }
    }
};
struct EpiResid {
    static constexpr bool PERM = true, AFTER_DRAIN = true;
    const float* xin; float* xout; bf16* xb; float* ss; float scale;
    __device__ __forceinline__ void fused(f32x4 (&acc)[2][2][4][2], const pg8::Unit& u, int wr, int wc, int fr, int fq, LAS unsigned char* lds, int wid, int lane) const {
        LAS float* P = (LAS float*)lds;
#pragma unroll
        for (int ai = 0; ai < 2; ++ai)
#pragma unroll
            for (int m = 0; m < 4; ++m) {
                const int rt = ai * 128 + wr * 64 + m * 16 + fr; const size_t row = (size_t)u.pm * 256 + rt; float sq = 0.f;
#pragma unroll
                for (int bj = 0; bj < 2; ++bj) { const size_t off = row * D + u.pn * 256 + bj * 128 + wc * 32 + 8 * fq;
                    f32x4 x0 = *(const f32x4*)(xin + off), x1 = *(const f32x4*)(xin + off + 4);
                    x0 += acc[ai][bj][m][0] * scale; x1 += acc[ai][bj][m][1] * scale;
                    *(f32x4*)(xout + off) = x0; *(f32x4*)(xout + off + 4) = x1;
                    u4 w; w.x = pk2(x0[0], x0[1]); w.y = pk2(x0[2], x0[3]); w.z = pk2(x1[0], x1[1]); w.w = pk2(x1[2], x1[3]);
                    *(u4*)(xb + off) = w;
                    sq += (x0[0] * x0[0] + x0[1] * x0[1]) + (x0[2] * x0[2] + x0[3] * x0[3]) + (x1[0] * x1[0] + x1[1] * x1[1]) + (x1[2] * x1[2] + x1[3] * x1[3]); }
                sq += __shfl_xor(sq, 16); sq += __shfl_xor(sq, 32);
                if (fq == 0) P[rt * 4 + wc] = sq;
            }
        __syncthreads();
        const int tid = wid * 64 + lane;
        if (tid < 256) ss[(size_t)(u.pm * 256 + tid) * 4 + u.pn] = (P[tid * 4 + 0] + P[tid * 4 + 1]) + (P[tid * 4 + 2] + P[tid * 4 + 3]);
        __syncthreads();
    }
};
struct OneUnit { pg8::StaticOrder b; int r;
    __device__ __forceinline__ bool next(int i, pg8::Unit& u) const { return i == 0 && b.next(r, u); }
    __device__ __forceinline__ void a_ready(const pg8::Unit&) const {}
    __device__ __forceinline__ void done(const pg8::Unit&) const {} };

__device__ __forceinline__ void tr_item(const float* W, int ldn, int nvalid, int col0, const float* sc, bf16* WT, int K, int row0, int k0, LAS float* scr, int lane) {
    const int c = col0 + (lane & 31);
#pragma unroll 8
    for (int i = 0; i < 32; ++i) { const int kk = 2 * i + (lane >> 5); float v = (c < nvalid) ? W[(size_t)(k0 + kk) * ldn + c] : 0.f; if (sc) v *= sc[k0 + kk]; scr[kk * 33 + (lane & 31)] = v; }
    asm volatile("s_waitcnt lgkmcnt(0)" ::: "memory");
    const int c8 = lane & 7;
#pragma unroll
    for (int j = 0; j < 4; ++j) { const int n = (lane >> 3) + 8 * j; const LAS float* s = scr + (8 * c8) * 33 + n;
        u4 o; o.x = pk2(s[0 * 33], s[1 * 33]); o.y = pk2(s[2 * 33], s[3 * 33]); o.z = pk2(s[4 * 33], s[5 * 33]); o.w = pk2(s[6 * 33], s[7 * 33]);
        *(u4*)(WT + (size_t)(row0 + n) * K + k0 + 8 * c8) = o; }
    asm volatile("s_waitcnt lgkmcnt(0)" ::: "memory");
}
__device__ __forceinline__ void tr_gu(const float* Wg, const float* Wu, const float* nw, bf16* WT, int it, LAS float* scr, int lane) {
    const int kb = it / 176, nb = it % 176, row0 = nb * 32, pn = row0 >> 8, half = (row0 >> 7) & 1, i0 = row0 & 127;
    tr_item(half ? Wu : Wg, FF, FF, pn * 128 + i0, nw, WT, D, row0, kb * 64, scr, lane);
}
__device__ __forceinline__ void phase_convert(const float* const* in, unsigned char* ws, int l, LAS unsigned char* lds, int gw, int NGW, int wave, int lane) {
    LAS float* scr = (LAS float*)(lds + wave * 16384);
    const size_t oFF = (size_t)l * D * FF;
    constexpr int I_GU = 2816, I_D = 1408, I_IN = 1664, I_OUT = 512, NIT = 2 * I_GU + 2 * I_D + I_IN + I_OUT;
    for (int it = gw; it < NIT; it += NGW) {
        int r = it;
        if (r < I_GU) { tr_gu(in[2] + oFF, in[3] + oFF, in[1] + l * D, (bf16*)(ws + WS_WGU1), r, scr, lane); continue; } r -= I_GU;
        if (r < I_D) { tr_item(in[4] + oFF, D, D, (r % 32) * 32, nullptr, (bf16*)(ws + WS_WD1), FF, (r % 32) * 32, (r / 32) * 64, scr, lane); continue; } r -= I_D;
        if (r < I_IN) { tr_item(in[6] + (size_t)l * D * NIN, NIN, NIN, (r % 104) * 32, in[5] + l * D, (bf16*)(ws + WS_WIN), D, (r % 104) * 32, (r / 104) * 64, scr, lane); continue; } r -= I_IN;
        if (r < I_OUT) { tr_item(in[7] + (size_t)l * D * D, D, D, (r % 32) * 32, nullptr, (bf16*)(ws + WS_WOUT), D, (r % 32) * 32, (r / 32) * 64, scr, lane); continue; } r -= I_OUT;
        if (r < I_GU) { tr_gu(in[39] + oFF, in[40] + oFF, in[38] + l * D, (bf16*)(ws + WS_WGU2), r, scr, lane); continue; } r -= I_GU;
        tr_item(in[41] + oFF, D, D, (r % 32) * 32, nullptr, (bf16*)(ws + WS_WD2), FF, (r % 32) * 32, (r / 32) * 64, scr, lane);
    }
}
__device__ __forceinline__ void phase_init_rows(const float* x, bf16* xb, float* ss, int gw, int NGW, int lane) {
    for (int m = gw; m < M; m += NGW) {
        const f4* xr = (const f4*)(x + (size_t)m * D) + lane; float s = 0.f; u2* o = (u2*)(xb + (size_t)m * D) + lane;
#pragma unroll
        for (int j = 0; j < 4; ++j) { const f4 v = xr[64 * j]; s += (v.x * v.x + v.y * v.y) + (v.z * v.z + v.w * v.w); u2 w; w.x = pk2(v.x, v.y); w.y = pk2(v.z, v.w); o[64 * j] = w; }
        s = wave_sum(s);
        if (lane < 4) ss[(size_t)m * 4 + lane] = lane == 0 ? s : 0.f;
    }
}
__device__ __forceinline__ void phase_final(float* x, const float* fw, int gw, int NGW, int lane) {
    for (int m = gw; m < M; m += NGW) {
        f4* xr = (f4*)(x + (size_t)m * D) + lane; f4 v[4]; float s = 0.f;
#pragma unroll
        for (int j = 0; j < 4; ++j) { v[j] = xr[64 * j]; s += (v[j].x * v[j].x + v[j].y * v[j].y) + (v[j].z * v[j].z + v[j].w * v[j].w); }
        const float rs = rsqrtf(wave_sum(s) * (1.f / 1024.f) + 1e-6f);
#pragma unroll
        for (int j = 0; j < 4; ++j) { const f4 w = ((const f4*)fw)[lane + 64 * j]; xr[64 * j] = v[j] * rs * w; }
    }
}
#define XB_TMO      128
#define XB_XCNT(j)  (256  + 64 * (j))
#define XB_XSUB(j)  (1280 + 64 * (j))
#define XB_XGEN(j)  (2304 + 64 * (j))
#define XB_TOP      3328
#define XB_TOPGEN   3392
#define XCD_BAR_WORDS 3456
#define XB_SPIN_CAP (1u << 18)

__device__ __forceinline__ unsigned xb_ld(unsigned* p)              { return __hip_atomic_load(p, __ATOMIC_RELAXED, __HIP_MEMORY_SCOPE_AGENT); }
__device__ __forceinline__ unsigned xb_add(unsigned* p, unsigned v) { return __hip_atomic_fetch_add(p, v, __ATOMIC_RELAXED, __HIP_MEMORY_SCOPE_AGENT); }
__device__ __forceinline__ unsigned xb_xcc_id() { return (unsigned)__builtin_amdgcn_s_getreg((3 << 11) | 20) & 0xFu; }
#define XB_SPIN(cond, bar) do { unsigned _sp = 0; while (cond) { __builtin_amdgcn_s_sleep(1); \
    if ((++_sp & 255u) == 0u) { if (xb_ld(&(bar)[XB_TMO])) break; if (_sp > XB_SPIN_CAP) { atomicAdd(&(bar)[XB_TMO], 1u); break; } } } } while (0)

struct XcdBarrier {
    unsigned* bar; unsigned x;
    volatile LAS unsigned* st;
};

__device__ __forceinline__ XcdBarrier xcd_barrier_post(unsigned* bar, volatile LAS unsigned* st) {
    XcdBarrier b; b.bar = bar; b.x = xb_xcc_id(); b.st = st;
    if (threadIdx.x == 0) (void)xb_add(&bar[XB_XCNT(b.x)], 1u);
    return b;
}
__device__ __forceinline__ void xcd_barrier_complete(unsigned* bar, unsigned x, unsigned& nloc, unsigned& nx) {
    const unsigned G = gridDim.x * gridDim.y * gridDim.z;
    unsigned sum, cnt, mine, sp = 0u;
    for (;;) {
        sum = 0u; cnt = 0u; mine = 0u;
#pragma unroll
        for (unsigned j = 0; j < 16; ++j) { const unsigned c = xb_ld(&bar[XB_XCNT(j)]); sum += c; cnt += (c > 0u) ? 1u : 0u; mine = (j == x) ? c : mine; }
        if (sum == G) break;
        __builtin_amdgcn_s_sleep(1);
        if ((++sp & 255u) == 0u) { if (xb_ld(&bar[XB_TMO])) break; if (sp > XB_SPIN_CAP) { atomicAdd(&bar[XB_TMO], 1u); break; } }
    }
    nloc = mine > 0u ? mine : 1u; nx = cnt > 0u ? cnt : 1u;
}

__device__ __forceinline__ void xcd_barrier(const XcdBarrier& b) {
    asm volatile("s_waitcnt vmcnt(0)" ::: "memory");
    __syncthreads();
    if (threadIdx.x == 0) {
        unsigned* bar = b.bar;
        __builtin_amdgcn_s_waitcnt(0);
        unsigned nloc = b.st[0], nx = b.st[1];
        if (nloc == 0u) { xcd_barrier_complete(bar, b.x, nloc, nx); b.st[0] = nloc; b.st[1] = nx; }
        const unsigned old = xb_add(&bar[XB_XSUB(b.x)], 1u);
        const unsigned gen = old / nloc;
        if (old + 1u == (gen + 1u) * nloc) {
            __builtin_amdgcn_fence(__ATOMIC_RELEASE, "agent");
            asm volatile("s_waitcnt vmcnt(0)" ::: "memory");
            const unsigned og = xb_add(&bar[XB_TOP], 1u);
            const unsigned tg = og / nx;
            if (og + 1u == (tg + 1u) * nx) xb_add(&bar[XB_TOPGEN], 1u);
            else XB_SPIN(xb_ld(&bar[XB_TOPGEN]) == tg, bar);
            __builtin_amdgcn_fence(__ATOMIC_ACQUIRE, "agent");
            xb_add(&bar[XB_XGEN(b.x)], 1u);
            asm volatile("s_waitcnt vmcnt(0)" ::: "memory");
        } else {
            XB_SPIN(xb_ld(&bar[XB_XGEN(b.x)]) == gen, bar);
            __builtin_amdgcn_fence(__ATOMIC_ACQUIRE, "agent");
            asm volatile("s_waitcnt vmcnt(0)" ::: "memory");
        }
    }
    __syncthreads();
}
__device__ __forceinline__ void prep_lru(const float* const* in, unsigned char* ws, int l, int item, LAS unsigned char* lds, int tid) {
    const bf16* PROJ = (const bf16*)(ws + WS_PROJ); LAS float* X = (LAS float*)lds; LAS float* G = X + 32 * 256;
    const int t0 = item * 32; const float* cw = in[11] + l * 4 * 256; const float* cb = in[12] + l * 256;
#pragma unroll
    for (int it = 0; it < 2; ++it) { const int idx = tid + it * 512, t = idx >> 5, cv = idx & 31, tok = t0 + t, pos = tok & (SEQ - 1);
        f4 a0 = *(const f4*)(cb + cv * 8), a1 = *(const f4*)(cb + cv * 8 + 4);
#pragma unroll
        for (int k = 0; k < 4; ++k) { u4 x = (u4){0u, 0u, 0u, 0u}; if (pos - 3 + k >= 0) x = *(const u4*)(PROJ + (size_t)(tok - 3 + k) * NINP + PC_LX + cv * 8);
            const f4 w0 = *(const f4*)(cw + k * 256 + cv * 8), w1 = *(const f4*)(cw + k * 256 + cv * 8 + 4);
            a0 += w0 * (f4){bflo(x.x), bfhi(x.x), bflo(x.y), bfhi(x.y)}; a1 += w1 * (f4){bflo(x.z), bfhi(x.z), bflo(x.w), bfhi(x.w)}; }
        *(LAS f4*)(X + t * 256 + cv * 8) = a0; *(LAS f4*)(X + t * 256 + cv * 8 + 4) = a1; }
    __syncthreads();
    const int gsel = tid >> 8, c = tid & 255, blk = c >> 6, j = c & 63;
    { const float* pw = (gsel ? in[15] : in[13]) + (size_t)l * 16384 + blk * 4096 + j; const float bias = (gsel ? in[16] : in[14])[l * 256 + c];
#pragma unroll 1
      for (int kh = 0; kh < 2; ++kh) { float wv[32];
#pragma unroll
          for (int k = 0; k < 32; ++k) wv[k] = pw[(kh * 32 + k) * 64];
#pragma unroll 1
          for (int t = 0; t < 32; ++t) { const LAS f4* xr = (const LAS f4*)(X + t * 256 + blk * 64 + kh * 32); float d0 = 0.f, d1 = 0.f;
#pragma unroll
              for (int k4 = 0; k4 < 8; k4 += 2) { const f4 v = xr[k4], w = xr[k4 + 1];
                  d0 += v.x * wv[4 * k4] + v.y * wv[4 * k4 + 1] + v.z * wv[4 * k4 + 2] + v.w * wv[4 * k4 + 3];
                  d1 += w.x * wv[4 * k4 + 4] + w.y * wv[4 * k4 + 5] + w.z * wv[4 * k4 + 6] + w.w * wv[4 * k4 + 7]; }
              LAS float* gp = G + (gsel * 32 + t) * 256 + c;
              if (kh == 0) *gp = d0 + d1; else *gp = sigmoidf_(*gp + d0 + d1 + bias); } } }
    __syncthreads();
    { const float sp = softplusf_(-in[17][l * 256 + c]);
#pragma unroll 4
      for (int tt = 0; tt < 16; ++tt) { const int t = gsel * 16 + tt; const float r = G[t * 256 + c], ig = G[(32 + t) * 256 + c], la = -8.f * r * sp, av = __expf(la), u = sqrtf(fmaxf(1.f - av * av, 0.f)) * (ig * X[t * 256 + c]);
          G[t * 256 + c] = av; G[(32 + t) * 256 + c] = u; } }
    __syncthreads();
    if (tid < 256) { float h = 0.f, A = 1.f; float* LRA = (float*)(ws + WS_LRA); float* LRH = (float*)(ws + WS_LRH);
#pragma unroll 4
        for (int t = 0; t < 32; ++t) { const float av = G[t * 256 + c], u = G[(32 + t) * 256 + c];
            h = av * h + u; A *= av; const size_t o = (size_t)(t0 + t) * 256 + c; LRA[o] = A; LRH[o] = h; }
        ((float*)(ws + WS_SEGA))[item * 256 + c] = A; ((float*)(ws + WS_SEGH))[item * 256 + c] = h; }
    __syncthreads();
}
__device__ __forceinline__ void prep_ssd(const float* const* in, unsigned char* ws, int l, int item, int tid) {
    const bf16* PROJ = (const bf16*)(ws + WS_PROJ);
    const int t0 = item * 32; const float* cw = in[32] + l * 4 * 768; const float* cb = in[33] + l * 768;
#pragma unroll 2
    for (int it = 0; it < 6; ++it) { const int idx = tid + it * 512, t = idx / 96, cv = idx - t * 96, tok = t0 + t, pos = tok & (SEQ - 1);
        f4 a0 = *(const f4*)(cb + cv * 8), a1 = *(const f4*)(cb + cv * 8 + 4);
#pragma unroll
        for (int k = 0; k < 4; ++k) { u4 x = (u4){0u, 0u, 0u, 0u}; if (pos - 3 + k >= 0) x = *(const u4*)(PROJ + (size_t)(tok - 3 + k) * NINP + PC_SXBC + cv * 8);
            const f4 w0 = *(const f4*)(cw + k * 768 + cv * 8), w1 = *(const f4*)(cw + k * 768 + cv * 8 + 4);
            a0 += w0 * (f4){bflo(x.x), bfhi(x.x), bflo(x.y), bfhi(x.y)}; a1 += w1 * (f4){bflo(x.z), bfhi(x.z), bflo(x.w), bfhi(x.w)}; }
        u4 o; o.x = pk2(siluf_(a0.x), siluf_(a0.y)); o.y = pk2(siluf_(a0.z), siluf_(a0.w)); o.z = pk2(siluf_(a1.x), siluf_(a1.y)); o.w = pk2(siluf_(a1.z), siluf_(a1.w));
        *(u4*)((bf16*)(ws + WS_XBC) + (size_t)tok * 768 + cv * 8) = o; }
    if (tid < 128) { const int t = tid >> 2, hh = tid & 3, tok = t0 + t; const float dt = softplusf_(bf2f(PROJ[(size_t)tok * NINP + PC_SDT + hh]) + in[34][l * 4 + hh]);
        ((float*)(ws + WS_DT))[tok * 4 + hh] = dt; ((float*)(ws + WS_DEC))[tok * 4 + hh] = __expf(-dt * __expf(in[35][l * 4 + hh])); }
}
__device__ __forceinline__ void prep_rw(const float* const* in, unsigned char* ws, int l, int item, LAS unsigned char* lds, int tid) {
    const bf16* PROJ = (const bf16*)(ws + WS_PROJ); LAS float* P = (LAS float*)lds; LAS float* VV = (LAS float*)(lds + 32 * 832 * 4);
    const int t0 = item * 32; const float* mu = in[18] + l * 832;
    LAS float* V1 = VV + 256;
#pragma unroll
    for (int it = 0; it < 7; ++it) { const int idx = tid + it * 512; if (idx < 3328) { const int t = idx / 104, cv = idx - t * 104, tok = t0 + t;
        const bf16* pc = PROJ + (size_t)tok * NINP + PC_RW + cv * 8; const u4 cur = *(const u4*)pc; u4 prv = (u4){0u, 0u, 0u, 0u}; if (tok & (SEQ - 1)) prv = *(const u4*)(pc - NINP);
        const f4 m0 = *(const f4*)(mu + cv * 8), m1 = *(const f4*)(mu + cv * 8 + 4);
        const f4 c0 = (f4){bflo(cur.x), bfhi(cur.x), bflo(cur.y), bfhi(cur.y)}, c1 = (f4){bflo(cur.z), bfhi(cur.z), bflo(cur.w), bfhi(cur.w)};
        const f4 p0 = (f4){bflo(prv.x), bfhi(prv.x), bflo(prv.y), bfhi(prv.y)}, p1 = (f4){bflo(prv.z), bfhi(prv.z), bflo(prv.w), bfhi(prv.w)};
        f4 v0 = c0 + (p0 - c0) * m0, v1 = c1 + (p1 - c1) * m1;
        if (cv == 96 || cv == 97) { v0 = (f4){tanhf_(v0.x), tanhf_(v0.y), tanhf_(v0.z), tanhf_(v0.w)}; v1 = (f4){tanhf_(v1.x), tanhf_(v1.y), tanhf_(v1.z), tanhf_(v1.w)}; }
        else if (cv >= 100) { v0 = (f4){sigmoidf_(v0.x), sigmoidf_(v0.y), sigmoidf_(v0.z), sigmoidf_(v0.w)}; v1 = (f4){sigmoidf_(v1.x), sigmoidf_(v1.y), sigmoidf_(v1.z), sigmoidf_(v1.w)}; }
        *(LAS f4*)(P + t * 832 + cv * 8) = v0; *(LAS f4*)(P + t * 832 + cv * 8 + 4) = v1; } }
    if (l > 0) *(LAS f4*)(V1 + tid * 4) = *(const f4*)(in[25] + (size_t)(l - 1) * 2048 + tid * 4);
    __syncthreads();
    if (l > 0 && tid < 256) { const int t = tid >> 3, j = tid & 7; float s = 0.f;
#pragma unroll 4
        for (int c4 = 0; c4 < 64; ++c4) { const f4 pv = *(const LAS f4*)(P + t * 832 + 512 + 4 * c4); s += pv.x * V1[(4 * c4) * 8 + j] + pv.y * V1[(4 * c4 + 1) * 8 + j] + pv.z * V1[(4 * c4 + 2) * 8 + j] + pv.w * V1[(4 * c4 + 3) * 8 + j]; }
        VV[t * 8 + j] = s; }
    __syncthreads();
    const int half = tid >> 8, c = tid & 255, hh = c >> 6, lane = tid & 63;
    float zw[16], za[16], gg[16], zv[16];
    { const float w0 = in[19][l * 256 + c], a0 = in[21][l * 256 + c], v0 = l > 0 ? in[24][(l - 1) * 256 + c] : 0.f;
#pragma unroll
      for (int tt = 0; tt < 16; ++tt) { zw[tt] = w0; za[tt] = a0; gg[tt] = 0.f; zv[tt] = v0; } }
    const LAS float* ph = P + half * 16 * 832;
    { const float* w2p = in[20] + (size_t)l * 4096 + c; const float* a2p = in[22] + (size_t)l * 4096 + c;
#pragma unroll 1
      for (int j4 = 0; j4 < 4; ++j4) { const float wa = w2p[(4 * j4) * 256], wb = w2p[(4 * j4 + 1) * 256], wc_ = w2p[(4 * j4 + 2) * 256], wd_ = w2p[(4 * j4 + 3) * 256];
          const float aa = a2p[(4 * j4) * 256], ab = a2p[(4 * j4 + 1) * 256], ac = a2p[(4 * j4 + 2) * 256], ad = a2p[(4 * j4 + 3) * 256];
#pragma unroll
          for (int tt = 0; tt < 16; ++tt) { const f4 sw = *(const LAS f4*)(ph + tt * 832 + 768 + 4 * j4), sa = *(const LAS f4*)(ph + tt * 832 + 784 + 4 * j4);
              zw[tt] += sw.x * wa + sw.y * wb + sw.z * wc_ + sw.w * wd_; za[tt] += sa.x * aa + sa.y * ab + sa.z * ac + sa.w * ad; } } }
    { const float* g2p = in[23] + (size_t)l * 8192 + c;
#pragma unroll 1
      for (int j4 = 0; j4 < 8; ++j4) { const float ga = g2p[(4 * j4) * 256], gb = g2p[(4 * j4 + 1) * 256], gc = g2p[(4 * j4 + 2) * 256], gd = g2p[(4 * j4 + 3) * 256];
#pragma unroll
          for (int tt = 0; tt < 16; ++tt) { const f4 sg = *(const LAS f4*)(ph + tt * 832 + 800 + 4 * j4); gg[tt] += sg.x * ga + sg.y * gb + sg.z * gc + sg.w * gd; } } }
    if (l > 0) { const float* v2p = in[26] + (size_t)(l - 1) * 2048 + c;
#pragma unroll 1
      for (int j4 = 0; j4 < 2; ++j4) { const float va = v2p[(4 * j4) * 256], vb = v2p[(4 * j4 + 1) * 256], vc = v2p[(4 * j4 + 2) * 256], vd = v2p[(4 * j4 + 3) * 256];
#pragma unroll
          for (int tt = 0; tt < 16; ++tt) { const f4 sv = *(const LAS f4*)(VV + (half * 16 + tt) * 8 + 4 * j4); zv[tt] += sv.x * va + sv.y * vb + sv.z * vc + sv.w * vd; } } }
    const float kkw = in[27][l * 256 + c], kaw = in[28][l * 256 + c], rkw = in[29][l * 256 + c];
    float* VF = (float*)(ws + WS_VFIRST);
#pragma unroll
    for (int tt = 0; tt < 16; ++tt) { const int t = half * 16 + tt; const size_t o = (size_t)(t0 + t) * 256 + c; const LAS float* pr = P + t * 832;
        const float r = pr[c], k = pr[256 + c]; float v = pr[512 + c];
        const float wd = __expf(-0.6065306597126334f * sigmoidf_(zw[tt])), av = sigmoidf_(za[tt]), g = gg[tt];
        if (l > 0) v = v + (VF[o] - v) * sigmoidf_(zv[tt]); else VF[o] = v;
        float kk = k * kkw; const float nrm = sqrtf(wave_sum(kk * kk)); kk = kk / fmaxf(nrm, 1e-12f);
        const float k2 = k * (1.f + (av - 1.f) * kaw);
        const float bon = wave_sum(r * k2 * rkw);
        ((bf16*)(ws + WS_RWR))[o] = (bf16)pk2(r, 0.f); ((bf16*)(ws + WS_RWK))[o] = (bf16)pk2(k2, 0.f); ((bf16*)(ws + WS_RWV))[o] = (bf16)pk2(v, 0.f);
        ((bf16*)(ws + WS_RWKK))[o] = (bf16)pk2(kk, 0.f); ((bf16*)(ws + WS_RWB))[o] = (bf16)pk2(kk * av, 0.f); ((bf16*)(ws + WS_RWG))[o] = (bf16)pk2(g, 0.f);
        ((float*)(ws + WS_RWW))[o] = wd;
        if (lane == 0) ((float*)(ws + WS_RWBON))[(t0 + t) * 4 + hh] = bon;
        asm volatile("" ::: "memory"); }
    __syncthreads();
}
__device__ __forceinline__ void phase_prep(const float* const* in, unsigned char* ws, int l, LAS unsigned char* lds, int tid) {
    constexpr int N_L = 512, N_R = 512, N_S = 512;
    for (int it = blockIdx.x; it < N_L + N_R + N_S; it += gridDim.x) {
        if (it < N_L) {
#ifndef SKIP_PL
            prep_lru(in, ws, l, it, lds, tid);
#endif
        } else if (it < N_L + N_R) {
#ifndef SKIP_PR
            prep_rw(in, ws, l, it - N_L, lds, tid);
#endif
        } else {
#ifndef SKIP_PS
            prep_ssd(in, ws, l, it - N_L - N_R, tid);
#endif
        }
    }
}

template <int MODE> __device__ __forceinline__ void scan_rw(unsigned char* ws, int item, LAS unsigned char* lds, int tid) {
    LAS float* LW = (LAS float*)lds; LAS float* LKK = LW + 2048; LAS float* LB = LW + 4096; LAS float* LK = LW + 6144; LAS float* LR = LW + 8192; LAS float* LV = LW + 10240; LAS float* LY = LW + 12288;
    const int bh = item / NCH, ch = item % NCH, hh = bh & 3, tokb = (bh >> 2) * SEQ + ch * CHL, nsub = CHL / 32;
    const int st = tid >> 4, sc4 = (tid & 15) * 4, row = tid >> 3, sl = tid & 7;
    const bf16* gR = (const bf16*)(ws + WS_RWR); const bf16* gK = (const bf16*)(ws + WS_RWK); const bf16* gV = (const bf16*)(ws + WS_RWV); const bf16* gKK = (const bf16*)(ws + WS_RWKK); const bf16* gB = (const bf16*)(ws + WS_RWB);
    const float* gW = (const float*)(ws + WS_RWW); bf16* gY = (bf16*)(ws + WS_YRW);
    float* gU = (float*)(ws + WS_RWU) + (size_t)item * 4096 + row * 64 + sl * 8; float* gP = (float*)(ws + WS_RWP) + (size_t)item * 4096 + row * 64 + sl * 8;
    float s[8], p[8];
    if (MODE == 1) { const f4 a = *(const f4*)gU, c = *(const f4*)(gU + 4); s[0] = a.x; s[1] = a.y; s[2] = a.z; s[3] = a.w; s[4] = c.x; s[5] = c.y; s[6] = c.z; s[7] = c.w; }
    else {
#pragma unroll
        for (int i = 0; i < 8; ++i) { s[i] = 0.f; p[i] = (sl * 8 + i == row) ? 1.f : 0.f; } }
    u2 pr, pk, pv, pkk, pb; f4 pw;
    { const size_t o = (size_t)(tokb + st) * 256 + hh * 64 + sc4; if (MODE == 1) pr = *(const u2*)(gR + o); pk = *(const u2*)(gK + o); pv = *(const u2*)(gV + o); pkk = *(const u2*)(gKK + o); pb = *(const u2*)(gB + o); pw = *(const f4*)(gW + o); }
    for (int sub = 0; sub < nsub; ++sub) {
        const int so = st * 64 + sc4;
        *(LAS f4*)(LW + so) = pw; if (MODE == 1) *(LAS f4*)(LR + so) = (f4){bflo(pr.x), bfhi(pr.x), bflo(pr.y), bfhi(pr.y)}; *(LAS f4*)(LK + so) = (f4){bflo(pk.x), bfhi(pk.x), bflo(pk.y), bfhi(pk.y)};
        *(LAS f4*)(LV + so) = (f4){bflo(pv.x), bfhi(pv.x), bflo(pv.y), bfhi(pv.y)}; *(LAS f4*)(LKK + so) = (f4){bflo(pkk.x), bfhi(pkk.x), bflo(pkk.y), bfhi(pkk.y)}; *(LAS f4*)(LB + so) = (f4){bflo(pb.x), bfhi(pb.x), bflo(pb.y), bfhi(pb.y)};
        __syncthreads();
        if (sub + 1 < nsub) { const size_t o = (size_t)(tokb + (sub + 1) * 32 + st) * 256 + hh * 64 + sc4; if (MODE == 1) pr = *(const u2*)(gR + o); pk = *(const u2*)(gK + o); pv = *(const u2*)(gV + o); pkk = *(const u2*)(gKK + o); pb = *(const u2*)(gB + o); pw = *(const f4*)(gW + o); }
        for (int t = 0; t < 32; ++t) { const int o = t * 64 + sl * 8;
            const f4 w0 = *(const LAS f4*)(LW + o), w1 = *(const LAS f4*)(LW + o + 4), a0 = *(const LAS f4*)(LKK + o), a1 = *(const LAS f4*)(LKK + o + 4), b0 = *(const LAS f4*)(LB + o), b1 = *(const LAS f4*)(LB + o + 4);
            const f4 k0 = *(const LAS f4*)(LK + o), k1 = *(const LAS f4*)(LK + o + 4); const float vv = LV[t * 64 + row];
            float dot = (s[0] * a0.x + s[1] * a0.y) + (s[2] * a0.z + s[3] * a0.w) + (s[4] * a1.x + s[5] * a1.y) + (s[6] * a1.z + s[7] * a1.w);
            if (MODE == 0) { float dp = (p[0] * a0.x + p[1] * a0.y) + (p[2] * a0.z + p[3] * a0.w) + (p[4] * a1.x + p[5] * a1.y) + (p[6] * a1.z + p[7] * a1.w);
                const float sp = -red8(dp);
                p[0] = p[0] * w0.x + sp * b0.x; p[1] = p[1] * w0.y + sp * b0.y; p[2] = p[2] * w0.z + sp * b0.z; p[3] = p[3] * w0.w + sp * b0.w;
                p[4] = p[4] * w1.x + sp * b1.x; p[5] = p[5] * w1.y + sp * b1.y; p[6] = p[6] * w1.z + sp * b1.z; p[7] = p[7] * w1.w + sp * b1.w; }
            const float sa = -red8(dot);
            s[0] = s[0] * w0.x + sa * b0.x + vv * k0.x; s[1] = s[1] * w0.y + sa * b0.y + vv * k0.y; s[2] = s[2] * w0.z + sa * b0.z + vv * k0.z; s[3] = s[3] * w0.w + sa * b0.w + vv * k0.w;
            s[4] = s[4] * w1.x + sa * b1.x + vv * k1.x; s[5] = s[5] * w1.y + sa * b1.y + vv * k1.y; s[6] = s[6] * w1.z + sa * b1.z + vv * k1.z; s[7] = s[7] * w1.w + sa * b1.w + vv * k1.w;
            if (MODE == 1) { const f4 r0 = *(const LAS f4*)(LR + o), r1 = *(const LAS f4*)(LR + o + 4);
                float y = (s[0] * r0.x + s[1] * r0.y) + (s[2] * r0.z + s[3] * r0.w) + (s[4] * r1.x + s[5] * r1.y) + (s[6] * r1.z + s[7] * r1.w);
                y = red8(y);
                if (sl == 0) LY[t * 64 + row] = y; } }
        __syncthreads();
        if (MODE == 1) { const f4 y = *(const LAS f4*)(LY + so); u2 w; w.x = pk2(y.x, y.y); w.y = pk2(y.z, y.w); *(u2*)(gY + (size_t)(tokb + sub * 32 + st) * 256 + hh * 64 + sc4) = w; }
    }
    if (MODE == 0) { *(f4*)gU = (f4){s[0], s[1], s[2], s[3]}; *(f4*)(gU + 4) = (f4){s[4], s[5], s[6], s[7]}; *(f4*)gP = (f4){p[0], p[1], p[2], p[3]}; *(f4*)(gP + 4) = (f4){p[4], p[5], p[6], p[7]}; }
    __syncthreads();
}
__device__ __forceinline__ void combine_rw(unsigned char* ws, int bh, LAS unsigned char* lds, int tid) {
    LAS float* LP = (LAS float*)lds; LAS float* LS = LP + 4096;
    const int row = tid >> 3, sl = tid & 7; float s[8];
#pragma unroll
    for (int i = 0; i < 8; ++i) s[i] = 0.f;
    const float* gP = (const float*)(ws + WS_RWP) + (size_t)bh * NCH * 4096; float* gU = (float*)(ws + WS_RWU) + (size_t)bh * NCH * 4096 + row * 64 + sl * 8;
    f4 q0 = *(const f4*)(gP + tid * 8), q1 = *(const f4*)(gP + tid * 8 + 4), u0 = *(const f4*)gU, u1 = *(const f4*)(gU + 4);
    for (int c = 0; c < NCH; ++c) {
        *(LAS f4*)(LP + tid * 8) = q0; *(LAS f4*)(LP + tid * 8 + 4) = q1;
        *(LAS f4*)(LS + row * 68 + sl * 8) = (f4){s[0], s[1], s[2], s[3]}; *(LAS f4*)(LS + row * 68 + sl * 8 + 4) = (f4){s[4], s[5], s[6], s[7]};
        *(f4*)(gU + (size_t)c * 4096) = (f4){s[0], s[1], s[2], s[3]}; *(f4*)(gU + (size_t)c * 4096 + 4) = (f4){s[4], s[5], s[6], s[7]};
        float n[8] = {u0.x, u0.y, u0.z, u0.w, u1.x, u1.y, u1.z, u1.w};
        __syncthreads();
        if (c + 1 < NCH) { q0 = *(const f4*)(gP + (size_t)(c + 1) * 4096 + tid * 8); q1 = *(const f4*)(gP + (size_t)(c + 1) * 4096 + tid * 8 + 4); u0 = *(const f4*)(gU + (size_t)(c + 1) * 4096); u1 = *(const f4*)(gU + (size_t)(c + 1) * 4096 + 4); }
#pragma unroll 4
        for (int i4 = 0; i4 < 16; ++i4) { const f4 sv = *(const LAS f4*)(LS + row * 68 + 4 * i4); const float se[4] = {sv.x, sv.y, sv.z, sv.w};
#pragma unroll
            for (int e = 0; e < 4; ++e) { const f4 pa = *(const LAS f4*)(LP + (4 * i4 + e) * 64 + sl * 8), pb = *(const LAS f4*)(LP + (4 * i4 + e) * 64 + sl * 8 + 4);
                n[0] += se[e] * pa.x; n[1] += se[e] * pa.y; n[2] += se[e] * pa.z; n[3] += se[e] * pa.w; n[4] += se[e] * pb.x; n[5] += se[e] * pb.y; n[6] += se[e] * pb.z; n[7] += se[e] * pb.w; } }
#pragma unroll
        for (int i = 0; i < 8; ++i) s[i] = n[i];
        __syncthreads();
    }
}
template <int MODE> __device__ __forceinline__ void scan_gla(const float* const* in, unsigned char* ws, int l, int item, LAS unsigned char* lds, int tid) {
    LAS float* LA = (LAS float*)lds; LAS float* LK = LA + 1024; LAS float* LQ = LA + 2048; LAS float* LV = LA + 3072; LAS float* LO = LA + 5120;
    const bf16* PROJ = (const bf16*)(ws + WS_PROJ); bf16* gO = (bf16*)(ws + WS_OGLA);
    const int bh = item / NCH, ch = item % NCH, hh = bh & 3, tokb = (bh >> 2) * SEQ + ch * CHL, nsub = CHL / 32;
    const int st = tid >> 4, si = tid & 15, vcol = tid >> 3, sl = tid & 7;
    float up0[16], up1[16];
#pragma unroll
    for (int r = 0; r < 16; ++r) { up0[r] = in[8][(l * 16 + r) * 128 + hh * 32 + 2 * si]; up1[r] = in[8][(l * 16 + r) * 128 + hh * 32 + 2 * si + 1]; }
    const float bi0 = in[9][l * 128 + hh * 32 + 2 * si], bi1 = in[9][l * 128 + hh * 32 + 2 * si + 1];
    float* gU = (float*)(ws + WS_GLU) + (size_t)item * 2048 + vcol * 32 + 4 * sl;
    float s[4] = {0.f, 0.f, 0.f, 0.f}, dp[4] = {1.f, 1.f, 1.f, 1.f};
    if (MODE == 1) { const f4 a = *(const f4*)gU; s[0] = a.x; s[1] = a.y; s[2] = a.z; s[3] = a.w; }
    u4 ps0, ps1; unsigned pq = 0, pk; u2 pv;
    { const bf16* p = PROJ + (size_t)(tokb + st) * NINP; ps0 = *(const u4*)(p + PC_GSTEM); ps1 = *(const u4*)(p + PC_GSTEM + 8); if (MODE == 1) pq = *(const unsigned*)(p + PC_GQ + hh * 32 + 2 * si); pk = *(const unsigned*)(p + PC_GK + hh * 32 + 2 * si); pv = *(const u2*)(p + PC_GV + hh * 64 + 4 * si); }
    for (int sub = 0; sub < nsub; ++sub) {
        { const unsigned sw[8] = {ps0.x, ps0.y, ps0.z, ps0.w, ps1.x, ps1.y, ps1.z, ps1.w}; float z0 = bi0, z1 = bi1;
#pragma unroll
          for (int r = 0; r < 8; ++r) { const float e0 = bflo(sw[r]), e1 = bfhi(sw[r]); z0 += e0 * up0[2 * r] + e1 * up0[2 * r + 1]; z1 += e0 * up1[2 * r] + e1 * up1[2 * r + 1]; }
          const float l0 = fminf(z0, 0.f) - log1pf(__expf(-fabsf(z0))), l1 = fminf(z1, 0.f) - log1pf(__expf(-fabsf(z1)));
          const int o = st * 32 + 2 * si; LA[o] = __expf(l0 * 0.0625f); LA[o + 1] = __expf(l1 * 0.0625f); LK[o] = bflo(pk); LK[o + 1] = bfhi(pk); if (MODE == 1) { LQ[o] = bflo(pq); LQ[o + 1] = bfhi(pq); }
          *(LAS f4*)(LV + st * 64 + 4 * si) = (f4){bflo(pv.x), bfhi(pv.x), bflo(pv.y), bfhi(pv.y)}; }
        __syncthreads();
        if (sub + 1 < nsub) { const bf16* p = PROJ + (size_t)(tokb + (sub + 1) * 32 + st) * NINP; ps0 = *(const u4*)(p + PC_GSTEM); ps1 = *(const u4*)(p + PC_GSTEM + 8); if (MODE == 1) pq = *(const unsigned*)(p + PC_GQ + hh * 32 + 2 * si); pk = *(const unsigned*)(p + PC_GK + hh * 32 + 2 * si); pv = *(const u2*)(p + PC_GV + hh * 64 + 4 * si); }
        for (int t = 0; t < 32; ++t) { const f4 al = *(const LAS f4*)(LA + t * 32 + 4 * sl), kk = *(const LAS f4*)(LK + t * 32 + 4 * sl); const float vv = LV[t * 64 + vcol];
            s[0] = s[0] * al.x + kk.x * vv; s[1] = s[1] * al.y + kk.y * vv; s[2] = s[2] * al.z + kk.z * vv; s[3] = s[3] * al.w + kk.w * vv;
            if (MODE == 0) { dp[0] *= al.x; dp[1] *= al.y; dp[2] *= al.z; dp[3] *= al.w; }
            else { const f4 qq = *(const LAS f4*)(LQ + t * 32 + 4 * sl); float o = (s[0] * qq.x + s[1] * qq.y) + (s[2] * qq.z + s[3] * qq.w); o = red8(o);
                if (sl == 0) LO[t * 64 + vcol] = o * 0.17677669529663687f; } }
        __syncthreads();
        if (MODE == 1) { const f4 y = *(const LAS f4*)(LO + st * 64 + 4 * si); u2 w; w.x = pk2(y.x, y.y); w.y = pk2(y.z, y.w); *(u2*)(gO + (size_t)(tokb + sub * 32 + st) * 256 + hh * 64 + 4 * si) = w; }
    }
    if (MODE == 0) { *(f4*)gU = (f4){s[0], s[1], s[2], s[3]}; if (vcol == 0) *(f4*)((float*)(ws + WS_GLD) + item * 32 + 4 * sl) = (f4){dp[0], dp[1], dp[2], dp[3]}; }
    __syncthreads();
}
template <int MODE> __device__ __forceinline__ void scan_ssd(unsigned char* ws, int item, LAS unsigned char* lds, int tid) {
    LAS float* LB = (LAS float*)lds; LAS float* LC = LB + 4096; LAS float* LX = LB + 8192; LAS float* LD = LB + 10240; LAS float* LY = LB + 10304;
    const bf16* XBC = (const bf16*)(ws + WS_XBC); const float* DT = (const float*)(ws + WS_DT); const float* DEC = (const float*)(ws + WS_DEC); bf16* gY = (bf16*)(ws + WS_YSSD);
    const int bh = item / NCH, ch = item % NCH, hh = bh & 3, tokb = (bh >> 2) * SEQ + ch * CHL, nsub = CHL / 32;
    const int st = tid >> 4, si = tid & 15, p = tid >> 3, sl = tid & 7, g = hh >> 1;
    float* gU = (float*)(ws + WS_SSU) + (size_t)item * 8192 + p * 128 + 16 * sl;
    float s[16]; float dprod = 1.f;
#pragma unroll
    for (int i = 0; i < 4; ++i) { f4 a = (f4){0.f, 0.f, 0.f, 0.f}; if (MODE == 1) a = *(const f4*)(gU + 4 * i); s[4 * i] = a.x; s[4 * i + 1] = a.y; s[4 * i + 2] = a.z; s[4 * i + 3] = a.w; }
    u4 pb, pc = (u4){0u, 0u, 0u, 0u}; u2 px; float pdt, pdec;
    { const size_t tok = tokb + st; const bf16* q = XBC + tok * 768; pb = *(const u4*)(q + 256 + g * 128 + 8 * si); if (MODE == 1) pc = *(const u4*)(q + 512 + g * 128 + 8 * si); px = *(const u2*)(q + hh * 64 + 4 * si); pdt = DT[tok * 4 + hh]; pdec = DEC[tok * 4 + hh]; }
    for (int sub = 0; sub < nsub; ++sub) {
        { const int o = st * 128 + 8 * si;
          *(LAS f4*)(LB + o) = (f4){bflo(pb.x), bfhi(pb.x), bflo(pb.y), bfhi(pb.y)}; *(LAS f4*)(LB + o + 4) = (f4){bflo(pb.z), bfhi(pb.z), bflo(pb.w), bfhi(pb.w)};
          if (MODE == 1) { *(LAS f4*)(LC + o) = (f4){bflo(pc.x), bfhi(pc.x), bflo(pc.y), bfhi(pc.y)}; *(LAS f4*)(LC + o + 4) = (f4){bflo(pc.z), bfhi(pc.z), bflo(pc.w), bfhi(pc.w)}; }
          *(LAS f4*)(LX + st * 64 + 4 * si) = (f4){bflo(px.x) * pdt, bfhi(px.x) * pdt, bflo(px.y) * pdt, bfhi(px.y) * pdt};
          if (si == 0) LD[st] = pdec; }
        __syncthreads();
        if (sub + 1 < nsub) { const size_t tok = tokb + (sub + 1) * 32 + st; const bf16* q = XBC + tok * 768; pb = *(const u4*)(q + 256 + g * 128 + 8 * si); if (MODE == 1) pc = *(const u4*)(q + 512 + g * 128 + 8 * si); px = *(const u2*)(q + hh * 64 + 4 * si); pdt = DT[tok * 4 + hh]; pdec = DEC[tok * 4 + hh]; }
        for (int t = 0; t < 32; ++t) { const float xv = LX[t * 64 + p], dc = LD[t]; float y = 0.f;
            if (MODE == 0) dprod *= dc;
#pragma unroll
            for (int q4 = 0; q4 < 4; ++q4) { const f4 bb = *(const LAS f4*)(LB + t * 128 + 16 * sl + 4 * q4);
                s[4 * q4] = s[4 * q4] * dc + bb.x * xv; s[4 * q4 + 1] = s[4 * q4 + 1] * dc + bb.y * xv; s[4 * q4 + 2] = s[4 * q4 + 2] * dc + bb.z * xv; s[4 * q4 + 3] = s[4 * q4 + 3] * dc + bb.w * xv;
                if (MODE == 1) { const f4 cc = *(const LAS f4*)(LC + t * 128 + 16 * sl + 4 * q4); y += (s[4 * q4] * cc.x + s[4 * q4 + 1] * cc.y) + (s[4 * q4 + 2] * cc.z + s[4 * q4 + 3] * cc.w); } }
            if (MODE == 1) { y = red8(y); if (sl == 0) LY[t * 64 + p] = y; } }
        __syncthreads();
        if (MODE == 1) { const f4 y = *(const LAS f4*)(LY + st * 64 + 4 * si); u2 w; w.x = pk2(y.x, y.y); w.y = pk2(y.z, y.w); *(u2*)(gY + (size_t)(tokb + sub * 32 + st) * 256 + hh * 64 + 4 * si) = w; }
    }
    if (MODE == 0) {
#pragma unroll
        for (int i = 0; i < 4; ++i) *(f4*)(gU + 4 * i) = (f4){s[4 * i], s[4 * i + 1], s[4 * i + 2], s[4 * i + 3]};
        if (tid == 0) ((float*)(ws + WS_SSD))[item] = dprod; }
    __syncthreads();
}
__device__ __forceinline__ void scan_lru_carry(unsigned char* ws, int tid) {
    const float* SA = (const float*)(ws + WS_SEGA); const float* SH = (const float*)(ws + WS_SEGH); float* CY = (float*)(ws + WS_CARRY);
    const int b = tid >> 8, c = tid & 255; float h = 0.f;
#pragma unroll 8
    for (int sg = 0; sg < 256; ++sg) { const int o = (b * 256 + sg) * 256 + c; CY[o] = h; h = SA[o] * h + SH[o]; }
}
__device__ __forceinline__ void combine_gla(unsigned char* ws, int bh, int tid) {
    float* gU = (float*)(ws + WS_GLU) + (size_t)bh * NCH * 2048 + tid * 4; const float* gD = (const float*)(ws + WS_GLD) + bh * NCH * 32 + (tid & 7) * 4; f4 s = (f4){0.f, 0.f, 0.f, 0.f};
#pragma unroll 4
    for (int c = 0; c < NCH; ++c) { const f4 u = *(const f4*)(gU + (size_t)c * 2048), d = *(const f4*)(gD + c * 32); *(f4*)(gU + (size_t)c * 2048) = s; s = s * d + u; }
}
__device__ __forceinline__ void combine_ssd(unsigned char* ws, int q, int tid) {
    const int bh = q >> 2; float* gU = (float*)(ws + WS_SSU) + (size_t)bh * NCH * 8192 + (q & 3) * 2048 + tid * 4; const float* gD = (const float*)(ws + WS_SSD) + bh * NCH; f4 s = (f4){0.f, 0.f, 0.f, 0.f};
#pragma unroll 4
    for (int c = 0; c < NCH; ++c) { const f4 u = *(const f4*)(gU + (size_t)c * 8192); const float d = gD[c]; *(f4*)(gU + (size_t)c * 8192) = s; s = s * d + u; }
}
template <int MODE> __device__ __forceinline__ void phase_scan(const float* const* in, unsigned char* ws, int l, LAS unsigned char* lds, int tid) {
    constexpr int NI = 8 * NCH;
    for (int it = blockIdx.x; it < 3 * NI + (MODE == 0 ? 1 : 0); it += gridDim.x) {
        if (it < NI) scan_rw<MODE>(ws, it, lds, tid);
        else if (it < 2 * NI) scan_ssd<MODE>(ws, it - NI, lds, tid);
        else if (it < 3 * NI) scan_gla<MODE>(in, ws, l, it - 2 * NI, lds, tid);
        else scan_lru_carry(ws, tid);
    }
}
__device__ __forceinline__ void phase_combine(unsigned char* ws, LAS unsigned char* lds, int tid) {
    for (int it = blockIdx.x; it < 48; it += gridDim.x) {
        if (it < 8) combine_rw(ws, it, lds, tid);
        else if (it < 16) combine_gla(ws, it - 8, tid);
        else combine_ssd(ws, it - 16, tid);
    }
}
__device__ __forceinline__ float red16(float x) { x += __shfl_xor(x, 1); x += __shfl_xor(x, 2); x += __shfl_xor(x, 4); x += __shfl_xor(x, 8); return x; }
__device__ __forceinline__ void phase_post(const float* const* in, unsigned char* ws, int l, int gw, int NGW, int lane) {
    const bf16* PROJ = (const bf16*)(ws + WS_PROJ); bf16* Y = (bf16*)(ws + WS_Y); const int c = 4 * lane, hh = lane >> 4;
    const f4 gnorm = *(const f4*)(in[10] + l * 64 + (c & 63)), gnw = *(const f4*)(in[30] + l * 256 + c), gnb = *(const f4*)(in[31] + l * 256 + c), snw = *(const f4*)(in[37] + l * 256 + c);
    const float dsk = in[36][l * 4 + hh];
    for (int tok = gw; tok < M; tok += NGW) { const bf16* pp = PROJ + (size_t)tok * NINP; const size_t o = (size_t)tok * 256 + c; bf16* yo = Y + (size_t)tok * D + c;
        { const u2 ov = *(const u2*)((const bf16*)(ws + WS_OGLA) + o), gv = *(const u2*)(pp + PC_GG + c);
          const float o0 = bflo(ov.x), o1 = bfhi(ov.x), o2 = bflo(ov.y), o3 = bfhi(ov.y);
          const float rs = rsqrtf(red16((o0 * o0 + o1 * o1) + (o2 * o2 + o3 * o3)) * (1.f / 64.f) + 1e-5f);
          u2 w; w.x = pk2(o0 * rs * gnorm.x * siluf_(bflo(gv.x)), o1 * rs * gnorm.y * siluf_(bfhi(gv.x))); w.y = pk2(o2 * rs * gnorm.z * siluf_(bflo(gv.y)), o3 * rs * gnorm.w * siluf_(bfhi(gv.y))); *(u2*)(yo) = w; }
        { const f4 A = *(const f4*)((const float*)(ws + WS_LRA) + o), H = *(const f4*)((const float*)(ws + WS_LRH) + o), cy = *(const f4*)((const float*)(ws + WS_CARRY) + (size_t)(tok >> 5) * 256 + c);
          const u2 gv = *(const u2*)(pp + PC_LG + c);
          u2 w; w.x = pk2((H.x + A.x * cy.x) * gelu_tanh(bflo(gv.x)), (H.y + A.y * cy.y) * gelu_tanh(bfhi(gv.x))); w.y = pk2((H.z + A.z * cy.z) * gelu_tanh(bflo(gv.y)), (H.w + A.w * cy.w) * gelu_tanh(bfhi(gv.y))); *(u2*)(yo + 256) = w; }
        { const u2 yv = *(const u2*)((const bf16*)(ws + WS_YRW) + o), vv = *(const u2*)((const bf16*)(ws + WS_RWV) + o), gv = *(const u2*)((const bf16*)(ws + WS_RWG) + o);
          const float bon = ((const float*)(ws + WS_RWBON))[tok * 4 + hh];
          float y0 = bflo(yv.x), y1 = bfhi(yv.x), y2 = bflo(yv.y), y3 = bfhi(yv.y);
          const float mean = red16((y0 + y1) + (y2 + y3)) * (1.f / 64.f); y0 -= mean; y1 -= mean; y2 -= mean; y3 -= mean;
          const float rs = rsqrtf(red16((y0 * y0 + y1 * y1) + (y2 * y2 + y3 * y3)) * (1.f / 64.f) + 64e-5f);
          u2 w; w.x = pk2((y0 * rs * gnw.x + gnb.x + bon * bflo(vv.x)) * bflo(gv.x), (y1 * rs * gnw.y + gnb.y + bon * bfhi(vv.x)) * bfhi(gv.x));
          w.y = pk2((y2 * rs * gnw.z + gnb.z + bon * bflo(vv.y)) * bflo(gv.y), (y3 * rs * gnw.w + gnb.w + bon * bfhi(vv.y)) * bfhi(gv.y)); *(u2*)(yo + 512) = w; }
        { const u2 yv = *(const u2*)((const bf16*)(ws + WS_YSSD) + o), xv = *(const u2*)((const bf16*)(ws + WS_XBC) + (size_t)tok * 768 + c), zv = *(const u2*)(pp + PC_SZ + c);
          const float y0 = (bflo(yv.x) + dsk * bflo(xv.x)) * siluf_(bflo(zv.x)), y1 = (bfhi(yv.x) + dsk * bfhi(xv.x)) * siluf_(bfhi(zv.x)), y2 = (bflo(yv.y) + dsk * bflo(xv.y)) * siluf_(bflo(zv.y)), y3 = (bfhi(yv.y) + dsk * bfhi(xv.y)) * siluf_(bfhi(zv.y));
          float q = red16((y0 * y0 + y1 * y1) + (y2 * y2 + y3 * y3)); q += __shfl_xor(q, 16);
          const float rs = rsqrtf(q * (1.f / 128.f) + 1e-5f);
          u2 w; w.x = pk2(y0 * rs * snw.x, y1 * rs * snw.y); w.y = pk2(y2 * rs * snw.z, y3 * rs * snw.w); *(u2*)(yo + 768) = w; }
    }
}
#ifndef PROBE_GEMM
#define PROBE_GEMM 1
#endif
#ifndef PROBE_SCAN
#define PROBE_SCAN 1
#endif
#ifndef PROBE_MISC
#define PROBE_MISC 1
#endif
struct Args { const float* in[43]; float* out; unsigned char* ws; };
template <class Epi> __device__ __forceinline__ void gemm_multi(LAS unsigned char* lds, const pg8::Gemm& g, const Epi& E) {
    pg8::StaticOrder S; S.init(g.M, g.N, (int)gridDim.x, (int)blockIdx.x);
    pg8::gemm_phase<Epi, pg8::StaticOrder, true, true>(lds, g, S, E);
}
template <class Epi> __device__ __forceinline__ void gemm_single(LAS unsigned char* lds, const pg8::Gemm& g, const Epi& E) {
    pg8::StaticOrder S; S.init(g.M, g.N, (int)gridDim.x, (int)blockIdx.x);
    for (int r = 0;; ++r) { pg8::Unit u; if (!S.next(r, u)) break; OneUnit O{S, r}; pg8::gemm_phase<Epi, OneUnit, false, true>(lds, g, O, E); }
}
__global__ void __launch_bounds__(512, 2) fwd(Args a) {
    extern __shared__ __attribute__((aligned(16))) unsigned char lds_raw[];
    LAS unsigned char* lds = (LAS unsigned char*)lds_raw;
    cg::grid_group grid = cg::this_grid();
    unsigned* ctl = (unsigned*)(a.ws + WS_CTL); volatile LAS unsigned* MISC = (volatile LAS unsigned*)(lds + LDS_BYTES - 64);
    if (blockIdx.x == 0) for (int i = threadIdx.x; i < XCD_BAR_WORDS; i += 512) __hip_atomic_store(ctl + i, 0u, __ATOMIC_RELAXED, __HIP_MEMORY_SCOPE_AGENT);
    if (threadIdx.x < 2) MISC[threadIdx.x] = 0u;
    __threadfence();
    grid.sync();
    const XcdBarrier bar = xcd_barrier_post(ctl, MISC);
#define TIDS int tid = threadIdx.x; asm volatile("" : "+v"(tid)); const int lane = tid & 63, wave = __builtin_amdgcn_readfirstlane(tid >> 6), gw = blockIdx.x * 8 + wave, NGW = gridDim.x * 8; (void)lane; (void)gw; (void)NGW;
    unsigned char* ws = a.ws; const float* const* in = a.in; float* X = a.out;
    bf16* XB = (bf16*)(ws + WS_XB); bf16* Y = (bf16*)(ws + WS_Y); bf16* H = (bf16*)(ws + WS_PROJ); bf16* PROJ = (bf16*)(ws + WS_PROJ); float* SS = (float*)(ws + WS_SS);
#pragma unroll 1
    for (int l = 0; l < NL; ++l) {
        for (int rep = 0; rep < PROBE_MISC; ++rep) { TIDS
#ifndef SKIP_CONV
        phase_convert(in, ws, l, lds, gw, NGW, wave, lane);
#endif
        if (l == 0) phase_init_rows(in[0], XB, SS, gw, NGW, lane); }
        xcd_barrier(bar);
#ifndef SKIP_G1
        for (int rep = 0; rep < PROBE_GEMM; ++rep) { pg8::Gemm g{XB, (const bf16*)(ws + WS_WGU1), M, 2 * FF, D}; EpiGU E{H, SS}; gemm_single(lds, g, E); }
#endif
        xcd_barrier(bar);
#ifndef SKIP_G2
        { pg8::Gemm g{H, (const bf16*)(ws + WS_WD1), M, D, FF}; EpiResid E{l == 0 ? in[0] : X, X, XB, SS, 0.5f}; gemm_single(lds, g, E); }
#endif
        xcd_barrier(bar);
#ifndef SKIP_G3
        for (int rep = 0; rep < PROBE_GEMM; ++rep) { pg8::Gemm g{XB, (const bf16*)(ws + WS_WIN), M, NINP, D}; EpiProj E{PROJ, SS}; gemm_single(lds, g, E); }
#endif
        xcd_barrier(bar);
#ifndef SKIP_PREP
        for (int rep = 0; rep < PROBE_MISC; ++rep) { TIDS phase_prep(in, ws, l, lds, tid); }
#endif
        xcd_barrier(bar);
#ifndef SKIP_SCAN
        for (int rep = 0; rep < PROBE_SCAN; ++rep) { TIDS phase_scan<0>(in, ws, l, lds, tid); }
        xcd_barrier(bar);
        { TIDS phase_combine(ws, lds, tid); }
        xcd_barrier(bar);
        for (int rep = 0; rep < PROBE_SCAN; ++rep) { TIDS phase_scan<1>(in, ws, l, lds, tid); }
#endif
        xcd_barrier(bar);
#ifndef SKIP_POST
        for (int rep = 0; rep < PROBE_MISC; ++rep) { TIDS phase_post(in, ws, l, gw, NGW, lane); }
#endif
        xcd_barrier(bar);
#ifndef SKIP_G4
        { pg8::Gemm g{Y, (const bf16*)(ws + WS_WOUT), M, D, D}; EpiResid E{X, X, XB, SS, 1.0f}; gemm_single(lds, g, E); }
#endif
        xcd_barrier(bar);
#ifndef SKIP_G5
        for (int rep = 0; rep < PROBE_GEMM; ++rep) { pg8::Gemm g{XB, (const bf16*)(ws + WS_WGU2), M, 2 * FF, D}; EpiGU E{H, SS}; gemm_single(lds, g, E); }
#endif
        xcd_barrier(bar);
#ifndef SKIP_G6
        { pg8::Gemm g{H, (const bf16*)(ws + WS_WD2), M, D, FF}; EpiResid E{X, X, XB, SS, 0.5f}; gemm_single(lds, g, E); }
#endif
        xcd_barrier(bar);
    }
    { TIDS phase_final(X, in[42], gw, NGW, lane); }
}

extern "C" void kernel_launch(void* const* d_in, const int* in_sizes, int n_in, void* d_out, int out_size, void* d_ws, size_t ws_size, hipStream_t stream) {
    static int grid = 0;
    if (grid == 0) {
        int dev = 0, cus = 0, per_cu = 0;
        (void)hipGetDevice(&dev);
        (void)hipDeviceGetAttribute(&cus, hipDeviceAttributeMultiprocessorCount, dev);
        (void)hipFuncSetAttribute((const void*)fwd, hipFuncAttributeMaxDynamicSharedMemorySize, LDS_BYTES);
        (void)hipOccupancyMaxActiveBlocksPerMultiprocessor(&per_cu, (const void*)fwd, 512, LDS_BYTES);
        if (per_cu < 1) per_cu = 1;
        grid = cus * per_cu;
        if (n_in != 43 || out_size != M * D || ws_size < WS_END) fprintf(stderr, "kernel_launch: unexpected sizes n_in %d out %d ws %zu (need %zu)\n", n_in, out_size, ws_size, (size_t)WS_END);
    }
    Args a{};
    for (int i = 0; i < 43 && i < n_in; ++i) a.in[i] = (const float*)d_in[i];
    a.out = (float*)d_out; a.ws = (unsigned char*)d_ws;
    void* args[] = {&a};
    hipError_t e = hipLaunchCooperativeKernel((const void*)fwd, dim3(grid), dim3(512), args, LDS_BYTES, stream);
    if (e != hipSuccess) fprintf(stderr, "cooperative launch failed: %s (grid %d)\n", hipGetErrorString(e), grid);
}
```

```cpp
#include <hip/hip_runtime.h>
#include <hip/hip_cooperative_groups.h>
#include <cstdio>
#include <cstdint>
namespace cg = cooperative_groups;
namespace pg8 {
#define PG8_LAS __attribute__((address_space(3)))
typedef unsigned short bf16_t;
typedef short bf16x8 __attribute__((ext_vector_type(8)));
typedef float f32x4 __attribute__((ext_vector_type(4)));
typedef unsigned u32x4 __attribute__((ext_vector_type(4)));
constexpr int BM = 256, BK = 64, HALF = 128, HTB = HALF * BK * 2  , STAGE_BYTES = 8 * HTB, NXCD = 8, WGM = 8;

__host__ __device__ __forceinline__ int lds_byte(int r, int c) { const int st = (r >> 4) * 2 + (c >> 5), rr = r & 15, cc = c & 31, ob = rr * 64 + cc * 2; return st * 1024 + (ob ^ (((ob >> 9) & 1) << 5)); }
__host__ __device__ __forceinline__ void stage_rc(int b, int& R, int& C) { const int st = b / 1024, sb = b % 1024, swz = sb ^ (((sb >> 9) & 1) << 5); R = (st >> 1) * 16 + swz / 64; C = (st & 1) * 32 + (swz % 64) / 2; }
__host__ __device__ __forceinline__ int perm32(int rho) { const int n = rho >> 4, i = rho & 15; return 8 * (i >> 2) + 4 * n + (i & 3); }

struct Unit { int pm, pn; };
struct Gemm { const bf16_t* A; const bf16_t* Bt; int M, N, K; };

struct StaticOrder {
    int nM, nN, nwg, G, c;
    __host__ __device__ void init(int M, int N, int G_, int c_) { nM = M / BM; nN = N / BM; nwg = nM * nN; G = G_; c = c_; }
    __host__ __device__ bool next(int i, Unit& u) const {
        const long L = (long)i * G + c; if (L >= nwg) return false;
        int wgid = (int)L; { const int q = nwg / NXCD, r = nwg % NXCD, xcd = wgid % NXCD, off = wgid / NXCD; wgid = (xcd < r ? xcd * (q + 1) : r * (q + 1) + (xcd - r) * q) + off; }
        const int nig = WGM * nN, gid = wgid / nig, fm = gid * WGM, gsz = (nM - fm) < WGM ? (nM - fm) : WGM;
        u.pm = fm + ((wgid % nig) % gsz); u.pn = (wgid % nig) / gsz; return true;
    }
    __device__ __forceinline__ void a_ready(const Unit&) const {}
    __device__ __forceinline__ void done(const Unit&) const {}
};

__device__ __forceinline__ unsigned cvt_pk_bf16(float lo, float hi) { unsigned r; asm volatile("v_cvt_pk_bf16_f32 %0, %1, %2" : "=v"(r) : "v"(lo), "v"(hi)); return r; }
typedef float f32x2 __attribute__((ext_vector_type(2)));
template <class Epi, class Sched, bool ALIGN_EPI = false, bool SP2 = false>
__device__ __forceinline__ void gemm_phase(PG8_LAS unsigned char* lds, const Gemm g, const Sched& S, const Epi& E) {
    int tid_ = threadIdx.x; asm volatile("" : "+v"(tid_));
    const int tid = tid_, wid = __builtin_amdgcn_readfirstlane(tid >> 6), lane = tid & 63, wr = wid >> 2, wc = wid & 3, fr = lane & 15, fq = lane >> 4;
    const int K = g.K, nt = K / BK;
    unsigned voffA[2], voffB[2];
#pragma unroll
    for (int i = 0; i < 2; ++i) { int R, C; stage_rc(tid * 16 + i * 8192, R, C); const int Rb = Epi::PERM ? ((R & ~31) + perm32(R & 31)) : R;
        voffA[i] = (unsigned)(R * K + C) * 2u; voffB[i] = (unsigned)(Rb * K + C) * 2u; }
    const size_t kstep = (size_t)(BK * 2);
    const size_t hstep = (size_t)HALF * K * 2;
    const size_t tstep = 2 * hstep;
    const unsigned ldsw = (unsigned)wid * 1024u;
    const int aoff = lds_byte(wr * 64 + fr, fq * 8), boff = lds_byte(wc * 32 + fr, fq * 8);
#define PG8_SA(b, h) (((b) * 2 + (h)) * HTB)
#define PG8_SB(b, h) ((4 + (b) * 2 + (h)) * HTB)
#define PG8_STAGE(bufoff, gbase, voff) do { _Pragma("unroll") for (int _i = 0; _i < 2; ++_i) \
        __builtin_amdgcn_global_load_lds((const unsigned*)((const char*)(gbase) + (voff)[_i]), (PG8_LAS unsigned*)(lds + (bufoff) + ldsw + _i * 8192), 16, 0, 0); } while (0)
#define PG8_LDA(dst, b, h) do { _Pragma("unroll") for (int m = 0; m < 4; ++m) _Pragma("unroll") for (int k = 0; k < 2; ++k) dst[m][k] = *(const PG8_LAS bf16x8*)(lds + PG8_SA(b, h) + aoff + m * 2048 + k * 1024); } while (0)
#define PG8_LDB(dst, b, h) do { _Pragma("unroll") for (int n = 0; n < 2; ++n) _Pragma("unroll") for (int k = 0; k < 2; ++k) dst[n][k] = *(const PG8_LAS bf16x8*)(lds + PG8_SB(b, h) + boff + n * 2048 + k * 1024); } while (0)
#define PG8_MMA(ai, bj, At, Bt) do { __builtin_amdgcn_s_setprio(1); _Pragma("unroll") for (int m = 0; m < 4; ++m) _Pragma("unroll") for (int n = 0; n < 2; ++n) _Pragma("unroll") for (int k = 0; k < 2; ++k) \
        acc[ai][bj][m][n] = __builtin_amdgcn_mfma_f32_16x16x32_bf16(Bt[n][k], At[m][k], acc[ai][bj][m][n], 0, 0, 0); __builtin_amdgcn_s_setprio(0); } while (0)
#define PG8_WAIT_V(n) asm volatile("s_waitcnt vmcnt(" #n ")" ::: "memory")
#define PG8_WAIT_L(n) asm volatile("s_waitcnt lgkmcnt(" #n ")" ::: "memory")
#define PG8_BAR __builtin_amdgcn_s_barrier()
#define PG8_SCHED __builtin_amdgcn_sched_barrier(0)
    Unit cur, nxt; int ui = 0;
    if (!S.next(0, cur)) return;
    f32x4 acc[2][2][4][2];
#pragma unroll
    for (int a = 0; a < 2; ++a)
#pragma unroll
        for (int b = 0; b < 2; ++b)
#pragma unroll
            for (int m = 0; m < 4; ++m)
#pragma unroll
                for (int n = 0; n < 2; ++n) acc[a][b][m][n] = (f32x4){0.f, 0.f, 0.f, 0.f};
    bf16x8 At[4][2], B0[2][2], B1[2][2];
    const char* cA = (const char*)g.A + (size_t)cur.pm * tstep; const char* cB = (const char*)g.Bt + (size_t)cur.pn * tstep;
    S.a_ready(cur);
    if constexpr (SP2) {
        PG8_STAGE(PG8_SB(0, 0), cB, voffB); PG8_STAGE(PG8_SB(0, 1), cB + hstep, voffB); PG8_STAGE(PG8_SA(0, 0), cA, voffA); PG8_STAGE(PG8_SA(0, 1), cA + hstep, voffA);
        if (wr == 1) PG8_BAR;
        PG8_WAIT_V(2); PG8_BAR;
        PG8_STAGE(PG8_SB(1, 0), cB + kstep, voffB); PG8_STAGE(PG8_SA(1, 0), cA + kstep, voffA); PG8_STAGE(PG8_SB(1, 1), cB + hstep + kstep, voffB);
        PG8_WAIT_V(6); PG8_BAR;
    } else {
        PG8_STAGE(PG8_SB(0, 0), cB, voffB); PG8_STAGE(PG8_SA(0, 0), cA, voffA); PG8_STAGE(PG8_SB(0, 1), cB + hstep, voffB); PG8_STAGE(PG8_SA(0, 1), cA + hstep, voffA);
        if (wr == 1) PG8_BAR;
        PG8_WAIT_V(4); PG8_BAR;
        PG8_STAGE(PG8_SB(1, 0), cB + kstep, voffB); PG8_STAGE(PG8_SA(1, 0), cA + kstep, voffA); PG8_STAGE(PG8_SB(1, 1), cB + hstep + kstep, voffB);
        PG8_WAIT_V(6); PG8_BAR;
    }
    for (;;) {
        const bool has_next = S.next(ui + 1, nxt);
        const char* nA = has_next ? (const char*)g.A + (size_t)nxt.pm * tstep : cA; const char* nB = has_next ? (const char*)g.Bt + (size_t)nxt.pn * tstep : cB;
        for (int t = 0; t < nt; t += 2) {
            const bool last = (t == nt - 2);
            const char* a1 = cA + (size_t)(t + 1) * kstep;
            const char* a2 = last ? nA : cA + (size_t)(t + 2) * kstep; const char* b2 = last ? nB : cB + (size_t)(t + 2) * kstep;
            const char* a3 = a2 + kstep; const char* b3 = b2 + kstep;
            if (last && has_next) S.a_ready(nxt);
            if constexpr (SP2) {
            PG8_LDB(B0, 0, 0); PG8_LDB(B1, 0, 1); PG8_SCHED; PG8_LDA(At, 0, 0); PG8_STAGE(PG8_SA(1, 1), a1 + hstep, voffA);
            PG8_WAIT_V(8); PG8_WAIT_L(0); PG8_BAR; PG8_MMA(0, 0, At, B0); PG8_MMA(0, 1, At, B1); PG8_BAR; PG8_SCHED;
            PG8_LDA(At, 0, 1); PG8_STAGE(PG8_SB(0, 0), b2, voffB); PG8_STAGE(PG8_SB(0, 1), b2 + hstep, voffB); PG8_STAGE(PG8_SA(0, 0), a2, voffA);
            PG8_WAIT_V(8); PG8_WAIT_L(0); PG8_BAR; PG8_MMA(1, 0, At, B0); PG8_MMA(1, 1, At, B1); PG8_BAR; PG8_SCHED;
            PG8_LDB(B0, 1, 0); PG8_LDB(B1, 1, 1); PG8_SCHED; PG8_LDA(At, 1, 0); PG8_STAGE(PG8_SA(0, 1), a2 + hstep, voffA);
            PG8_WAIT_V(8); PG8_WAIT_L(0); PG8_BAR; PG8_MMA(0, 0, At, B0); PG8_MMA(0, 1, At, B1); PG8_BAR; PG8_SCHED;
            PG8_LDA(At, 1, 1); PG8_STAGE(PG8_SB(1, 0), b3, voffB); PG8_STAGE(PG8_SB(1, 1), b3 + hstep, voffB); PG8_STAGE(PG8_SA(1, 0), a3, voffA);
            PG8_WAIT_V(8); PG8_WAIT_L(0); PG8_BAR; PG8_MMA(1, 0, At, B0); PG8_MMA(1, 1, At, B1); PG8_BAR; PG8_SCHED;
            } else {
            PG8_LDB(B0, 0, 0); PG8_SCHED; PG8_LDA(At, 0, 0); PG8_STAGE(PG8_SA(1, 1), a1 + hstep, voffA);
            PG8_WAIT_L(8); PG8_BAR; PG8_WAIT_L(0); PG8_MMA(0, 0, At, B0); PG8_BAR; PG8_SCHED;
            PG8_LDB(B1, 0, 1); PG8_STAGE(PG8_SB(0, 0), b2, voffB);
            PG8_BAR; PG8_WAIT_L(0); PG8_MMA(0, 1, At, B1); PG8_BAR;
            PG8_LDA(At, 0, 1); PG8_STAGE(PG8_SA(0, 0), a2, voffA);
            PG8_BAR; PG8_WAIT_L(0); PG8_MMA(1, 0, At, B0); PG8_BAR; PG8_SCHED;
            PG8_STAGE(PG8_SB(0, 1), b2 + hstep, voffB);
            PG8_WAIT_V(6); PG8_BAR; PG8_MMA(1, 1, At, B1); PG8_BAR;
            PG8_LDB(B0, 1, 0); PG8_SCHED; PG8_LDA(At, 1, 0); PG8_STAGE(PG8_SA(0, 1), a2 + hstep, voffA);
            PG8_WAIT_L(8); PG8_BAR; PG8_WAIT_L(0); PG8_MMA(0, 0, At, B0); PG8_BAR; PG8_SCHED;
            PG8_LDB(B1, 1, 1); PG8_STAGE(PG8_SB(1, 0), b3, voffB);
            PG8_BAR; PG8_WAIT_L(0); PG8_MMA(0, 1, At, B1); PG8_BAR;
            PG8_LDA(At, 1, 1); PG8_STAGE(PG8_SA(1, 0), a3, voffA);
            PG8_BAR; PG8_WAIT_L(0); PG8_MMA(1, 0, At, B0); PG8_BAR; PG8_SCHED;
            PG8_STAGE(PG8_SB(1, 1), b3 + hstep, voffB);
            PG8_WAIT_V(6); PG8_BAR; PG8_MMA(1, 1, At, B1); PG8_BAR;
            }
        }
        if constexpr (ALIGN_EPI) { if (wr == 0) PG8_BAR; }
        if constexpr (!Epi::AFTER_DRAIN) { E(acc, cur, wr, wc, fr, fq); S.done(cur); }
        if (!has_next) break;
#pragma unroll
        for (int a = 0; a < 2; ++a)
#pragma unroll
            for (int b = 0; b < 2; ++b)
#pragma unroll
                for (int m = 0; m < 4; ++m)
#pragma unroll
                    for (int n = 0; n < 2; ++n) acc[a][b][m][n] = (f32x4){0.f, 0.f, 0.f, 0.f};
        cur = nxt; cA = nA; cB = nB; ++ui;
        if constexpr (ALIGN_EPI) { if (wr == 1) PG8_BAR; }
    }
    PG8_WAIT_V(0);
    if constexpr (!ALIGN_EPI) { if (wr == 0) PG8_BAR; }
    PG8_BAR;
    if constexpr (Epi::AFTER_DRAIN) { E.fused(acc, cur, wr, wc, fr, fq, lds, wid, lane); S.done(cur); }
#undef PG8_SA
#undef PG8_SB
#undef PG8_STAGE
#undef PG8_LDA
#undef PG8_LDB
#undef PG8_MMA
#undef PG8_WAIT_V
#undef PG8_WAIT_L
#undef PG8_BAR
#undef PG8_SCHED
}
}
#define LAS __attribute__((address_space(3)))
typedef unsigned short bf16;
typedef float f4 __attribute__((ext_vector_type(4)));
typedef float f2 __attribute__((ext_vector_type(2)));
#define LO2(v) __builtin_shufflevector(v, v, 0, 1)
#define HI2(v) __builtin_shufflevector(v, v, 2, 3)
typedef unsigned u2 __attribute__((ext_vector_type(2)));
typedef unsigned u4 __attribute__((ext_vector_type(4)));
using pg8::f32x4;

constexpr int M = 16384, D = 1024, FF = 2816, NIN = 3156, NINP = 3328, NL = 4, SEQ = 8192;
constexpr int LDS_BYTES = 147456;
constexpr size_t HM = 524288;
constexpr size_t WS_WGU1 = 0, WS_WD1 = 22 * HM, WS_WIN = 33 * HM, WS_WOUT = 46 * HM, WS_WGU2 = 50 * HM, WS_WD2 = 72 * HM;
constexpr size_t MiB = 1048576;
constexpr size_t WS_XB = 42 * MiB;
constexpr size_t WS_OGLA = WS_XB, WS_YRW = WS_XB + 8 * MiB, WS_YSSD = WS_XB + 16 * MiB;
constexpr size_t WS_Y = 74 * MiB;
constexpr size_t WS_PROJ = 106 * MiB;
constexpr size_t WS_VFIRST = 210 * MiB;
constexpr size_t WS_SS = 226 * MiB;
constexpr size_t WS_RWR = 227 * MiB, WS_RWK = 235 * MiB, WS_RWV = 243 * MiB, WS_RWKK = 251 * MiB, WS_RWB = 259 * MiB;
constexpr size_t WS_RWW = 267 * MiB;
constexpr size_t WS_RWG = 283 * MiB;
constexpr size_t WS_RWBON = 291 * MiB;
constexpr size_t WS_XBC = 292 * MiB;
constexpr size_t WS_DT = 316 * MiB, WS_DEC = 317 * MiB;
constexpr size_t WS_LRA = 318 * MiB, WS_LRH = 334 * MiB;
constexpr size_t WS_SEGA = 350 * MiB, WS_SEGH = 351 * MiB, WS_CARRY = 352 * MiB;
constexpr int NCH = 32, CHL = SEQ / NCH;
constexpr size_t WS_RWP = 353 * MiB, WS_RWU = 357 * MiB;
constexpr size_t WS_GLU = 361 * MiB, WS_GLD = 363 * MiB;
constexpr size_t WS_SSU = 364 * MiB, WS_SSD = 372 * MiB;
constexpr size_t WS_CTL = 373 * MiB;
constexpr size_t WS_END = 374 * MiB;

constexpr int PC_GQ = 0, PC_GK = 128, PC_GV = 256, PC_GG = 512, PC_GSTEM = 768, PC_LX = 784, PC_LG = 1040, PC_RW = 1296, PC_SZ = 2128, PC_SXBC = 2384, PC_SDT = 3152;

__device__ __forceinline__ float bf2f(bf16 v) { return __uint_as_float((unsigned)v << 16); }
__device__ __forceinline__ float bflo(unsigned w) { return __uint_as_float(w << 16); }
__device__ __forceinline__ float bfhi(unsigned w) { return __uint_as_float(w & 0xffff0000u); }
__device__ __forceinline__ unsigned pk2(float lo, float hi) { return pg8::cvt_pk_bf16(lo, hi); }
__device__ __forceinline__ float sigmoidf_(float x) { return 1.f / (1.f + __expf(-x)); }
__device__ __forceinline__ float siluf_(float x) { return x / (1.f + __expf(-x)); }
__device__ __forceinline__ float tanhf_(float x) { return 1.f - 2.f / (1.f + __expf(2.f * x)); }
__device__ __forceinline__ float softplusf_(float x) { return fmaxf(x, 0.f) + log1pf(__expf(-fabsf(x))); }
__device__ __forceinline__ float gelu_tanh(float x) { const float u = 0.7978845608028654f * (x + 0.044715f * x * x * x); return 0.5f * x * (1.f + tanhf_(u)); }
__device__ __forceinline__ float wave_sum(float v) {
#pragma unroll
    for (int o = 1; o < 64; o <<= 1) v += __shfl_xor(v, o);
    return v;
}
__device__ __forceinline__ float dpp_mov(float x, const int ctrl_sel) {
    const int v = __builtin_bit_cast(int, x); int r;
    if (ctrl_sel == 0) r = __builtin_amdgcn_update_dpp(0, v, 0xB1, 0xF, 0xF, true);
    else if (ctrl_sel == 1) r = __builtin_amdgcn_update_dpp(0, v, 0x4E, 0xF, 0xF, true);
    else r = __builtin_amdgcn_update_dpp(0, v, 0x141, 0xF, 0xF, true);
    return __builtin_bit_cast(float, r);
}
__device__ __forceinline__ float red8(float x) { x += dpp_mov(x, 0); x += dpp_mov(x, 1); x += dpp_mov(x, 2); return x; }
__device__ __forceinline__ float rstd_row(const float* ss, int row) { const f4 p = *(const f4*)(ss + (size_t)row * 4); return rsqrtf(((p.x + p.y) + (p.z + p.w)) * (1.f / 1024.f) + 1e-6f); }

struct EpiGU {
    static constexpr bool PERM = true, AFTER_DRAIN = true;
    bf16* H; const float* ss;
    __device__ __forceinline__ void fused(f32x4 (&acc)[2][2][4][2], const pg8::Unit& u, int wr, int wc, int fr, int fq, LAS unsigned char* lds, int wid, int lane) const {
#pragma unroll
        for (int ai = 0; ai < 2; ++ai)
#pragma unroll
            for (int m = 0; m < 4; ++m) {
                const int row = u.pm * 256 + ai * 128 + wr * 64 + m * 16 + fr; const float rs = rstd_row(ss, row);
                float hv[8];
#pragma unroll
                for (int n = 0; n < 2; ++n)
#pragma unroll
                    for (int e = 0; e < 4; ++e) { const float g = acc[ai][0][m][n][e] * rs, up = acc[ai][1][m][n][e] * rs; hv[n * 4 + e] = siluf_(g) * up; }
                u4 w; w.x = pk2(hv[0], hv[1]); w.y = pk2(hv[2], hv[3]); w.z = pk2(hv[4], hv[5]); w.w = pk2(hv[6], hv[7]);
                *(u4*)(H + (size_t)row * FF + u.pn * 128 + wc * 32 + 8 * fq) = w;
                asm volatile("" ::: "memory");
            }
    }
};
struct EpiProj {
    static constexpr bool PERM = true, AFTER_DRAIN = true;
    bf16* O; const float* ss;
    __device__ __forceinline__ void fused(f32x4 (&acc)[2][2][4][2], const pg8::Unit& u, int wr, int wc, int fr, int fq, LAS unsigned char* lds, int wid, int lane) const {
#pragma unroll
        for (int ai = 0; ai < 2; ++ai)
#pragma unroll
            for (int m = 0; m < 4; ++m) {
                const int row = u.pm * 256 + ai * 128 + wr * 64 + m * 16 + fr; const float rs = rstd_row(ss, row);
#pragma unroll
                for (int bj = 0; bj < 2; ++bj) { const f32x4 v0 = acc[ai][bj][m][0] * rs, v1 = acc[ai][bj][m][1] * rs;
                    u4 w; w.x = pk2(v0[0], v0[1]); w.y = pk2(v0[2], v0[3]); w.z = pk2(v1[0], v1[1]); w.w = pk2(v1[2], v1[3]);
                    *(u4*)(O + (size_t)row * NINP + u.pn * 256 + bj * 128 + wc * 32 + 8 * fq) = w; }
                asm volatile("" ::: "memory");
            }
    }
};
struct EpiResid {
    static constexpr bool PERM = true, AFTER_DRAIN = true;
    const float* xin; float* xout; bf16* xb; float* ss; float scale;
    __device__ __forceinline__ void fused(f32x4 (&acc)[2][2][4][2], const pg8::Unit& u, int wr, int wc, int fr, int fq, LAS unsigned char* lds, int wid, int lane) const {
        LAS float* P = (LAS float*)lds;
#pragma unroll
        for (int ai = 0; ai < 2; ++ai)
#pragma unroll
            for (int m = 0; m < 4; ++m) {
                const int rt = ai * 128 + wr * 64 + m * 16 + fr; const size_t row = (size_t)u.pm * 256 + rt; float sq = 0.f;
#pragma unroll
                for (int bj = 0; bj < 2; ++bj) { const size_t off = row * D + u.pn * 256 + bj * 128 + wc * 32 + 8 * fq;
                    f32x4 x0 = *(const f32x4*)(xin + off), x1 = *(const f32x4*)(xin + off + 4);
                    x0 += acc[ai][bj][m][0] * scale; x1 += acc[ai][bj][m][1] * scale;
                    *(f32x4*)(xout + off) = x0; *(f32x4*)(xout + off + 4) = x1;
                    u4 w; w.x = pk2(x0[0], x0[1]); w.y = pk2(x0[2], x0[3]); w.z = pk2(x1[0], x1[1]); w.w = pk2(x1[2], x1[3]);
                    *(u4*)(xb + off) = w;
                    sq += (x0[0] * x0[0] + x0[1] * x0[1]) + (x0[2] * x0[2] + x0[3] * x0[3]) + (x1[0] * x1[0] + x1[1] * x1[1]) + (x1[2] * x1[2] + x1[3] * x1[3]); }
                sq += __shfl_xor(sq, 16); sq += __shfl_xor(sq, 32);
                if (fq == 0) P[rt * 4 + wc] = sq;
            }
        __syncthreads();
        const int tid = wid * 64 + lane;
        if (tid < 256) ss[(size_t)(u.pm * 256 + tid) * 4 + u.pn] = (P[tid * 4 + 0] + P[tid * 4 + 1]) + (P[tid * 4 + 2] + P[tid * 4 + 3]);
        __syncthreads();
    }
};
struct OneUnit { pg8::StaticOrder b; int r;
    __device__ __forceinline__ bool next(int i, pg8::Unit& u) const { return i == 0 && b.next(r, u); }
    __device__ __forceinline__ void a_ready(const pg8::Unit&) const {}
    __device__ __forceinline__ void done(const pg8::Unit&) const {} };

__device__ __forceinline__ void tr_item(const float* W, int ldn, int nvalid, int col0, const float* sc, bf16* WT, int K, int row0, int k0, LAS float* scr, int lane) {
    const int c = col0 + (lane & 31);
#pragma unroll 8
    for (int i = 0; i < 32; ++i) { const int kk = 2 * i + (lane >> 5); float v = (c < nvalid) ? W[(size_t)(k0 + kk) * ldn + c] : 0.f; if (sc) v *= sc[k0 + kk]; scr[kk * 33 + (lane & 31)] = v; }
    asm volatile("s_waitcnt lgkmcnt(0)" ::: "memory");
    const int c8 = lane & 7;
#pragma unroll
    for (int j = 0; j < 4; ++j) { const int n = (lane >> 3) + 8 * j; const LAS float* s = scr + (8 * c8) * 33 + n;
        u4 o; o.x = pk2(s[0 * 33], s[1 * 33]); o.y = pk2(s[2 * 33], s[3 * 33]); o.z = pk2(s[4 * 33], s[5 * 33]); o.w = pk2(s[6 * 33], s[7 * 33]);
        *(u4*)(WT + (size_t)(row0 + n) * K + k0 + 8 * c8) = o; }
    asm volatile("s_waitcnt lgkmcnt(0)" ::: "memory");
}
__device__ __forceinline__ void tr_gu(const float* Wg, const float* Wu, const float* nw, bf16* WT, int it, LAS float* scr, int lane) {
    const int kb = it / 176, nb = it % 176, row0 = nb * 32, pn = row0 >> 8, half = (row0 >> 7) & 1, i0 = row0 & 127;
    tr_item(half ? Wu : Wg, FF, FF, pn * 128 + i0, nw, WT, D, row0, kb * 64, scr, lane);
}
__device__ __forceinline__ void phase_convert(const float* const* in, unsigned char* ws, int l, LAS unsigned char* lds, int gw, int NGW, int wave, int lane) {
    LAS float* scr = (LAS float*)(lds + wave * 16384);
    const size_t oFF = (size_t)l * D * FF;
    constexpr int I_GU = 2816, I_D = 1408, I_IN = 1664, I_OUT = 512, NIT = 2 * I_GU + 2 * I_D + I_IN + I_OUT;
    for (int it = gw; it < NIT; it += NGW) {
        int r = it;
        if (r < I_GU) { tr_gu(in[2] + oFF, in[3] + oFF, in[1] + l * D, (bf16*)(ws + WS_WGU1), r, scr, lane); continue; } r -= I_GU;
        if (r < I_D) { tr_item(in[4] + oFF, D, D, (r % 32) * 32, nullptr, (bf16*)(ws + WS_WD1), FF, (r % 32) * 32, (r / 32) * 64, scr, lane); continue; } r -= I_D;
        if (r < I_IN) { tr_item(in[6] + (size_t)l * D * NIN, NIN, NIN, (r % 104) * 32, in[5] + l * D, (bf16*)(ws + WS_WIN), D, (r % 104) * 32, (r / 104) * 64, scr, lane); continue; } r -= I_IN;
        if (r < I_OUT) { tr_item(in[7] + (size_t)l * D * D, D, D, (r % 32) * 32, nullptr, (bf16*)(ws + WS_WOUT), D, (r % 32) * 32, (r / 32) * 64, scr, lane); continue; } r -= I_OUT;
        if (r < I_GU) { tr_gu(in[39] + oFF, in[40] + oFF, in[38] + l * D, (bf16*)(ws + WS_WGU2), r, scr, lane); continue; } r -= I_GU;
        tr_item(in[41] + oFF, D, D, (r % 32) * 32, nullptr, (bf16*)(ws + WS_WD2), FF, (r % 32) * 32, (r / 32) * 64, scr, lane);
    }
}
__device__ __forceinline__ void phase_init_rows(const float* x, bf16* xb, float* ss, int gw, int NGW, int lane) {
    for (int m = gw; m < M; m += NGW) {
        const f4* xr = (const f4*)(x + (size_t)m * D) + lane; float s = 0.f; u2* o = (u2*)(xb + (size_t)m * D) + lane;
#pragma unroll
        for (int j = 0; j < 4; ++j) { const f4 v = xr[64 * j]; s += (v.x * v.x + v.y * v.y) + (v.z * v.z + v.w * v.w); u2 w; w.x = pk2(v.x, v.y); w.y = pk2(v.z, v.w); o[64 * j] = w; }
        s = wave_sum(s);
        if (lane < 4) ss[(size_t)m * 4 + lane] = lane == 0 ? s : 0.f;
    }
}
__device__ __forceinline__ void phase_final(float* x, const float* fw, int gw, int NGW, int lane) {
    for (int m = gw; m < M; m += NGW) {
        f4* xr = (f4*)(x + (size_t)m * D) + lane; f4 v[4]; float s = 0.f;
#pragma unroll
        for (int j = 0; j < 4; ++j) { v[j] = xr[64 * j]; s += (v[j].x * v[j].x + v[j].y * v[j].y) + (v[j].z * v[j].z + v[j].w * v[j].w); }
        const float rs = rsqrtf(wave_sum(s) * (1.f / 1024.f) + 1e-6f);
#pragma unroll
        for (int j = 0; j < 4; ++j) { const f4 w = ((const f4*)fw)[lane + 64 * j]; xr[64 * j] = v[j] * rs * w; }
    }
}
#define XB_TMO      128
#define XB_XCNT(j)  (256  + 64 * (j))
#define XB_XSUB(j)  (1280 + 64 * (j))
#define XB_XGEN(j)  (2304 + 64 * (j))
#define XB_TOP      3328
#define XB_TOPGEN   3392
#define XCD_BAR_WORDS 3456
#define XB_SPIN_CAP (1u << 18)

__device__ __forceinline__ unsigned xb_ld(unsigned* p)              { return __hip_atomic_load(p, __ATOMIC_RELAXED, __HIP_MEMORY_SCOPE_AGENT); }
__device__ __forceinline__ unsigned xb_add(unsigned* p, unsigned v) { return __hip_atomic_fetch_add(p, v, __ATOMIC_RELAXED, __HIP_MEMORY_SCOPE_AGENT); }
__device__ __forceinline__ unsigned xb_xcc_id() { return (unsigned)__builtin_amdgcn_s_getreg((3 << 11) | 20) & 0xFu; }
#define XB_SPIN(cond, bar) do { unsigned _sp = 0; while (cond) { __builtin_amdgcn_s_sleep(1); \
    if ((++_sp & 255u) == 0u) { if (xb_ld(&(bar)[XB_TMO])) break; if (_sp > XB_SPIN_CAP) { atomicAdd(&(bar)[XB_TMO], 1u); break; } } } } while (0)

struct XcdBarrier {
    unsigned* bar; unsigned x;
    volatile LAS unsigned* st;
};

__device__ __forceinline__ XcdBarrier xcd_barrier_post(unsigned* bar, volatile LAS unsigned* st) {
    XcdBarrier b; b.bar = bar; b.x = xb_xcc_id(); b.st = st;
    if (threadIdx.x == 0) (void)xb_add(&bar[XB_XCNT(b.x)], 1u);
    return b;
}
__device__ __forceinline__ void xcd_barrier_complete(unsigned* bar, unsigned x, unsigned& nloc, unsigned& nx) {
    const unsigned G = gridDim.x * gridDim.y * gridDim.z;
    unsigned sum, cnt, mine, sp = 0u;
    for (;;) {
        sum = 0u; cnt = 0u; mine = 0u;
#pragma unroll
        for (unsigned j = 0; j < 16; ++j) { const unsigned c = xb_ld(&bar[XB_XCNT(j)]); sum += c; cnt += (c > 0u) ? 1u : 0u; mine = (j == x) ? c : mine; }
        if (sum == G) break;
        __builtin_amdgcn_s_sleep(1);
        if ((++sp & 255u) == 0u) { if (xb_ld(&bar[XB_TMO])) break; if (sp > XB_SPIN_CAP) { atomicAdd(&bar[XB_TMO], 1u); break; } }
    }
    nloc = mine > 0u ? mine : 1u; nx = cnt > 0u ? cnt : 1u;
}

__device__ __forceinline__ void xcd_barrier(const XcdBarrier& b) {
    asm volatile("s_waitcnt vmcnt(0)" ::: "memory");
    __syncthreads();
    if (threadIdx.x == 0) {
        unsigned* bar = b.bar;
        __builtin_amdgcn_s_waitcnt(0);
        unsigned nloc = b.st[0], nx = b.st[1];
        if (nloc == 0u) { xcd_barrier_complete(bar, b.x, nloc, nx); b.st[0] = nloc; b.st[1] = nx; }
        const unsigned old = xb_add(&bar[XB_XSUB(b.x)], 1u);
        const unsigned gen = old / nloc;
        if (old + 1u == (gen + 1u) * nloc) {
            __builtin_amdgcn_fence(__ATOMIC_RELEASE, "agent");
            asm volatile("s_waitcnt vmcnt(0)" ::: "memory");
            const unsigned og = xb_add(&bar[XB_TOP], 1u);
            const unsigned tg = og / nx;
            if (og + 1u == (tg + 1u) * nx) xb_add(&bar[XB_TOPGEN], 1u);
            else XB_SPIN(xb_ld(&bar[XB_TOPGEN]) == tg, bar);
            __builtin_amdgcn_fence(__ATOMIC_ACQUIRE, "agent");
            xb_add(&bar[XB_XGEN(b.x)], 1u);
            asm volatile("s_waitcnt vmcnt(0)" ::: "memory");
        } else {
            XB_SPIN(xb_ld(&bar[XB_XGEN(b.x)]) == gen, bar);
            __builtin_amdgcn_fence(__ATOMIC_ACQUIRE, "agent");
            asm volatile("s_waitcnt vmcnt(0)" ::: "memory");
        }
    }
    __syncthreads();
}
__device__ __forceinline__ void prep_lru(const float* const* in, unsigned char* ws, int l, int item, LAS unsigned char* lds, int tid) {
    const bf16* PROJ = (const bf16*)(ws + WS_PROJ); LAS float* X = (LAS float*)lds; LAS float* G = X + 32 * 256;
    const int t0 = item * 32; const float* cw = in[11] + l * 4 * 256; const float* cb = in[12] + l * 256;
#pragma unroll
    for (int it = 0; it < 2; ++it) { const int idx = tid + it * 512, t = idx >> 5, cv = idx & 31, tok = t0 + t, pos = tok & (SEQ - 1);
        f4 a0 = *(const f4*)(cb + cv * 8), a1 = *(const f4*)(cb + cv * 8 + 4);
#pragma unroll
        for (int k = 0; k < 4; ++k) { u4 x = (u4){0u, 0u, 0u, 0u}; if (pos - 3 + k >= 0) x = *(const u4*)(PROJ + (size_t)(tok - 3 + k) * NINP + PC_LX + cv * 8);
            const f4 w0 = *(const f4*)(cw + k * 256 + cv * 8), w1 = *(const f4*)(cw + k * 256 + cv * 8 + 4);
            a0 += w0 * (f4){bflo(x.x), bfhi(x.x), bflo(x.y), bfhi(x.y)}; a1 += w1 * (f4){bflo(x.z), bfhi(x.z), bflo(x.w), bfhi(x.w)}; }
        *(LAS f4*)(X + t * 256 + cv * 8) = a0; *(LAS f4*)(X + t * 256 + cv * 8 + 4) = a1; }
    __syncthreads();
    const int gsel = tid >> 8, c = tid & 255, blk = c >> 6, j = c & 63;
    { const float* pw = (gsel ? in[15] : in[13]) + (size_t)l * 16384 + blk * 4096 + j; const float bias = (gsel ? in[16] : in[14])[l * 256 + c];
#pragma unroll 1
      for (int kh = 0; kh < 2; ++kh) { float wv[32];
#pragma unroll
          for (int k = 0; k < 32; ++k) wv[k] = pw[(kh * 32 + k) * 64];
#pragma unroll 1
          for (int t = 0; t < 32; ++t) { const LAS f4* xr = (const LAS f4*)(X + t * 256 + blk * 64 + kh * 32); float d0 = 0.f, d1 = 0.f;
#pragma unroll
              for (int k4 = 0; k4 < 8; k4 += 2) { const f4 v = xr[k4], w = xr[k4 + 1];
                  d0 += v.x * wv[4 * k4] + v.y * wv[4 * k4 + 1] + v.z * wv[4 * k4 + 2] + v.w * wv[4 * k4 + 3];
                  d1 += w.x * wv[4 * k4 + 4] + w.y * wv[4 * k4 + 5] + w.z * wv[4 * k4 + 6] + w.w * wv[4 * k4 + 7]; }
              LAS float* gp = G + (gsel * 32 + t) * 256 + c;
              if (kh == 0) *gp = d0 + d1; else *gp = sigmoidf_(*gp + d0 + d1 + bias); } } }
    __syncthreads();
    { const float sp = softplusf_(-in[17][l * 256 + c]);
#pragma unroll 4
      for (int tt = 0; tt < 16; ++tt) { const int t = gsel * 16 + tt; const float r = G[t * 256 + c], ig = G[(32 + t) * 256 + c], la = -8.f * r * sp, av = __expf(la), u = sqrtf(fmaxf(1.f - av * av, 0.f)) * (ig * X[t * 256 + c]);
          G[t * 256 + c] = av; G[(32 + t) * 256 + c] = u; } }
    __syncthreads();
    if (tid < 256) { float h = 0.f, A = 1.f; float* LRA = (float*)(ws + WS_LRA); float* LRH = (float*)(ws + WS_LRH);
#pragma unroll 4
        for (int t = 0; t < 32; ++t) { const float av = G[t * 256 + c], u = G[(32 + t) * 256 + c];
            h = av * h + u; A *= av; const size_t o = (size_t)(t0 + t) * 256 + c; LRA[o] = A; LRH[o] = h; }
        ((float*)(ws + WS_SEGA))[item * 256 + c] = A; ((float*)(ws + WS_SEGH))[item * 256 + c] = h; }
    __syncthreads();
}
__device__ __forceinline__ void prep_ssd(const float* const* in, unsigned char* ws, int l, int item, int tid) {
    const bf16* PROJ = (const bf16*)(ws + WS_PROJ);
    const int t0 = item * 32; const float* cw = in[32] + l * 4 * 768; const float* cb = in[33] + l * 768;
#pragma unroll 2
    for (int it = 0; it < 6; ++it) { const int idx = tid + it * 512, t = idx / 96, cv = idx - t * 96, tok = t0 + t, pos = tok & (SEQ - 1);
        f4 a0 = *(const f4*)(cb + cv * 8), a1 = *(const f4*)(cb + cv * 8 + 4);
#pragma unroll
        for (int k = 0; k < 4; ++k) { u4 x = (u4){0u, 0u, 0u, 0u}; if (pos - 3 + k >= 0) x = *(const u4*)(PROJ + (size_t)(tok - 3 + k) * NINP + PC_SXBC + cv * 8);
            const f4 w0 = *(const f4*)(cw + k * 768 + cv * 8), w1 = *(const f4*)(cw + k * 768 + cv * 8 + 4);
            a0 += w0 * (f4){bflo(x.x), bfhi(x.x), bflo(x.y), bfhi(x.y)}; a1 += w1 * (f4){bflo(x.z), bfhi(x.z), bflo(x.w), bfhi(x.w)}; }
        u4 o; o.x = pk2(siluf_(a0.x), siluf_(a0.y)); o.y = pk2(siluf_(a0.z), siluf_(a0.w)); o.z = pk2(siluf_(a1.x), siluf_(a1.y)); o.w = pk2(siluf_(a1.z), siluf_(a1.w));
        *(u4*)((bf16*)(ws + WS_XBC) + (size_t)tok * 768 + cv * 8) = o; }
    if (tid < 128) { const int t = tid >> 2, hh = tid & 3, tok = t0 + t; const float dt = softplusf_(bf2f(PROJ[(size_t)tok * NINP + PC_SDT + hh]) + in[34][l * 4 + hh]);
        ((float*)(ws + WS_DT))[tok * 4 + hh] = dt; ((float*)(ws + WS_DEC))[tok * 4 + hh] = __expf(-dt * __expf(in[35][l * 4 + hh])); }
}
__device__ __forceinline__ void prep_rw(const float* const* in, unsigned char* ws, int l, int item, LAS unsigned char* lds, int tid) {
    const bf16* PROJ = (const bf16*)(ws + WS_PROJ); LAS float* P = (LAS float*)lds; LAS float* VV = (LAS float*)(lds + 32 * 832 * 4);
    const int t0 = item * 32; const float* mu = in[18] + l * 832;
    LAS float* V1 = VV + 256;
#pragma unroll
    for (int it = 0; it < 7; ++it) { const int idx = tid + it * 512; if (idx < 3328) { const int t = idx / 104, cv = idx - t * 104, tok = t0 + t;
        const bf16* pc = PROJ + (size_t)tok * NINP + PC_RW + cv * 8; const u4 cur = *(const u4*)pc; u4 prv = (u4){0u, 0u, 0u, 0u}; if (tok & (SEQ - 1)) prv = *(const u4*)(pc - NINP);
        const f4 m0 = *(const f4*)(mu + cv * 8), m1 = *(const f4*)(mu + cv * 8 + 4);
        const f4 c0 = (f4){bflo(cur.x), bfhi(cur.x), bflo(cur.y), bfhi(cur.y)}, c1 = (f4){bflo(cur.z), bfhi(cur.z), bflo(cur.w), bfhi(cur.w)};
        const f4 p0 = (f4){bflo(prv.x), bfhi(prv.x), bflo(prv.y), bfhi(prv.y)}, p1 = (f4){bflo(prv.z), bfhi(prv.z), bflo(prv.w), bfhi(prv.w)};
        f4 v0 = c0 + (p0 - c0) * m0, v1 = c1 + (p1 - c1) * m1;
        if (cv == 96 || cv == 97) { v0 = (f4){tanhf_(v0.x), tanhf_(v0.y), tanhf_(v0.z), tanhf_(v0.w)}; v1 = (f4){tanhf_(v1.x), tanhf_(v1.y), tanhf_(v1.z), tanhf_(v1.w)}; }
        else if (cv >= 100) { v0 = (f4){sigmoidf_(v0.x), sigmoidf_(v0.y), sigmoidf_(v0.z), sigmoidf_(v0.w)}; v1 = (f4){sigmoidf_(v1.x), sigmoidf_(v1.y), sigmoidf_(v1.z), sigmoidf_(v1.w)}; }
        *(LAS f4*)(P + t * 832 + cv * 8) = v0; *(LAS f4*)(P + t * 832 + cv * 8 + 4) = v1; } }
    if (l > 0) *(LAS f4*)(V1 + tid * 4) = *(const f4*)(in[25] + (size_t)(l - 1) * 2048 + tid * 4);
    __syncthreads();
    if (l > 0 && tid < 256) { const int t = tid >> 3, j = tid & 7; float s = 0.f;
#pragma unroll 4
        for (int c4 = 0; c4 < 64; ++c4) { const f4 pv = *(const LAS f4*)(P + t * 832 + 512 + 4 * c4); s += pv.x * V1[(4 * c4) * 8 + j] + pv.y * V1[(4 * c4 + 1) * 8 + j] + pv.z * V1[(4 * c4 + 2) * 8 + j] + pv.w * V1[(4 * c4 + 3) * 8 + j]; }
        VV[t * 8 + j] = s; }
    __syncthreads();
    const int half = tid >> 8, c = tid & 255, hh = c >> 6, lane = tid & 63;
    float zw[16], za[16], gg[16], zv[16];
    { const float w0 = in[19][l * 256 + c], a0 = in[21][l * 256 + c], v0 = l > 0 ? in[24][(l - 1) * 256 + c] : 0.f;
#pragma unroll
      for (int tt = 0; tt < 16; ++tt) { zw[tt] = w0; za[tt] = a0; gg[tt] = 0.f; zv[tt] = v0; } }
    const LAS float* ph = P + half * 16 * 832;
    { const float* w2p = in[20] + (size_t)l * 4096 + c; const float* a2p = in[22] + (size_t)l * 4096 + c;
#pragma unroll 1
      for (int j4 = 0; j4 < 4; ++j4) { const float wa = w2p[(4 * j4) * 256], wb = w2p[(4 * j4 + 1) * 256], wc_ = w2p[(4 * j4 + 2) * 256], wd_ = w2p[(4 * j4 + 3) * 256];
          const float aa = a2p[(4 * j4) * 256], ab = a2p[(4 * j4 + 1) * 256], ac = a2p[(4 * j4 + 2) * 256], ad = a2p[(4 * j4 + 3) * 256];
#pragma unroll
          for (int tt = 0; tt < 16; ++tt) { const f4 sw = *(const LAS f4*)(ph + tt * 832 + 768 + 4 * j4), sa = *(const LAS f4*)(ph + tt * 832 + 784 + 4 * j4);
              zw[tt] += sw.x * wa + sw.y * wb + sw.z * wc_ + sw.w * wd_; za[tt] += sa.x * aa + sa.y * ab + sa.z * ac + sa.w * ad; } } }
    { const float* g2p = in[23] + (size_t)l * 8192 + c;
#pragma unroll 1
      for (int j4 = 0; j4 < 8; ++j4) { const float ga = g2p[(4 * j4) * 256], gb = g2p[(4 * j4 + 1) * 256], gc = g2p[(4 * j4 + 2) * 256], gd = g2p[(4 * j4 + 3) * 256];
#pragma unroll
          for (int tt = 0; tt < 16; ++tt) { const f4 sg = *(const LAS f4*)(ph + tt * 832 + 800 + 4 * j4); gg[tt] += sg.x * ga + sg.y * gb + sg.z * gc + sg.w * gd; } } }
    if (l > 0) { const float* v2p = in[26] + (size_t)(l - 1) * 2048 + c;
#pragma unroll 1
      for (int j4 = 0; j4 < 2; ++j4) { const float va = v2p[(4 * j4) * 256], vb = v2p[(4 * j4 + 1) * 256], vc = v2p[(4 * j4 + 2) * 256], vd = v2p[(4 * j4 + 3) * 256];
#pragma unroll
          for (int tt = 0; tt < 16; ++tt) { const f4 sv = *(const LAS f4*)(VV + (half * 16 + tt) * 8 + 4 * j4); zv[tt] += sv.x * va + sv.y * vb + sv.z * vc + sv.w * vd; } } }
    const float kkw = in[27][l * 256 + c], kaw = in[28][l * 256 + c], rkw = in[29][l * 256 + c];
    float* VF = (float*)(ws + WS_VFIRST);
#pragma unroll
    for (int tt = 0; tt < 16; ++tt) { const int t = half * 16 + tt; const size_t o = (size_t)(t0 + t) * 256 + c; const LAS float* pr = P + t * 832;
        const float r = pr[c], k = pr[256 + c]; float v = pr[512 + c];
        const float wd = __expf(-0.6065306597126334f * sigmoidf_(zw[tt])), av = sigmoidf_(za[tt]), g = gg[tt];
        if (l > 0) v = v + (VF[o] - v) * sigmoidf_(zv[tt]); else VF[o] = v;
        float kk = k * kkw; const float nrm = sqrtf(wave_sum(kk * kk)); kk = kk / fmaxf(nrm, 1e-12f);
        const float k2 = k * (1.f + (av - 1.f) * kaw);
        const float bon = wave_sum(r * k2 * rkw);
        ((bf16*)(ws + WS_RWR))[o] = (bf16)pk2(r, 0.f); ((bf16*)(ws + WS_RWK))[o] = (bf16)pk2(k2, 0.f); ((bf16*)(ws + WS_RWV))[o] = (bf16)pk2(v, 0.f);
        ((bf16*)(ws + WS_RWKK))[o] = (bf16)pk2(kk, 0.f); ((bf16*)(ws + WS_RWB))[o] = (bf16)pk2(kk * av, 0.f); ((bf16*)(ws + WS_RWG))[o] = (bf16)pk2(g, 0.f);
        ((float*)(ws + WS_RWW))[o] = wd;
        if (lane == 0) ((float*)(ws + WS_RWBON))[(t0 + t) * 4 + hh] = bon;
        asm volatile("" ::: "memory"); }
    __syncthreads();
}
__device__ __forceinline__ void phase_prep(const float* const* in, unsigned char* ws, int l, LAS unsigned char* lds, int tid) {
    constexpr int N_L = 512, N_R = 512, N_S = 512;
    for (int it = blockIdx.x; it < N_L + N_R + N_S; it += gridDim.x) {
        if (it < N_L) {
#ifndef SKIP_PL
            prep_lru(in, ws, l, it, lds, tid);
#endif
        } else if (it < N_L + N_R) {
#ifndef SKIP_PR
            prep_rw(in, ws, l, it - N_L, lds, tid);
#endif
        } else {
#ifndef SKIP_PS
            prep_ssd(in, ws, l, it - N_L - N_R, tid);
#endif
        }
    }
}

template <int MODE> __device__ __forceinline__ void scan_rw(unsigned char* ws, int item, LAS unsigned char* lds, int tid) {
    LAS float* LW = (LAS float*)lds; LAS float* LKK = LW + 2048; LAS float* LB = LW + 4096; LAS float* LK = LW + 6144; LAS float* LR = LW + 8192; LAS float* LV = LW + 10240; LAS float* LY = LW + 12288;
    const int bh = item / NCH, ch = item % NCH, hh = bh & 3, tokb = (bh >> 2) * SEQ + ch * CHL, nsub = CHL / 32;
    const int st = tid >> 4, sc4 = (tid & 15) * 4, row = tid >> 3, sl = tid & 7;
    const bf16* gR = (const bf16*)(ws + WS_RWR); const bf16* gK = (const bf16*)(ws + WS_RWK); const bf16* gV = (const bf16*)(ws + WS_RWV); const bf16* gKK = (const bf16*)(ws + WS_RWKK); const bf16* gB = (const bf16*)(ws + WS_RWB);
    const float* gW = (const float*)(ws + WS_RWW); bf16* gY = (bf16*)(ws + WS_YRW);
    float* gU = (float*)(ws + WS_RWU) + (size_t)item * 4096 + row * 64 + sl * 8; float* gP = (float*)(ws + WS_RWP) + (size_t)item * 4096 + row * 64 + sl * 8;
    f2 s[4], p[4];
    if (MODE == 1) { const f4 a = *(const f4*)gU, c = *(const f4*)(gU + 4); s[0] = LO2(a); s[1] = HI2(a); s[2] = LO2(c); s[3] = HI2(c); }
    else {
#pragma unroll
        for (int i = 0; i < 4; ++i) { s[i] = (f2){0.f, 0.f}; p[i] = (f2){(sl * 8 + 2 * i == row) ? 1.f : 0.f, (sl * 8 + 2 * i + 1 == row) ? 1.f : 0.f}; } }
    u2 pr, pk, pv, pkk, pb; f4 pw;
    { const size_t o = (size_t)(tokb + st) * 256 + hh * 64 + sc4; if (MODE == 1) pr = *(const u2*)(gR + o); pk = *(const u2*)(gK + o); pv = *(const u2*)(gV + o); pkk = *(const u2*)(gKK + o); pb = *(const u2*)(gB + o); pw = *(const f4*)(gW + o); }
    for (int sub = 0; sub < nsub; ++sub) {
        const int so = st * 64 + sc4;
        *(LAS f4*)(LW + so) = pw; if (MODE == 1) *(LAS f4*)(LR + so) = (f4){bflo(pr.x), bfhi(pr.x), bflo(pr.y), bfhi(pr.y)}; *(LAS f4*)(LK + so) = (f4){bflo(pk.x), bfhi(pk.x), bflo(pk.y), bfhi(pk.y)};
        *(LAS f4*)(LV + so) = (f4){bflo(pv.x), bfhi(pv.x), bflo(pv.y), bfhi(pv.y)}; *(LAS f4*)(LKK + so) = (f4){bflo(pkk.x), bfhi(pkk.x), bflo(pkk.y), bfhi(pkk.y)}; *(LAS f4*)(LB + so) = (f4){bflo(pb.x), bfhi(pb.x), bflo(pb.y), bfhi(pb.y)};
        __syncthreads();
        if (sub + 1 < nsub) { const size_t o = (size_t)(tokb + (sub + 1) * 32 + st) * 256 + hh * 64 + sc4; if (MODE == 1) pr = *(const u2*)(gR + o); pk = *(const u2*)(gK + o); pv = *(const u2*)(gV + o); pkk = *(const u2*)(gKK + o); pb = *(const u2*)(gB + o); pw = *(const f4*)(gW + o); }
        {
            const int ob = sl * 8; f4 w0, w1, a0, a1, b0, b1, k0, k1, r0 = (f4){0.f, 0.f, 0.f, 0.f}, r1 = r0; float vv;
#define RW_LOAD(T) { const int o_ = ((T) & 31) * 64 + ob; w0 = *(const LAS f4*)(LW + o_); w1 = *(const LAS f4*)(LW + o_ + 4); a0 = *(const LAS f4*)(LKK + o_); a1 = *(const LAS f4*)(LKK + o_ + 4); b0 = *(const LAS f4*)(LB + o_); b1 = *(const LAS f4*)(LB + o_ + 4); \
            k0 = *(const LAS f4*)(LK + o_); k1 = *(const LAS f4*)(LK + o_ + 4); if (MODE == 1) { r0 = *(const LAS f4*)(LR + o_); r1 = *(const LAS f4*)(LR + o_ + 4); } vv = LV[((T) & 31) * 64 + row]; }
            RW_LOAD(0)
#pragma unroll 2
            for (int t = 0; t < 32; ++t) {
                const f4 cw0 = w0, cw1 = w1, ca0 = a0, ca1 = a1, cb0 = b0, cb1 = b1, ck0 = k0, ck1 = k1, cr0 = r0, cr1 = r1; const float cv = vv;
                RW_LOAD(t + 1)
                f2 d2 = s[0] * LO2(ca0); d2 = s[1] * HI2(ca0) + d2; d2 = s[2] * LO2(ca1) + d2; d2 = s[3] * HI2(ca1) + d2;
                if (MODE == 0) { f2 e2 = p[0] * LO2(ca0); e2 = p[1] * HI2(ca0) + e2; e2 = p[2] * LO2(ca1) + e2; e2 = p[3] * HI2(ca1) + e2;
                    const float sp = -red8(e2.x + e2.y); const f2 sp2 = (f2){sp, sp};
                    p[0] = p[0] * LO2(cw0) + sp2 * LO2(cb0); p[1] = p[1] * HI2(cw0) + sp2 * HI2(cb0); p[2] = p[2] * LO2(cw1) + sp2 * LO2(cb1); p[3] = p[3] * HI2(cw1) + sp2 * HI2(cb1); }
                const float sa = -red8(d2.x + d2.y); const f2 sa2 = (f2){sa, sa}, cv2 = (f2){cv, cv};
                s[0] = s[0] * LO2(cw0) + sa2 * LO2(cb0) + cv2 * LO2(ck0); s[1] = s[1] * HI2(cw0) + sa2 * HI2(cb0) + cv2 * HI2(ck0);
                s[2] = s[2] * LO2(cw1) + sa2 * LO2(cb1) + cv2 * LO2(ck1); s[3] = s[3] * HI2(cw1) + sa2 * HI2(cb1) + cv2 * HI2(ck1);
                if (MODE == 1) { f2 y2 = s[0] * LO2(cr0); y2 = s[1] * HI2(cr0) + y2; y2 = s[2] * LO2(cr1) + y2; y2 = s[3] * HI2(cr1) + y2;
                    LY[t * 64 + row] = red8(y2.x + y2.y); } }
#undef RW_LOAD
        }
        __syncthreads();
        if (MODE == 1) { const f4 y = *(const LAS f4*)(LY + so); u2 w; w.x = pk2(y.x, y.y); w.y = pk2(y.z, y.w); *(u2*)(gY + (size_t)(tokb + sub * 32 + st) * 256 + hh * 64 + sc4) = w; }
    }
    if (MODE == 0) { *(f4*)gU = (f4){s[0].x, s[0].y, s[1].x, s[1].y}; *(f4*)(gU + 4) = (f4){s[2].x, s[2].y, s[3].x, s[3].y}; *(f4*)gP = (f4){p[0].x, p[0].y, p[1].x, p[1].y}; *(f4*)(gP + 4) = (f4){p[2].x, p[2].y, p[3].x, p[3].y}; }
    __syncthreads();
}
__device__ __forceinline__ void combine_rw(unsigned char* ws, int bh, LAS unsigned char* lds, int tid) {
    LAS float* LP = (LAS float*)lds; LAS float* LS = LP + 4096;
    const int row = tid >> 3, sl = tid & 7; float s[8];
#pragma unroll
    for (int i = 0; i < 8; ++i) s[i] = 0.f;
    const float* gP = (const float*)(ws + WS_RWP) + (size_t)bh * NCH * 4096; float* gU = (float*)(ws + WS_RWU) + (size_t)bh * NCH * 4096 + row * 64 + sl * 8;
    f4 q0 = *(const f4*)(gP + tid * 8), q1 = *(const f4*)(gP + tid * 8 + 4), u0 = *(const f4*)gU, u1 = *(const f4*)(gU + 4);
    for (int c = 0; c < NCH; ++c) {
        *(LAS f4*)(LP + tid * 8) = q0; *(LAS f4*)(LP + tid * 8 + 4) = q1;
        *(LAS f4*)(LS + row * 68 + sl * 8) = (f4){s[0], s[1], s[2], s[3]}; *(LAS f4*)(LS + row * 68 + sl * 8 + 4) = (f4){s[4], s[5], s[6], s[7]};
        *(f4*)(gU + (size_t)c * 4096) = (f4){s[0], s[1], s[2], s[3]}; *(f4*)(gU + (size_t)c * 4096 + 4) = (f4){s[4], s[5], s[6], s[7]};
        float n[8] = {u0.x, u0.y, u0.z, u0.w, u1.x, u1.y, u1.z, u1.w};
        __syncthreads();
        if (c + 1 < NCH) { q0 = *(const f4*)(gP + (size_t)(c + 1) * 4096 + tid * 8); q1 = *(const f4*)(gP + (size_t)(c + 1) * 4096 + tid * 8 + 4); u0 = *(const f4*)(gU + (size_t)(c + 1) * 4096); u1 = *(const f4*)(gU + (size_t)(c + 1) * 4096 + 4); }
#pragma unroll 4
        for (int i4 = 0; i4 < 16; ++i4) { const f4 sv = *(const LAS f4*)(LS + row * 68 + 4 * i4); const float se[4] = {sv.x, sv.y, sv.z, sv.w};
#pragma unroll
            for (int e = 0; e < 4; ++e) { const f4 pa = *(const LAS f4*)(LP + (4 * i4 + e) * 64 + sl * 8), pb = *(const LAS f4*)(LP + (4 * i4 + e) * 64 + sl * 8 + 4);
                n[0] += se[e] * pa.x; n[1] += se[e] * pa.y; n[2] += se[e] * pa.z; n[3] += se[e] * pa.w; n[4] += se[e] * pb.x; n[5] += se[e] * pb.y; n[6] += se[e] * pb.z; n[7] += se[e] * pb.w; } }
#pragma unroll
        for (int i = 0; i < 8; ++i) s[i] = n[i];
        __syncthreads();
    }
}
template <int MODE> __device__ __forceinline__ void scan_gla(const float* const* in, unsigned char* ws, int l, int item, LAS unsigned char* lds, int tid) {
    LAS float* LA = (LAS float*)lds; LAS float* LK = LA + 1024; LAS float* LQ = LA + 2048; LAS float* LV = LA + 3072; LAS float* LO = LA + 5120;
    const bf16* PROJ = (const bf16*)(ws + WS_PROJ); bf16* gO = (bf16*)(ws + WS_OGLA);
    const int bh = item / NCH, ch = item % NCH, hh = bh & 3, tokb = (bh >> 2) * SEQ + ch * CHL, nsub = CHL / 32;
    const int st = tid >> 4, si = tid & 15, vcol = tid >> 3, sl = tid & 7;
    float up0[16], up1[16];
#pragma unroll
    for (int r = 0; r < 16; ++r) { up0[r] = in[8][(l * 16 + r) * 128 + hh * 32 + 2 * si]; up1[r] = in[8][(l * 16 + r) * 128 + hh * 32 + 2 * si + 1]; }
    const float bi0 = in[9][l * 128 + hh * 32 + 2 * si], bi1 = in[9][l * 128 + hh * 32 + 2 * si + 1];
    float* gU = (float*)(ws + WS_GLU) + (size_t)item * 2048 + vcol * 32 + 4 * sl;
    float s[4] = {0.f, 0.f, 0.f, 0.f}, dp[4] = {1.f, 1.f, 1.f, 1.f};
    if (MODE == 1) { const f4 a = *(const f4*)gU; s[0] = a.x; s[1] = a.y; s[2] = a.z; s[3] = a.w; }
    u4 ps0, ps1; unsigned pq = 0, pk; u2 pv;
    { const bf16* p = PROJ + (size_t)(tokb + st) * NINP; ps0 = *(const u4*)(p + PC_GSTEM); ps1 = *(const u4*)(p + PC_GSTEM + 8); if (MODE == 1) pq = *(const unsigned*)(p + PC_GQ + hh * 32 + 2 * si); pk = *(const unsigned*)(p + PC_GK + hh * 32 + 2 * si); pv = *(const u2*)(p + PC_GV + hh * 64 + 4 * si); }
    for (int sub = 0; sub < nsub; ++sub) {
        { const unsigned sw[8] = {ps0.x, ps0.y, ps0.z, ps0.w, ps1.x, ps1.y, ps1.z, ps1.w}; float z0 = bi0, z1 = bi1;
#pragma unroll
          for (int r = 0; r < 8; ++r) { const float e0 = bflo(sw[r]), e1 = bfhi(sw[r]); z0 += e0 * up0[2 * r] + e1 * up0[2 * r + 1]; z1 += e0 * up1[2 * r] + e1 * up1[2 * r + 1]; }
          const float l0 = fminf(z0, 0.f) - log1pf(__expf(-fabsf(z0))), l1 = fminf(z1, 0.f) - log1pf(__expf(-fabsf(z1)));
          const int o = st * 32 + 2 * si; LA[o] = __expf(l0 * 0.0625f); LA[o + 1] = __expf(l1 * 0.0625f); LK[o] = bflo(pk); LK[o + 1] = bfhi(pk); if (MODE == 1) { LQ[o] = bflo(pq); LQ[o + 1] = bfhi(pq); }
          *(LAS f4*)(LV + st * 64 + 4 * si) = (f4){bflo(pv.x), bfhi(pv.x), bflo(pv.y), bfhi(pv.y)}; }
        __syncthreads();
        if (sub + 1 < nsub) { const bf16* p = PROJ + (size_t)(tokb + (sub + 1) * 32 + st) * NINP; ps0 = *(const u4*)(p + PC_GSTEM); ps1 = *(const u4*)(p + PC_GSTEM + 8); if (MODE == 1) pq = *(const unsigned*)(p + PC_GQ + hh * 32 + 2 * si); pk = *(const unsigned*)(p + PC_GK + hh * 32 + 2 * si); pv = *(const u2*)(p + PC_GV + hh * 64 + 4 * si); }
        {   f4 al, kk, qq = (f4){0.f, 0.f, 0.f, 0.f}; float vv;
#define GL_LOAD(T) { const int o_ = ((T) & 31) * 32 + 4 * sl; al = *(const LAS f4*)(LA + o_); kk = *(const LAS f4*)(LK + o_); if (MODE == 1) qq = *(const LAS f4*)(LQ + o_); vv = LV[((T) & 31) * 64 + vcol]; }
            GL_LOAD(0)
#pragma unroll 4
            for (int t = 0; t < 32; ++t) { const f4 ca = al, ck = kk, cq = qq; const float cv = vv;
                GL_LOAD(t + 1)
                s[0] = s[0] * ca.x + ck.x * cv; s[1] = s[1] * ca.y + ck.y * cv; s[2] = s[2] * ca.z + ck.z * cv; s[3] = s[3] * ca.w + ck.w * cv;
                if (MODE == 0) { dp[0] *= ca.x; dp[1] *= ca.y; dp[2] *= ca.z; dp[3] *= ca.w; }
                else { const float o = (s[0] * cq.x + s[1] * cq.y) + (s[2] * cq.z + s[3] * cq.w); LO[t * 64 + vcol] = red8(o) * 0.17677669529663687f; } }
#undef GL_LOAD
        }
        __syncthreads();
        if (MODE == 1) { const f4 y = *(const LAS f4*)(LO + st * 64 + 4 * si); u2 w; w.x = pk2(y.x, y.y); w.y = pk2(y.z, y.w); *(u2*)(gO + (size_t)(tokb + sub * 32 + st) * 256 + hh * 64 + 4 * si) = w; }
    }
    if (MODE == 0) { *(f4*)gU = (f4){s[0], s[1], s[2], s[3]}; if (vcol == 0) *(f4*)((float*)(ws + WS_GLD) + item * 32 + 4 * sl) = (f4){dp[0], dp[1], dp[2], dp[3]}; }
    __syncthreads();
}
template <int MODE> __device__ __forceinline__ void scan_ssd(unsigned char* ws, int item, LAS unsigned char* lds, int tid) {
    LAS float* LB = (LAS float*)lds; LAS float* LC = LB + 4096; LAS float* LX = LB + 8192; LAS float* LD = LB + 10240; LAS float* LY = LB + 10304;
    const bf16* XBC = (const bf16*)(ws + WS_XBC); const float* DT = (const float*)(ws + WS_DT); const float* DEC = (const float*)(ws + WS_DEC); bf16* gY = (bf16*)(ws + WS_YSSD);
    const int bh = item / NCH, ch = item % NCH, hh = bh & 3, tokb = (bh >> 2) * SEQ + ch * CHL, nsub = CHL / 32;
    const int st = tid >> 4, si = tid & 15, p = tid >> 3, sl = tid & 7, g = hh >> 1;
    float* gU = (float*)(ws + WS_SSU) + (size_t)item * 8192 + p * 128 + 16 * sl;
    f2 s[8]; float dprod = 1.f;
#pragma unroll
    for (int i = 0; i < 4; ++i) { f4 a = (f4){0.f, 0.f, 0.f, 0.f}; if (MODE == 1) a = *(const f4*)(gU + 4 * i); s[2 * i] = LO2(a); s[2 * i + 1] = HI2(a); }
    u4 pb, pc = (u4){0u, 0u, 0u, 0u}; u2 px; float pdt, pdec;
    { const size_t tok = tokb + st; const bf16* q = XBC + tok * 768; pb = *(const u4*)(q + 256 + g * 128 + 8 * si); if (MODE == 1) pc = *(const u4*)(q + 512 + g * 128 + 8 * si); px = *(const u2*)(q + hh * 64 + 4 * si); pdt = DT[tok * 4 + hh]; pdec = DEC[tok * 4 + hh]; }
    for (int sub = 0; sub < nsub; ++sub) {
        { const int o = st * 128 + 8 * si;
          *(LAS f4*)(LB + o) = (f4){bflo(pb.x), bfhi(pb.x), bflo(pb.y), bfhi(pb.y)}; *(LAS f4*)(LB + o + 4) = (f4){bflo(pb.z), bfhi(pb.z), bflo(pb.w), bfhi(pb.w)};
          if (MODE == 1) { *(LAS f4*)(LC + o) = (f4){bflo(pc.x), bfhi(pc.x), bflo(pc.y), bfhi(pc.y)}; *(LAS f4*)(LC + o + 4) = (f4){bflo(pc.z), bfhi(pc.z), bflo(pc.w), bfhi(pc.w)}; }
          *(LAS f4*)(LX + st * 64 + 4 * si) = (f4){bflo(px.x) * pdt, bfhi(px.x) * pdt, bflo(px.y) * pdt, bfhi(px.y) * pdt};
          if (si == 0) LD[st] = pdec; }
        __syncthreads();
        if (sub + 1 < nsub) { const size_t tok = tokb + (sub + 1) * 32 + st; const bf16* q = XBC + tok * 768; pb = *(const u4*)(q + 256 + g * 128 + 8 * si); if (MODE == 1) pc = *(const u4*)(q + 512 + g * 128 + 8 * si); px = *(const u2*)(q + hh * 64 + 4 * si); pdt = DT[tok * 4 + hh]; pdec = DEC[tok * 4 + hh]; }
        {   f4 bb[4], cc[4]; float xv, dc;
#pragma unroll
            for (int q4 = 0; q4 < 4; ++q4) cc[q4] = (f4){0.f, 0.f, 0.f, 0.f};
#define SS_LOAD(T) { const int o_ = ((T) & 31) * 128 + 16 * sl; _Pragma("unroll") for (int q4 = 0; q4 < 4; ++q4) { bb[q4] = *(const LAS f4*)(LB + o_ + 4 * q4); if (MODE == 1) cc[q4] = *(const LAS f4*)(LC + o_ + 4 * q4); } xv = LX[((T) & 31) * 64 + p]; dc = LD[(T) & 31]; }
            SS_LOAD(0)
#pragma unroll 2
            for (int t = 0; t < 32; ++t) { f4 cb_[4], cc_[4]; const float cx = xv, cd = dc;
#pragma unroll
                for (int q4 = 0; q4 < 4; ++q4) { cb_[q4] = bb[q4]; cc_[q4] = cc[q4]; }
                SS_LOAD(t + 1)
                if (MODE == 0) dprod *= cd;
                const f2 cd2 = (f2){cd, cd}, cx2 = (f2){cx, cx}; f2 y2 = (f2){0.f, 0.f};
#pragma unroll
                for (int q4 = 0; q4 < 4; ++q4) {
                    s[2 * q4] = s[2 * q4] * cd2 + LO2(cb_[q4]) * cx2; s[2 * q4 + 1] = s[2 * q4 + 1] * cd2 + HI2(cb_[q4]) * cx2;
                    if (MODE == 1) { y2 = s[2 * q4] * LO2(cc_[q4]) + y2; y2 = s[2 * q4 + 1] * HI2(cc_[q4]) + y2; } }
                if (MODE == 1) LY[t * 64 + p] = red8(y2.x + y2.y); }
#undef SS_LOAD
        }
        __syncthreads();
        if (MODE == 1) { const f4 y = *(const LAS f4*)(LY + st * 64 + 4 * si); u2 w; w.x = pk2(y.x, y.y); w.y = pk2(y.z, y.w); *(u2*)(gY + (size_t)(tokb + sub * 32 + st) * 256 + hh * 64 + 4 * si) = w; }
    }
    if (MODE == 0) {
#pragma unroll
        for (int i = 0; i < 4; ++i) *(f4*)(gU + 4 * i) = (f4){s[2 * i].x, s[2 * i].y, s[2 * i + 1].x, s[2 * i + 1].y};
        if (tid == 0) ((float*)(ws + WS_SSD))[item] = dprod; }
    __syncthreads();
}
__device__ __forceinline__ void scan_lru_carry(unsigned char* ws, int tid) {
    const float* SA = (const float*)(ws + WS_SEGA); const float* SH = (const float*)(ws + WS_SEGH); float* CY = (float*)(ws + WS_CARRY);
    const int b = tid >> 8, c = tid & 255; float h = 0.f;
#pragma unroll 8
    for (int sg = 0; sg < 256; ++sg) { const int o = (b * 256 + sg) * 256 + c; CY[o] = h; h = SA[o] * h + SH[o]; }
}
__device__ __forceinline__ void combine_gla(unsigned char* ws, int bh, int tid) {
    float* gU = (float*)(ws + WS_GLU) + (size_t)bh * NCH * 2048 + tid * 4; const float* gD = (const float*)(ws + WS_GLD) + bh * NCH * 32 + (tid & 7) * 4; f4 s = (f4){0.f, 0.f, 0.f, 0.f};
#pragma unroll 4
    for (int c = 0; c < NCH; ++c) { const f4 u = *(const f4*)(gU + (size_t)c * 2048), d = *(const f4*)(gD + c * 32); *(f4*)(gU + (size_t)c * 2048) = s; s = s * d + u; }
}
__device__ __forceinline__ void combine_ssd(unsigned char* ws, int q, int tid) {
    const int bh = q >> 2; float* gU = (float*)(ws + WS_SSU) + (size_t)bh * NCH * 8192 + (q & 3) * 2048 + tid * 4; const float* gD = (const float*)(ws + WS_SSD) + bh * NCH; f4 s = (f4){0.f, 0.f, 0.f, 0.f};
#pragma unroll 4
    for (int c = 0; c < NCH; ++c) { const f4 u = *(const f4*)(gU + (size_t)c * 8192); const float d = gD[c]; *(f4*)(gU + (size_t)c * 8192) = s; s = s * d + u; }
}
template <int MODE> __device__ __forceinline__ void phase_scan(const float* const* in, unsigned char* ws, int l, LAS unsigned char* lds, int tid) {
    constexpr int NI = 8 * NCH;
    for (int it = blockIdx.x; it < 3 * NI + (MODE == 0 ? 1 : 0); it += gridDim.x) {
        if (it < NI) scan_rw<MODE>(ws, it, lds, tid);
        else if (it < 2 * NI) scan_ssd<MODE>(ws, it - NI, lds, tid);
        else if (it < 3 * NI) scan_gla<MODE>(in, ws, l, it - 2 * NI, lds, tid);
        else scan_lru_carry(ws, tid);
    }
}
__device__ __forceinline__ void phase_combine(unsigned char* ws, LAS unsigned char* lds, int tid) {
    for (int it = blockIdx.x; it < 48; it += gridDim.x) {
        if (it < 8) combine_rw(ws, it, lds, tid);
        else if (it < 16) combine_gla(ws, it - 8, tid);
        else combine_ssd(ws, it - 16, tid);
    }
}
__device__ __forceinline__ float red16(float x) { x += __shfl_xor(x, 1); x += __shfl_xor(x, 2); x += __shfl_xor(x, 4); x += __shfl_xor(x, 8); return x; }
__device__ __forceinline__ void phase_post(const float* const* in, unsigned char* ws, int l, int gw, int NGW, int lane) {
    const bf16* PROJ = (const bf16*)(ws + WS_PROJ); bf16* Y = (bf16*)(ws + WS_Y); const int c = 4 * lane, hh = lane >> 4;
    const f4 gnorm = *(const f4*)(in[10] + l * 64 + (c & 63)), gnw = *(const f4*)(in[30] + l * 256 + c), gnb = *(const f4*)(in[31] + l * 256 + c), snw = *(const f4*)(in[37] + l * 256 + c);
    const float dsk = in[36][l * 4 + hh];
    for (int tok = gw; tok < M; tok += NGW) { const bf16* pp = PROJ + (size_t)tok * NINP; const size_t o = (size_t)tok * 256 + c; bf16* yo = Y + (size_t)tok * D + c;
        { const u2 ov = *(const u2*)((const bf16*)(ws + WS_OGLA) + o), gv = *(const u2*)(pp + PC_GG + c);
          const float o0 = bflo(ov.x), o1 = bfhi(ov.x), o2 = bflo(ov.y), o3 = bfhi(ov.y);
          const float rs = rsqrtf(red16((o0 * o0 + o1 * o1) + (o2 * o2 + o3 * o3)) * (1.f / 64.f) + 1e-5f);
          u2 w; w.x = pk2(o0 * rs * gnorm.x * siluf_(bflo(gv.x)), o1 * rs * gnorm.y * siluf_(bfhi(gv.x))); w.y = pk2(o2 * rs * gnorm.z * siluf_(bflo(gv.y)), o3 * rs * gnorm.w * siluf_(bfhi(gv.y))); *(u2*)(yo) = w; }
        { const f4 A = *(const f4*)((const float*)(ws + WS_LRA) + o), H = *(const f4*)((const float*)(ws + WS_LRH) + o), cy = *(const f4*)((const float*)(ws + WS_CARRY) + (size_t)(tok >> 5) * 256 + c);
          const u2 gv = *(const u2*)(pp + PC_LG + c);
          u2 w; w.x = pk2((H.x + A.x * cy.x) * gelu_tanh(bflo(gv.x)), (H.y + A.y * cy.y) * gelu_tanh(bfhi(gv.x))); w.y = pk2((H.z + A.z * cy.z) * gelu_tanh(bflo(gv.y)), (H.w + A.w * cy.w) * gelu_tanh(bfhi(gv.y))); *(u2*)(yo + 256) = w; }
        { const u2 yv = *(const u2*)((const bf16*)(ws + WS_YRW) + o), vv = *(const u2*)((const bf16*)(ws + WS_RWV) + o), gv = *(const u2*)((const bf16*)(ws + WS_RWG) + o);
          const float bon = ((const float*)(ws + WS_RWBON))[tok * 4 + hh];
          float y0 = bflo(yv.x), y1 = bfhi(yv.x), y2 = bflo(yv.y), y3 = bfhi(yv.y);
          const float mean = red16((y0 + y1) + (y2 + y3)) * (1.f / 64.f); y0 -= mean; y1 -= mean; y2 -= mean; y3 -= mean;
          const float rs = rsqrtf(red16((y0 * y0 + y1 * y1) + (y2 * y2 + y3 * y3)) * (1.f / 64.f) + 64e-5f);
          u2 w; w.x = pk2((y0 * rs * gnw.x + gnb.x + bon * bflo(vv.x)) * bflo(gv.x), (y1 * rs * gnw.y + gnb.y + bon * bfhi(vv.x)) * bfhi(gv.x));
          w.y = pk2((y2 * rs * gnw.z + gnb.z + bon * bflo(vv.y)) * bflo(gv.y), (y3 * rs * gnw.w + gnb.w + bon * bfhi(vv.y)) * bfhi(gv.y)); *(u2*)(yo + 512) = w; }
        { const u2 yv = *(const u2*)((const bf16*)(ws + WS_YSSD) + o), xv = *(const u2*)((const bf16*)(ws + WS_XBC) + (size_t)tok * 768 + c), zv = *(const u2*)(pp + PC_SZ + c);
          const float y0 = (bflo(yv.x) + dsk * bflo(xv.x)) * siluf_(bflo(zv.x)), y1 = (bfhi(yv.x) + dsk * bfhi(xv.x)) * siluf_(bfhi(zv.x)), y2 = (bflo(yv.y) + dsk * bflo(xv.y)) * siluf_(bflo(zv.y)), y3 = (bfhi(yv.y) + dsk * bfhi(xv.y)) * siluf_(bfhi(zv.y));
          float q = red16((y0 * y0 + y1 * y1) + (y2 * y2 + y3 * y3)); q += __shfl_xor(q, 16);
          const float rs = rsqrtf(q * (1.f / 128.f) + 1e-5f);
          u2 w; w.x = pk2(y0 * rs * snw.x, y1 * rs * snw.y); w.y = pk2(y2 * rs * snw.z, y3 * rs * snw.w); *(u2*)(yo + 768) = w; }
    }
}
#ifndef PROBE_GEMM
#define PROBE_GEMM 1
#endif
#ifndef PROBE_SCAN
#define PROBE_SCAN 1
#endif
#ifndef PROBE_MISC
#define PROBE_MISC 1
#endif
struct Args { const float* in[43]; float* out; unsigned char* ws; };
template <class Epi> __device__ __forceinline__ void gemm_multi(LAS unsigned char* lds, const pg8::Gemm& g, const Epi& E) {
    pg8::StaticOrder S; S.init(g.M, g.N, (int)gridDim.x, (int)blockIdx.x);
    pg8::gemm_phase<Epi, pg8::StaticOrder, true, true>(lds, g, S, E);
}
template <class Epi> __device__ __forceinline__ void gemm_single(LAS unsigned char* lds, const pg8::Gemm& g, const Epi& E) {
    pg8::StaticOrder S; S.init(g.M, g.N, (int)gridDim.x, (int)blockIdx.x);
    for (int r = 0;; ++r) { pg8::Unit u; if (!S.next(r, u)) break; OneUnit O{S, r}; pg8::gemm_phase<Epi, OneUnit, false, true>(lds, g, O, E); }
}
__global__ void __launch_bounds__(512, 2) fwd(Args a) {
    extern __shared__ __attribute__((aligned(16))) unsigned char lds_raw[];
    LAS unsigned char* lds = (LAS unsigned char*)lds_raw;
    cg::grid_group grid = cg::this_grid();
    unsigned* ctl = (unsigned*)(a.ws + WS_CTL); volatile LAS unsigned* MISC = (volatile LAS unsigned*)(lds + LDS_BYTES - 64);
    if (blockIdx.x == 0) for (int i = threadIdx.x; i < XCD_BAR_WORDS; i += 512) __hip_atomic_store(ctl + i, 0u, __ATOMIC_RELAXED, __HIP_MEMORY_SCOPE_AGENT);
    if (threadIdx.x < 2) MISC[threadIdx.x] = 0u;
    __threadfence();
    grid.sync();
    const XcdBarrier bar = xcd_barrier_post(ctl, MISC);
#define TIDS int tid = threadIdx.x; asm volatile("" : "+v"(tid)); const int lane = tid & 63, wave = __builtin_amdgcn_readfirstlane(tid >> 6), gw = blockIdx.x * 8 + wave, NGW = gridDim.x * 8; (void)lane; (void)gw; (void)NGW;
    unsigned char* ws = a.ws; const float* const* in = a.in; float* X = a.out;
    bf16* XB = (bf16*)(ws + WS_XB); bf16* Y = (bf16*)(ws + WS_Y); bf16* H = (bf16*)(ws + WS_PROJ); bf16* PROJ = (bf16*)(ws + WS_PROJ); float* SS = (float*)(ws + WS_SS);
#pragma unroll 1
    for (int l = 0; l < NL; ++l) {
        for (int rep = 0; rep < PROBE_MISC; ++rep) { TIDS
#ifndef SKIP_CONV
        phase_convert(in, ws, l, lds, gw, NGW, wave, lane);
#endif
        if (l == 0) phase_init_rows(in[0], XB, SS, gw, NGW, lane); }
        xcd_barrier(bar);
#ifndef SKIP_G1
        for (int rep = 0; rep < PROBE_GEMM; ++rep) { pg8::Gemm g{XB, (const bf16*)(ws + WS_WGU1), M, 2 * FF, D}; EpiGU E{H, SS}; gemm_single(lds, g, E); }
#endif
        xcd_barrier(bar);
#ifndef SKIP_G2
        { pg8::Gemm g{H, (const bf16*)(ws + WS_WD1), M, D, FF}; EpiResid E{l == 0 ? in[0] : X, X, XB, SS, 0.5f}; gemm_single(lds, g, E); }
#endif
        xcd_barrier(bar);
#ifndef SKIP_G3
        for (int rep = 0; rep < PROBE_GEMM; ++rep) { pg8::Gemm g{XB, (const bf16*)(ws + WS_WIN), M, NINP, D}; EpiProj E{PROJ, SS}; gemm_single(lds, g, E); }
#endif
        xcd_barrier(bar);
#ifndef SKIP_PREP
        for (int rep = 0; rep < PROBE_MISC; ++rep) { TIDS phase_prep(in, ws, l, lds, tid); }
#endif
        xcd_barrier(bar);
#ifndef SKIP_SCAN
        for (int rep = 0; rep < PROBE_SCAN; ++rep) { TIDS phase_scan<0>(in, ws, l, lds, tid); }
        xcd_barrier(bar);
        { TIDS phase_combine(ws, lds, tid); }
        xcd_barrier(bar);
        for (int rep = 0; rep < PROBE_SCAN; ++rep) { TIDS phase_scan<1>(in, ws, l, lds, tid); }
#endif
        xcd_barrier(bar);
#ifndef SKIP_POST
        for (int rep = 0; rep < PROBE_MISC; ++rep) { TIDS phase_post(in, ws, l, gw, NGW, lane); }
#endif
        xcd_barrier(bar);
#ifndef SKIP_G4
        { pg8::Gemm g{Y, (const bf16*)(ws + WS_WOUT), M, D, D}; EpiResid E{X, X, XB, SS, 1.0f}; gemm_single(lds, g, E); }
#endif
        xcd_barrier(bar);
#ifndef SKIP_G5
        for (int rep = 0; rep < PROBE_GEMM; ++rep) { pg8::Gemm g{XB, (const bf16*)(ws + WS_WGU2), M, 2 * FF, D}; EpiGU E{H, SS}; gemm_single(lds, g, E); }
#endif
        xcd_barrier(bar);
#ifndef SKIP_G6
        { pg8::Gemm g{H, (const bf16*)(ws + WS_WD2), M, D, FF}; EpiResid E{X, X, XB, SS, 0.5f}; gemm_single(lds, g, E); }
#endif
        xcd_barrier(bar);
    }
    { TIDS phase_final(X, in[42], gw, NGW, lane); }
}

extern "C" void kernel_launch(void* const* d_in, const int* in_sizes, int n_in, void* d_out, int out_size, void* d_ws, size_t ws_size, hipStream_t stream) {
    static int grid = 0;
    if (grid == 0) {
        int dev = 0, cus = 0, per_cu = 0;
        (void)hipGetDevice(&dev);
        (void)hipDeviceGetAttribute(&cus, hipDeviceAttributeMultiprocessorCount, dev);
        (void)hipFuncSetAttribute((const void*)fwd, hipFuncAttributeMaxDynamicSharedMemorySize, LDS_BYTES);
        (void)hipOccupancyMaxActiveBlocksPerMultiprocessor(&per_cu, (const void*)fwd, 512, LDS_BYTES);
        if (per_cu < 1) per_cu = 1;
        grid = cus * per_cu;
        if (n_in != 43 || out_size != M * D || ws_size < WS_END) fprintf(stderr, "kernel_launch: unexpected sizes n_in %d out %d ws %zu (need %zu)\n", n_in, out_size, ws_size, (size_t)WS_END);
    }
    Args a{};
    for (int i = 0; i < 43 && i < n_in; ++i) a.in[i] = (const float*)d_in[i];
    a.out = (float*)d_out; a.ws = (unsigned char*)d_ws;
    void* args[] = {&a};
    hipError_t e = hipLaunchCooperativeKernel((const void*)fwd, dim3(grid), dim3(512), args, LDS_BYTES, stream);
    if (e != hipSuccess) fprintf(stderr, "cooperative launch failed: %s (grid %d)\n", hipGetErrorString(e), grid);
}
```

```cpp
#include <hip/hip_runtime.h>
#include <hip/hip_cooperative_groups.h>
#include <cstdio>
#include <cstdint>
namespace cg = cooperative_groups;
namespace pg8 {
#define PG8_LAS __attribute__((address_space(3)))
typedef unsigned short bf16_t;
typedef short bf16x8 __attribute__((ext_vector_type(8)));
typedef float f32x4 __attribute__((ext_vector_type(4)));
typedef unsigned u32x4 __attribute__((ext_vector_type(4)));
constexpr int BM = 256, BK = 64, HALF = 128, HTB = HALF * BK * 2  , STAGE_BYTES = 8 * HTB, NXCD = 8, WGM = 8;

__host__ __device__ __forceinline__ int lds_byte(int r, int c) { const int st = (r >> 4) * 2 + (c >> 5), rr = r & 15, cc = c & 31, ob = rr * 64 + cc * 2; return st * 1024 + (ob ^ (((ob >> 9) & 1) << 5)); }
__host__ __device__ __forceinline__ void stage_rc(int b, int& R, int& C) { const int st = b / 1024, sb = b % 1024, swz = sb ^ (((sb >> 9) & 1) << 5); R = (st >> 1) * 16 + swz / 64; C = (st & 1) * 32 + (swz % 64) / 2; }
__host__ __device__ __forceinline__ int perm32(int rho) { const int n = rho >> 4, i = rho & 15; return 8 * (i >> 2) + 4 * n + (i & 3); }

struct Unit { int pm, pn; };
struct Gemm { const bf16_t* A; const bf16_t* Bt; int M, N, K; };

struct StaticOrder {
    int nM, nN, nwg, G, c;
    __host__ __device__ void init(int M, int N, int G_, int c_) { nM = M / BM; nN = N / BM; nwg = nM * nN; G = G_; c = c_; }
    __host__ __device__ bool next(int i, Unit& u) const {
        const long L = (long)i * G + c; if (L >= nwg) return false;
        int wgid = (int)L; { const int q = nwg / NXCD, r = nwg % NXCD, xcd = wgid % NXCD, off = wgid / NXCD; wgid = (xcd < r ? xcd * (q + 1) : r * (q + 1) + (xcd - r) * q) + off; }
        const int nig = WGM * nN, gid = wgid / nig, fm = gid * WGM, gsz = (nM - fm) < WGM ? (nM - fm) : WGM;
        u.pm = fm + ((wgid % nig) % gsz); u.pn = (wgid % nig) / gsz; return true;
    }
    __device__ __forceinline__ void a_ready(const Unit&) const {}
    __device__ __forceinline__ void done(const Unit&) const {}
};

__device__ __forceinline__ unsigned cvt_pk_bf16(float lo, float hi) { unsigned r; asm volatile("v_cvt_pk_bf16_f32 %0, %1, %2" : "=v"(r) : "v"(lo), "v"(hi)); return r; }
typedef float f32x2 __attribute__((ext_vector_type(2)));
template <class Epi, class Sched, bool ALIGN_EPI = false, bool SP2 = false>
__device__ __forceinline__ void gemm_phase(PG8_LAS unsigned char* lds, const Gemm g, const Sched& S, const Epi& E) {
    int tid_ = threadIdx.x; asm volatile("" : "+v"(tid_));
    const int tid = tid_, wid = __builtin_amdgcn_readfirstlane(tid >> 6), lane = tid & 63, wr = wid >> 2, wc = wid & 3, fr = lane & 15, fq = lane >> 4;
    const int K = g.K, nt = K / BK;
    unsigned voffA[2], voffB[2];
#pragma unroll
    for (int i = 0; i < 2; ++i) { int R, C; stage_rc(tid * 16 + i * 8192, R, C); const int Rb = Epi::PERM ? ((R & ~31) + perm32(R & 31)) : R;
        voffA[i] = (unsigned)(R * K + C) * 2u; voffB[i] = (unsigned)(Rb * K + C) * 2u; }
    const size_t kstep = (size_t)(BK * 2);
    const size_t hstep = (size_t)HALF * K * 2;
    const size_t tstep = 2 * hstep;
    const unsigned ldsw = (unsigned)wid * 1024u;
    const int aoff = lds_byte(wr * 64 + fr, fq * 8), boff = lds_byte(wc * 32 + fr, fq * 8);
#define PG8_SA(b, h) (((b) * 2 + (h)) * HTB)
#define PG8_SB(b, h) ((4 + (b) * 2 + (h)) * HTB)
#define PG8_STAGE(bufoff, gbase, voff) do { _Pragma("unroll") for (int _i = 0; _i < 2; ++_i) \
        __builtin_amdgcn_global_load_lds((const unsigned*)((const char*)(gbase) + (voff)[_i]), (PG8_LAS unsigned*)(lds + (bufoff) + ldsw + _i * 8192), 16, 0, 0); } while (0)
#define PG8_LDA(dst, b, h) do { _Pragma("unroll") for (int m = 0; m < 4; ++m) _Pragma("unroll") for (int k = 0; k < 2; ++k) dst[m][k] = *(const PG8_LAS bf16x8*)(lds + PG8_SA(b, h) + aoff + m * 2048 + k * 1024); } while (0)
#define PG8_LDB(dst, b, h) do { _Pragma("unroll") for (int n = 0; n < 2; ++n) _Pragma("unroll") for (int k = 0; k < 2; ++k) dst[n][k] = *(const PG8_LAS bf16x8*)(lds + PG8_SB(b, h) + boff + n * 2048 + k * 1024); } while (0)
#define PG8_MMA(ai, bj, At, Bt) do { __builtin_amdgcn_s_setprio(1); _Pragma("unroll") for (int m = 0; m < 4; ++m) _Pragma("unroll") for (int n = 0; n < 2; ++n) _Pragma("unroll") for (int k = 0; k < 2; ++k) \
        acc[ai][bj][m][n] = __builtin_amdgcn_mfma_f32_16x16x32_bf16(Bt[n][k], At[m][k], acc[ai][bj][m][n], 0, 0, 0); __builtin_amdgcn_s_setprio(0); } while (0)
#define PG8_WAIT_V(n) asm volatile("s_waitcnt vmcnt(" #n ")" ::: "memory")
#define PG8_WAIT_L(n) asm volatile("s_waitcnt lgkmcnt(" #n ")" ::: "memory")
#define PG8_BAR __builtin_amdgcn_s_barrier()
#define PG8_SCHED __builtin_amdgcn_sched_barrier(0)
    Unit cur, nxt; int ui = 0;
    if (!S.next(0, cur)) return;
    f32x4 acc[2][2][4][2];
#pragma unroll
    for (int a = 0; a < 2; ++a)
#pragma unroll
        for (int b = 0; b < 2; ++b)
#pragma unroll
            for (int m = 0; m < 4; ++m)
#pragma unroll
                for (int n = 0; n < 2; ++n) acc[a][b][m][n] = (f32x4){0.f, 0.f, 0.f, 0.f};
    bf16x8 At[4][2], B0[2][2], B1[2][2];
    const char* cA = (const char*)g.A + (size_t)cur.pm * tstep; const char* cB = (const char*)g.Bt + (size_t)cur.pn * tstep;
    S.a_ready(cur);
    if constexpr (SP2) {
        PG8_STAGE(PG8_SB(0, 0), cB, voffB); PG8_STAGE(PG8_SB(0, 1), cB + hstep, voffB); PG8_STAGE(PG8_SA(0, 0), cA, voffA); PG8_STAGE(PG8_SA(0, 1), cA + hstep, voffA);
        if (wr == 1) PG8_BAR;
        PG8_WAIT_V(2); PG8_BAR;
        PG8_STAGE(PG8_SB(1, 0), cB + kstep, voffB); PG8_STAGE(PG8_SA(1, 0), cA + kstep, voffA); PG8_STAGE(PG8_SB(1, 1), cB + hstep + kstep, voffB);
        PG8_WAIT_V(6); PG8_BAR;
    } else {
        PG8_STAGE(PG8_SB(0, 0), cB, voffB); PG8_STAGE(PG8_SA(0, 0), cA, voffA); PG8_STAGE(PG8_SB(0, 1), cB + hstep, voffB); PG8_STAGE(PG8_SA(0, 1), cA + hstep, voffA);
        if (wr == 1) PG8_BAR;
        PG8_WAIT_V(4); PG8_BAR;
        PG8_STAGE(PG8_SB(1, 0), cB + kstep, voffB); PG8_STAGE(PG8_SA(1, 0), cA + kstep, voffA); PG8_STAGE(PG8_SB(1, 1), cB + hstep + kstep, voffB);
        PG8_WAIT_V(6); PG8_BAR;
    }
    for (;;) {
        const bool has_next = S.next(ui + 1, nxt);
        const char* nA = has_next ? (const char*)g.A + (size_t)nxt.pm * tstep : cA; const char* nB = has_next ? (const char*)g.Bt + (size_t)nxt.pn * tstep : cB;
        for (int t = 0; t < nt; t += 2) {
            const bool last = (t == nt - 2);
            const char* a1 = cA + (size_t)(t + 1) * kstep;
            const char* a2 = last ? nA : cA + (size_t)(t + 2) * kstep; const char* b2 = last ? nB : cB + (size_t)(t + 2) * kstep;
            const char* a3 = a2 + kstep; const char* b3 = b2 + kstep;
            if (last && has_next) S.a_ready(nxt);
            if constexpr (SP2) {
            PG8_LDB(B0, 0, 0); PG8_LDB(B1, 0, 1); PG8_SCHED; PG8_LDA(At, 0, 0); PG8_STAGE(PG8_SA(1, 1), a1 + hstep, voffA);
            PG8_WAIT_V(8); PG8_WAIT_L(0); PG8_BAR; PG8_MMA(0, 0, At, B0); PG8_MMA(0, 1, At, B1); PG8_BAR; PG8_SCHED;
            PG8_LDA(At, 0, 1); PG8_STAGE(PG8_SB(0, 0), b2, voffB); PG8_STAGE(PG8_SB(0, 1), b2 + hstep, voffB); PG8_STAGE(PG8_SA(0, 0), a2, voffA);
            PG8_WAIT_V(8); PG8_WAIT_L(0); PG8_BAR; PG8_MMA(1, 0, At, B0); PG8_MMA(1, 1, At, B1); PG8_BAR; PG8_SCHED;
            PG8_LDB(B0, 1, 0); PG8_LDB(B1, 1, 1); PG8_SCHED; PG8_LDA(At, 1, 0); PG8_STAGE(PG8_SA(0, 1), a2 + hstep, voffA);
            PG8_WAIT_V(8); PG8_WAIT_L(0); PG8_BAR; PG8_MMA(0, 0, At, B0); PG8_MMA(0, 1, At, B1); PG8_BAR; PG8_SCHED;
            PG8_LDA(At, 1, 1); PG8_STAGE(PG8_SB(1, 0), b3, voffB); PG8_STAGE(PG8_SB(1, 1), b3 + hstep, voffB); PG8_STAGE(PG8_SA(1, 0), a3, voffA);
            PG8_WAIT_V(8); PG8_WAIT_L(0); PG8_BAR; PG8_MMA(1, 0, At, B0); PG8_MMA(1, 1, At, B1); PG8_BAR; PG8_SCHED;
            } else {
            PG8_LDB(B0, 0, 0); PG8_SCHED; PG8_LDA(At, 0, 0); PG8_STAGE(PG8_SA(1, 1), a1 + hstep, voffA);
            PG8_WAIT_L(8); PG8_BAR; PG8_WAIT_L(0); PG8_MMA(0, 0, At, B0); PG8_BAR; PG8_SCHED;
            PG8_LDB(B1, 0, 1); PG8_STAGE(PG8_SB(0, 0), b2, voffB);
            PG8_BAR; PG8_WAIT_L(0); PG8_MMA(0, 1, At, B1); PG8_BAR;
            PG8_LDA(At, 0, 1); PG8_STAGE(PG8_SA(0, 0), a2, voffA);
            PG8_BAR; PG8_WAIT_L(0); PG8_MMA(1, 0, At, B0); PG8_BAR; PG8_SCHED;
            PG8_STAGE(PG8_SB(0, 1), b2 + hstep, voffB);
            PG8_WAIT_V(6); PG8_BAR; PG8_MMA(1, 1, At, B1); PG8_BAR;
            PG8_LDB(B0, 1, 0); PG8_SCHED; PG8_LDA(At, 1, 0); PG8_STAGE(PG8_SA(0, 1), a2 + hstep, voffA);
            PG8_WAIT_L(8); PG8_BAR; PG8_WAIT_L(0); PG8_MMA(0, 0, At, B0); PG8_BAR; PG8_SCHED;
            PG8_LDB(B1, 1, 1); PG8_STAGE(PG8_SB(1, 0), b3, voffB);
            PG8_BAR; PG8_WAIT_L(0); PG8_MMA(0, 1, At, B1); PG8_BAR;
            PG8_LDA(At, 1, 1); PG8_STAGE(PG8_SA(1, 0), a3, voffA);
            PG8_BAR; PG8_WAIT_L(0); PG8_MMA(1, 0, At, B0); PG8_BAR; PG8_SCHED;
            PG8_STAGE(PG8_SB(1, 1), b3 + hstep, voffB);
            PG8_WAIT_V(6); PG8_BAR; PG8_MMA(1, 1, At, B1); PG8_BAR;
            }
        }
        if constexpr (ALIGN_EPI) { if (wr == 0) PG8_BAR; }
        if constexpr (!Epi::AFTER_DRAIN) { E(acc, cur, wr, wc, fr, fq); S.done(cur); }
        if (!has_next) break;
#pragma unroll
        for (int a = 0; a < 2; ++a)
#pragma unroll
            for (int b = 0; b < 2; ++b)
#pragma unroll
                for (int m = 0; m < 4; ++m)
#pragma unroll
                    for (int n = 0; n < 2; ++n) acc[a][b][m][n] = (f32x4){0.f, 0.f, 0.f, 0.f};
        cur = nxt; cA = nA; cB = nB; ++ui;
        if constexpr (ALIGN_EPI) { if (wr == 1) PG8_BAR; }
    }
    PG8_WAIT_V(0);
    if constexpr (!ALIGN_EPI) { if (wr == 0) PG8_BAR; }
    PG8_BAR;
    if constexpr (Epi::AFTER_DRAIN) { E.fused(acc, cur, wr, wc, fr, fq, lds, wid, lane); S.done(cur); }
#undef PG8_SA
#undef PG8_SB
#undef PG8_STAGE
#undef PG8_LDA
#undef PG8_LDB
#undef PG8_MMA
#undef PG8_WAIT_V
#undef PG8_WAIT_L
#undef PG8_BAR
#undef PG8_SCHED
}
}
#define LAS __attribute__((address_space(3)))
typedef unsigned short bf16;
typedef float f4 __attribute__((ext_vector_type(4)));
typedef float f2 __attribute__((ext_vector_type(2)));
#define LO2(v) __builtin_shufflevector(v, v, 0, 1)
#define HI2(v) __builtin_shufflevector(v, v, 2, 3)
typedef unsigned u2 __attribute__((ext_vector_type(2)));
typedef unsigned u4 __attribute__((ext_vector_type(4)));
using pg8::f32x4;

constexpr int M = 16384, D = 1024, FF = 2816, NIN = 3156, NINP = 3328, NL = 4, SEQ = 8192;
constexpr int LDS_BYTES = 147456;
constexpr size_t HM = 524288;
constexpr size_t WS_WGU1 = 0, WS_WD1 = 22 * HM, WS_WIN = 33 * HM, WS_WOUT = 46 * HM, WS_WGU2 = 50 * HM, WS_WD2 = 72 * HM;
constexpr size_t MiB = 1048576;
constexpr size_t WS_XB = 42 * MiB;
constexpr size_t WS_OGLA = WS_XB, WS_YRW = WS_XB + 8 * MiB, WS_YSSD = WS_XB + 16 * MiB;
constexpr size_t WS_Y = 74 * MiB;
constexpr size_t WS_PROJ = 106 * MiB;
constexpr size_t WS_VFIRST = 210 * MiB;
constexpr size_t WS_SS = 226 * MiB;
constexpr size_t WS_RWR = 227 * MiB, WS_RWK = 235 * MiB, WS_RWV = 243 * MiB, WS_RWKK = 251 * MiB, WS_RWB = 259 * MiB;
constexpr size_t WS_RWW = 267 * MiB;
constexpr size_t WS_RWG = 283 * MiB;
constexpr size_t WS_RWBON = 291 * MiB;
constexpr size_t WS_XBC = 292 * MiB;
constexpr size_t WS_DT = 316 * MiB, WS_DEC = 317 * MiB;
constexpr size_t WS_LRA = 318 * MiB, WS_LRH = 334 * MiB;
constexpr size_t WS_SEGA = 350 * MiB, WS_SEGH = 351 * MiB, WS_CARRY = 352 * MiB;
constexpr int NCH = 32, CHL = SEQ / NCH;
constexpr size_t WS_RWP = 353 * MiB, WS_RWU = 357 * MiB;
constexpr size_t WS_GLU = 361 * MiB, WS_GLD = 363 * MiB;
constexpr size_t WS_SSU = 364 * MiB, WS_SSD = 372 * MiB;
constexpr size_t WS_CTL = 373 * MiB;
constexpr size_t WS_END = 374 * MiB;

constexpr int PC_GQ = 0, PC_GK = 128, PC_GV = 256, PC_GG = 512, PC_GSTEM = 768, PC_LX = 784, PC_LG = 1040, PC_RW = 1296, PC_SZ = 2128, PC_SXBC = 2384, PC_SDT = 3152;

__device__ __forceinline__ float bf2f(bf16 v) { return __uint_as_float((unsigned)v << 16); }
__device__ __forceinline__ float bflo(unsigned w) { return __uint_as_float(w << 16); }
__device__ __forceinline__ float bfhi(unsigned w) { return __uint_as_float(w & 0xffff0000u); }
__device__ __forceinline__ unsigned pk2(float lo, float hi) { return pg8::cvt_pk_bf16(lo, hi); }
__device__ __forceinline__ float sigmoidf_(float x) { return 1.f / (1.f + __expf(-x)); }
__device__ __forceinline__ float siluf_(float x) { return x / (1.f + __expf(-x)); }
__device__ __forceinline__ float tanhf_(float x) { return 1.f - 2.f / (1.f + __expf(2.f * x)); }
__device__ __forceinline__ float softplusf_(float x) { return fmaxf(x, 0.f) + log1pf(__expf(-fabsf(x))); }
__device__ __forceinline__ float gelu_tanh(float x) { const float u = 0.7978845608028654f * (x + 0.044715f * x * x * x); return 0.5f * x * (1.f + tanhf_(u)); }
__device__ __forceinline__ float wave_sum(float v) {
#pragma unroll
    for (int o = 1; o < 64; o <<= 1) v += __shfl_xor(v, o);
    return v;
}
__device__ __forceinline__ float dpp_mov(float x, const int ctrl_sel) {
    const int v = __builtin_bit_cast(int, x); int r;
    if (ctrl_sel == 0) r = __builtin_amdgcn_update_dpp(0, v, 0xB1, 0xF, 0xF, true);
    else if (ctrl_sel == 1) r = __builtin_amdgcn_update_dpp(0, v, 0x4E, 0xF, 0xF, true);
    else r = __builtin_amdgcn_update_dpp(0, v, 0x141, 0xF, 0xF, true);
    return __builtin_bit_cast(float, r);
}
__device__ __forceinline__ float red8(float x) { x += dpp_mov(x, 0); x += dpp_mov(x, 1); x += dpp_mov(x, 2); return x; }
__device__ __forceinline__ float rstd_row(const float* ss, int row) { const f4 p = *(const f4*)(ss + (size_t)row * 4); return rsqrtf(((p.x + p.y) + (p.z + p.w)) * (1.f / 1024.f) + 1e-6f); }

__device__ __forceinline__ void lds_barrier() { asm volatile("s_waitcnt lgkmcnt(0)" ::: "memory"); __builtin_amdgcn_s_barrier(); asm volatile("" ::: "memory"); }
struct EpiGU {
    static constexpr bool PERM = true, AFTER_DRAIN = true;
    bf16* H; const float* ss;
    __device__ __forceinline__ void fused(f32x4 (&acc)[2][2][4][2], const pg8::Unit& u, int wr, int wc, int fr, int fq, LAS unsigned char* lds, int wid, int lane) const {
#pragma unroll
        for (int ai = 0; ai < 2; ++ai)
#pragma unroll
            for (int m = 0; m < 4; ++m) {
                const int row = u.pm * 256 + ai * 128 + wr * 64 + m * 16 + fr; const float rs = rstd_row(ss, row);
                float hv[8];
#pragma unroll
                for (int n = 0; n < 2; ++n)
#pragma unroll
                    for (int e = 0; e < 4; ++e) { const float g = acc[ai][0][m][n][e] * rs, up = acc[ai][1][m][n][e] * rs; hv[n * 4 + e] = siluf_(g) * up; }
                u4 w; w.x = pk2(hv[0], hv[1]); w.y = pk2(hv[2], hv[3]); w.z = pk2(hv[4], hv[5]); w.w = pk2(hv[6], hv[7]);
                *(u4*)(H + (size_t)row * FF + u.pn * 128 + wc * 32 + 8 * fq) = w;
                asm volatile("" ::: "memory");
            }
    }
};
struct EpiProj {
    static constexpr bool PERM = true, AFTER_DRAIN = true;
    bf16* O; const float* ss;
    __device__ __forceinline__ void fused(f32x4 (&acc)[2][2][4][2], const pg8::Unit& u, int wr, int wc, int fr, int fq, LAS unsigned char* lds, int wid, int lane) const {
#pragma unroll
        for (int ai = 0; ai < 2; ++ai)
#pragma unroll
            for (int m = 0; m < 4; ++m) {
                const int row = u.pm * 256 + ai * 128 + wr * 64 + m * 16 + fr; const float rs = rstd_row(ss, row);
#pragma unroll
                for (int bj = 0; bj < 2; ++bj) { const f32x4 v0 = acc[ai][bj][m][0] * rs, v1 = acc[ai][bj][m][1] * rs;
                    u4 w; w.x = pk2(v0[0], v0[1]); w.y = pk2(v0[2], v0[3]); w.z = pk2(v1[0], v1[1]); w.w = pk2(v1[2], v1[3]);
                    *(u4*)(O + (size_t)row * NINP + u.pn * 256 + bj * 128 + wc * 32 + 8 * fq) = w; }
                asm volatile("" ::: "memory");
            }
    }
};
struct EpiResid {
    static constexpr bool PERM = true, AFTER_DRAIN = true;
    const float* xin; float* xout; bf16* xb; float* ss; float scale;
    __device__ __forceinline__ void fused(f32x4 (&acc)[2][2][4][2], const pg8::Unit& u, int wr, int wc, int fr, int fq, LAS unsigned char* lds, int wid, int lane) const {
        LAS float* P = (LAS float*)lds;
#pragma unroll
        for (int ai = 0; ai < 2; ++ai)
#pragma unroll
            for (int m = 0; m < 4; ++m) {
                const int rt = ai * 128 + wr * 64 + m * 16 + fr; const size_t row = (size_t)u.pm * 256 + rt; float sq = 0.f;
#pragma unroll
                for (int bj = 0; bj < 2; ++bj) { const size_t off = row * D + u.pn * 256 + bj * 128 + wc * 32 + 8 * fq;
                    f32x4 x0 = *(const f32x4*)(xin + off), x1 = *(const f32x4*)(xin + off + 4);
                    x0 += acc[ai][bj][m][0] * scale; x1 += acc[ai][bj][m][1] * scale;
                    *(f32x4*)(xout + off) = x0; *(f32x4*)(xout + off + 4) = x1;
                    u4 w; w.x = pk2(x0[0], x0[1]); w.y = pk2(x0[2], x0[3]); w.z = pk2(x1[0], x1[1]); w.w = pk2(x1[2], x1[3]);
                    *(u4*)(xb + off) = w;
                    sq += (x0[0] * x0[0] + x0[1] * x0[1]) + (x0[2] * x0[2] + x0[3] * x0[3]) + (x1[0] * x1[0] + x1[1] * x1[1]) + (x1[2] * x1[2] + x1[3] * x1[3]); }
                sq += __shfl_xor(sq, 16); sq += __shfl_xor(sq, 32);
                if (fq == 0) P[rt * 4 + wc] = sq;
            }
        __syncthreads();
        const int tid = wid * 64 + lane;
        if (tid < 256) ss[(size_t)(u.pm * 256 + tid) * 4 + u.pn] = (P[tid * 4 + 0] + P[tid * 4 + 1]) + (P[tid * 4 + 2] + P[tid * 4 + 3]);
        __syncthreads();
    }
};
struct OneUnit { pg8::StaticOrder b; int r;
    __device__ __forceinline__ bool next(int i, pg8::Unit& u) const { return i == 0 && b.next(r, u); }
    __device__ __forceinline__ void a_ready(const pg8::Unit&) const {}
    __device__ __forceinline__ void done(const pg8::Unit&) const {} };

__device__ __forceinline__ void tr_item(const float* W, int ldn, int nvalid, int col0, const float* sc, bf16* WT, int K, int row0, int k0, LAS float* scr, int lane) {
    const int c4 = col0 + (lane & 31) * 4; const bool ok = c4 < nvalid;
#pragma unroll 8
    for (int i = 0; i < 16; ++i) { const int kk = 2 * i + (lane >> 5); f4 v = (f4){0.f, 0.f, 0.f, 0.f}; if (ok) v = *(const f4*)(W + (size_t)(k0 + kk) * ldn + c4); if (sc) v = v * sc[k0 + kk]; *(LAS f4*)(scr + kk * 132 + (lane & 31) * 4) = v; }
    asm volatile("s_waitcnt lgkmcnt(0)" ::: "memory");
    const int kq = lane & 3;
#pragma unroll
    for (int j = 0; j < 8; ++j) { const int n = (lane >> 2) + 16 * j; const LAS float* s = scr + (8 * kq) * 132 + n;
        u4 o; o.x = pk2(s[0 * 132], s[1 * 132]); o.y = pk2(s[2 * 132], s[3 * 132]); o.z = pk2(s[4 * 132], s[5 * 132]); o.w = pk2(s[6 * 132], s[7 * 132]);
        *(u4*)(WT + (size_t)(row0 + n) * K + k0 + 8 * kq) = o; }
    asm volatile("s_waitcnt lgkmcnt(0)" ::: "memory");
}
__device__ __forceinline__ void tr_gu(const float* Wg, const float* Wu, const float* nw, bf16* WT, int it, LAS float* scr, int lane) {
    const int kb = it / 44, nb = it % 44, row0 = nb * 128, pn = row0 >> 8, half = (row0 >> 7) & 1;
    tr_item(half ? Wu : Wg, FF, FF, pn * 128, nw, WT, D, row0, kb * 32, scr, lane);
}
__device__ __forceinline__ void phase_convert(const float* const* in, unsigned char* ws, int l, int sets, LAS unsigned char* lds, int gw, int NGW, int wave, int lane) {
    LAS float* scr = (LAS float*)(lds + wave * 17408);
    constexpr int I_GU = 1408, I_D = 704, I_IN = 832, I_OUT = 256, NA = I_GU + I_D + I_IN, NB = I_OUT + I_GU + I_D;
    const int la = (sets & 4) ? l : l + 1; const bool doA = (sets & 4) || ((sets & 2) && l + 1 < NL), doB = (sets & 1) != 0;
    const int lo = doA ? 0 : NA, hi = doB ? NA + NB : NA;
    for (int it = lo + gw; it < hi; it += NGW) {
        int r = it;
        if (r < NA) { const size_t oFF = (size_t)la * D * FF;
            if (r < I_GU) { tr_gu(in[2] + oFF, in[3] + oFF, in[1] + la * D, (bf16*)(ws + WS_WGU1), r, scr, lane); continue; } r -= I_GU;
            if (r < I_D) { tr_item(in[4] + oFF, D, D, (r % 8) * 128, nullptr, (bf16*)(ws + WS_WD1), FF, (r % 8) * 128, (r / 8) * 32, scr, lane); continue; } r -= I_D;
            tr_item(in[6] + (size_t)la * D * NIN, NIN, NIN, (r % 26) * 128, in[5] + la * D, (bf16*)(ws + WS_WIN), D, (r % 26) * 128, (r / 26) * 32, scr, lane); continue; }
        r -= NA; const size_t oFF = (size_t)l * D * FF;
        if (r < I_OUT) { tr_item(in[7] + (size_t)l * D * D, D, D, (r % 8) * 128, nullptr, (bf16*)(ws + WS_WOUT), D, (r % 8) * 128, (r / 8) * 32, scr, lane); continue; } r -= I_OUT;
        if (r < I_GU) { tr_gu(in[39] + oFF, in[40] + oFF, in[38] + l * D, (bf16*)(ws + WS_WGU2), r, scr, lane); continue; } r -= I_GU;
        tr_item(in[41] + oFF, D, D, (r % 8) * 128, nullptr, (bf16*)(ws + WS_WD2), FF, (r % 8) * 128, (r / 8) * 32, scr, lane);
    }
}
__device__ __forceinline__ void phase_init_rows(const float* x, bf16* xb, float* ss, int gw, int NGW, int lane) {
    for (int m = gw; m < M; m += NGW) {
        const f4* xr = (const f4*)(x + (size_t)m * D) + lane; float s = 0.f; u2* o = (u2*)(xb + (size_t)m * D) + lane;
#pragma unroll
        for (int j = 0; j < 4; ++j) { const f4 v = xr[64 * j]; s += (v.x * v.x + v.y * v.y) + (v.z * v.z + v.w * v.w); u2 w; w.x = pk2(v.x, v.y); w.y = pk2(v.z, v.w); o[64 * j] = w; }
        s = wave_sum(s);
        if (lane < 4) ss[(size_t)m * 4 + lane] = lane == 0 ? s : 0.f;
    }
}
__device__ __forceinline__ void phase_final(float* x, const float* fw, int gw, int NGW, int lane) {
    for (int m = gw; m < M; m += NGW) {
        f4* xr = (f4*)(x + (size_t)m * D) + lane; f4 v[4]; float s = 0.f;
#pragma unroll
        for (int j = 0; j < 4; ++j) { v[j] = xr[64 * j]; s += (v[j].x * v[j].x + v[j].y * v[j].y) + (v[j].z * v[j].z + v[j].w * v[j].w); }
        const float rs = rsqrtf(wave_sum(s) * (1.f / 1024.f) + 1e-6f);
#pragma unroll
        for (int j = 0; j < 4; ++j) { const f4 w = ((const f4*)fw)[lane + 64 * j]; xr[64 * j] = v[j] * rs * w; }
    }
}
#define XB_TMO      128
#define XB_XCNT(j)  (256  + 64 * (j))
#define XB_XSUB(j)  (1280 + 64 * (j))
#define XB_XGEN(j)  (2304 + 64 * (j))
#define XB_TOP      3328
#define XB_TOPGEN   3392
#define XCD_BAR_WORDS 3456
#define XB_SPIN_CAP (1u << 18)

__device__ __forceinline__ unsigned xb_ld(unsigned* p)              { return __hip_atomic_load(p, __ATOMIC_RELAXED, __HIP_MEMORY_SCOPE_AGENT); }
__device__ __forceinline__ unsigned xb_add(unsigned* p, unsigned v) { return __hip_atomic_fetch_add(p, v, __ATOMIC_RELAXED, __HIP_MEMORY_SCOPE_AGENT); }
__device__ __forceinline__ unsigned xb_xcc_id() { return (unsigned)__builtin_amdgcn_s_getreg((3 << 11) | 20) & 0xFu; }
#define XB_SPIN(cond, bar) do { unsigned _sp = 0; while (cond) { __builtin_amdgcn_s_sleep(1); \
    if ((++_sp & 255u) == 0u) { if (xb_ld(&(bar)[XB_TMO])) break; if (_sp > XB_SPIN_CAP) { atomicAdd(&(bar)[XB_TMO], 1u); break; } } } } while (0)

struct XcdBarrier {
    unsigned* bar; unsigned x;
    volatile LAS unsigned* st;
};

__device__ __forceinline__ XcdBarrier xcd_barrier_post(unsigned* bar, volatile LAS unsigned* st) {
    XcdBarrier b; b.bar = bar; b.x = xb_xcc_id(); b.st = st;
    if (threadIdx.x == 0) (void)xb_add(&bar[XB_XCNT(b.x)], 1u);
    return b;
}
__device__ __forceinline__ void xcd_barrier_complete(unsigned* bar, unsigned x, unsigned& nloc, unsigned& nx) {
    const unsigned G = gridDim.x * gridDim.y * gridDim.z;
    unsigned sum, cnt, mine, sp = 0u;
    for (;;) {
        sum = 0u; cnt = 0u; mine = 0u;
#pragma unroll
        for (unsigned j = 0; j < 16; ++j) { const unsigned c = xb_ld(&bar[XB_XCNT(j)]); sum += c; cnt += (c > 0u) ? 1u : 0u; mine = (j == x) ? c : mine; }
        if (sum == G) break;
        __builtin_amdgcn_s_sleep(1);
        if ((++sp & 255u) == 0u) { if (xb_ld(&bar[XB_TMO])) break; if (sp > XB_SPIN_CAP) { atomicAdd(&bar[XB_TMO], 1u); break; } }
    }
    nloc = mine > 0u ? mine : 1u; nx = cnt > 0u ? cnt : 1u;
}

__device__ __forceinline__ void xcd_barrier(const XcdBarrier& b) {
    asm volatile("s_waitcnt vmcnt(0)" ::: "memory");
    __syncthreads();
    if (threadIdx.x == 0) {
        unsigned* bar = b.bar;
        __builtin_amdgcn_s_waitcnt(0);
        unsigned nloc = b.st[0], nx = b.st[1];
        if (nloc == 0u) { xcd_barrier_complete(bar, b.x, nloc, nx); b.st[0] = nloc; b.st[1] = nx; }
        const unsigned old = xb_add(&bar[XB_XSUB(b.x)], 1u);
        const unsigned gen = old / nloc;
        if (old + 1u == (gen + 1u) * nloc) {
            __builtin_amdgcn_fence(__ATOMIC_RELEASE, "agent");
            asm volatile("s_waitcnt vmcnt(0)" ::: "memory");
            const unsigned og = xb_add(&bar[XB_TOP], 1u);
            const unsigned tg = og / nx;
            if (og + 1u == (tg + 1u) * nx) xb_add(&bar[XB_TOPGEN], 1u);
            else XB_SPIN(xb_ld(&bar[XB_TOPGEN]) == tg, bar);
            __builtin_amdgcn_fence(__ATOMIC_ACQUIRE, "agent");
            xb_add(&bar[XB_XGEN(b.x)], 1u);
            asm volatile("s_waitcnt vmcnt(0)" ::: "memory");
        } else {
            XB_SPIN(xb_ld(&bar[XB_XGEN(b.x)]) == gen, bar);
            __builtin_amdgcn_fence(__ATOMIC_ACQUIRE, "agent");
            asm volatile("s_waitcnt vmcnt(0)" ::: "memory");
        }
    }
    __syncthreads();
}
__device__ __forceinline__ void prep_lru(const float* const* in, unsigned char* ws, int l, int item, LAS unsigned char* lds, int tid) {
    const bf16* PROJ = (const bf16*)(ws + WS_PROJ); LAS float* X = (LAS float*)lds; LAS float* G = X + 32 * 256;
    const int t0 = item * 32; const float* cw = in[11] + l * 4 * 256; const float* cb = in[12] + l * 256;
#pragma unroll
    for (int it = 0; it < 2; ++it) { const int idx = tid + it * 512, t = idx >> 5, cv = idx & 31, tok = t0 + t, pos = tok & (SEQ - 1);
        f4 a0 = *(const f4*)(cb + cv * 8), a1 = *(const f4*)(cb + cv * 8 + 4);
#pragma unroll
        for (int k = 0; k < 4; ++k) { u4 x = (u4){0u, 0u, 0u, 0u}; if (pos - 3 + k >= 0) x = *(const u4*)(PROJ + (size_t)(tok - 3 + k) * NINP + PC_LX + cv * 8);
            const f4 w0 = *(const f4*)(cw + k * 256 + cv * 8), w1 = *(const f4*)(cw + k * 256 + cv * 8 + 4);
            a0 += w0 * (f4){bflo(x.x), bfhi(x.x), bflo(x.y), bfhi(x.y)}; a1 += w1 * (f4){bflo(x.z), bfhi(x.z), bflo(x.w), bfhi(x.w)}; }
        *(LAS f4*)(X + t * 256 + cv * 8) = a0; *(LAS f4*)(X + t * 256 + cv * 8 + 4) = a1; }
    __syncthreads();
    const int gsel = tid >> 8, c = tid & 255, blk = c >> 6, j = c & 63;
    { const float* pw = (gsel ? in[15] : in[13]) + (size_t)l * 16384 + blk * 4096 + j; const float bias = (gsel ? in[16] : in[14])[l * 256 + c];
#pragma unroll 1
      for (int kh = 0; kh < 2; ++kh) { float wv[32];
#pragma unroll
          for (int k = 0; k < 32; ++k) wv[k] = pw[(kh * 32 + k) * 64];
#pragma unroll 1
          for (int t = 0; t < 32; ++t) { const LAS f4* xr = (const LAS f4*)(X + t * 256 + blk * 64 + kh * 32); float d0 = 0.f, d1 = 0.f;
#pragma unroll
              for (int k4 = 0; k4 < 8; k4 += 2) { const f4 v = xr[k4], w = xr[k4 + 1];
                  d0 += v.x * wv[4 * k4] + v.y * wv[4 * k4 + 1] + v.z * wv[4 * k4 + 2] + v.w * wv[4 * k4 + 3];
                  d1 += w.x * wv[4 * k4 + 4] + w.y * wv[4 * k4 + 5] + w.z * wv[4 * k4 + 6] + w.w * wv[4 * k4 + 7]; }
              LAS float* gp = G + (gsel * 32 + t) * 256 + c;
              if (kh == 0) *gp = d0 + d1; else *gp = sigmoidf_(*gp + d0 + d1 + bias); } } }
    __syncthreads();
    { const float sp = softplusf_(-in[17][l * 256 + c]);
#pragma unroll 4
      for (int tt = 0; tt < 16; ++tt) { const int t = gsel * 16 + tt; const float r = G[t * 256 + c], ig = G[(32 + t) * 256 + c], la = -8.f * r * sp, av = __expf(la), u = sqrtf(fmaxf(1.f - av * av, 0.f)) * (ig * X[t * 256 + c]);
          G[t * 256 + c] = av; G[(32 + t) * 256 + c] = u; } }
    __syncthreads();
    if (tid < 256) { float h = 0.f, A = 1.f; float* LRA = (float*)(ws + WS_LRA); float* LRH = (float*)(ws + WS_LRH);
#pragma unroll 4
        for (int t = 0; t < 32; ++t) { const float av = G[t * 256 + c], u = G[(32 + t) * 256 + c];
            h = av * h + u; A *= av; const size_t o = (size_t)(t0 + t) * 256 + c; LRA[o] = A; LRH[o] = h; }
        ((float*)(ws + WS_SEGA))[item * 256 + c] = A; ((float*)(ws + WS_SEGH))[item * 256 + c] = h; }
    __syncthreads();
}
__device__ __forceinline__ void prep_ssd(const float* const* in, unsigned char* ws, int l, int item, int tid) {
    const bf16* PROJ = (const bf16*)(ws + WS_PROJ);
    const int t0 = item * 32; const float* cw = in[32] + l * 4 * 768; const float* cb = in[33] + l * 768;
#pragma unroll 2
    for (int it = 0; it < 6; ++it) { const int idx = tid + it * 512, t = idx / 96, cv = idx - t * 96, tok = t0 + t, pos = tok & (SEQ - 1);
        f4 a0 = *(const f4*)(cb + cv * 8), a1 = *(const f4*)(cb + cv * 8 + 4);
#pragma unroll
        for (int k = 0; k < 4; ++k) { u4 x = (u4){0u, 0u, 0u, 0u}; if (pos - 3 + k >= 0) x = *(const u4*)(PROJ + (size_t)(tok - 3 + k) * NINP + PC_SXBC + cv * 8);
            const f4 w0 = *(const f4*)(cw + k * 768 + cv * 8), w1 = *(const f4*)(cw + k * 768 + cv * 8 + 4);
            a0 += w0 * (f4){bflo(x.x), bfhi(x.x), bflo(x.y), bfhi(x.y)}; a1 += w1 * (f4){bflo(x.z), bfhi(x.z), bflo(x.w), bfhi(x.w)}; }
        u4 o; o.x = pk2(siluf_(a0.x), siluf_(a0.y)); o.y = pk2(siluf_(a0.z), siluf_(a0.w)); o.z = pk2(siluf_(a1.x), siluf_(a1.y)); o.w = pk2(siluf_(a1.z), siluf_(a1.w));
        *(u4*)((bf16*)(ws + WS_XBC) + (size_t)tok * 768 + cv * 8) = o; }
    if (tid < 128) { const int t = tid >> 2, hh = tid & 3, tok = t0 + t; const float dt = softplusf_(bf2f(PROJ[(size_t)tok * NINP + PC_SDT + hh]) + in[34][l * 4 + hh]);
        ((float*)(ws + WS_DT))[tok * 4 + hh] = dt; ((float*)(ws + WS_DEC))[tok * 4 + hh] = __expf(-dt * __expf(in[35][l * 4 + hh])); }
}
__device__ __forceinline__ void prep_rw(const float* const* in, unsigned char* ws, int l, int item, LAS unsigned char* lds, int tid) {
    const bf16* PROJ = (const bf16*)(ws + WS_PROJ); LAS float* P = (LAS float*)lds; LAS float* VV = (LAS float*)(lds + 32 * 832 * 4);
    const int t0 = item * 32; const float* mu = in[18] + l * 832;
    LAS float* V1 = VV + 256;
#pragma unroll
    for (int it = 0; it < 7; ++it) { const int idx = tid + it * 512; if (idx < 3328) { const int t = idx / 104, cv = idx - t * 104, tok = t0 + t;
        const bf16* pc = PROJ + (size_t)tok * NINP + PC_RW + cv * 8; const u4 cur = *(const u4*)pc; u4 prv = (u4){0u, 0u, 0u, 0u}; if (tok & (SEQ - 1)) prv = *(const u4*)(pc - NINP);
        const f4 m0 = *(const f4*)(mu + cv * 8), m1 = *(const f4*)(mu + cv * 8 + 4);
        const f4 c0 = (f4){bflo(cur.x), bfhi(cur.x), bflo(cur.y), bfhi(cur.y)}, c1 = (f4){bflo(cur.z), bfhi(cur.z), bflo(cur.w), bfhi(cur.w)};
        const f4 p0 = (f4){bflo(prv.x), bfhi(prv.x), bflo(prv.y), bfhi(prv.y)}, p1 = (f4){bflo(prv.z), bfhi(prv.z), bflo(prv.w), bfhi(prv.w)};
        f4 v0 = c0 + (p0 - c0) * m0, v1 = c1 + (p1 - c1) * m1;
        if (cv == 96 || cv == 97) { v0 = (f4){tanhf_(v0.x), tanhf_(v0.y), tanhf_(v0.z), tanhf_(v0.w)}; v1 = (f4){tanhf_(v1.x), tanhf_(v1.y), tanhf_(v1.z), tanhf_(v1.w)}; }
        else if (cv >= 100) { v0 = (f4){sigmoidf_(v0.x), sigmoidf_(v0.y), sigmoidf_(v0.z), sigmoidf_(v0.w)}; v1 = (f4){sigmoidf_(v1.x), sigmoidf_(v1.y), sigmoidf_(v1.z), sigmoidf_(v1.w)}; }
        *(LAS f4*)(P + t * 832 + cv * 8) = v0; *(LAS f4*)(P + t * 832 + cv * 8 + 4) = v1; } }
    if (l > 0) *(LAS f4*)(V1 + tid * 4) = *(const f4*)(in[25] + (size_t)(l - 1) * 2048 + tid * 4);
    __syncthreads();
    if (l > 0 && tid < 256) { const int t = tid >> 3, j = tid & 7; float s = 0.f;
#pragma unroll 4
        for (int c4 = 0; c4 < 64; ++c4) { const f4 pv = *(const LAS f4*)(P + t * 832 + 512 + 4 * c4); s += pv.x * V1[(4 * c4) * 8 + j] + pv.y * V1[(4 * c4 + 1) * 8 + j] + pv.z * V1[(4 * c4 + 2) * 8 + j] + pv.w * V1[(4 * c4 + 3) * 8 + j]; }
        VV[t * 8 + j] = s; }
    __syncthreads();
    const int half = tid >> 8, c = tid & 255, hh = c >> 6, lane = tid & 63;
    float zw[16], za[16], gg[16], zv[16];
    { const float w0 = in[19][l * 256 + c], a0 = in[21][l * 256 + c], v0 = l > 0 ? in[24][(l - 1) * 256 + c] : 0.f;
#pragma unroll
      for (int tt = 0; tt < 16; ++tt) { zw[tt] = w0; za[tt] = a0; gg[tt] = 0.f; zv[tt] = v0; } }
    const LAS float* ph = P + half * 16 * 832;
    { const float* w2p = in[20] + (size_t)l * 4096 + c; const float* a2p = in[22] + (size_t)l * 4096 + c;
#pragma unroll 1
      for (int j4 = 0; j4 < 4; ++j4) { const float wa = w2p[(4 * j4) * 256], wb = w2p[(4 * j4 + 1) * 256], wc_ = w2p[(4 * j4 + 2) * 256], wd_ = w2p[(4 * j4 + 3) * 256];
          const float aa = a2p[(4 * j4) * 256], ab = a2p[(4 * j4 + 1) * 256], ac = a2p[(4 * j4 + 2) * 256], ad = a2p[(4 * j4 + 3) * 256];
#pragma unroll
          for (int tt = 0; tt < 16; ++tt) { const f4 sw = *(const LAS f4*)(ph + tt * 832 + 768 + 4 * j4), sa = *(const LAS f4*)(ph + tt * 832 + 784 + 4 * j4);
              zw[tt] += sw.x * wa + sw.y * wb + sw.z * wc_ + sw.w * wd_; za[tt] += sa.x * aa + sa.y * ab + sa.z * ac + sa.w * ad; } } }
    { const float* g2p = in[23] + (size_t)l * 8192 + c;
#pragma unroll 1
      for (int j4 = 0; j4 < 8; ++j4) { const float ga = g2p[(4 * j4) * 256], gb = g2p[(4 * j4 + 1) * 256], gc = g2p[(4 * j4 + 2) * 256], gd = g2p[(4 * j4 + 3) * 256];
#pragma unroll
          for (int tt = 0; tt < 16; ++tt) { const f4 sg = *(const LAS f4*)(ph + tt * 832 + 800 + 4 * j4); gg[tt] += sg.x * ga + sg.y * gb + sg.z * gc + sg.w * gd; } } }
    if (l > 0) { const float* v2p = in[26] + (size_t)(l - 1) * 2048 + c;
#pragma unroll 1
      for (int j4 = 0; j4 < 2; ++j4) { const float va = v2p[(4 * j4) * 256], vb = v2p[(4 * j4 + 1) * 256], vc = v2p[(4 * j4 + 2) * 256], vd = v2p[(4 * j4 + 3) * 256];
#pragma unroll
          for (int tt = 0; tt < 16; ++tt) { const f4 sv = *(const LAS f4*)(VV + (half * 16 + tt) * 8 + 4 * j4); zv[tt] += sv.x * va + sv.y * vb + sv.z * vc + sv.w * vd; } } }
    const float kkw = in[27][l * 256 + c], kaw = in[28][l * 256 + c], rkw = in[29][l * 256 + c];
    float* VF = (float*)(ws + WS_VFIRST);
#pragma unroll
    for (int tt = 0; tt < 16; ++tt) { const int t = half * 16 + tt; const size_t o = (size_t)(t0 + t) * 256 + c; const LAS float* pr = P + t * 832;
        const float r = pr[c], k = pr[256 + c]; float v = pr[512 + c];
        const float wd = __expf(-0.6065306597126334f * sigmoidf_(zw[tt])), av = sigmoidf_(za[tt]), g = gg[tt];
        if (l > 0) v = v + (VF[o] - v) * sigmoidf_(zv[tt]); else VF[o] = v;
        float kk = k * kkw; const float nrm = sqrtf(wave_sum(kk * kk)); kk = kk / fmaxf(nrm, 1e-12f);
        const float k2 = k * (1.f + (av - 1.f) * kaw);
        const float bon = wave_sum(r * k2 * rkw);
        ((bf16*)(ws + WS_RWR))[o] = (bf16)pk2(r, 0.f); ((bf16*)(ws + WS_RWK))[o] = (bf16)pk2(k2, 0.f); ((bf16*)(ws + WS_RWV))[o] = (bf16)pk2(v, 0.f);
        ((bf16*)(ws + WS_RWKK))[o] = (bf16)pk2(kk, 0.f); ((bf16*)(ws + WS_RWB))[o] = (bf16)pk2(kk * av, 0.f); ((bf16*)(ws + WS_RWG))[o] = (bf16)pk2(g, 0.f);
        ((float*)(ws + WS_RWW))[o] = wd;
        if (lane == 0) ((float*)(ws + WS_RWBON))[(t0 + t) * 4 + hh] = bon;
        asm volatile("" ::: "memory"); }
    __syncthreads();
}
__device__ __forceinline__ void phase_prep(const float* const* in, unsigned char* ws, int l, LAS unsigned char* lds, int tid) {
    constexpr int N_L = 512, N_R = 512, N_S = 512;
    for (int it = blockIdx.x; it < N_L + N_R + N_S; it += gridDim.x) {
        if (it < N_L) {
#ifndef SKIP_PL
            prep_lru(in, ws, l, it, lds, tid);
#endif
        } else if (it < N_L + N_R) {
#ifndef SKIP_PR
            prep_rw(in, ws, l, it - N_L, lds, tid);
#endif
        } else {
#ifndef SKIP_PS
            prep_ssd(in, ws, l, it - N_L - N_R, tid);
#endif
        }
    }
}

template <int MODE> __device__ __forceinline__ void scan_rw(unsigned char* ws, int item, LAS unsigned char* lds, int tid) {
    LAS float* LW = (LAS float*)lds; LAS float* LKK = LW + 2048; LAS float* LB = LW + 4096; LAS float* LK = LW + 6144; LAS float* LR = LW + 8192; LAS float* LV = LW + 10240; LAS float* LY = LW + 12288;
    const int bh = item / NCH, ch = item % NCH, hh = bh & 3, tokb = (bh >> 2) * SEQ + ch * CHL, nsub = CHL / 32;
    const int st = tid >> 4, sc4 = (tid & 15) * 4, row = tid >> 3, sl = tid & 7;
    const bf16* gR = (const bf16*)(ws + WS_RWR); const bf16* gK = (const bf16*)(ws + WS_RWK); const bf16* gV = (const bf16*)(ws + WS_RWV); const bf16* gKK = (const bf16*)(ws + WS_RWKK); const bf16* gB = (const bf16*)(ws + WS_RWB);
    const float* gW = (const float*)(ws + WS_RWW); bf16* gY = (bf16*)(ws + WS_YRW);
    float* gU = (float*)(ws + WS_RWU) + (size_t)item * 4096 + row * 64 + sl * 8; float* gP = (float*)(ws + WS_RWP) + (size_t)item * 4096 + row * 64 + sl * 8;
    f2 s[4], p[4];
    if (MODE == 1) { const f4 a = *(const f4*)gU, c = *(const f4*)(gU + 4); s[0] = LO2(a); s[1] = HI2(a); s[2] = LO2(c); s[3] = HI2(c); }
    else {
#pragma unroll
        for (int i = 0; i < 4; ++i) { s[i] = (f2){0.f, 0.f}; p[i] = (f2){(sl * 8 + 2 * i == row) ? 1.f : 0.f, (sl * 8 + 2 * i + 1 == row) ? 1.f : 0.f}; } }
    u2 pr, pk, pv, pkk, pb; f4 pw;
    { const size_t o = (size_t)(tokb + st) * 256 + hh * 64 + sc4; if (MODE == 1) pr = *(const u2*)(gR + o); pk = *(const u2*)(gK + o); pv = *(const u2*)(gV + o); pkk = *(const u2*)(gKK + o); pb = *(const u2*)(gB + o); pw = *(const f4*)(gW + o); }
    for (int sub = 0; sub < nsub; ++sub) {
        const int so = st * 64 + sc4;
        *(LAS f4*)(LW + so) = pw; if (MODE == 1) *(LAS f4*)(LR + so) = (f4){bflo(pr.x), bfhi(pr.x), bflo(pr.y), bfhi(pr.y)}; *(LAS f4*)(LK + so) = (f4){bflo(pk.x), bfhi(pk.x), bflo(pk.y), bfhi(pk.y)};
        *(LAS f4*)(LV + so) = (f4){bflo(pv.x), bfhi(pv.x), bflo(pv.y), bfhi(pv.y)}; *(LAS f4*)(LKK + so) = (f4){bflo(pkk.x), bfhi(pkk.x), bflo(pkk.y), bfhi(pkk.y)}; *(LAS f4*)(LB + so) = (f4){bflo(pb.x), bfhi(pb.x), bflo(pb.y), bfhi(pb.y)};
        lds_barrier();
        if (sub + 1 < nsub) { const size_t o = (size_t)(tokb + (sub + 1) * 32 + st) * 256 + hh * 64 + sc4; if (MODE == 1) pr = *(const u2*)(gR + o); pk = *(const u2*)(gK + o); pv = *(const u2*)(gV + o); pkk = *(const u2*)(gKK + o); pb = *(const u2*)(gB + o); pw = *(const f4*)(gW + o); }
        {
            const int ob = sl * 8; f4 w0, w1, a0, a1, b0, b1, k0, k1, r0 = (f4){0.f, 0.f, 0.f, 0.f}, r1 = r0; float vv;
#define RW_LOAD(T) { const int o_ = ((T) & 31) * 64 + ob; w0 = *(const LAS f4*)(LW + o_); w1 = *(const LAS f4*)(LW + o_ + 4); a0 = *(const LAS f4*)(LKK + o_); a1 = *(const LAS f4*)(LKK + o_ + 4); b0 = *(const LAS f4*)(LB + o_); b1 = *(const LAS f4*)(LB + o_ + 4); \
            k0 = *(const LAS f4*)(LK + o_); k1 = *(const LAS f4*)(LK + o_ + 4); if (MODE == 1) { r0 = *(const LAS f4*)(LR + o_); r1 = *(const LAS f4*)(LR + o_ + 4); } vv = LV[((T) & 31) * 64 + row]; }
            RW_LOAD(0)
#pragma unroll 2
            for (int t = 0; t < 32; ++t) {
                const f4 cw0 = w0, cw1 = w1, ca0 = a0, ca1 = a1, cb0 = b0, cb1 = b1, ck0 = k0, ck1 = k1, cr0 = r0, cr1 = r1; const float cv = vv;
                RW_LOAD(t + 1)
                f2 d2 = s[0] * LO2(ca0); d2 = s[1] * HI2(ca0) + d2; d2 = s[2] * LO2(ca1) + d2; d2 = s[3] * HI2(ca1) + d2;
                if (MODE == 0) { f2 e2 = p[0] * LO2(ca0); e2 = p[1] * HI2(ca0) + e2; e2 = p[2] * LO2(ca1) + e2; e2 = p[3] * HI2(ca1) + e2;
                    const float sp = -red8(e2.x + e2.y); const f2 sp2 = (f2){sp, sp};
                    p[0] = p[0] * LO2(cw0) + sp2 * LO2(cb0); p[1] = p[1] * HI2(cw0) + sp2 * HI2(cb0); p[2] = p[2] * LO2(cw1) + sp2 * LO2(cb1); p[3] = p[3] * HI2(cw1) + sp2 * HI2(cb1); }
                const float sa = -red8(d2.x + d2.y); const f2 sa2 = (f2){sa, sa}, cv2 = (f2){cv, cv};
                s[0] = s[0] * LO2(cw0) + sa2 * LO2(cb0) + cv2 * LO2(ck0); s[1] = s[1] * HI2(cw0) + sa2 * HI2(cb0) + cv2 * HI2(ck0);
                s[2] = s[2] * LO2(cw1) + sa2 * LO2(cb1) + cv2 * LO2(ck1); s[3] = s[3] * HI2(cw1) + sa2 * HI2(cb1) + cv2 * HI2(ck1);
                if (MODE == 1) { f2 y2 = s[0] * LO2(cr0); y2 = s[1] * HI2(cr0) + y2; y2 = s[2] * LO2(cr1) + y2; y2 = s[3] * HI2(cr1) + y2;
                    LY[t * 64 + row] = red8(y2.x + y2.y); } }
#undef RW_LOAD
        }
        lds_barrier();
        if (MODE == 1) { const f4 y = *(const LAS f4*)(LY + so); u2 w; w.x = pk2(y.x, y.y); w.y = pk2(y.z, y.w); *(u2*)(gY + (size_t)(tokb + sub * 32 + st) * 256 + hh * 64 + sc4) = w; }
    }
    if (MODE == 0) { *(f4*)gU = (f4){s[0].x, s[0].y, s[1].x, s[1].y}; *(f4*)(gU + 4) = (f4){s[2].x, s[2].y, s[3].x, s[3].y}; *(f4*)gP = (f4){p[0].x, p[0].y, p[1].x, p[1].y}; *(f4*)(gP + 4) = (f4){p[2].x, p[2].y, p[3].x, p[3].y}; }
    __syncthreads();
}
__device__ __forceinline__ void combine_rw(unsigned char* ws, int w, int lane) {
    const int bh = w >> 6, row = w & 63;
    const float* gP = (const float*)(ws + WS_RWP) + (size_t)bh * NCH * 4096 + lane; float* gU = (float*)(ws + WS_RWU) + (size_t)bh * NCH * 4096 + row * 64 + lane;
    float pc[64], s = 0.f, u = gU[0];
#pragma unroll
    for (int i = 0; i < 64; ++i) pc[i] = gP[i * 64];
#pragma unroll 1
    for (int c = 0; c < NCH; ++c) {
        float pn[64], un = 0.f; const int cn = (c + 1 < NCH) ? c + 1 : c;
#pragma unroll
        for (int i = 0; i < 64; ++i) pn[i] = gP[(size_t)cn * 4096 + i * 64];
        un = gU[(size_t)cn * 4096];
        gU[(size_t)c * 4096] = s;
        float n0 = u, n1 = 0.f; const int si = __builtin_bit_cast(int, s);
#pragma unroll
        for (int i = 0; i < 64; i += 2) { n0 += __builtin_bit_cast(float, __builtin_amdgcn_readlane(si, i)) * pc[i]; n1 += __builtin_bit_cast(float, __builtin_amdgcn_readlane(si, i + 1)) * pc[i + 1]; }
        s = n0 + n1; u = un;
#pragma unroll
        for (int i = 0; i < 64; ++i) pc[i] = pn[i];
    }
}
template <int MODE> __device__ __forceinline__ void scan_gla(const float* const* in, unsigned char* ws, int l, int item, LAS unsigned char* lds, int tid) {
    LAS float* LA = (LAS float*)lds; LAS float* LK = LA + 1024; LAS float* LQ = LA + 2048; LAS float* LV = LA + 3072; LAS float* LO = LA + 5120;
    const bf16* PROJ = (const bf16*)(ws + WS_PROJ); bf16* gO = (bf16*)(ws + WS_OGLA);
    const int bh = item / NCH, ch = item % NCH, hh = bh & 3, tokb = (bh >> 2) * SEQ + ch * CHL, nsub = CHL / 32;
    const int st = tid >> 4, si = tid & 15, vcol = tid >> 3, sl = tid & 7;
    float up0[16], up1[16];
#pragma unroll
    for (int r = 0; r < 16; ++r) { up0[r] = in[8][(l * 16 + r) * 128 + hh * 32 + 2 * si]; up1[r] = in[8][(l * 16 + r) * 128 + hh * 32 + 2 * si + 1]; }
    const float bi0 = in[9][l * 128 + hh * 32 + 2 * si], bi1 = in[9][l * 128 + hh * 32 + 2 * si + 1];
    float* gU = (float*)(ws + WS_GLU) + (size_t)item * 2048 + vcol * 32 + 4 * sl;
    float s[4] = {0.f, 0.f, 0.f, 0.f}, dp[4] = {1.f, 1.f, 1.f, 1.f};
    if (MODE == 1) { const f4 a = *(const f4*)gU; s[0] = a.x; s[1] = a.y; s[2] = a.z; s[3] = a.w; }
    u4 ps0, ps1; unsigned pq = 0, pk; u2 pv;
    { const bf16* p = PROJ + (size_t)(tokb + st) * NINP; ps0 = *(const u4*)(p + PC_GSTEM); ps1 = *(const u4*)(p + PC_GSTEM + 8); if (MODE == 1) pq = *(const unsigned*)(p + PC_GQ + hh * 32 + 2 * si); pk = *(const unsigned*)(p + PC_GK + hh * 32 + 2 * si); pv = *(const u2*)(p + PC_GV + hh * 64 + 4 * si); }
    for (int sub = 0; sub < nsub; ++sub) {
        { const unsigned sw[8] = {ps0.x, ps0.y, ps0.z, ps0.w, ps1.x, ps1.y, ps1.z, ps1.w}; float z0 = bi0, z1 = bi1;
#pragma unroll
          for (int r = 0; r < 8; ++r) { const float e0 = bflo(sw[r]), e1 = bfhi(sw[r]); z0 += e0 * up0[2 * r] + e1 * up0[2 * r + 1]; z1 += e0 * up1[2 * r] + e1 * up1[2 * r + 1]; }
          const float l0 = fminf(z0, 0.f) - log1pf(__expf(-fabsf(z0))), l1 = fminf(z1, 0.f) - log1pf(__expf(-fabsf(z1)));
          const int o = st * 32 + 2 * si; LA[o] = __expf(l0 * 0.0625f); LA[o + 1] = __expf(l1 * 0.0625f); LK[o] = bflo(pk); LK[o + 1] = bfhi(pk); if (MODE == 1) { LQ[o] = bflo(pq); LQ[o + 1] = bfhi(pq); }
          *(LAS f4*)(LV + st * 64 + 4 * si) = (f4){bflo(pv.x), bfhi(pv.x), bflo(pv.y), bfhi(pv.y)}; }
        lds_barrier();
        if (sub + 1 < nsub) { const bf16* p = PROJ + (size_t)(tokb + (sub + 1) * 32 + st) * NINP; ps0 = *(const u4*)(p + PC_GSTEM); ps1 = *(const u4*)(p + PC_GSTEM + 8); if (MODE == 1) pq = *(const unsigned*)(p + PC_GQ + hh * 32 + 2 * si); pk = *(const unsigned*)(p + PC_GK + hh * 32 + 2 * si); pv = *(const u2*)(p + PC_GV + hh * 64 + 4 * si); }
        {   f4 al, kk, qq = (f4){0.f, 0.f, 0.f, 0.f}; float vv;
#define GL_LOAD(T) { const int o_ = ((T) & 31) * 32 + 4 * sl; al = *(const LAS f4*)(LA + o_); kk = *(const LAS f4*)(LK + o_); if (MODE == 1) qq = *(const LAS f4*)(LQ + o_); vv = LV[((T) & 31) * 64 + vcol]; }
            GL_LOAD(0)
#pragma unroll 4
            for (int t = 0; t < 32; ++t) { const f4 ca = al, ck = kk, cq = qq; const float cv = vv;
                GL_LOAD(t + 1)
                s[0] = s[0] * ca.x + ck.x * cv; s[1] = s[1] * ca.y + ck.y * cv; s[2] = s[2] * ca.z + ck.z * cv; s[3] = s[3] * ca.w + ck.w * cv;
                if (MODE == 0) { dp[0] *= ca.x; dp[1] *= ca.y; dp[2] *= ca.z; dp[3] *= ca.w; }
                else { const float o = (s[0] * cq.x + s[1] * cq.y) + (s[2] * cq.z + s[3] * cq.w); LO[t * 64 + vcol] = red8(o) * 0.17677669529663687f; } }
#undef GL_LOAD
        }
        lds_barrier();
        if (MODE == 1) { const f4 y = *(const LAS f4*)(LO + st * 64 + 4 * si); u2 w; w.x = pk2(y.x, y.y); w.y = pk2(y.z, y.w); *(u2*)(gO + (size_t)(tokb + sub * 32 + st) * 256 + hh * 64 + 4 * si) = w; }
    }
    if (MODE == 0) { *(f4*)gU = (f4){s[0], s[1], s[2], s[3]}; if (vcol == 0) *(f4*)((float*)(ws + WS_GLD) + item * 32 + 4 * sl) = (f4){dp[0], dp[1], dp[2], dp[3]}; }
    __syncthreads();
}
template <int MODE> __device__ __forceinline__ void scan_ssd(unsigned char* ws, int item, LAS unsigned char* lds, int tid) {
    LAS float* LB = (LAS float*)lds; LAS float* LC = LB + 4096; LAS float* LX = LB + 8192; LAS float* LD = LB + 10240; LAS float* LY = LB + 10304;
    const bf16* XBC = (const bf16*)(ws + WS_XBC); const float* DT = (const float*)(ws + WS_DT); const float* DEC = (const float*)(ws + WS_DEC); bf16* gY = (bf16*)(ws + WS_YSSD);
    const int bh = item / NCH, ch = item % NCH, hh = bh & 3, tokb = (bh >> 2) * SEQ + ch * CHL, nsub = CHL / 32;
    const int st = tid >> 4, si = tid & 15, p = tid >> 3, sl = tid & 7, g = hh >> 1;
    float* gU = (float*)(ws + WS_SSU) + (size_t)item * 8192 + p * 128 + 16 * sl;
    f2 s[8]; float dprod = 1.f;
#pragma unroll
    for (int i = 0; i < 4; ++i) { f4 a = (f4){0.f, 0.f, 0.f, 0.f}; if (MODE == 1) a = *(const f4*)(gU + 4 * i); s[2 * i] = LO2(a); s[2 * i + 1] = HI2(a); }
    u4 pb, pc = (u4){0u, 0u, 0u, 0u}; u2 px; float pdt, pdec;
    { const size_t tok = tokb + st; const bf16* q = XBC + tok * 768; pb = *(const u4*)(q + 256 + g * 128 + 8 * si); if (MODE == 1) pc = *(const u4*)(q + 512 + g * 128 + 8 * si); px = *(const u2*)(q + hh * 64 + 4 * si); pdt = DT[tok * 4 + hh]; pdec = DEC[tok * 4 + hh]; }
    for (int sub = 0; sub < nsub; ++sub) {
        { const int o = st * 128 + 8 * si;
          *(LAS f4*)(LB + o) = (f4){bflo(pb.x), bfhi(pb.x), bflo(pb.y), bfhi(pb.y)}; *(LAS f4*)(LB + o + 4) = (f4){bflo(pb.z), bfhi(pb.z), bflo(pb.w), bfhi(pb.w)};
          if (MODE == 1) { *(LAS f4*)(LC + o) = (f4){bflo(pc.x), bfhi(pc.x), bflo(pc.y), bfhi(pc.y)}; *(LAS f4*)(LC + o + 4) = (f4){bflo(pc.z), bfhi(pc.z), bflo(pc.w), bfhi(pc.w)}; }
          *(LAS f4*)(LX + st * 64 + 4 * si) = (f4){bflo(px.x) * pdt, bfhi(px.x) * pdt, bflo(px.y) * pdt, bfhi(px.y) * pdt};
          if (si == 0) LD[st] = pdec; }
        lds_barrier();
        if (sub + 1 < nsub) { const size_t tok = tokb + (sub + 1) * 32 + st; const bf16* q = XBC + tok * 768; pb = *(const u4*)(q + 256 + g * 128 + 8 * si); if (MODE == 1) pc = *(const u4*)(q + 512 + g * 128 + 8 * si); px = *(const u2*)(q + hh * 64 + 4 * si); pdt = DT[tok * 4 + hh]; pdec = DEC[tok * 4 + hh]; }
        {   f4 bb[4], cc[4]; float xv, dc;
#pragma unroll
            for (int q4 = 0; q4 < 4; ++q4) cc[q4] = (f4){0.f, 0.f, 0.f, 0.f};
#define SS_LOAD(T) { const int o_ = ((T) & 31) * 128 + 16 * sl; _Pragma("unroll") for (int q4 = 0; q4 < 4; ++q4) { bb[q4] = *(const LAS f4*)(LB + o_ + 4 * q4); if (MODE == 1) cc[q4] = *(const LAS f4*)(LC + o_ + 4 * q4); } xv = LX[((T) & 31) * 64 + p]; dc = LD[(T) & 31]; }
            SS_LOAD(0)
#pragma unroll 2
            for (int t = 0; t < 32; ++t) { f4 cb_[4], cc_[4]; const float cx = xv, cd = dc;
#pragma unroll
                for (int q4 = 0; q4 < 4; ++q4) { cb_[q4] = bb[q4]; cc_[q4] = cc[q4]; }
                SS_LOAD(t + 1)
                if (MODE == 0) dprod *= cd;
                const f2 cd2 = (f2){cd, cd}, cx2 = (f2){cx, cx}; f2 y2 = (f2){0.f, 0.f};
#pragma unroll
                for (int q4 = 0; q4 < 4; ++q4) {
                    s[2 * q4] = s[2 * q4] * cd2 + LO2(cb_[q4]) * cx2; s[2 * q4 + 1] = s[2 * q4 + 1] * cd2 + HI2(cb_[q4]) * cx2;
                    if (MODE == 1) { y2 = s[2 * q4] * LO2(cc_[q4]) + y2; y2 = s[2 * q4 + 1] * HI2(cc_[q4]) + y2; } }
                if (MODE == 1) LY[t * 64 + p] = red8(y2.x + y2.y); }
#undef SS_LOAD
        }
        lds_barrier();
        if (MODE == 1) { const f4 y = *(const LAS f4*)(LY + st * 64 + 4 * si); u2 w; w.x = pk2(y.x, y.y); w.y = pk2(y.z, y.w); *(u2*)(gY + (size_t)(tokb + sub * 32 + st) * 256 + hh * 64 + 4 * si) = w; }
    }
    if (MODE == 0) {
#pragma unroll
        for (int i = 0; i < 4; ++i) *(f4*)(gU + 4 * i) = (f4){s[2 * i].x, s[2 * i].y, s[2 * i + 1].x, s[2 * i + 1].y};
        if (tid == 0) ((float*)(ws + WS_SSD))[item] = dprod; }
    __syncthreads();
}
__device__ __forceinline__ void scan_lru_carry(unsigned char* ws, int tid) {
    const float* SA = (const float*)(ws + WS_SEGA); const float* SH = (const float*)(ws + WS_SEGH); float* CY = (float*)(ws + WS_CARRY);
    const int b = tid >> 8, c = tid & 255; float h = 0.f;
#pragma unroll 8
    for (int sg = 0; sg < 256; ++sg) { const int o = (b * 256 + sg) * 256 + c; CY[o] = h; h = SA[o] * h + SH[o]; }
}
__device__ __forceinline__ void combine_gla(unsigned char* ws, int bh, int tid) {
    float* gU = (float*)(ws + WS_GLU) + (size_t)bh * NCH * 2048 + tid * 4; const float* gD = (const float*)(ws + WS_GLD) + bh * NCH * 32 + (tid & 7) * 4; f4 s = (f4){0.f, 0.f, 0.f, 0.f};
#pragma unroll 4
    for (int c = 0; c < NCH; ++c) { const f4 u = *(const f4*)(gU + (size_t)c * 2048), d = *(const f4*)(gD + c * 32); *(f4*)(gU + (size_t)c * 2048) = s; s = s * d + u; }
}
__device__ __forceinline__ void combine_ssd(unsigned char* ws, int q, int tid) {
    const int bh = q >> 2; float* gU = (float*)(ws + WS_SSU) + (size_t)bh * NCH * 8192 + (q & 3) * 2048 + tid * 4; const float* gD = (const float*)(ws + WS_SSD) + bh * NCH; f4 s = (f4){0.f, 0.f, 0.f, 0.f};
#pragma unroll 4
    for (int c = 0; c < NCH; ++c) { const f4 u = *(const f4*)(gU + (size_t)c * 8192); const float d = gD[c]; *(f4*)(gU + (size_t)c * 8192) = s; s = s * d + u; }
}
template <int MODE> __device__ __forceinline__ void phase_scan(const float* const* in, unsigned char* ws, int l, LAS unsigned char* lds, int tid) {
    constexpr int NI = 8 * NCH;
    for (int it = blockIdx.x; it < 3 * NI + (MODE == 0 ? 1 : 0); it += gridDim.x) {
        if (it < NI) scan_rw<MODE>(ws, it, lds, tid);
        else if (it < 2 * NI) scan_ssd<MODE>(ws, it - NI, lds, tid);
        else if (it < 3 * NI) scan_gla<MODE>(in, ws, l, it - 2 * NI, lds, tid);
        else scan_lru_carry(ws, tid);
    }
}
__device__ __forceinline__ void phase_combine(const float* const* in, unsigned char* ws, int l, LAS unsigned char* lds, int tid) {
    const int wave = __builtin_amdgcn_readfirstlane(tid >> 6), lane = tid & 63; constexpr int NCW = 104;
    if ((int)gridDim.x > NCW + 8) {
        if ((int)blockIdx.x < 64) combine_rw(ws, blockIdx.x * 8 + wave, lane);
        else if ((int)blockIdx.x < 72) combine_gla(ws, blockIdx.x - 64, tid);
        else if ((int)blockIdx.x < NCW) combine_ssd(ws, blockIdx.x - 72, tid);
        else phase_convert(in, ws, l, 3, lds, ((int)blockIdx.x - NCW) * 8 + wave, ((int)gridDim.x - NCW) * 8, wave, lane);
    } else {
        for (int it = blockIdx.x; it < NCW; it += gridDim.x) {
            if (it < 64) combine_rw(ws, it * 8 + wave, lane);
            else if (it < 72) combine_gla(ws, it - 64, tid);
            else combine_ssd(ws, it - 72, tid);
        }
        phase_convert(in, ws, l, 3, lds, blockIdx.x * 8 + wave, gridDim.x * 8, wave, lane);
    }
}
__device__ __forceinline__ float red16(float x) { x += __shfl_xor(x, 1); x += __shfl_xor(x, 2); x += __shfl_xor(x, 4); x += __shfl_xor(x, 8); return x; }
__device__ __forceinline__ void phase_post(const float* const* in, unsigned char* ws, int l, int gw, int NGW, int lane) {
    const bf16* PROJ = (const bf16*)(ws + WS_PROJ); bf16* Y = (bf16*)(ws + WS_Y); const int c = 4 * lane, hh = lane >> 4;
    const f4 gnorm = *(const f4*)(in[10] + l * 64 + (c & 63)), gnw = *(const f4*)(in[30] + l * 256 + c), gnb = *(const f4*)(in[31] + l * 256 + c), snw = *(const f4*)(in[37] + l * 256 + c);
    const float dsk = in[36][l * 4 + hh];
    for (int tok = gw; tok < M; tok += NGW) { const bf16* pp = PROJ + (size_t)tok * NINP; const size_t o = (size_t)tok * 256 + c; bf16* yo = Y + (size_t)tok * D + c;
        { const u2 ov = *(const u2*)((const bf16*)(ws + WS_OGLA) + o), gv = *(const u2*)(pp + PC_GG + c);
          const float o0 = bflo(ov.x), o1 = bfhi(ov.x), o2 = bflo(ov.y), o3 = bfhi(ov.y);
          const float rs = rsqrtf(red16((o0 * o0 + o1 * o1) + (o2 * o2 + o3 * o3)) * (1.f / 64.f) + 1e-5f);
          u2 w; w.x = pk2(o0 * rs * gnorm.x * siluf_(bflo(gv.x)), o1 * rs * gnorm.y * siluf_(bfhi(gv.x))); w.y = pk2(o2 * rs * gnorm.z * siluf_(bflo(gv.y)), o3 * rs * gnorm.w * siluf_(bfhi(gv.y))); *(u2*)(yo) = w; }
        { const f4 A = *(const f4*)((const float*)(ws + WS_LRA) + o), H = *(const f4*)((const float*)(ws + WS_LRH) + o), cy = *(const f4*)((const float*)(ws + WS_CARRY) + (size_t)(tok >> 5) * 256 + c);
          const u2 gv = *(const u2*)(pp + PC_LG + c);
          u2 w; w.x = pk2((H.x + A.x * cy.x) * gelu_tanh(bflo(gv.x)), (H.y + A.y * cy.y) * gelu_tanh(bfhi(gv.x))); w.y = pk2((H.z + A.z * cy.z) * gelu_tanh(bflo(gv.y)), (H.w + A.w * cy.w) * gelu_tanh(bfhi(gv.y))); *(u2*)(yo + 256) = w; }
        { const u2 yv = *(const u2*)((const bf16*)(ws + WS_YRW) + o), vv = *(const u2*)((const bf16*)(ws + WS_RWV) + o), gv = *(const u2*)((const bf16*)(ws + WS_RWG) + o);
          const float bon = ((const float*)(ws + WS_RWBON))[tok * 4 + hh];
          float y0 = bflo(yv.x), y1 = bfhi(yv.x), y2 = bflo(yv.y), y3 = bfhi(yv.y);
          const float mean = red16((y0 + y1) + (y2 + y3)) * (1.f / 64.f); y0 -= mean; y1 -= mean; y2 -= mean; y3 -= mean;
          const float rs = rsqrtf(red16((y0 * y0 + y1 * y1) + (y2 * y2 + y3 * y3)) * (1.f / 64.f) + 64e-5f);
          u2 w; w.x = pk2((y0 * rs * gnw.x + gnb.x + bon * bflo(vv.x)) * bflo(gv.x), (y1 * rs * gnw.y + gnb.y + bon * bfhi(vv.x)) * bfhi(gv.x));
          w.y = pk2((y2 * rs * gnw.z + gnb.z + bon * bflo(vv.y)) * bflo(gv.y), (y3 * rs * gnw.w + gnb.w + bon * bfhi(vv.y)) * bfhi(gv.y)); *(u2*)(yo + 512) = w; }
        { const u2 yv = *(const u2*)((const bf16*)(ws + WS_YSSD) + o), xv = *(const u2*)((const bf16*)(ws + WS_XBC) + (size_t)tok * 768 + c), zv = *(const u2*)(pp + PC_SZ + c);
          const float y0 = (bflo(yv.x) + dsk * bflo(xv.x)) * siluf_(bflo(zv.x)), y1 = (bfhi(yv.x) + dsk * bfhi(xv.x)) * siluf_(bfhi(zv.x)), y2 = (bflo(yv.y) + dsk * bflo(xv.y)) * siluf_(bflo(zv.y)), y3 = (bfhi(yv.y) + dsk * bfhi(xv.y)) * siluf_(bfhi(zv.y));
          float q = red16((y0 * y0 + y1 * y1) + (y2 * y2 + y3 * y3)); q += __shfl_xor(q, 16);
          const float rs = rsqrtf(q * (1.f / 128.f) + 1e-5f);
          u2 w; w.x = pk2(y0 * rs * snw.x, y1 * rs * snw.y); w.y = pk2(y2 * rs * snw.z, y3 * rs * snw.w); *(u2*)(yo + 768) = w; }
    }
}
#ifndef PROBE_GEMM
#define PROBE_GEMM 1
#endif
#ifndef PROBE_SCAN
#define PROBE_SCAN 1
#endif
#ifndef PROBE_MISC
#define PROBE_MISC 1
#endif
struct Args { const float* in[43]; float* out; unsigned char* ws; };
template <class Epi> __device__ __forceinline__ void gemm_multi(LAS unsigned char* lds, const pg8::Gemm& g, const Epi& E) {
    pg8::StaticOrder S; S.init(g.M, g.N, (int)gridDim.x, (int)blockIdx.x);
    pg8::gemm_phase<Epi, pg8::StaticOrder, true, true>(lds, g, S, E);
}
template <class Epi> __device__ __forceinline__ void gemm_single(LAS unsigned char* lds, const pg8::Gemm& g, const Epi& E) {
    pg8::StaticOrder S; S.init(g.M, g.N, (int)gridDim.x, (int)blockIdx.x);
    for (int r = 0;; ++r) { pg8::Unit u; if (!S.next(r, u)) break; OneUnit O{S, r}; pg8::gemm_phase<Epi, OneUnit, false, true>(lds, g, O, E); }
}
__global__ void __launch_bounds__(512, 2) fwd(Args a) {
    extern __shared__ __attribute__((aligned(16))) unsigned char lds_raw[];
    LAS unsigned char* lds = (LAS unsigned char*)lds_raw;
    cg::grid_group grid = cg::this_grid();
    unsigned* ctl = (unsigned*)(a.ws + WS_CTL); volatile LAS unsigned* MISC = (volatile LAS unsigned*)(lds + LDS_BYTES - 64);
    if (blockIdx.x == 0) for (int i = threadIdx.x; i < XCD_BAR_WORDS; i += 512) __hip_atomic_store(ctl + i, 0u, __ATOMIC_RELAXED, __HIP_MEMORY_SCOPE_AGENT);
    if (threadIdx.x < 2) MISC[threadIdx.x] = 0u;
    __threadfence();
    grid.sync();
    const XcdBarrier bar = xcd_barrier_post(ctl, MISC);
#define TIDS int tid = threadIdx.x; asm volatile("" : "+v"(tid)); const int lane = tid & 63, wave = __builtin_amdgcn_readfirstlane(tid >> 6), gw = blockIdx.x * 8 + wave, NGW = gridDim.x * 8; (void)lane; (void)gw; (void)NGW;
    unsigned char* ws = a.ws; const float* const* in = a.in; float* X = a.out;
    bf16* XB = (bf16*)(ws + WS_XB); bf16* Y = (bf16*)(ws + WS_Y); bf16* H = (bf16*)(ws + WS_PROJ); bf16* PROJ = (bf16*)(ws + WS_PROJ); float* SS = (float*)(ws + WS_SS);
    { TIDS phase_convert(in, ws, 0, 4, lds, gw, NGW, wave, lane); phase_init_rows(in[0], XB, SS, gw, NGW, lane); }
    xcd_barrier(bar);
#pragma unroll 1
    for (int l = 0; l < NL; ++l) {
#ifndef SKIP_G1
        for (int rep = 0; rep < PROBE_GEMM; ++rep) { pg8::Gemm g{XB, (const bf16*)(ws + WS_WGU1), M, 2 * FF, D}; EpiGU E{H, SS}; gemm_single(lds, g, E); }
#endif
        xcd_barrier(bar);
#ifndef SKIP_G2
        { pg8::Gemm g{H, (const bf16*)(ws + WS_WD1), M, D, FF}; EpiResid E{l == 0 ? in[0] : X, X, XB, SS, 0.5f}; gemm_single(lds, g, E); }
#endif
        xcd_barrier(bar);
#ifndef SKIP_G3
        for (int rep = 0; rep < PROBE_GEMM; ++rep) { pg8::Gemm g{XB, (const bf16*)(ws + WS_WIN), M, NINP, D}; EpiProj E{PROJ, SS}; gemm_single(lds, g, E); }
#endif
        xcd_barrier(bar);
#ifndef SKIP_PREP
        for (int rep = 0; rep < PROBE_MISC; ++rep) { TIDS phase_prep(in, ws, l, lds, tid); }
#endif
        xcd_barrier(bar);
#ifndef SKIP_SCAN
        for (int rep = 0; rep < PROBE_SCAN; ++rep) { TIDS phase_scan<0>(in, ws, l, lds, tid); }
        xcd_barrier(bar);
        { TIDS phase_combine(in, ws, l, lds, tid); }
        xcd_barrier(bar);
        for (int rep = 0; rep < PROBE_SCAN; ++rep) { TIDS phase_scan<1>(in, ws, l, lds, tid); }
#endif
        xcd_barrier(bar);
#ifndef SKIP_POST
        for (int rep = 0; rep < PROBE_MISC; ++rep) { TIDS phase_post(in, ws, l, gw, NGW, lane); }
#endif
        xcd_barrier(bar);
#ifndef SKIP_G4
        { pg8::Gemm g{Y, (const bf16*)(ws + WS_WOUT), M, D, D}; EpiResid E{X, X, XB, SS, 1.0f}; gemm_single(lds, g, E); }
#endif
        xcd_barrier(bar);
#ifndef SKIP_G5
        for (int rep = 0; rep < PROBE_GEMM; ++rep) { pg8::Gemm g{XB, (const bf16*)(ws + WS_WGU2), M, 2 * FF, D}; EpiGU E{H, SS}; gemm_single(lds, g, E); }
#endif
        xcd_barrier(bar);
#ifndef SKIP_G6
        { pg8::Gemm g{H, (const bf16*)(ws + WS_WD2), M, D, FF}; EpiResid E{X, X, XB, SS, 0.5f}; gemm_single(lds, g, E); }
#endif
        xcd_barrier(bar);
    }
    { TIDS phase_final(X, in[42], gw, NGW, lane); }
}

extern "C" void kernel_launch(void* const* d_in, const int* in_sizes, int n_in, void* d_out, int out_size, void* d_ws, size_t ws_size, hipStream_t stream) {
    static int grid = 0;
    if (grid == 0) {
        int dev = 0, cus = 0, per_cu = 0;
        (void)hipGetDevice(&dev);
        (void)hipDeviceGetAttribute(&cus, hipDeviceAttributeMultiprocessorCount, dev);
        (void)hipFuncSetAttribute((const void*)fwd, hipFuncAttributeMaxDynamicSharedMemorySize, LDS_BYTES);
        (void)hipOccupancyMaxActiveBlocksPerMultiprocessor(&per_cu, (const void*)fwd, 512, LDS_BYTES);
        if (per_cu < 1) per_cu = 1;
        grid = cus * per_cu;
        if (n_in != 43 || out_size != M * D || ws_size < WS_END) fprintf(stderr, "kernel_launch: unexpected sizes n_in %d out %d ws %zu (need %zu)\n", n_in, out_size, ws_size, (size_t)WS_END);
    }
    Args a{};
    for (int i = 0; i < 43 && i < n_in; ++i) a.in[i] = (const float*)d_in[i];
    a.out = (float*)d_out; a.ws = (unsigned char*)d_ws;
    void* args[] = {&a};
    hipError_t e = hipLaunchCooperativeKernel((const void*)fwd, dim3(grid), dim3(512), args, LDS_BYTES, stream);
    if (e != hipSuccess) fprintf(stderr, "cooperative launch failed: %s (grid %d)\n", hipGetErrorString(e), grid);
}
```

```cpp
#include <hip/hip_runtime.h>
#include <hip/hip_cooperative_groups.h>
#include <cstdio>
#include <cstdint>
namespace cg = cooperative_groups;
namespace pg8 {
#define PG8_LAS __attribute__((address_space(3)))
typedef unsigned short bf16_t;
typedef short bf16x8 __attribute__((ext_vector_type(8)));
typedef float f32x4 __attribute__((ext_vector_type(4)));
typedef unsigned u32x4 __attribute__((ext_vector_type(4)));
constexpr int BM = 256, BK = 64, HALF = 128, HTB = HALF * BK * 2  , STAGE_BYTES = 8 * HTB, NXCD = 8, WGM = 8;

__host__ __device__ __forceinline__ int lds_byte(int r, int c) { const int st = (r >> 4) * 2 + (c >> 5), rr = r & 15, cc = c & 31, ob = rr * 64 + cc * 2; return st * 1024 + (ob ^ (((ob >> 9) & 1) << 5)); }
__host__ __device__ __forceinline__ void stage_rc(int b, int& R, int& C) { const int st = b / 1024, sb = b % 1024, swz = sb ^ (((sb >> 9) & 1) << 5); R = (st >> 1) * 16 + swz / 64; C = (st & 1) * 32 + (swz % 64) / 2; }
__host__ __device__ __forceinline__ int perm32(int rho) { const int n = rho >> 4, i = rho & 15; return 8 * (i >> 2) + 4 * n + (i & 3); }

struct Unit { int pm, pn; };
struct Gemm { const bf16_t* A; const bf16_t* Bt; int M, N, K; };

struct StaticOrder {
    int nM, nN, nwg, G, c;
    __host__ __device__ void init(int M, int N, int G_, int c_) { nM = M / BM; nN = N / BM; nwg = nM * nN; G = G_; c = c_; }
    __host__ __device__ bool next(int i, Unit& u) const {
        const long L = (long)i * G + c; if (L >= nwg) return false;
        int wgid = (int)L; { const int q = nwg / NXCD, r = nwg % NXCD, xcd = wgid % NXCD, off = wgid / NXCD; wgid = (xcd < r ? xcd * (q + 1) : r * (q + 1) + (xcd - r) * q) + off; }
        const int nig = WGM * nN, gid = wgid / nig, fm = gid * WGM, gsz = (nM - fm) < WGM ? (nM - fm) : WGM;
        u.pm = fm + ((wgid % nig) % gsz); u.pn = (wgid % nig) / gsz; return true;
    }
    __device__ __forceinline__ void a_ready(const Unit&) const {}
    __device__ __forceinline__ void done(const Unit&) const {}
};

__device__ __forceinline__ unsigned cvt_pk_bf16(float lo, float hi) { unsigned r; asm volatile("v_cvt_pk_bf16_f32 %0, %1, %2" : "=v"(r) : "v"(lo), "v"(hi)); return r; }
typedef float f32x2 __attribute__((ext_vector_type(2)));
template <class Epi, class Sched, bool ALIGN_EPI = false, bool SP2 = false>
__device__ __forceinline__ void gemm_phase(PG8_LAS unsigned char* lds, const Gemm g, const Sched& S, const Epi& E) {
    int tid_ = threadIdx.x; asm volatile("" : "+v"(tid_));
    const int tid = tid_, wid = __builtin_amdgcn_readfirstlane(tid >> 6), lane = tid & 63, wr = wid >> 2, wc = wid & 3, fr = lane & 15, fq = lane >> 4;
    const int K = g.K, nt = K / BK;
    unsigned voffA[2], voffB[2];
#pragma unroll
    for (int i = 0; i < 2; ++i) { int R, C; stage_rc(tid * 16 + i * 8192, R, C); const int Rb = Epi::PERM ? ((R & ~31) + perm32(R & 31)) : R;
        voffA[i] = (unsigned)(R * K + C) * 2u; voffB[i] = (unsigned)(Rb * K + C) * 2u; }
    const size_t kstep = (size_t)(BK * 2);
    const size_t hstep = (size_t)HALF * K * 2;
    const size_t tstep = 2 * hstep;
    const unsigned ldsw = (unsigned)wid * 1024u;
    const int aoff = lds_byte(wr * 64 + fr, fq * 8), boff = lds_byte(wc * 32 + fr, fq * 8);
#define PG8_SA(b, h) (((b) * 2 + (h)) * HTB)
#define PG8_SB(b, h) ((4 + (b) * 2 + (h)) * HTB)
#define PG8_STAGE(bufoff, gbase, voff) do { _Pragma("unroll") for (int _i = 0; _i < 2; ++_i) \
        __builtin_amdgcn_global_load_lds((const unsigned*)((const char*)(gbase) + (voff)[_i]), (PG8_LAS unsigned*)(lds + (bufoff) + ldsw + _i * 8192), 16, 0, 0); } while (0)
#define PG8_LDA(dst, b, h) do { _Pragma("unroll") for (int m = 0; m < 4; ++m) _Pragma("unroll") for (int k = 0; k < 2; ++k) dst[m][k] = *(const PG8_LAS bf16x8*)(lds + PG8_SA(b, h) + aoff + m * 2048 + k * 1024); } while (0)
#define PG8_LDB(dst, b, h) do { _Pragma("unroll") for (int n = 0; n < 2; ++n) _Pragma("unroll") for (int k = 0; k < 2; ++k) dst[n][k] = *(const PG8_LAS bf16x8*)(lds + PG8_SB(b, h) + boff + n * 2048 + k * 1024); } while (0)
#define PG8_MMA(ai, bj, At, Bt) do { __builtin_amdgcn_s_setprio(1); _Pragma("unroll") for (int m = 0; m < 4; ++m) _Pragma("unroll") for (int n = 0; n < 2; ++n) _Pragma("unroll") for (int k = 0; k < 2; ++k) \
        acc[ai][bj][m][n] = __builtin_amdgcn_mfma_f32_16x16x32_bf16(Bt[n][k], At[m][k], acc[ai][bj][m][n], 0, 0, 0); __builtin_amdgcn_s_setprio(0); } while (0)
#define PG8_WAIT_V(n) asm volatile("s_waitcnt vmcnt(" #n ")" ::: "memory")
#define PG8_WAIT_L(n) asm volatile("s_waitcnt lgkmcnt(" #n ")" ::: "memory")
#define PG8_BAR __builtin_amdgcn_s_barrier()
#define PG8_SCHED __builtin_amdgcn_sched_barrier(0)
    Unit cur, nxt; int ui = 0;
    if (!S.next(0, cur)) return;
    f32x4 acc[2][2][4][2];
#pragma unroll
    for (int a = 0; a < 2; ++a)
#pragma unroll
        for (int b = 0; b < 2; ++b)
#pragma unroll
            for (int m = 0; m < 4; ++m)
#pragma unroll
                for (int n = 0; n < 2; ++n) acc[a][b][m][n] = (f32x4){0.f, 0.f, 0.f, 0.f};
    bf16x8 At[4][2], B0[2][2], B1[2][2];
    const char* cA = (const char*)g.A + (size_t)cur.pm * tstep; const char* cB = (const char*)g.Bt + (size_t)cur.pn * tstep;
    S.a_ready(cur);
    if constexpr (SP2) {
        PG8_STAGE(PG8_SB(0, 0), cB, voffB); PG8_STAGE(PG8_SB(0, 1), cB + hstep, voffB); PG8_STAGE(PG8_SA(0, 0), cA, voffA); PG8_STAGE(PG8_SA(0, 1), cA + hstep, voffA);
        if (wr == 1) PG8_BAR;
        PG8_WAIT_V(2); PG8_BAR;
        PG8_STAGE(PG8_SB(1, 0), cB + kstep, voffB); PG8_STAGE(PG8_SA(1, 0), cA + kstep, voffA); PG8_STAGE(PG8_SB(1, 1), cB + hstep + kstep, voffB);
        PG8_WAIT_V(6); PG8_BAR;
    } else {
        PG8_STAGE(PG8_SB(0, 0), cB, voffB); PG8_STAGE(PG8_SA(0, 0), cA, voffA); PG8_STAGE(PG8_SB(0, 1), cB + hstep, voffB); PG8_STAGE(PG8_SA(0, 1), cA + hstep, voffA);
        if (wr == 1) PG8_BAR;
        PG8_WAIT_V(4); PG8_BAR;
        PG8_STAGE(PG8_SB(1, 0), cB + kstep, voffB); PG8_STAGE(PG8_SA(1, 0), cA + kstep, voffA); PG8_STAGE(PG8_SB(1, 1), cB + hstep + kstep, voffB);
        PG8_WAIT_V(6); PG8_BAR;
    }
    for (;;) {
        const bool has_next = S.next(ui + 1, nxt);
        const char* nA = has_next ? (const char*)g.A + (size_t)nxt.pm * tstep : cA; const char* nB = has_next ? (const char*)g.Bt + (size_t)nxt.pn * tstep : cB;
        for (int t = 0; t < nt; t += 2) {
            const bool last = (t == nt - 2);
            const char* a1 = cA + (size_t)(t + 1) * kstep;
            const char* a2 = last ? nA : cA + (size_t)(t + 2) * kstep; const char* b2 = last ? nB : cB + (size_t)(t + 2) * kstep;
            const char* a3 = a2 + kstep; const char* b3 = b2 + kstep;
            if (last && has_next) S.a_ready(nxt);
            if constexpr (SP2) {
            PG8_LDB(B0, 0, 0); PG8_LDB(B1, 0, 1); PG8_SCHED; PG8_LDA(At, 0, 0); PG8_STAGE(PG8_SA(1, 1), a1 + hstep, voffA);
            PG8_WAIT_V(8); PG8_WAIT_L(0); PG8_BAR; PG8_MMA(0, 0, At, B0); PG8_MMA(0, 1, At, B1); PG8_BAR; PG8_SCHED;
            PG8_LDA(At, 0, 1); PG8_STAGE(PG8_SB(0, 0), b2, voffB); PG8_STAGE(PG8_SB(0, 1), b2 + hstep, voffB); PG8_STAGE(PG8_SA(0, 0), a2, voffA);
            PG8_WAIT_V(8); PG8_WAIT_L(0); PG8_BAR; PG8_MMA(1, 0, At, B0); PG8_MMA(1, 1, At, B1); PG8_BAR; PG8_SCHED;
            PG8_LDB(B0, 1, 0); PG8_LDB(B1, 1, 1); PG8_SCHED; PG8_LDA(At, 1, 0); PG8_STAGE(PG8_SA(0, 1), a2 + hstep, voffA);
            PG8_WAIT_V(8); PG8_WAIT_L(0); PG8_BAR; PG8_MMA(0, 0, At, B0); PG8_MMA(0, 1, At, B1); PG8_BAR; PG8_SCHED;
            PG8_LDA(At, 1, 1); PG8_STAGE(PG8_SB(1, 0), b3, voffB); PG8_STAGE(PG8_SB(1, 1), b3 + hstep, voffB); PG8_STAGE(PG8_SA(1, 0), a3, voffA);
            PG8_WAIT_V(8); PG8_WAIT_L(0); PG8_BAR; PG8_MMA(1, 0, At, B0); PG8_MMA(1, 1, At, B1); PG8_BAR; PG8_SCHED;
            } else {
            PG8_LDB(B0, 0, 0); PG8_SCHED; PG8_LDA(At, 0, 0); PG8_STAGE(PG8_SA(1, 1), a1 + hstep, voffA);
            PG8_WAIT_L(8); PG8_BAR; PG8_WAIT_L(0); PG8_MMA(0, 0, At, B0); PG8_BAR; PG8_SCHED;
            PG8_LDB(B1, 0, 1); PG8_STAGE(PG8_SB(0, 0), b2, voffB);
            PG8_BAR; PG8_WAIT_L(0); PG8_MMA(0, 1, At, B1); PG8_BAR;
            PG8_LDA(At, 0, 1); PG8_STAGE(PG8_SA(0, 0), a2, voffA);
            PG8_BAR; PG8_WAIT_L(0); PG8_MMA(1, 0, At, B0); PG8_BAR; PG8_SCHED;
            PG8_STAGE(PG8_SB(0, 1), b2 + hstep, voffB);
            PG8_WAIT_V(6); PG8_BAR; PG8_MMA(1, 1, At, B1); PG8_BAR;
            PG8_LDB(B0, 1, 0); PG8_SCHED; PG8_LDA(At, 1, 0); PG8_STAGE(PG8_SA(0, 1), a2 + hstep, voffA);
            PG8_WAIT_L(8); PG8_BAR; PG8_WAIT_L(0); PG8_MMA(0, 0, At, B0); PG8_BAR; PG8_SCHED;
            PG8_LDB(B1, 1, 1); PG8_STAGE(PG8_SB(1, 0), b3, voffB);
            PG8_BAR; PG8_WAIT_L(0); PG8_MMA(0, 1, At, B1); PG8_BAR;
            PG8_LDA(At, 1, 1); PG8_STAGE(PG8_SA(1, 0), a3, voffA);
            PG8_BAR; PG8_WAIT_L(0); PG8_MMA(1, 0, At, B0); PG8_BAR; PG8_SCHED;
            PG8_STAGE(PG8_SB(1, 1), b3 + hstep, voffB);
            PG8_WAIT_V(6); PG8_BAR; PG8_MMA(1, 1, At, B1); PG8_BAR;
            }
        }
        if constexpr (ALIGN_EPI) { if (wr == 0) PG8_BAR; }
        if constexpr (!Epi::AFTER_DRAIN) { E(acc, cur, wr, wc, fr, fq); S.done(cur); }
        if (!has_next) break;
#pragma unroll
        for (int a = 0; a < 2; ++a)
#pragma unroll
            for (int b = 0; b < 2; ++b)
#pragma unroll
                for (int m = 0; m < 4; ++m)
#pragma unroll
                    for (int n = 0; n < 2; ++n) acc[a][b][m][n] = (f32x4){0.f, 0.f, 0.f, 0.f};
        cur = nxt; cA = nA; cB = nB; ++ui;
        if constexpr (ALIGN_EPI) { if (wr == 1) PG8_BAR; }
    }
    PG8_WAIT_V(0);
    if constexpr (!ALIGN_EPI) { if (wr == 0) PG8_BAR; }
    PG8_BAR;
    if constexpr (Epi::AFTER_DRAIN) { E.fused(acc, cur, wr, wc, fr, fq, lds, wid, lane); S.done(cur); }
#undef PG8_SA
#undef PG8_SB
#undef PG8_STAGE
#undef PG8_LDA
#undef PG8_LDB
#undef PG8_MMA
#undef PG8_WAIT_V
#undef PG8_WAIT_L
#undef PG8_BAR
#undef PG8_SCHED
}
}
#define LAS __attribute__((address_space(3)))
typedef unsigned short bf16;
typedef float f4 __attribute__((ext_vector_type(4)));
typedef float f2 __attribute__((ext_vector_type(2)));
#define LO2(v) __builtin_shufflevector(v, v, 0, 1)
#define HI2(v) __builtin_shufflevector(v, v, 2, 3)
typedef unsigned u2 __attribute__((ext_vector_type(2)));
typedef unsigned u4 __attribute__((ext_vector_type(4)));
using pg8::f32x4;

constexpr int M = 16384, D = 1024, FF = 2816, NIN = 3156, NINP = 3328, NL = 4, SEQ = 8192;
constexpr int LDS_BYTES = 147456;
constexpr size_t HM = 524288;
constexpr size_t WS_WGU1 = 0, WS_WD1 = 22 * HM, WS_WIN = 33 * HM, WS_WOUT = 46 * HM, WS_WGU2 = 50 * HM, WS_WD2 = 72 * HM;
constexpr size_t MiB = 1048576;
constexpr size_t WS_XB = 42 * MiB;
constexpr size_t WS_OGLA = WS_XB, WS_YRW = WS_XB + 8 * MiB, WS_YSSD = WS_XB + 16 * MiB;
constexpr size_t WS_Y = 74 * MiB;
constexpr size_t WS_PROJ = 106 * MiB;
constexpr size_t WS_VFIRST = 210 * MiB;
constexpr size_t WS_SS = 226 * MiB;
constexpr size_t WS_RWR = 227 * MiB, WS_RWK = 235 * MiB, WS_RWV = 243 * MiB, WS_RWKK = 251 * MiB, WS_RWB = 259 * MiB;
constexpr size_t WS_RWW = 267 * MiB;
constexpr size_t WS_RWG = 283 * MiB;
constexpr size_t WS_RWBON = 291 * MiB;
constexpr size_t WS_XBC = 292 * MiB;
constexpr size_t WS_DT = 316 * MiB, WS_DEC = 317 * MiB;
constexpr size_t WS_LRA = 318 * MiB, WS_LRH = 334 * MiB;
constexpr size_t WS_SEGA = 350 * MiB, WS_SEGH = 351 * MiB, WS_CARRY = 352 * MiB;
constexpr int NCH = 32, CHL = SEQ / NCH;
constexpr size_t WS_RWP = 353 * MiB, WS_RWU = 357 * MiB;
constexpr size_t WS_GLU = 361 * MiB, WS_GLD = 363 * MiB;
constexpr int NCS = 64;
constexpr size_t WS_SSU = 364 * MiB, WS_SSD = 380 * MiB;
constexpr size_t WS_CTL = 381 * MiB;
constexpr size_t WS_END = 382 * MiB;

constexpr int PC_GQ = 0, PC_GK = 128, PC_GV = 256, PC_GG = 512, PC_GSTEM = 768, PC_LX = 784, PC_LG = 1040, PC_RW = 1296, PC_SZ = 2128, PC_SXBC = 2384, PC_SDT = 3152;

__device__ __forceinline__ float bf2f(bf16 v) { return __uint_as_float((unsigned)v << 16); }
__device__ __forceinline__ float bflo(unsigned w) { return __uint_as_float(w << 16); }
__device__ __forceinline__ float bfhi(unsigned w) { return __uint_as_float(w & 0xffff0000u); }
__device__ __forceinline__ unsigned pk2(float lo, float hi) { return pg8::cvt_pk_bf16(lo, hi); }
__device__ __forceinline__ float sigmoidf_(float x) { return 1.f / (1.f + __expf(-x)); }
__device__ __forceinline__ float siluf_(float x) { return x / (1.f + __expf(-x)); }
__device__ __forceinline__ float tanhf_(float x) { return 1.f - 2.f / (1.f + __expf(2.f * x)); }
__device__ __forceinline__ float softplusf_(float x) { return fmaxf(x, 0.f) + log1pf(__expf(-fabsf(x))); }
__device__ __forceinline__ float gelu_tanh(float x) { const float u = 0.7978845608028654f * (x + 0.044715f * x * x * x); return 0.5f * x * (1.f + tanhf_(u)); }
__device__ __forceinline__ float wave_sum(float v) {
#pragma unroll
    for (int o = 1; o < 64; o <<= 1) v += __shfl_xor(v, o);
    return v;
}
__device__ __forceinline__ float dpp_mov(float x, const int ctrl_sel) {
    const int v = __builtin_bit_cast(int, x); int r;
    if (ctrl_sel == 0) r = __builtin_amdgcn_update_dpp(0, v, 0xB1, 0xF, 0xF, true);
    else if (ctrl_sel == 1) r = __builtin_amdgcn_update_dpp(0, v, 0x4E, 0xF, 0xF, true);
    else r = __builtin_amdgcn_update_dpp(0, v, 0x141, 0xF, 0xF, true);
    return __builtin_bit_cast(float, r);
}
__device__ __forceinline__ float red8(float x) { x += dpp_mov(x, 0); x += dpp_mov(x, 1); x += dpp_mov(x, 2); return x; }
__device__ __forceinline__ float rstd_row(const float* ss, int row) { const f4 p = *(const f4*)(ss + (size_t)row * 4); return rsqrtf(((p.x + p.y) + (p.z + p.w)) * (1.f / 1024.f) + 1e-6f); }

__device__ __forceinline__ void lds_barrier() { asm volatile("s_waitcnt lgkmcnt(0)" ::: "memory"); __builtin_amdgcn_s_barrier(); asm volatile("" ::: "memory"); }
struct EpiGU {
    static constexpr bool PERM = true, AFTER_DRAIN = true;
    bf16* H; const float* ss;
    __device__ __forceinline__ void fused(f32x4 (&acc)[2][2][4][2], const pg8::Unit& u, int wr, int wc, int fr, int fq, LAS unsigned char* lds, int wid, int lane) const {
#pragma unroll
        for (int ai = 0; ai < 2; ++ai)
#pragma unroll
            for (int m = 0; m < 4; ++m) {
                const int row = u.pm * 256 + ai * 128 + wr * 64 + m * 16 + fr; const float rs = rstd_row(ss, row);
                float hv[8];
#pragma unroll
                for (int n = 0; n < 2; ++n)
#pragma unroll
                    for (int e = 0; e < 4; ++e) { const float g = acc[ai][0][m][n][e] * rs, up = acc[ai][1][m][n][e] * rs; hv[n * 4 + e] = siluf_(g) * up; }
                u4 w; w.x = pk2(hv[0], hv[1]); w.y = pk2(hv[2], hv[3]); w.z = pk2(hv[4], hv[5]); w.w = pk2(hv[6], hv[7]);
                *(u4*)(H + (size_t)row * FF + u.pn * 128 + wc * 32 + 8 * fq) = w;
                asm volatile("" ::: "memory");
            }
    }
};
struct EpiProj {
    static constexpr bool PERM = true, AFTER_DRAIN = true;
    bf16* O; const float* ss;
    __device__ __forceinline__ void fused(f32x4 (&acc)[2][2][4][2], const pg8::Unit& u, int wr, int wc, int fr, int fq, LAS unsigned char* lds, int wid, int lane) const {
#pragma unroll
        for (int ai = 0; ai < 2; ++ai)
#pragma unroll
            for (int m = 0; m < 4; ++m) {
                const int row = u.pm * 256 + ai * 128 + wr * 64 + m * 16 + fr; const float rs = rstd_row(ss, row);
#pragma unroll
                for (int bj = 0; bj < 2; ++bj) { const f32x4 v0 = acc[ai][bj][m][0] * rs, v1 = acc[ai][bj][m][1] * rs;
                    u4 w; w.x = pk2(v0[0], v0[1]); w.y = pk2(v0[2], v0[3]); w.z = pk2(v1[0], v1[1]); w.w = pk2(v1[2], v1[3]);
                    *(u4*)(O + (size_t)row * NINP + u.pn * 256 + bj * 128 + wc * 32 + 8 * fq) = w; }
                asm volatile("" ::: "memory");
            }
    }
};
struct EpiResid {
    static constexpr bool PERM = true, AFTER_DRAIN = true;
    const float* xin; float* xout; bf16* xb; float* ss; float scale;
    __device__ __forceinline__ void fused(f32x4 (&acc)[2][2][4][2], const pg8::Unit& u, int wr, int wc, int fr, int fq, LAS unsigned char* lds, int wid, int lane) const {
        LAS float* P = (LAS float*)lds;
#pragma unroll
        for (int ai = 0; ai < 2; ++ai)
#pragma unroll
            for (int m = 0; m < 4; ++m) {
                const int rt = ai * 128 + wr * 64 + m * 16 + fr; const size_t row = (size_t)u.pm * 256 + rt; float sq = 0.f;
#pragma unroll
                for (int bj = 0; bj < 2; ++bj) { const size_t off = row * D + u.pn * 256 + bj * 128 + wc * 32 + 8 * fq;
                    f32x4 x0 = *(const f32x4*)(xin + off), x1 = *(const f32x4*)(xin + off + 4);
                    x0 += acc[ai][bj][m][0] * scale; x1 += acc[ai][bj][m][1] * scale;
                    *(f32x4*)(xout + off) = x0; *(f32x4*)(xout + off + 4) = x1;
                    u4 w; w.x = pk2(x0[0], x0[1]); w.y = pk2(x0[2], x0[3]); w.z = pk2(x1[0], x1[1]); w.w = pk2(x1[2], x1[3]);
                    *(u4*)(xb + off) = w;
                    sq += (x0[0] * x0[0] + x0[1] * x0[1]) + (x0[2] * x0[2] + x0[3] * x0[3]) + (x1[0] * x1[0] + x1[1] * x1[1]) + (x1[2] * x1[2] + x1[3] * x1[3]); }
                sq += __shfl_xor(sq, 16); sq += __shfl_xor(sq, 32);
                if (fq == 0) P[rt * 4 + wc] = sq;
            }
        __syncthreads();
        const int tid = wid * 64 + lane;
        if (tid < 256) ss[(size_t)(u.pm * 256 + tid) * 4 + u.pn] = (P[tid * 4 + 0] + P[tid * 4 + 1]) + (P[tid * 4 + 2] + P[tid * 4 + 3]);
        __syncthreads();
    }
};
struct OneUnit { pg8::StaticOrder b; int r;
    __device__ __forceinline__ bool next(int i, pg8::Unit& u) const { return i == 0 && b.next(r, u); }
    __device__ __forceinline__ void a_ready(const pg8::Unit&) const {}
    __device__ __forceinline__ void done(const pg8::Unit&) const {} };

__device__ __forceinline__ void tr_item(const float* W, int ldn, int nvalid, int col0, const float* sc, bf16* WT, int K, int row0, int k0, LAS float* scr, int lane) {
    const int c4 = col0 + (lane & 31) * 4; const bool ok = c4 < nvalid;
#pragma unroll 8
    for (int i = 0; i < 16; ++i) { const int kk = 2 * i + (lane >> 5); f4 v = (f4){0.f, 0.f, 0.f, 0.f}; if (ok) v = *(const f4*)(W + (size_t)(k0 + kk) * ldn + c4); if (sc) v = v * sc[k0 + kk]; *(LAS f4*)(scr + kk * 132 + (lane & 31) * 4) = v; }
    asm volatile("s_waitcnt lgkmcnt(0)" ::: "memory");
    const int kq = lane & 3;
#pragma unroll
    for (int j = 0; j < 8; ++j) { const int n = (lane >> 2) + 16 * j; const LAS float* s = scr + (8 * kq) * 132 + n;
        u4 o; o.x = pk2(s[0 * 132], s[1 * 132]); o.y = pk2(s[2 * 132], s[3 * 132]); o.z = pk2(s[4 * 132], s[5 * 132]); o.w = pk2(s[6 * 132], s[7 * 132]);
        *(u4*)(WT + (size_t)(row0 + n) * K + k0 + 8 * kq) = o; }
    asm volatile("s_waitcnt lgkmcnt(0)" ::: "memory");
}
__device__ __forceinline__ void tr_gu(const float* Wg, const float* Wu, const float* nw, bf16* WT, int it, LAS float* scr, int lane) {
    const int kb = it / 44, nb = it % 44, row0 = nb * 128, pn = row0 >> 8, half = (row0 >> 7) & 1;
    tr_item(half ? Wu : Wg, FF, FF, pn * 128, nw, WT, D, row0, kb * 32, scr, lane);
}
__device__ __forceinline__ void phase_convert(const float* const* in, unsigned char* ws, int l, int sets, LAS unsigned char* lds, int gw, int NGW, int wave, int lane) {
    LAS float* scr = (LAS float*)(lds + wave * 17408);
    constexpr int I_GU = 1408, I_D = 704, I_IN = 832, I_OUT = 256, NA = I_GU + I_D + I_IN, NB = I_OUT + I_GU + I_D;
    const int la = (sets & 4) ? l : l + 1; const bool doA = (sets & 4) || ((sets & 2) && l + 1 < NL), doB = (sets & 1) != 0;
    const int lo = doA ? 0 : NA, hi = doB ? NA + NB : NA;
    for (int it = lo + gw; it < hi; it += NGW) {
        int r = it;
        if (r < NA) { const size_t oFF = (size_t)la * D * FF;
            if (r < I_GU) { tr_gu(in[2] + oFF, in[3] + oFF, in[1] + la * D, (bf16*)(ws + WS_WGU1), r, scr, lane); continue; } r -= I_GU;
            if (r < I_D) { tr_item(in[4] + oFF, D, D, (r % 8) * 128, nullptr, (bf16*)(ws + WS_WD1), FF, (r % 8) * 128, (r / 8) * 32, scr, lane); continue; } r -= I_D;
            tr_item(in[6] + (size_t)la * D * NIN, NIN, NIN, (r % 26) * 128, in[5] + la * D, (bf16*)(ws + WS_WIN), D, (r % 26) * 128, (r / 26) * 32, scr, lane); continue; }
        r -= NA; const size_t oFF = (size_t)l * D * FF;
        if (r < I_OUT) { tr_item(in[7] + (size_t)l * D * D, D, D, (r % 8) * 128, nullptr, (bf16*)(ws + WS_WOUT), D, (r % 8) * 128, (r / 8) * 32, scr, lane); continue; } r -= I_OUT;
        if (r < I_GU) { tr_gu(in[39] + oFF, in[40] + oFF, in[38] + l * D, (bf16*)(ws + WS_WGU2), r, scr, lane); continue; } r -= I_GU;
        tr_item(in[41] + oFF, D, D, (r % 8) * 128, nullptr, (bf16*)(ws + WS_WD2), FF, (r % 8) * 128, (r / 8) * 32, scr, lane);
    }
}
__device__ __forceinline__ void phase_init_rows(const float* x, bf16* xb, float* ss, int gw, int NGW, int lane) {
    for (int m = gw; m < M; m += NGW) {
        const f4* xr = (const f4*)(x + (size_t)m * D) + lane; float s = 0.f; u2* o = (u2*)(xb + (size_t)m * D) + lane;
#pragma unroll
        for (int j = 0; j < 4; ++j) { const f4 v = xr[64 * j]; s += (v.x * v.x + v.y * v.y) + (v.z * v.z + v.w * v.w); u2 w; w.x = pk2(v.x, v.y); w.y = pk2(v.z, v.w); o[64 * j] = w; }
        s = wave_sum(s);
        if (lane < 4) ss[(size_t)m * 4 + lane] = lane == 0 ? s : 0.f;
    }
}
__device__ __forceinline__ void phase_final(float* x, const float* fw, int gw, int NGW, int lane) {
    for (int m = gw; m < M; m += NGW) {
        f4* xr = (f4*)(x + (size_t)m * D) + lane; f4 v[4]; float s = 0.f;
#pragma unroll
        for (int j = 0; j < 4; ++j) { v[j] = xr[64 * j]; s += (v[j].x * v[j].x + v[j].y * v[j].y) + (v[j].z * v[j].z + v[j].w * v[j].w); }
        const float rs = rsqrtf(wave_sum(s) * (1.f / 1024.f) + 1e-6f);
#pragma unroll
        for (int j = 0; j < 4; ++j) { const f4 w = ((const f4*)fw)[lane + 64 * j]; xr[64 * j] = v[j] * rs * w; }
    }
}
#define XB_TMO      128
#define XB_XCNT(j)  (256  + 64 * (j))
#define XB_XSUB(j)  (1280 + 64 * (j))
#define XB_XGEN(j)  (2304 + 64 * (j))
#define XB_TOP      3328
#define XB_TOPGEN   3392
#define XCD_BAR_WORDS 3456
#define XB_SPIN_CAP (1u << 18)

__device__ __forceinline__ unsigned xb_ld(unsigned* p)              { return __hip_atomic_load(p, __ATOMIC_RELAXED, __HIP_MEMORY_SCOPE_AGENT); }
__device__ __forceinline__ unsigned xb_add(unsigned* p, unsigned v) { return __hip_atomic_fetch_add(p, v, __ATOMIC_RELAXED, __HIP_MEMORY_SCOPE_AGENT); }
__device__ __forceinline__ unsigned xb_xcc_id() { return (unsigned)__builtin_amdgcn_s_getreg((3 << 11) | 20) & 0xFu; }
#define XB_SPIN(cond, bar) do { unsigned _sp = 0; while (cond) { __builtin_amdgcn_s_sleep(1); \
    if ((++_sp & 255u) == 0u) { if (xb_ld(&(bar)[XB_TMO])) break; if (_sp > XB_SPIN_CAP) { atomicAdd(&(bar)[XB_TMO], 1u); break; } } } } while (0)

struct XcdBarrier {
    unsigned* bar; unsigned x;
    volatile LAS unsigned* st;
};

__device__ __forceinline__ XcdBarrier xcd_barrier_post(unsigned* bar, volatile LAS unsigned* st) {
    XcdBarrier b; b.bar = bar; b.x = xb_xcc_id(); b.st = st;
    if (threadIdx.x == 0) (void)xb_add(&bar[XB_XCNT(b.x)], 1u);
    return b;
}
__device__ __forceinline__ void xcd_barrier_complete(unsigned* bar, unsigned x, unsigned& nloc, unsigned& nx) {
    const unsigned G = gridDim.x * gridDim.y * gridDim.z;
    unsigned sum, cnt, mine, sp = 0u;
    for (;;) {
        sum = 0u; cnt = 0u; mine = 0u;
#pragma unroll
        for (unsigned j = 0; j < 16; ++j) { const unsigned c = xb_ld(&bar[XB_XCNT(j)]); sum += c; cnt += (c > 0u) ? 1u : 0u; mine = (j == x) ? c : mine; }
        if (sum == G) break;
        __builtin_amdgcn_s_sleep(1);
        if ((++sp & 255u) == 0u) { if (xb_ld(&bar[XB_TMO])) break; if (sp > XB_SPIN_CAP) { atomicAdd(&bar[XB_TMO], 1u); break; } }
    }
    nloc = mine > 0u ? mine : 1u; nx = cnt > 0u ? cnt : 1u;
}

__device__ __forceinline__ void xcd_barrier(const XcdBarrier& b) {
    asm volatile("s_waitcnt vmcnt(0)" ::: "memory");
    __syncthreads();
    if (threadIdx.x == 0) {
        unsigned* bar = b.bar;
        __builtin_amdgcn_s_waitcnt(0);
        unsigned nloc = b.st[0], nx = b.st[1];
        if (nloc == 0u) { xcd_barrier_complete(bar, b.x, nloc, nx); b.st[0] = nloc; b.st[1] = nx; }
        const unsigned old = xb_add(&bar[XB_XSUB(b.x)], 1u);
        const unsigned gen = old / nloc;
        if (old + 1u == (gen + 1u) * nloc) {
            __builtin_amdgcn_fence(__ATOMIC_RELEASE, "agent");
            asm volatile("s_waitcnt vmcnt(0)" ::: "memory");
            const unsigned og = xb_add(&bar[XB_TOP], 1u);
            const unsigned tg = og / nx;
            if (og + 1u == (tg + 1u) * nx) xb_add(&bar[XB_TOPGEN], 1u);
            else XB_SPIN(xb_ld(&bar[XB_TOPGEN]) == tg, bar);
            __builtin_amdgcn_fence(__ATOMIC_ACQUIRE, "agent");
            xb_add(&bar[XB_XGEN(b.x)], 1u);
            asm volatile("s_waitcnt vmcnt(0)" ::: "memory");
        } else {
            XB_SPIN(xb_ld(&bar[XB_XGEN(b.x)]) == gen, bar);
            __builtin_amdgcn_fence(__ATOMIC_ACQUIRE, "agent");
            asm volatile("s_waitcnt vmcnt(0)" ::: "memory");
        }
    }
    __syncthreads();
}
__device__ __forceinline__ void prep_lru(const float* const* in, unsigned char* ws, int l, int item, LAS unsigned char* lds, int tid) {
    const bf16* PROJ = (const bf16*)(ws + WS_PROJ); LAS float* X = (LAS float*)lds; LAS float* G = X + 32 * 256;
    const int t0 = item * 32; const float* cw = in[11] + l * 4 * 256; const float* cb = in[12] + l * 256;
#pragma unroll
    for (int it = 0; it < 2; ++it) { const int idx = tid + it * 512, t = idx >> 5, cv = idx & 31, tok = t0 + t, pos = tok & (SEQ - 1);
        f4 a0 = *(const f4*)(cb + cv * 8), a1 = *(const f4*)(cb + cv * 8 + 4);
#pragma unroll
        for (int k = 0; k < 4; ++k) { u4 x = (u4){0u, 0u, 0u, 0u}; if (pos - 3 + k >= 0) x = *(const u4*)(PROJ + (size_t)(tok - 3 + k) * NINP + PC_LX + cv * 8);
            const f4 w0 = *(const f4*)(cw + k * 256 + cv * 8), w1 = *(const f4*)(cw + k * 256 + cv * 8 + 4);
            a0 += w0 * (f4){bflo(x.x), bfhi(x.x), bflo(x.y), bfhi(x.y)}; a1 += w1 * (f4){bflo(x.z), bfhi(x.z), bflo(x.w), bfhi(x.w)}; }
        *(LAS f4*)(X + t * 256 + cv * 8) = a0; *(LAS f4*)(X + t * 256 + cv * 8 + 4) = a1; }
    __syncthreads();
    const int gsel = tid >> 8, c = tid & 255, blk = c >> 6, j = c & 63;
    { const float* pw = (gsel ? in[15] : in[13]) + (size_t)l * 16384 + blk * 4096 + j; const float bias = (gsel ? in[16] : in[14])[l * 256 + c];
#pragma unroll 1
      for (int kh = 0; kh < 2; ++kh) { float wv[32];
#pragma unroll
          for (int k = 0; k < 32; ++k) wv[k] = pw[(kh * 32 + k) * 64];
#pragma unroll 1
          for (int t = 0; t < 32; ++t) { const LAS f4* xr = (const LAS f4*)(X + t * 256 + blk * 64 + kh * 32); float d0 = 0.f, d1 = 0.f;
#pragma unroll
              for (int k4 = 0; k4 < 8; k4 += 2) { const f4 v = xr[k4], w = xr[k4 + 1];
                  d0 += v.x * wv[4 * k4] + v.y * wv[4 * k4 + 1] + v.z * wv[4 * k4 + 2] + v.w * wv[4 * k4 + 3];
                  d1 += w.x * wv[4 * k4 + 4] + w.y * wv[4 * k4 + 5] + w.z * wv[4 * k4 + 6] + w.w * wv[4 * k4 + 7]; }
              LAS float* gp = G + (gsel * 32 + t) * 256 + c;
              if (kh == 0) *gp = d0 + d1; else *gp = sigmoidf_(*gp + d0 + d1 + bias); } } }
    __syncthreads();
    { const float sp = softplusf_(-in[17][l * 256 + c]);
#pragma unroll 4
      for (int tt = 0; tt < 16; ++tt) { const int t = gsel * 16 + tt; const float r = G[t * 256 + c], ig = G[(32 + t) * 256 + c], la = -8.f * r * sp, av = __expf(la), u = sqrtf(fmaxf(1.f - av * av, 0.f)) * (ig * X[t * 256 + c]);
          G[t * 256 + c] = av; G[(32 + t) * 256 + c] = u; } }
    __syncthreads();
    if (tid < 256) { float h = 0.f, A = 1.f; float* LRA = (float*)(ws + WS_LRA); float* LRH = (float*)(ws + WS_LRH);
#pragma unroll 4
        for (int t = 0; t < 32; ++t) { const float av = G[t * 256 + c], u = G[(32 + t) * 256 + c];
            h = av * h + u; A *= av; const size_t o = (size_t)(t0 + t) * 256 + c; LRA[o] = A; LRH[o] = h; }
        ((float*)(ws + WS_SEGA))[item * 256 + c] = A; ((float*)(ws + WS_SEGH))[item * 256 + c] = h; }
    __syncthreads();
}
__device__ __forceinline__ void prep_ssd(const float* const* in, unsigned char* ws, int l, int item, int tid) {
    const bf16* PROJ = (const bf16*)(ws + WS_PROJ);
    const int t0 = item * 32; const float* cw = in[32] + l * 4 * 768; const float* cb = in[33] + l * 768;
#pragma unroll 2
    for (int it = 0; it < 6; ++it) { const int idx = tid + it * 512, t = idx / 96, cv = idx - t * 96, tok = t0 + t, pos = tok & (SEQ - 1);
        f4 a0 = *(const f4*)(cb + cv * 8), a1 = *(const f4*)(cb + cv * 8 + 4);
#pragma unroll
        for (int k = 0; k < 4; ++k) { u4 x = (u4){0u, 0u, 0u, 0u}; if (pos - 3 + k >= 0) x = *(const u4*)(PROJ + (size_t)(tok - 3 + k) * NINP + PC_SXBC + cv * 8);
            const f4 w0 = *(const f4*)(cw + k * 768 + cv * 8), w1 = *(const f4*)(cw + k * 768 + cv * 8 + 4);
            a0 += w0 * (f4){bflo(x.x), bfhi(x.x), bflo(x.y), bfhi(x.y)}; a1 += w1 * (f4){bflo(x.z), bfhi(x.z), bflo(x.w), bfhi(x.w)}; }
        u4 o; o.x = pk2(siluf_(a0.x), siluf_(a0.y)); o.y = pk2(siluf_(a0.z), siluf_(a0.w)); o.z = pk2(siluf_(a1.x), siluf_(a1.y)); o.w = pk2(siluf_(a1.z), siluf_(a1.w));
        *(u4*)((bf16*)(ws + WS_XBC) + (size_t)tok * 768 + cv * 8) = o; }
    if (tid < 128) { const int t = tid >> 2, hh = tid & 3, tok = t0 + t; const float dt = softplusf_(bf2f(PROJ[(size_t)tok * NINP + PC_SDT + hh]) + in[34][l * 4 + hh]);
        ((float*)(ws + WS_DT))[tok * 4 + hh] = dt; ((float*)(ws + WS_DEC))[tok * 4 + hh] = -dt * __expf(in[35][l * 4 + hh]); }
}
__device__ __forceinline__ void prep_rw(const float* const* in, unsigned char* ws, int l, int item, LAS unsigned char* lds, int tid) {
    const bf16* PROJ = (const bf16*)(ws + WS_PROJ); LAS float* P = (LAS float*)lds; LAS float* VV = (LAS float*)(lds + 32 * 832 * 4);
    const int t0 = item * 32; const float* mu = in[18] + l * 832;
    LAS float* V1 = VV + 256;
#pragma unroll
    for (int it = 0; it < 7; ++it) { const int idx = tid + it * 512; if (idx < 3328) { const int t = idx / 104, cv = idx - t * 104, tok = t0 + t;
        const bf16* pc = PROJ + (size_t)tok * NINP + PC_RW + cv * 8; const u4 cur = *(const u4*)pc; u4 prv = (u4){0u, 0u, 0u, 0u}; if (tok & (SEQ - 1)) prv = *(const u4*)(pc - NINP);
        const f4 m0 = *(const f4*)(mu + cv * 8), m1 = *(const f4*)(mu + cv * 8 + 4);
        const f4 c0 = (f4){bflo(cur.x), bfhi(cur.x), bflo(cur.y), bfhi(cur.y)}, c1 = (f4){bflo(cur.z), bfhi(cur.z), bflo(cur.w), bfhi(cur.w)};
        const f4 p0 = (f4){bflo(prv.x), bfhi(prv.x), bflo(prv.y), bfhi(prv.y)}, p1 = (f4){bflo(prv.z), bfhi(prv.z), bflo(prv.w), bfhi(prv.w)};
        f4 v0 = c0 + (p0 - c0) * m0, v1 = c1 + (p1 - c1) * m1;
        if (cv == 96 || cv == 97) { v0 = (f4){tanhf_(v0.x), tanhf_(v0.y), tanhf_(v0.z), tanhf_(v0.w)}; v1 = (f4){tanhf_(v1.x), tanhf_(v1.y), tanhf_(v1.z), tanhf_(v1.w)}; }
        else if (cv >= 100) { v0 = (f4){sigmoidf_(v0.x), sigmoidf_(v0.y), sigmoidf_(v0.z), sigmoidf_(v0.w)}; v1 = (f4){sigmoidf_(v1.x), sigmoidf_(v1.y), sigmoidf_(v1.z), sigmoidf_(v1.w)}; }
        *(LAS f4*)(P + t * 832 + cv * 8) = v0; *(LAS f4*)(P + t * 832 + cv * 8 + 4) = v1; } }
    if (l > 0) *(LAS f4*)(V1 + tid * 4) = *(const f4*)(in[25] + (size_t)(l - 1) * 2048 + tid * 4);
    __syncthreads();
    if (l > 0 && tid < 256) { const int t = tid >> 3, j = tid & 7; float s = 0.f;
#pragma unroll 4
        for (int c4 = 0; c4 < 64; ++c4) { const f4 pv = *(const LAS f4*)(P + t * 832 + 512 + 4 * c4); s += pv.x * V1[(4 * c4) * 8 + j] + pv.y * V1[(4 * c4 + 1) * 8 + j] + pv.z * V1[(4 * c4 + 2) * 8 + j] + pv.w * V1[(4 * c4 + 3) * 8 + j]; }
        VV[t * 8 + j] = s; }
    __syncthreads();
    const int half = tid >> 8, c = tid & 255, hh = c >> 6, lane = tid & 63;
    float zw[16], za[16], gg[16], zv[16];
    { const float w0 = in[19][l * 256 + c], a0 = in[21][l * 256 + c], v0 = l > 0 ? in[24][(l - 1) * 256 + c] : 0.f;
#pragma unroll
      for (int tt = 0; tt < 16; ++tt) { zw[tt] = w0; za[tt] = a0; gg[tt] = 0.f; zv[tt] = v0; } }
    const LAS float* ph = P + half * 16 * 832;
    { const float* w2p = in[20] + (size_t)l * 4096 + c; const float* a2p = in[22] + (size_t)l * 4096 + c;
#pragma unroll 1
      for (int j4 = 0; j4 < 4; ++j4) { const float wa = w2p[(4 * j4) * 256], wb = w2p[(4 * j4 + 1) * 256], wc_ = w2p[(4 * j4 + 2) * 256], wd_ = w2p[(4 * j4 + 3) * 256];
          const float aa = a2p[(4 * j4) * 256], ab = a2p[(4 * j4 + 1) * 256], ac = a2p[(4 * j4 + 2) * 256], ad = a2p[(4 * j4 + 3) * 256];
#pragma unroll
          for (int tt = 0; tt < 16; ++tt) { const f4 sw = *(const LAS f4*)(ph + tt * 832 + 768 + 4 * j4), sa = *(const LAS f4*)(ph + tt * 832 + 784 + 4 * j4);
              zw[tt] += sw.x * wa + sw.y * wb + sw.z * wc_ + sw.w * wd_; za[tt] += sa.x * aa + sa.y * ab + sa.z * ac + sa.w * ad; } } }
    { const float* g2p = in[23] + (size_t)l * 8192 + c;
#pragma unroll 1
      for (int j4 = 0; j4 < 8; ++j4) { const float ga = g2p[(4 * j4) * 256], gb = g2p[(4 * j4 + 1) * 256], gc = g2p[(4 * j4 + 2) * 256], gd = g2p[(4 * j4 + 3) * 256];
#pragma unroll
          for (int tt = 0; tt < 16; ++tt) { const f4 sg = *(const LAS f4*)(ph + tt * 832 + 800 + 4 * j4); gg[tt] += sg.x * ga + sg.y * gb + sg.z * gc + sg.w * gd; } } }
    if (l > 0) { const float* v2p = in[26] + (size_t)(l - 1) * 2048 + c;
#pragma unroll 1
      for (int j4 = 0; j4 < 2; ++j4) { const float va = v2p[(4 * j4) * 256], vb = v2p[(4 * j4 + 1) * 256], vc = v2p[(4 * j4 + 2) * 256], vd = v2p[(4 * j4 + 3) * 256];
#pragma unroll
          for (int tt = 0; tt < 16; ++tt) { const f4 sv = *(const LAS f4*)(VV + (half * 16 + tt) * 8 + 4 * j4); zv[tt] += sv.x * va + sv.y * vb + sv.z * vc + sv.w * vd; } } }
    const float kkw = in[27][l * 256 + c], kaw = in[28][l * 256 + c], rkw = in[29][l * 256 + c];
    float* VF = (float*)(ws + WS_VFIRST);
#pragma unroll
    for (int tt = 0; tt < 16; ++tt) { const int t = half * 16 + tt; const size_t o = (size_t)(t0 + t) * 256 + c; const LAS float* pr = P + t * 832;
        const float r = pr[c], k = pr[256 + c]; float v = pr[512 + c];
        const float wd = __expf(-0.6065306597126334f * sigmoidf_(zw[tt])), av = sigmoidf_(za[tt]), g = gg[tt];
        if (l > 0) v = v + (VF[o] - v) * sigmoidf_(zv[tt]); else VF[o] = v;
        float kk = k * kkw; const float nrm = sqrtf(wave_sum(kk * kk)); kk = kk / fmaxf(nrm, 1e-12f);
        const float k2 = k * (1.f + (av - 1.f) * kaw);
        const float bon = wave_sum(r * k2 * rkw);
        ((bf16*)(ws + WS_RWR))[o] = (bf16)pk2(r, 0.f); ((bf16*)(ws + WS_RWK))[o] = (bf16)pk2(k2, 0.f); ((bf16*)(ws + WS_RWV))[o] = (bf16)pk2(v, 0.f);
        ((bf16*)(ws + WS_RWKK))[o] = (bf16)pk2(kk, 0.f); ((bf16*)(ws + WS_RWB))[o] = (bf16)pk2(kk * av, 0.f); ((bf16*)(ws + WS_RWG))[o] = (bf16)pk2(g, 0.f);
        ((float*)(ws + WS_RWW))[o] = wd;
        if (lane == 0) ((float*)(ws + WS_RWBON))[(t0 + t) * 4 + hh] = bon;
        asm volatile("" ::: "memory"); }
    __syncthreads();
}
__device__ __forceinline__ void phase_prep(const float* const* in, unsigned char* ws, int l, LAS unsigned char* lds, int tid) {
    constexpr int N_L = 512, N_R = 512, N_S = 512;
    for (int it = blockIdx.x; it < N_L + N_R + N_S; it += gridDim.x) {
        if (it < N_L) {
#ifndef SKIP_PL
            prep_lru(in, ws, l, it, lds, tid);
#endif
        } else if (it < N_L + N_R) {
#ifndef SKIP_PR
            prep_rw(in, ws, l, it - N_L, lds, tid);
#endif
        } else {
#ifndef SKIP_PS
            prep_ssd(in, ws, l, it - N_L - N_R, tid);
#endif
        }
    }
}

template <int MODE> __device__ __forceinline__ void scan_rw(unsigned char* ws, int item, LAS unsigned char* lds, int tid) {
    LAS float* LW = (LAS float*)lds; LAS float* LKK = LW + 2048; LAS float* LB = LW + 4096; LAS float* LK = LW + 6144; LAS float* LR = LW + 8192; LAS float* LV = LW + 10240; LAS float* LY = LW + 12288;
    const int bh = item / NCH, ch = item % NCH, hh = bh & 3, tokb = (bh >> 2) * SEQ + ch * CHL, nsub = CHL / 32;
    const int st = tid >> 4, sc4 = (tid & 15) * 4, row = tid >> 3, sl = tid & 7;
    const bf16* gR = (const bf16*)(ws + WS_RWR); const bf16* gK = (const bf16*)(ws + WS_RWK); const bf16* gV = (const bf16*)(ws + WS_RWV); const bf16* gKK = (const bf16*)(ws + WS_RWKK); const bf16* gB = (const bf16*)(ws + WS_RWB);
    const float* gW = (const float*)(ws + WS_RWW); bf16* gY = (bf16*)(ws + WS_YRW);
    float* gU = (float*)(ws + WS_RWU) + (size_t)item * 4096 + row * 64 + sl * 8; float* gP = (float*)(ws + WS_RWP) + (size_t)item * 4096 + row * 64 + sl * 8;
    f2 s[4], p[4];
    if (MODE == 1) { const f4 a = *(const f4*)gU, c = *(const f4*)(gU + 4); s[0] = LO2(a); s[1] = HI2(a); s[2] = LO2(c); s[3] = HI2(c); }
    else {
#pragma unroll
        for (int i = 0; i < 4; ++i) { s[i] = (f2){0.f, 0.f}; p[i] = (f2){(sl * 8 + 2 * i == row) ? 1.f : 0.f, (sl * 8 + 2 * i + 1 == row) ? 1.f : 0.f}; } }
    u2 pr, pk, pv, pkk, pb; f4 pw;
    { const size_t o = (size_t)(tokb + st) * 256 + hh * 64 + sc4; if (MODE == 1) pr = *(const u2*)(gR + o); pk = *(const u2*)(gK + o); pv = *(const u2*)(gV + o); pkk = *(const u2*)(gKK + o); pb = *(const u2*)(gB + o); pw = *(const f4*)(gW + o); }
    for (int sub = 0; sub < nsub; ++sub) {
        const int so = st * 64 + sc4;
        *(LAS f4*)(LW + so) = pw; if (MODE == 1) *(LAS f4*)(LR + so) = (f4){bflo(pr.x), bfhi(pr.x), bflo(pr.y), bfhi(pr.y)}; *(LAS f4*)(LK + so) = (f4){bflo(pk.x), bfhi(pk.x), bflo(pk.y), bfhi(pk.y)};
        *(LAS f4*)(LV + so) = (f4){bflo(pv.x), bfhi(pv.x), bflo(pv.y), bfhi(pv.y)}; *(LAS f4*)(LKK + so) = (f4){bflo(pkk.x), bfhi(pkk.x), bflo(pkk.y), bfhi(pkk.y)}; *(LAS f4*)(LB + so) = (f4){bflo(pb.x), bfhi(pb.x), bflo(pb.y), bfhi(pb.y)};
        lds_barrier();
        if (sub + 1 < nsub) { const size_t o = (size_t)(tokb + (sub + 1) * 32 + st) * 256 + hh * 64 + sc4; if (MODE == 1) pr = *(const u2*)(gR + o); pk = *(const u2*)(gK + o); pv = *(const u2*)(gV + o); pkk = *(const u2*)(gKK + o); pb = *(const u2*)(gB + o); pw = *(const f4*)(gW + o); }
        {
            const int ob = sl * 8; f4 w0, w1, a0, a1, b0, b1, k0, k1, r0 = (f4){0.f, 0.f, 0.f, 0.f}, r1 = r0; float vv;
#define RW_LOAD(T) { const int o_ = ((T) & 31) * 64 + ob; w0 = *(const LAS f4*)(LW + o_); w1 = *(const LAS f4*)(LW + o_ + 4); a0 = *(const LAS f4*)(LKK + o_); a1 = *(const LAS f4*)(LKK + o_ + 4); b0 = *(const LAS f4*)(LB + o_); b1 = *(const LAS f4*)(LB + o_ + 4); \
            k0 = *(const LAS f4*)(LK + o_); k1 = *(const LAS f4*)(LK + o_ + 4); if (MODE == 1) { r0 = *(const LAS f4*)(LR + o_); r1 = *(const LAS f4*)(LR + o_ + 4); } vv = LV[((T) & 31) * 64 + row]; }
            RW_LOAD(0)
#pragma unroll 2
            for (int t = 0; t < 32; ++t) {
                const f4 cw0 = w0, cw1 = w1, ca0 = a0, ca1 = a1, cb0 = b0, cb1 = b1, ck0 = k0, ck1 = k1, cr0 = r0, cr1 = r1; const float cv = vv;
                RW_LOAD(t + 1)
                f2 d2 = s[0] * LO2(ca0); d2 = s[1] * HI2(ca0) + d2; d2 = s[2] * LO2(ca1) + d2; d2 = s[3] * HI2(ca1) + d2;
                if (MODE == 0) { f2 e2 = p[0] * LO2(ca0); e2 = p[1] * HI2(ca0) + e2; e2 = p[2] * LO2(ca1) + e2; e2 = p[3] * HI2(ca1) + e2;
                    const float sp = -red8(e2.x + e2.y); const f2 sp2 = (f2){sp, sp};
                    p[0] = p[0] * LO2(cw0) + sp2 * LO2(cb0); p[1] = p[1] * HI2(cw0) + sp2 * HI2(cb0); p[2] = p[2] * LO2(cw1) + sp2 * LO2(cb1); p[3] = p[3] * HI2(cw1) + sp2 * HI2(cb1); }
                const float sa = -red8(d2.x + d2.y); const f2 sa2 = (f2){sa, sa}, cv2 = (f2){cv, cv};
                s[0] = s[0] * LO2(cw0) + sa2 * LO2(cb0) + cv2 * LO2(ck0); s[1] = s[1] * HI2(cw0) + sa2 * HI2(cb0) + cv2 * HI2(ck0);
                s[2] = s[2] * LO2(cw1) + sa2 * LO2(cb1) + cv2 * LO2(ck1); s[3] = s[3] * HI2(cw1) + sa2 * HI2(cb1) + cv2 * HI2(ck1);
                if (MODE == 1) { f2 y2 = s[0] * LO2(cr0); y2 = s[1] * HI2(cr0) + y2; y2 = s[2] * LO2(cr1) + y2; y2 = s[3] * HI2(cr1) + y2;
                    LY[t * 64 + row] = red8(y2.x + y2.y); } }
#undef RW_LOAD
        }
        lds_barrier();
        if (MODE == 1) { const f4 y = *(const LAS f4*)(LY + so); u2 w; w.x = pk2(y.x, y.y); w.y = pk2(y.z, y.w); *(u2*)(gY + (size_t)(tokb + sub * 32 + st) * 256 + hh * 64 + sc4) = w; }
    }
    if (MODE == 0) { *(f4*)gU = (f4){s[0].x, s[0].y, s[1].x, s[1].y}; *(f4*)(gU + 4) = (f4){s[2].x, s[2].y, s[3].x, s[3].y}; *(f4*)gP = (f4){p[0].x, p[0].y, p[1].x, p[1].y}; *(f4*)(gP + 4) = (f4){p[2].x, p[2].y, p[3].x, p[3].y}; }
    __syncthreads();
}
__device__ __forceinline__ void combine_rw(unsigned char* ws, int w, int lane) {
    const int bh = w >> 6, row = w & 63;
    const float* gP = (const float*)(ws + WS_RWP) + (size_t)bh * NCH * 4096 + lane; float* gU = (float*)(ws + WS_RWU) + (size_t)bh * NCH * 4096 + row * 64 + lane;
    float pc[64], s = 0.f, u = gU[0];
#pragma unroll
    for (int i = 0; i < 64; ++i) pc[i] = gP[i * 64];
#pragma unroll 1
    for (int c = 0; c < NCH; ++c) {
        float pn[64], un = 0.f; const int cn = (c + 1 < NCH) ? c + 1 : c;
#pragma unroll
        for (int i = 0; i < 64; ++i) pn[i] = gP[(size_t)cn * 4096 + i * 64];
        un = gU[(size_t)cn * 4096];
        gU[(size_t)c * 4096] = s;
        float n0 = u, n1 = 0.f; const int si = __builtin_bit_cast(int, s);
#pragma unroll
        for (int i = 0; i < 64; i += 2) { n0 += __builtin_bit_cast(float, __builtin_amdgcn_readlane(si, i)) * pc[i]; n1 += __builtin_bit_cast(float, __builtin_amdgcn_readlane(si, i + 1)) * pc[i + 1]; }
        s = n0 + n1; u = un;
#pragma unroll
        for (int i = 0; i < 64; ++i) pc[i] = pn[i];
    }
}
template <int MODE> __device__ __forceinline__ void scan_gla(const float* const* in, unsigned char* ws, int l, int item, LAS unsigned char* lds, int tid) {
    LAS float* LA = (LAS float*)lds; LAS float* LK = LA + 1024; LAS float* LQ = LA + 2048; LAS float* LV = LA + 3072; LAS float* LO = LA + 5120;
    const bf16* PROJ = (const bf16*)(ws + WS_PROJ); bf16* gO = (bf16*)(ws + WS_OGLA);
    const int bh = item / NCH, ch = item % NCH, hh = bh & 3, tokb = (bh >> 2) * SEQ + ch * CHL, nsub = CHL / 32;
    const int st = tid >> 4, si = tid & 15, vcol = tid >> 3, sl = tid & 7;
    float up0[16], up1[16];
#pragma unroll
    for (int r = 0; r < 16; ++r) { up0[r] = in[8][(l * 16 + r) * 128 + hh * 32 + 2 * si]; up1[r] = in[8][(l * 16 + r) * 128 + hh * 32 + 2 * si + 1]; }
    const float bi0 = in[9][l * 128 + hh * 32 + 2 * si], bi1 = in[9][l * 128 + hh * 32 + 2 * si + 1];
    float* gU = (float*)(ws + WS_GLU) + (size_t)item * 2048 + vcol * 32 + 4 * sl;
    float s[4] = {0.f, 0.f, 0.f, 0.f}, dp[4] = {1.f, 1.f, 1.f, 1.f};
    if (MODE == 1) { const f4 a = *(const f4*)gU; s[0] = a.x; s[1] = a.y; s[2] = a.z; s[3] = a.w; }
    u4 ps0, ps1; unsigned pq = 0, pk; u2 pv;
    { const bf16* p = PROJ + (size_t)(tokb + st) * NINP; ps0 = *(const u4*)(p + PC_GSTEM); ps1 = *(const u4*)(p + PC_GSTEM + 8); if (MODE == 1) pq = *(const unsigned*)(p + PC_GQ + hh * 32 + 2 * si); pk = *(const unsigned*)(p + PC_GK + hh * 32 + 2 * si); pv = *(const u2*)(p + PC_GV + hh * 64 + 4 * si); }
    for (int sub = 0; sub < nsub; ++sub) {
        { const unsigned sw[8] = {ps0.x, ps0.y, ps0.z, ps0.w, ps1.x, ps1.y, ps1.z, ps1.w}; float z0 = bi0, z1 = bi1;
#pragma unroll
          for (int r = 0; r < 8; ++r) { const float e0 = bflo(sw[r]), e1 = bfhi(sw[r]); z0 += e0 * up0[2 * r] + e1 * up0[2 * r + 1]; z1 += e0 * up1[2 * r] + e1 * up1[2 * r + 1]; }
          const float l0 = fminf(z0, 0.f) - log1pf(__expf(-fabsf(z0))), l1 = fminf(z1, 0.f) - log1pf(__expf(-fabsf(z1)));
          const int o = st * 32 + 2 * si; LA[o] = __expf(l0 * 0.0625f); LA[o + 1] = __expf(l1 * 0.0625f); LK[o] = bflo(pk); LK[o + 1] = bfhi(pk); if (MODE == 1) { LQ[o] = bflo(pq); LQ[o + 1] = bfhi(pq); }
          *(LAS f4*)(LV + st * 64 + 4 * si) = (f4){bflo(pv.x), bfhi(pv.x), bflo(pv.y), bfhi(pv.y)}; }
        lds_barrier();
        if (sub + 1 < nsub) { const bf16* p = PROJ + (size_t)(tokb + (sub + 1) * 32 + st) * NINP; ps0 = *(const u4*)(p + PC_GSTEM); ps1 = *(const u4*)(p + PC_GSTEM + 8); if (MODE == 1) pq = *(const unsigned*)(p + PC_GQ + hh * 32 + 2 * si); pk = *(const unsigned*)(p + PC_GK + hh * 32 + 2 * si); pv = *(const u2*)(p + PC_GV + hh * 64 + 4 * si); }
        {   f4 al, kk, qq = (f4){0.f, 0.f, 0.f, 0.f}; float vv;
#define GL_LOAD(T) { const int o_ = ((T) & 31) * 32 + 4 * sl; al = *(const LAS f4*)(LA + o_); kk = *(const LAS f4*)(LK + o_); if (MODE == 1) qq = *(const LAS f4*)(LQ + o_); vv = LV[((T) & 31) * 64 + vcol]; }
            GL_LOAD(0)
#pragma unroll 4
            for (int t = 0; t < 32; ++t) { const f4 ca = al, ck = kk, cq = qq; const float cv = vv;
                GL_LOAD(t + 1)
                s[0] = s[0] * ca.x + ck.x * cv; s[1] = s[1] * ca.y + ck.y * cv; s[2] = s[2] * ca.z + ck.z * cv; s[3] = s[3] * ca.w + ck.w * cv;
                if (MODE == 0) { dp[0] *= ca.x; dp[1] *= ca.y; dp[2] *= ca.z; dp[3] *= ca.w; }
                else { const float o = (s[0] * cq.x + s[1] * cq.y) + (s[2] * cq.z + s[3] * cq.w); LO[t * 64 + vcol] = red8(o) * 0.17677669529663687f; } }
#undef GL_LOAD
        }
        lds_barrier();
        if (MODE == 1) { const f4 y = *(const LAS f4*)(LO + st * 64 + 4 * si); u2 w; w.x = pk2(y.x, y.y); w.y = pk2(y.z, y.w); *(u2*)(gO + (size_t)(tokb + sub * 32 + st) * 256 + hh * 64 + 4 * si) = w; }
    }
    if (MODE == 0) { *(f4*)gU = (f4){s[0], s[1], s[2], s[3]}; if (vcol == 0) *(f4*)((float*)(ws + WS_GLD) + item * 32 + 4 * sl) = (f4){dp[0], dp[1], dp[2], dp[3]}; }
    __syncthreads();
}
template <int MODE> __device__ __forceinline__ void scan_ssd(unsigned char* ws, int item, LAS unsigned char* lds, int tid) {
    LAS float* LB = (LAS float*)lds; LAS float* LC = LB + 4096; LAS float* LX = LB + 8192; LAS float* LD = LB + 10240; LAS float* LY = LB + 10304;
    const bf16* XBC = (const bf16*)(ws + WS_XBC); const float* DT = (const float*)(ws + WS_DT); const float* DEC = (const float*)(ws + WS_DEC); bf16* gY = (bf16*)(ws + WS_YSSD);
    const int bh = item / NCH, ch = item % NCH, hh = bh & 3, tokb = (bh >> 2) * SEQ + ch * CHL, nsub = CHL / 32;
    const int st = tid >> 4, si = tid & 15, p = tid >> 3, sl = tid & 7, g = hh >> 1;
    float* gU = (float*)(ws + WS_SSU) + (size_t)item * 8192 + p * 128 + 16 * sl;
    f2 s[8]; float dprod = 1.f;
#pragma unroll
    for (int i = 0; i < 4; ++i) { f4 a = (f4){0.f, 0.f, 0.f, 0.f}; if (MODE == 1) a = *(const f4*)(gU + 4 * i); s[2 * i] = LO2(a); s[2 * i + 1] = HI2(a); }
    u4 pb, pc = (u4){0u, 0u, 0u, 0u}; u2 px; float pdt, pdec;
    { const size_t tok = tokb + st; const bf16* q = XBC + tok * 768; pb = *(const u4*)(q + 256 + g * 128 + 8 * si); if (MODE == 1) pc = *(const u4*)(q + 512 + g * 128 + 8 * si); px = *(const u2*)(q + hh * 64 + 4 * si); pdt = DT[tok * 4 + hh]; pdec = DEC[tok * 4 + hh]; }
    for (int sub = 0; sub < nsub; ++sub) {
        { const int o = st * 128 + 8 * si;
          *(LAS f4*)(LB + o) = (f4){bflo(pb.x), bfhi(pb.x), bflo(pb.y), bfhi(pb.y)}; *(LAS f4*)(LB + o + 4) = (f4){bflo(pb.z), bfhi(pb.z), bflo(pb.w), bfhi(pb.w)};
          if (MODE == 1) { *(LAS f4*)(LC + o) = (f4){bflo(pc.x), bfhi(pc.x), bflo(pc.y), bfhi(pc.y)}; *(LAS f4*)(LC + o + 4) = (f4){bflo(pc.z), bfhi(pc.z), bflo(pc.w), bfhi(pc.w)}; }
          *(LAS f4*)(LX + st * 64 + 4 * si) = (f4){bflo(px.x) * pdt, bfhi(px.x) * pdt, bflo(px.y) * pdt, bfhi(px.y) * pdt};
          if (si == 0) LD[st] = pdec; }
        lds_barrier();
        if (sub + 1 < nsub) { const size_t tok = tokb + (sub + 1) * 32 + st; const bf16* q = XBC + tok * 768; pb = *(const u4*)(q + 256 + g * 128 + 8 * si); if (MODE == 1) pc = *(const u4*)(q + 512 + g * 128 + 8 * si); px = *(const u2*)(q + hh * 64 + 4 * si); pdt = DT[tok * 4 + hh]; pdec = DEC[tok * 4 + hh]; }
        {   f4 bb[4], cc[4]; float xv, dc;
#pragma unroll
            for (int q4 = 0; q4 < 4; ++q4) cc[q4] = (f4){0.f, 0.f, 0.f, 0.f};
#define SS_LOAD(T) { const int o_ = ((T) & 31) * 128 + 16 * sl; _Pragma("unroll") for (int q4 = 0; q4 < 4; ++q4) { bb[q4] = *(const LAS f4*)(LB + o_ + 4 * q4); if (MODE == 1) cc[q4] = *(const LAS f4*)(LC + o_ + 4 * q4); } xv = LX[((T) & 31) * 64 + p]; dc = LD[(T) & 31]; }
            SS_LOAD(0)
#pragma unroll 2
            for (int t = 0; t < 32; ++t) { f4 cb_[4], cc_[4]; const float cx = xv, cd = dc;
#pragma unroll
                for (int q4 = 0; q4 < 4; ++q4) { cb_[q4] = bb[q4]; cc_[q4] = cc[q4]; }
                SS_LOAD(t + 1)
                if (MODE == 0) dprod *= cd;
                const f2 cd2 = (f2){cd, cd}, cx2 = (f2){cx, cx}; f2 y2 = (f2){0.f, 0.f};
#pragma unroll
                for (int q4 = 0; q4 < 4; ++q4) {
                    s[2 * q4] = s[2 * q4] * cd2 + LO2(cb_[q4]) * cx2; s[2 * q4 + 1] = s[2 * q4 + 1] * cd2 + HI2(cb_[q4]) * cx2;
                    if (MODE == 1) { y2 = s[2 * q4] * LO2(cc_[q4]) + y2; y2 = s[2 * q4 + 1] * HI2(cc_[q4]) + y2; } }
                if (MODE == 1) LY[t * 64 + p] = red8(y2.x + y2.y); }
#undef SS_LOAD
        }
        lds_barrier();
        if (MODE == 1) { const f4 y = *(const LAS f4*)(LY + st * 64 + 4 * si); u2 w; w.x = pk2(y.x, y.y); w.y = pk2(y.z, y.w); *(u2*)(gY + (size_t)(tokb + sub * 32 + st) * 256 + hh * 64 + 4 * si) = w; }
    }
    if (MODE == 0) {
#pragma unroll
        for (int i = 0; i < 4; ++i) *(f4*)(gU + 4 * i) = (f4){s[2 * i].x, s[2 * i].y, s[2 * i + 1].x, s[2 * i + 1].y};
        if (tid == 0) ((float*)(ws + WS_SSD))[item] = dprod; }
    __syncthreads();
}
typedef short s8v __attribute__((ext_vector_type(8)));
#define MFMA16(a, b, c) __builtin_amdgcn_mfma_f32_16x16x32_bf16(a, b, c, 0, 0, 0)
constexpr int SP = 136;
__device__ __forceinline__ bf16 u4_elem(const u4& w, int e) { const unsigned x = (e >> 1) == 0 ? w.x : (e >> 1) == 1 ? w.y : (e >> 1) == 2 ? w.z : w.w; return (bf16)((e & 1) ? (x >> 16) : (x & 0xffffu)); }
__device__ __forceinline__ void ssd_cumsum(unsigned char* ws, int tok0, int g, LAS float* CS, int tid) {
    const int wave = tid >> 6, lane = tid & 63;
    if (wave < 2) { const float* DA = (const float*)(ws + WS_DEC); const float a0 = DA[(size_t)(tok0 + 2 * lane) * 4 + 2 * g + wave], a1 = DA[(size_t)(tok0 + 2 * lane + 1) * 4 + 2 * g + wave]; float v = a0 + a1;
#pragma unroll
        for (int o = 1; o < 64; o <<= 1) { const float t = __shfl_up(v, o); if (lane >= o) v += t; }
        CS[wave * 128 + 2 * lane] = v - a1; CS[wave * 128 + 2 * lane + 1] = v; }
}
__device__ __forceinline__ void ssd_passA(unsigned char* ws, int item, LAS unsigned char* lds, int tid) {
    const int b = item >> 7, g = (item >> 6) & 1, ch = item & 63, tok0 = b * SEQ + ch * 128;
    LAS bf16* LB = (LAS bf16*)(lds + 34816); LAS bf16* LX = (LAS bf16*)(lds + 69632); LAS float* CS = (LAS float*)(lds + 139264);
    const bf16* XBC = (const bf16*)(ws + WS_XBC); const float* DT = (const float*)(ws + WS_DT);
    ssd_cumsum(ws, tok0, g, CS, tid);
    const int sr = tid >> 2, part = tid & 3;
    { const bf16* q = XBC + (size_t)(tok0 + sr) * 768 + 256 + g * 128 + part * 32;
#pragma unroll
      for (int v = 0; v < 4; ++v) { const u4 w = *(const u4*)(q + 8 * v);
#pragma unroll
          for (int e = 0; e < 8; ++e) LB[(part * 32 + 8 * v + e) * SP + sr] = u4_elem(w, e); } }
    lds_barrier();
    { const int hl = part >> 1, p0 = (part & 1) * 32, h = 2 * g + hl; const float sc = DT[(size_t)(tok0 + sr) * 4 + h] * __expf(CS[hl * 128 + 127] - CS[hl * 128 + sr]);
      const bf16* q = XBC + (size_t)(tok0 + sr) * 768 + h * 64 + p0;
#pragma unroll
      for (int v = 0; v < 4; ++v) { const u4 w = *(const u4*)(q + 8 * v);
#pragma unroll
          for (int e = 0; e < 8; ++e) LX[(hl * 64 + p0 + 8 * v + e) * SP + sr] = (bf16)pk2(bf2f(u4_elem(w, e)) * sc, 0.f); } }
    lds_barrier();
    const int wave = tid >> 6, lane = tid & 63, r16 = lane & 15, q4 = lane >> 4, hl = wave >> 2, pt = wave & 3;
    f32x4 acc[8];
#pragma unroll
    for (int nt = 0; nt < 8; ++nt) acc[nt] = (f32x4){0.f, 0.f, 0.f, 0.f};
#pragma unroll
    for (int ks = 0; ks < 4; ++ks) { const s8v af = *(const LAS s8v*)(LX + (hl * 64 + 16 * pt + r16) * SP + 32 * ks + 8 * q4);
#pragma unroll
        for (int nt = 0; nt < 8; ++nt) { const s8v bfr = *(const LAS s8v*)(LB + (16 * nt + r16) * SP + 32 * ks + 8 * q4); acc[nt] = MFMA16(af, bfr, acc[nt]); } }
    float* gU = (float*)(ws + WS_SSU) + ((size_t)(b * 4 + 2 * g + hl) * NCS + ch) * 8192;
#pragma unroll
    for (int nt = 0; nt < 8; ++nt)
#pragma unroll
        for (int i = 0; i < 4; ++i) gU[(16 * pt + 4 * q4 + i) * 128 + 16 * nt + r16] = acc[nt][i];
    if (tid < 2) ((float*)(ws + WS_SSD))[(b * 4 + 2 * g + tid) * NCS + ch] = __expf(CS[tid * 128 + 127]);
    __syncthreads();
}
__device__ __forceinline__ void ssd_passB(unsigned char* ws, int item, LAS unsigned char* lds, int tid) {
    const int b = item >> 7, g = (item >> 6) & 1, ch = item & 63, tok0 = b * SEQ + ch * 128;
    LAS bf16* LC = (LAS bf16*)lds; LAS bf16* LB = (LAS bf16*)(lds + 34816); LAS bf16* LX = (LAS bf16*)(lds + 69632); LAS bf16* LS = (LAS bf16*)(lds + 104448); LAS float* CS = (LAS float*)(lds + 139264);
    const bf16* XBC = (const bf16*)(ws + WS_XBC); const float* DT = (const float*)(ws + WS_DT); bf16* gY = (bf16*)(ws + WS_YSSD);
    ssd_cumsum(ws, tok0, g, CS, tid);
    const int sr = tid >> 2, part = tid & 3;
    { const bf16* q = XBC + (size_t)(tok0 + sr) * 768;
#pragma unroll
      for (int v = 0; v < 4; ++v) { *(LAS u4*)(LB + sr * SP + part * 32 + 8 * v) = *(const u4*)(q + 256 + g * 128 + part * 32 + 8 * v); *(LAS u4*)(LC + sr * SP + part * 32 + 8 * v) = *(const u4*)(q + 512 + g * 128 + part * 32 + 8 * v); } }
    { const int hl = part >> 1, p0 = (part & 1) * 32, h = 2 * g + hl; const float sc = DT[(size_t)(tok0 + sr) * 4 + h];
      const bf16* q = XBC + (size_t)(tok0 + sr) * 768 + h * 64 + p0;
#pragma unroll
      for (int v = 0; v < 4; ++v) { const u4 w = *(const u4*)(q + 8 * v);
#pragma unroll
          for (int e = 0; e < 8; ++e) LX[(hl * 64 + p0 + 8 * v + e) * SP + sr] = (bf16)pk2(bf2f(u4_elem(w, e)) * sc, 0.f); } }
    { const int hl = sr >> 6, p = sr & 63; const float* gS = (const float*)(ws + WS_SSU) + ((size_t)(b * 4 + 2 * g + hl) * NCS + ch) * 8192 + p * 128 + part * 32;
#pragma unroll
      for (int v = 0; v < 4; ++v) { const f4 x0 = *(const f4*)(gS + 8 * v), x1 = *(const f4*)(gS + 8 * v + 4); u4 w; w.x = pk2(x0.x, x0.y); w.y = pk2(x0.z, x0.w); w.z = pk2(x1.x, x1.y); w.w = pk2(x1.z, x1.w); *(LAS u4*)(LS + sr * SP + part * 32 + 8 * v) = w; } }
    lds_barrier();
    const int wave = tid >> 6, lane = tid & 63, r16 = lane & 15, q4 = lane >> 4, lt = wave;
    f32x4 cb[8];
#pragma unroll
    for (int st = 0; st < 8; ++st) cb[st] = (f32x4){0.f, 0.f, 0.f, 0.f};
#pragma unroll
    for (int ks = 0; ks < 4; ++ks) { const s8v af = *(const LAS s8v*)(LC + (16 * lt + r16) * SP + 32 * ks + 8 * q4);
#pragma unroll
        for (int st = 0; st < 8; ++st) { const s8v bfr = *(const LAS s8v*)(LB + (16 * st + r16) * SP + 32 * ks + 8 * q4); cb[st] = MFMA16(af, bfr, cb[st]); } }
#pragma unroll 1
    for (int hl = 0; hl < 2; ++hl) {
        lds_barrier();
#pragma unroll
        for (int st = 0; st < 8; ++st)
#pragma unroll
            for (int i = 0; i < 4; ++i) { const int l = 16 * lt + 4 * q4 + i, s2 = 16 * st + r16; const float m = (s2 <= l) ? cb[st][i] * __expf(CS[hl * 128 + l] - CS[hl * 128 + s2]) : 0.f; LB[l * SP + s2] = (bf16)pk2(m, 0.f); }
        lds_barrier();
        f32x4 yd[4], yo[4];
#pragma unroll
        for (int p4 = 0; p4 < 4; ++p4) { yd[p4] = (f32x4){0.f, 0.f, 0.f, 0.f}; yo[p4] = (f32x4){0.f, 0.f, 0.f, 0.f}; }
#pragma unroll
        for (int ks = 0; ks < 4; ++ks) { const s8v mf = *(const LAS s8v*)(LB + (16 * lt + r16) * SP + 32 * ks + 8 * q4), cf = *(const LAS s8v*)(LC + (16 * lt + r16) * SP + 32 * ks + 8 * q4);
#pragma unroll
            for (int p4 = 0; p4 < 4; ++p4) { const s8v xf = *(const LAS s8v*)(LX + (hl * 64 + 16 * p4 + r16) * SP + 32 * ks + 8 * q4), sf = *(const LAS s8v*)(LS + (hl * 64 + 16 * p4 + r16) * SP + 32 * ks + 8 * q4);
                yd[p4] = MFMA16(xf, mf, yd[p4]); yo[p4] = MFMA16(sf, cf, yo[p4]); } }
        const float el = __expf(CS[hl * 128 + 16 * lt + r16]);
#pragma unroll
        for (int p4 = 0; p4 < 4; ++p4) { const f32x4 y = yd[p4] + yo[p4] * el; u2 w; w.x = pk2(y[0], y[1]); w.y = pk2(y[2], y[3]);
            *(u2*)(gY + (size_t)(tok0 + 16 * lt + r16) * 256 + (2 * g + hl) * 64 + 16 * p4 + 4 * q4) = w; }
    }
    __syncthreads();
}
__device__ __forceinline__ void scan_lru_carry(unsigned char* ws, int tid) {
    const float* SA = (const float*)(ws + WS_SEGA); const float* SH = (const float*)(ws + WS_SEGH); float* CY = (float*)(ws + WS_CARRY);
    const int b = tid >> 8, c = tid & 255; float h = 0.f;
#pragma unroll 8
    for (int sg = 0; sg < 256; ++sg) { const int o = (b * 256 + sg) * 256 + c; CY[o] = h; h = SA[o] * h + SH[o]; }
}
__device__ __forceinline__ void combine_gla(unsigned char* ws, int bh, int tid) {
    float* gU = (float*)(ws + WS_GLU) + (size_t)bh * NCH * 2048 + tid * 4; const float* gD = (const float*)(ws + WS_GLD) + bh * NCH * 32 + (tid & 7) * 4; f4 s = (f4){0.f, 0.f, 0.f, 0.f};
#pragma unroll 4
    for (int c = 0; c < NCH; ++c) { const f4 u = *(const f4*)(gU + (size_t)c * 2048), d = *(const f4*)(gD + c * 32); *(f4*)(gU + (size_t)c * 2048) = s; s = s * d + u; }
}
__device__ __forceinline__ void combine_ssd(unsigned char* ws, int q, int tid) {
    const int bh = q >> 2; float* gU = (float*)(ws + WS_SSU) + (size_t)bh * NCS * 8192 + (q & 3) * 2048 + tid * 4; const float* gD = (const float*)(ws + WS_SSD) + bh * NCS; f4 s = (f4){0.f, 0.f, 0.f, 0.f};
#pragma unroll 4
    for (int c = 0; c < NCS; ++c) { const f4 u = *(const f4*)(gU + (size_t)c * 8192); const float d = gD[c]; *(f4*)(gU + (size_t)c * 8192) = s; s = s * d + u; }
}
template <int MODE> __device__ __forceinline__ void phase_scan(const float* const* in, unsigned char* ws, int l, LAS unsigned char* lds, int tid) {
    constexpr int NI = 8 * NCH;
    for (int it = blockIdx.x; it < 3 * NI + (MODE == 0 ? 1 : 0); it += gridDim.x) {
        if (it < NI) scan_rw<MODE>(ws, it, lds, tid);
        else if (it < 2 * NI) { if (MODE == 0) ssd_passA(ws, it - NI, lds, tid); else ssd_passB(ws, it - NI, lds, tid); }
        else if (it < 3 * NI) scan_gla<MODE>(in, ws, l, it - 2 * NI, lds, tid);
        else scan_lru_carry(ws, tid);
    }
}
__device__ __forceinline__ void phase_combine(const float* const* in, unsigned char* ws, int l, LAS unsigned char* lds, int tid) {
    const int wave = __builtin_amdgcn_readfirstlane(tid >> 6), lane = tid & 63; constexpr int NCW = 104;
    if ((int)gridDim.x > NCW + 8) {
        if ((int)blockIdx.x < 64) combine_rw(ws, blockIdx.x * 8 + wave, lane);
        else if ((int)blockIdx.x < 72) combine_gla(ws, blockIdx.x - 64, tid);
        else if ((int)blockIdx.x < NCW) combine_ssd(ws, blockIdx.x - 72, tid);
        else phase_convert(in, ws, l, 3, lds, ((int)blockIdx.x - NCW) * 8 + wave, ((int)gridDim.x - NCW) * 8, wave, lane);
    } else {
        for (int it = blockIdx.x; it < NCW; it += gridDim.x) {
            if (it < 64) combine_rw(ws, it * 8 + wave, lane);
            else if (it < 72) combine_gla(ws, it - 64, tid);
            else combine_ssd(ws, it - 72, tid);
        }
        phase_convert(in, ws, l, 3, lds, blockIdx.x * 8 + wave, gridDim.x * 8, wave, lane);
    }
}
__device__ __forceinline__ float red16(float x) { x += __shfl_xor(x, 1); x += __shfl_xor(x, 2); x += __shfl_xor(x, 4); x += __shfl_xor(x, 8); return x; }
__device__ __forceinline__ void phase_post(const float* const* in, unsigned char* ws, int l, int gw, int NGW, int lane) {
    const bf16* PROJ = (const bf16*)(ws + WS_PROJ); bf16* Y = (bf16*)(ws + WS_Y); const int c = 4 * lane, hh = lane >> 4;
    const f4 gnorm = *(const f4*)(in[10] + l * 64 + (c & 63)), gnw = *(const f4*)(in[30] + l * 256 + c), gnb = *(const f4*)(in[31] + l * 256 + c), snw = *(const f4*)(in[37] + l * 256 + c);
    const float dsk = in[36][l * 4 + hh];
    for (int tok = gw; tok < M; tok += NGW) { const bf16* pp = PROJ + (size_t)tok * NINP; const size_t o = (size_t)tok * 256 + c; bf16* yo = Y + (size_t)tok * D + c;
        { const u2 ov = *(const u2*)((const bf16*)(ws + WS_OGLA) + o), gv = *(const u2*)(pp + PC_GG + c);
          const float o0 = bflo(ov.x), o1 = bfhi(ov.x), o2 = bflo(ov.y), o3 = bfhi(ov.y);
          const float rs = rsqrtf(red16((o0 * o0 + o1 * o1) + (o2 * o2 + o3 * o3)) * (1.f / 64.f) + 1e-5f);
          u2 w; w.x = pk2(o0 * rs * gnorm.x * siluf_(bflo(gv.x)), o1 * rs * gnorm.y * siluf_(bfhi(gv.x))); w.y = pk2(o2 * rs * gnorm.z * siluf_(bflo(gv.y)), o3 * rs * gnorm.w * siluf_(bfhi(gv.y))); *(u2*)(yo) = w; }
        { const f4 A = *(const f4*)((const float*)(ws + WS_LRA) + o), H = *(const f4*)((const float*)(ws + WS_LRH) + o), cy = *(const f4*)((const float*)(ws + WS_CARRY) + (size_t)(tok >> 5) * 256 + c);
          const u2 gv = *(const u2*)(pp + PC_LG + c);
          u2 w; w.x = pk2((H.x + A.x * cy.x) * gelu_tanh(bflo(gv.x)), (H.y + A.y * cy.y) * gelu_tanh(bfhi(gv.x))); w.y = pk2((H.z + A.z * cy.z) * gelu_tanh(bflo(gv.y)), (H.w + A.w * cy.w) * gelu_tanh(bfhi(gv.y))); *(u2*)(yo + 256) = w; }
        { const u2 yv = *(const u2*)((const bf16*)(ws + WS_YRW) + o), vv = *(const u2*)((const bf16*)(ws + WS_RWV) + o), gv = *(const u2*)((const bf16*)(ws + WS_RWG) + o);
          const float bon = ((const float*)(ws + WS_RWBON))[tok * 4 + hh];
          float y0 = bflo(yv.x), y1 = bfhi(yv.x), y2 = bflo(yv.y), y3 = bfhi(yv.y);
          const float mean = red16((y0 + y1) + (y2 + y3)) * (1.f / 64.f); y0 -= mean; y1 -= mean; y2 -= mean; y3 -= mean;
          const float rs = rsqrtf(red16((y0 * y0 + y1 * y1) + (y2 * y2 + y3 * y3)) * (1.f / 64.f) + 64e-5f);
          u2 w; w.x = pk2((y0 * rs * gnw.x + gnb.x + bon * bflo(vv.x)) * bflo(gv.x), (y1 * rs * gnw.y + gnb.y + bon * bfhi(vv.x)) * bfhi(gv.x));
          w.y = pk2((y2 * rs * gnw.z + gnb.z + bon * bflo(vv.y)) * bflo(gv.y), (y3 * rs * gnw.w + gnb.w + bon * bfhi(vv.y)) * bfhi(gv.y)); *(u2*)(yo + 512) = w; }
        { const u2 yv = *(const u2*)((const bf16*)(ws + WS_YSSD) + o), xv = *(const u2*)((const bf16*)(ws + WS_XBC) + (size_t)tok * 768 + c), zv = *(const u2*)(pp + PC_SZ + c);
          const float y0 = (bflo(yv.x) + dsk * bflo(xv.x)) * siluf_(bflo(zv.x)), y1 = (bfhi(yv.x) + dsk * bfhi(xv.x)) * siluf_(bfhi(zv.x)), y2 = (bflo(yv.y) + dsk * bflo(xv.y)) * siluf_(bflo(zv.y)), y3 = (bfhi(yv.y) + dsk * bfhi(xv.y)) * siluf_(bfhi(zv.y));
          float q = red16((y0 * y0 + y1 * y1) + (y2 * y2 + y3 * y3)); q += __shfl_xor(q, 16);
          const float rs = rsqrtf(q * (1.f / 128.f) + 1e-5f);
          u2 w; w.x = pk2(y0 * rs * snw.x, y1 * rs * snw.y); w.y = pk2(y2 * rs * snw.z, y3 * rs * snw.w); *(u2*)(yo + 768) = w; }
    }
}
#ifndef PROBE_GEMM
#define PROBE_GEMM 1
#endif
#ifndef PROBE_SCAN
#define PROBE_SCAN 1
#endif
#ifndef PROBE_MISC
#define PROBE_MISC 1
#endif
struct Args { const float* in[43]; float* out; unsigned char* ws; };
template <class Epi> __device__ __forceinline__ void gemm_multi(LAS unsigned char* lds, const pg8::Gemm& g, const Epi& E) {
    pg8::StaticOrder S; S.init(g.M, g.N, (int)gridDim.x, (int)blockIdx.x);
    pg8::gemm_phase<Epi, pg8::StaticOrder, true, true>(lds, g, S, E);
}
template <class Epi> __device__ __forceinline__ void gemm_single(LAS unsigned char* lds, const pg8::Gemm& g, const Epi& E) {
    pg8::StaticOrder S; S.init(g.M, g.N, (int)gridDim.x, (int)blockIdx.x);
    for (int r = 0;; ++r) { pg8::Unit u; if (!S.next(r, u)) break; OneUnit O{S, r}; pg8::gemm_phase<Epi, OneUnit, false, true>(lds, g, O, E); }
}
__global__ void __launch_bounds__(512, 2) fwd(Args a) {
    extern __shared__ __attribute__((aligned(16))) unsigned char lds_raw[];
    LAS unsigned char* lds = (LAS unsigned char*)lds_raw;
    cg::grid_group grid = cg::this_grid();
    unsigned* ctl = (unsigned*)(a.ws + WS_CTL); volatile LAS unsigned* MISC = (volatile LAS unsigned*)(lds + LDS_BYTES - 64);
    if (blockIdx.x == 0) for (int i = threadIdx.x; i < XCD_BAR_WORDS; i += 512) __hip_atomic_store(ctl + i, 0u, __ATOMIC_RELAXED, __HIP_MEMORY_SCOPE_AGENT);
    if (threadIdx.x < 2) MISC[threadIdx.x] = 0u;
    __threadfence();
    grid.sync();
    const XcdBarrier bar = xcd_barrier_post(ctl, MISC);
#define TIDS int tid = threadIdx.x; asm volatile("" : "+v"(tid)); const int lane = tid & 63, wave = __builtin_amdgcn_readfirstlane(tid >> 6), gw = blockIdx.x * 8 + wave, NGW = gridDim.x * 8; (void)lane; (void)gw; (void)NGW;
    unsigned char* ws = a.ws; const float* const* in = a.in; float* X = a.out;
    bf16* XB = (bf16*)(ws + WS_XB); bf16* Y = (bf16*)(ws + WS_Y); bf16* H = (bf16*)(ws + WS_PROJ); bf16* PROJ = (bf16*)(ws + WS_PROJ); float* SS = (float*)(ws + WS_SS);
    { TIDS phase_convert(in, ws, 0, 4, lds, gw, NGW, wave, lane); phase_init_rows(in[0], XB, SS, gw, NGW, lane); }
    xcd_barrier(bar);
#pragma unroll 1
    for (int l = 0; l < NL; ++l) {
#ifndef SKIP_G1
        for (int rep = 0; rep < PROBE_GEMM; ++rep) { pg8::Gemm g{XB, (const bf16*)(ws + WS_WGU1), M, 2 * FF, D}; EpiGU E{H, SS}; gemm_single(lds, g, E); }
#endif
        xcd_barrier(bar);
#ifndef SKIP_G2
        { pg8::Gemm g{H, (const bf16*)(ws + WS_WD1), M, D, FF}; EpiResid E{l == 0 ? in[0] : X, X, XB, SS, 0.5f}; gemm_single(lds, g, E); }
#endif
        xcd_barrier(bar);
#ifndef SKIP_G3
        for (int rep = 0; rep < PROBE_GEMM; ++rep) { pg8::Gemm g{XB, (const bf16*)(ws + WS_WIN), M, NINP, D}; EpiProj E{PROJ, SS}; gemm_single(lds, g, E); }
#endif
        xcd_barrier(bar);
#ifndef SKIP_PREP
        for (int rep = 0; rep < PROBE_MISC; ++rep) { TIDS phase_prep(in, ws, l, lds, tid); }
#endif
        xcd_barrier(bar);
#ifndef SKIP_SCAN
        for (int rep = 0; rep < PROBE_SCAN; ++rep) { TIDS phase_scan<0>(in, ws, l, lds, tid); }
        xcd_barrier(bar);
        { TIDS phase_combine(in, ws, l, lds, tid); }
        xcd_barrier(bar);
        for (int rep = 0; rep < PROBE_SCAN; ++rep) { TIDS phase_scan<1>(in, ws, l, lds, tid); }
#endif
        xcd_barrier(bar);
#ifndef SKIP_POST
        for (int rep = 0; rep < PROBE_MISC; ++rep) { TIDS phase_post(in, ws, l, gw, NGW, lane); }
#endif
        xcd_barrier(bar);
#ifndef SKIP_G4
        { pg8::Gemm g{Y, (const bf16*)(ws + WS_WOUT), M, D, D}; EpiResid E{X, X, XB, SS, 1.0f}; gemm_single(lds, g, E); }
#endif
        xcd_barrier(bar);
#ifndef SKIP_G5
        for (int rep = 0; rep < PROBE_GEMM; ++rep) { pg8::Gemm g{XB, (const bf16*)(ws + WS_WGU2), M, 2 * FF, D}; EpiGU E{H, SS}; gemm_single(lds, g, E); }
#endif
        xcd_barrier(bar);
#ifndef SKIP_G6
        { pg8::Gemm g{H, (const bf16*)(ws + WS_WD2), M, D, FF}; EpiResid E{X, X, XB, SS, 0.5f}; gemm_single(lds, g, E); }
#endif
        xcd_barrier(bar);
    }
    { TIDS phase_final(X, in[42], gw, NGW, lane); }
}

extern "C" void kernel_launch(void* const* d_in, const int* in_sizes, int n_in, void* d_out, int out_size, void* d_ws, size_t ws_size, hipStream_t stream) {
    static int grid = 0;
    if (grid == 0) {
        int dev = 0, cus = 0, per_cu = 0;
        (void)hipGetDevice(&dev);
        (void)hipDeviceGetAttribute(&cus, hipDeviceAttributeMultiprocessorCount, dev);
        (void)hipFuncSetAttribute((const void*)fwd, hipFuncAttributeMaxDynamicSharedMemorySize, LDS_BYTES);
        (void)hipOccupancyMaxActiveBlocksPerMultiprocessor(&per_cu, (const void*)fwd, 512, LDS_BYTES);
        if (per_cu < 1) per_cu = 1;
        grid = cus * per_cu;
        if (n_in != 43 || out_size != M * D || ws_size < WS_END) fprintf(stderr, "kernel_launch: unexpected sizes n_in %d out %d ws %zu (need %zu)\n", n_in, out_size, ws_size, (size_t)WS_END);
    }
    Args a{};
    for (int i = 0; i < 43 && i < n_in; ++i) a.in[i] = (const float*)d_in[i];
    a.out = (float*)d_out; a.ws = (unsigned char*)d_ws;
    void* args[] = {&a};
    hipError_t e = hipLaunchCooperativeKernel((const void*)fwd, dim3(grid), dim3(512), args, LDS_BYTES, stream);
    if (e != hipSuccess) fprintf(stderr, "cooperative launch failed: %s (grid %d)\n", hipGetErrorString(e), grid);
}
```

```cpp
#include <hip/hip_runtime.h>
#include <hip/hip_cooperative_groups.h>
#include <cstdio>
#include <cstdint>
namespace cg = cooperative_groups;
namespace pg8 {
#define PG8_LAS __attribute__((address_space(3)))
typedef unsigned short bf16_t;
typedef short bf16x8 __attribute__((ext_vector_type(8)));
typedef float f32x4 __attribute__((ext_vector_type(4)));
typedef unsigned u32x4 __attribute__((ext_vector_type(4)));
constexpr int BM = 256, BK = 64, HALF = 128, HTB = HALF * BK * 2  , STAGE_BYTES = 8 * HTB, NXCD = 8, WGM = 8;

__host__ __device__ __forceinline__ int lds_byte(int r, int c) { const int st = (r >> 4) * 2 + (c >> 5), rr = r & 15, cc = c & 31, ob = rr * 64 + cc * 2; return st * 1024 + (ob ^ (((ob >> 9) & 1) << 5)); }
__host__ __device__ __forceinline__ void stage_rc(int b, int& R, int& C) { const int st = b / 1024, sb = b % 1024, swz = sb ^ (((sb >> 9) & 1) << 5); R = (st >> 1) * 16 + swz / 64; C = (st & 1) * 32 + (swz % 64) / 2; }
__host__ __device__ __forceinline__ int perm32(int rho) { const int n = rho >> 4, i = rho & 15; return 8 * (i >> 2) + 4 * n + (i & 3); }

struct Unit { int pm, pn; };
struct Gemm { const bf16_t* A; const bf16_t* Bt; int M, N, K; };

struct StaticOrder {
    int nM, nN, nwg, G, c;
    __host__ __device__ void init(int M, int N, int G_, int c_) { nM = M / BM; nN = N / BM; nwg = nM * nN; G = G_; c = c_; }
    __host__ __device__ bool next(int i, Unit& u) const {
        const long L = (long)i * G + c; if (L >= nwg) return false;
        int wgid = (int)L; { const int q = nwg / NXCD, r = nwg % NXCD, xcd = wgid % NXCD, off = wgid / NXCD; wgid = (xcd < r ? xcd * (q + 1) : r * (q + 1) + (xcd - r) * q) + off; }
        const int nig = WGM * nN, gid = wgid / nig, fm = gid * WGM, gsz = (nM - fm) < WGM ? (nM - fm) : WGM;
        u.pm = fm + ((wgid % nig) % gsz); u.pn = (wgid % nig) / gsz; return true;
    }
    __device__ __forceinline__ void a_ready(const Unit&) const {}
    __device__ __forceinline__ void done(const Unit&) const {}
};

__device__ __forceinline__ unsigned cvt_pk_bf16(float lo, float hi) { unsigned r; asm volatile("v_cvt_pk_bf16_f32 %0, %1, %2" : "=v"(r) : "v"(lo), "v"(hi)); return r; }
typedef float f32x2 __attribute__((ext_vector_type(2)));
template <class Epi, class Sched, bool ALIGN_EPI = false, bool SP2 = false>
__device__ __forceinline__ void gemm_phase(PG8_LAS unsigned char* lds, const Gemm g, const Sched& S, const Epi& E) {
    int tid_ = threadIdx.x; asm volatile("" : "+v"(tid_));
    const int tid = tid_, wid = __builtin_amdgcn_readfirstlane(tid >> 6), lane = tid & 63, wr = wid >> 2, wc = wid & 3, fr = lane & 15, fq = lane >> 4;
    const int K = g.K, nt = K / BK;
    unsigned voffA[2], voffB[2];
#pragma unroll
    for (int i = 0; i < 2; ++i) { int R, C; stage_rc(tid * 16 + i * 8192, R, C); const int Rb = Epi::PERM ? ((R & ~31) + perm32(R & 31)) : R;
        voffA[i] = (unsigned)(R * K + C) * 2u; voffB[i] = (unsigned)(Rb * K + C) * 2u; }
    const size_t kstep = (size_t)(BK * 2);
    const size_t hstep = (size_t)HALF * K * 2;
    const size_t tstep = 2 * hstep;
    const unsigned ldsw = (unsigned)wid * 1024u;
    const int aoff = lds_byte(wr * 64 + fr, fq * 8), boff = lds_byte(wc * 32 + fr, fq * 8);
#define PG8_SA(b, h) (((b) * 2 + (h)) * HTB)
#define PG8_SB(b, h) ((4 + (b) * 2 + (h)) * HTB)
#define PG8_STAGE(bufoff, gbase, voff) do { _Pragma("unroll") for (int _i = 0; _i < 2; ++_i) \
        __builtin_amdgcn_global_load_lds((const unsigned*)((const char*)(gbase) + (voff)[_i]), (PG8_LAS unsigned*)(lds + (bufoff) + ldsw + _i * 8192), 16, 0, 0); } while (0)
#define PG8_LDA(dst, b, h) do { _Pragma("unroll") for (int m = 0; m < 4; ++m) _Pragma("unroll") for (int k = 0; k < 2; ++k) dst[m][k] = *(const PG8_LAS bf16x8*)(lds + PG8_SA(b, h) + aoff + m * 2048 + k * 1024); } while (0)
#define PG8_LDB(dst, b, h) do { _Pragma("unroll") for (int n = 0; n < 2; ++n) _Pragma("unroll") for (int k = 0; k < 2; ++k) dst[n][k] = *(const PG8_LAS bf16x8*)(lds + PG8_SB(b, h) + boff + n * 2048 + k * 1024); } while (0)
#define PG8_MMA(ai, bj, At, Bt) do { __builtin_amdgcn_s_setprio(1); _Pragma("unroll") for (int m = 0; m < 4; ++m) _Pragma("unroll") for (int n = 0; n < 2; ++n) _Pragma("unroll") for (int k = 0; k < 2; ++k) \
        acc[ai][bj][m][n] = __builtin_amdgcn_mfma_f32_16x16x32_bf16(Bt[n][k], At[m][k], acc[ai][bj][m][n], 0, 0, 0); __builtin_amdgcn_s_setprio(0); } while (0)
#define PG8_WAIT_V(n) asm volatile("s_waitcnt vmcnt(" #n ")" ::: "memory")
#define PG8_WAIT_L(n) asm volatile("s_waitcnt lgkmcnt(" #n ")" ::: "memory")
#define PG8_BAR __builtin_amdgcn_s_barrier()
#define PG8_SCHED __builtin_amdgcn_sched_barrier(0)
    Unit cur, nxt; int ui = 0;
    if (!S.next(0, cur)) return;
    f32x4 acc[2][2][4][2];
#pragma unroll
    for (int a = 0; a < 2; ++a)
#pragma unroll
        for (int b = 0; b < 2; ++b)
#pragma unroll
            for (int m = 0; m < 4; ++m)
#pragma unroll
                for (int n = 0; n < 2; ++n) acc[a][b][m][n] = (f32x4){0.f, 0.f, 0.f, 0.f};
    bf16x8 At[4][2], B0[2][2], B1[2][2];
    const char* cA = (const char*)g.A + (size_t)cur.pm * tstep; const char* cB = (const char*)g.Bt + (size_t)cur.pn * tstep;
    S.a_ready(cur);
    if constexpr (SP2) {
        PG8_STAGE(PG8_SB(0, 0), cB, voffB); PG8_STAGE(PG8_SB(0, 1), cB + hstep, voffB); PG8_STAGE(PG8_SA(0, 0), cA, voffA); PG8_STAGE(PG8_SA(0, 1), cA + hstep, voffA);
        if (wr == 1) PG8_BAR;
        PG8_WAIT_V(2); PG8_BAR;
        PG8_STAGE(PG8_SB(1, 0), cB + kstep, voffB); PG8_STAGE(PG8_SA(1, 0), cA + kstep, voffA); PG8_STAGE(PG8_SB(1, 1), cB + hstep + kstep, voffB);
        PG8_WAIT_V(6); PG8_BAR;
    } else {
        PG8_STAGE(PG8_SB(0, 0), cB, voffB); PG8_STAGE(PG8_SA(0, 0), cA, voffA); PG8_STAGE(PG8_SB(0, 1), cB + hstep, voffB); PG8_STAGE(PG8_SA(0, 1), cA + hstep, voffA);
        if (wr == 1) PG8_BAR;
        PG8_WAIT_V(4); PG8_BAR;
        PG8_STAGE(PG8_SB(1, 0), cB + kstep, voffB); PG8_STAGE(PG8_SA(1, 0), cA + kstep, voffA); PG8_STAGE(PG8_SB(1, 1), cB + hstep + kstep, voffB);
        PG8_WAIT_V(6); PG8_BAR;
    }
    for (;;) {
        const bool has_next = S.next(ui + 1, nxt);
        const char* nA = has_next ? (const char*)g.A + (size_t)nxt.pm * tstep : cA; const char* nB = has_next ? (const char*)g.Bt + (size_t)nxt.pn * tstep : cB;
        for (int t = 0; t < nt; t += 2) {
            const bool last = (t == nt - 2);
            const char* a1 = cA + (size_t)(t + 1) * kstep;
            const char* a2 = last ? nA : cA + (size_t)(t + 2) * kstep; const char* b2 = last ? nB : cB + (size_t)(t + 2) * kstep;
            const char* a3 = a2 + kstep; const char* b3 = b2 + kstep;
            if (last && has_next) S.a_ready(nxt);
            if constexpr (SP2) {
            PG8_LDB(B0, 0, 0); PG8_LDB(B1, 0, 1); PG8_SCHED; PG8_LDA(At, 0, 0); PG8_STAGE(PG8_SA(1, 1), a1 + hstep, voffA);
            PG8_WAIT_V(8); PG8_WAIT_L(0); PG8_BAR; PG8_MMA(0, 0, At, B0); PG8_MMA(0, 1, At, B1); PG8_BAR; PG8_SCHED;
            PG8_LDA(At, 0, 1); PG8_STAGE(PG8_SB(0, 0), b2, voffB); PG8_STAGE(PG8_SB(0, 1), b2 + hstep, voffB); PG8_STAGE(PG8_SA(0, 0), a2, voffA);
            PG8_WAIT_V(8); PG8_WAIT_L(0); PG8_BAR; PG8_MMA(1, 0, At, B0); PG8_MMA(1, 1, At, B1); PG8_BAR; PG8_SCHED;
            PG8_LDB(B0, 1, 0); PG8_LDB(B1, 1, 1); PG8_SCHED; PG8_LDA(At, 1, 0); PG8_STAGE(PG8_SA(0, 1), a2 + hstep, voffA);
            PG8_WAIT_V(8); PG8_WAIT_L(0); PG8_BAR; PG8_MMA(0, 0, At, B0); PG8_MMA(0, 1, At, B1); PG8_BAR; PG8_SCHED;
            PG8_LDA(At, 1, 1); PG8_STAGE(PG8_SB(1, 0), b3, voffB); PG8_STAGE(PG8_SB(1, 1), b3 + hstep, voffB); PG8_STAGE(PG8_SA(1, 0), a3, voffA);
            PG8_WAIT_V(8); PG8_WAIT_L(0); PG8_BAR; PG8_MMA(1, 0, At, B0); PG8_MMA(1, 1, At, B1); PG8_BAR; PG8_SCHED;
            } else {
            PG8_LDB(B0, 0, 0); PG8_SCHED; PG8_LDA(At, 0, 0); PG8_STAGE(PG8_SA(1, 1), a1 + hstep, voffA);
            PG8_WAIT_L(8); PG8_BAR; PG8_WAIT_L(0); PG8_MMA(0, 0, At, B0); PG8_BAR; PG8_SCHED;
            PG8_LDB(B1, 0, 1); PG8_STAGE(PG8_SB(0, 0), b2, voffB);
            PG8_BAR; PG8_WAIT_L(0); PG8_MMA(0, 1, At, B1); PG8_BAR;
            PG8_LDA(At, 0, 1); PG8_STAGE(PG8_SA(0, 0), a2, voffA);
            PG8_BAR; PG8_WAIT_L(0); PG8_MMA(1, 0, At, B0); PG8_BAR; PG8_SCHED;
            PG8_STAGE(PG8_SB(0, 1), b2 + hstep, voffB);
            PG8_WAIT_V(6); PG8_BAR; PG8_MMA(1, 1, At, B1); PG8_BAR;
            PG8_LDB(B0, 1, 0); PG8_SCHED; PG8_LDA(At, 1, 0); PG8_STAGE(PG8_SA(0, 1), a2 + hstep, voffA);
            PG8_WAIT_L(8); PG8_BAR; PG8_WAIT_L(0); PG8_MMA(0, 0, At, B0); PG8_BAR; PG8_SCHED;
            PG8_LDB(B1, 1, 1); PG8_STAGE(PG8_SB(1, 0), b3, voffB);
            PG8_BAR; PG8_WAIT_L(0); PG8_MMA(0, 1, At, B1); PG8_BAR;
            PG8_LDA(At, 1, 1); PG8_STAGE(PG8_SA(1, 0), a3, voffA);
            PG8_BAR; PG8_WAIT_L(0); PG8_MMA(1, 0, At, B0); PG8_BAR; PG8_SCHED;
            PG8_STAGE(PG8_SB(1, 1), b3 + hstep, voffB);
            PG8_WAIT_V(6); PG8_BAR; PG8_MMA(1, 1, At, B1); PG8_BAR;
            }
        }
        if constexpr (ALIGN_EPI) { if (wr == 0) PG8_BAR; }
        if constexpr (!Epi::AFTER_DRAIN) { E(acc, cur, wr, wc, fr, fq); S.done(cur); }
        if (!has_next) break;
#pragma unroll
        for (int a = 0; a < 2; ++a)
#pragma unroll
            for (int b = 0; b < 2; ++b)
#pragma unroll
                for (int m = 0; m < 4; ++m)
#pragma unroll
                    for (int n = 0; n < 2; ++n) acc[a][b][m][n] = (f32x4){0.f, 0.f, 0.f, 0.f};
        cur = nxt; cA = nA; cB = nB; ++ui;
        if constexpr (ALIGN_EPI) { if (wr == 1) PG8_BAR; }
    }
    PG8_WAIT_V(0);
    if constexpr (!ALIGN_EPI) { if (wr == 0) PG8_BAR; }
    PG8_BAR;
    if constexpr (Epi::AFTER_DRAIN) { E.fused(acc, cur, wr, wc, fr, fq, lds, wid, lane); S.done(cur); }
#undef PG8_SA
#undef PG8_SB
#undef PG8_STAGE
#undef PG8_LDA
#undef PG8_LDB
#undef PG8_MMA
#undef PG8_WAIT_V
#undef PG8_WAIT_L
#undef PG8_BAR
#undef PG8_SCHED
}
}
#define LAS __attribute__((address_space(3)))
typedef unsigned short bf16;
typedef float f4 __attribute__((ext_vector_type(4)));
typedef float f2 __attribute__((ext_vector_type(2)));
#define LO2(v) __builtin_shufflevector(v, v, 0, 1)
#define HI2(v) __builtin_shufflevector(v, v, 2, 3)
typedef unsigned u2 __attribute__((ext_vector_type(2)));
typedef unsigned u4 __attribute__((ext_vector_type(4)));
using pg8::f32x4;

constexpr int M = 16384, D = 1024, FF = 2816, NIN = 3156, NINP = 3328, NL = 4, SEQ = 8192;
constexpr int LDS_BYTES = 147456;
constexpr size_t HM = 524288;
constexpr size_t WS_WGU1 = 0, WS_WD1 = 22 * HM, WS_WIN = 33 * HM, WS_WOUT = 46 * HM, WS_WGU2 = 50 * HM, WS_WD2 = 72 * HM;
constexpr size_t MiB = 1048576;
constexpr size_t WS_XB = 42 * MiB;
constexpr size_t WS_OGLA = WS_XB, WS_YRW = WS_XB + 8 * MiB, WS_YSSD = WS_XB + 16 * MiB;
constexpr size_t WS_Y = 74 * MiB;
constexpr size_t WS_PROJ = 106 * MiB;
constexpr size_t WS_VFIRST = 210 * MiB;
constexpr size_t WS_SS = 226 * MiB;
constexpr size_t WS_RWR = 227 * MiB, WS_RWK = 235 * MiB, WS_RWV = 243 * MiB, WS_RWKK = 251 * MiB, WS_RWB = 259 * MiB;
constexpr size_t WS_RWW = 267 * MiB;
constexpr size_t WS_RWG = 283 * MiB;
constexpr size_t WS_RWBON = 291 * MiB;
constexpr size_t WS_XBC = 292 * MiB;
constexpr size_t WS_DT = 316 * MiB, WS_DEC = 317 * MiB;
constexpr size_t WS_LRA = 318 * MiB, WS_LRH = 334 * MiB;
constexpr size_t WS_SEGA = 350 * MiB, WS_SEGH = 351 * MiB, WS_CARRY = 352 * MiB;
constexpr int NCH = 32, CHL = SEQ / NCH;
constexpr size_t WS_RWP = 353 * MiB, WS_RWU = 357 * MiB;
constexpr size_t WS_GLU = 361 * MiB, WS_GLD = 363 * MiB;
constexpr int NCS = 64;
constexpr size_t WS_SSU = 364 * MiB, WS_SSD = 380 * MiB;
constexpr size_t WS_CTL = 381 * MiB;
constexpr size_t WS_END = 382 * MiB;

constexpr int PC_GQ = 0, PC_GK = 128, PC_GV = 256, PC_GG = 512, PC_GSTEM = 768, PC_LX = 784, PC_LG = 1040, PC_RW = 1296, PC_SZ = 2128, PC_SXBC = 2384, PC_SDT = 3152;

__device__ __forceinline__ float bf2f(bf16 v) { return __uint_as_float((unsigned)v << 16); }
__device__ __forceinline__ float bflo(unsigned w) { return __uint_as_float(w << 16); }
__device__ __forceinline__ float bfhi(unsigned w) { return __uint_as_float(w & 0xffff0000u); }
__device__ __forceinline__ unsigned pk2(float lo, float hi) { return pg8::cvt_pk_bf16(lo, hi); }
__device__ __forceinline__ float sigmoidf_(float x) { return 1.f / (1.f + __expf(-x)); }
__device__ __forceinline__ float siluf_(float x) { return x / (1.f + __expf(-x)); }
__device__ __forceinline__ float tanhf_(float x) { return 1.f - 2.f / (1.f + __expf(2.f * x)); }
__device__ __forceinline__ float softplusf_(float x) { return fmaxf(x, 0.f) + log1pf(__expf(-fabsf(x))); }
__device__ __forceinline__ float gelu_tanh(float x) { const float u = 0.7978845608028654f * (x + 0.044715f * x * x * x); return 0.5f * x * (1.f + tanhf_(u)); }
__device__ __forceinline__ float wave_sum(float v) {
#pragma unroll
    for (int o = 1; o < 64; o <<= 1) v += __shfl_xor(v, o);
    return v;
}
__device__ __forceinline__ float dpp_mov(float x, const int ctrl_sel) {
    const int v = __builtin_bit_cast(int, x); int r;
    if (ctrl_sel == 0) r = __builtin_amdgcn_update_dpp(0, v, 0xB1, 0xF, 0xF, true);
    else if (ctrl_sel == 1) r = __builtin_amdgcn_update_dpp(0, v, 0x4E, 0xF, 0xF, true);
    else r = __builtin_amdgcn_update_dpp(0, v, 0x141, 0xF, 0xF, true);
    return __builtin_bit_cast(float, r);
}
__device__ __forceinline__ float red8(float x) { x += dpp_mov(x, 0); x += dpp_mov(x, 1); x += dpp_mov(x, 2); return x; }
__device__ __forceinline__ float rstd_row(const float* ss, int row) { const f4 p = *(const f4*)(ss + (size_t)row * 4); return rsqrtf(((p.x + p.y) + (p.z + p.w)) * (1.f / 1024.f) + 1e-6f); }

__device__ __forceinline__ void lds_barrier() { asm volatile("s_waitcnt lgkmcnt(0)" ::: "memory"); __builtin_amdgcn_s_barrier(); asm volatile("" ::: "memory"); }
struct EpiGU {
    static constexpr bool PERM = true, AFTER_DRAIN = true;
    bf16* H; const float* ss;
    __device__ __forceinline__ void fused(f32x4 (&acc)[2][2][4][2], const pg8::Unit& u, int wr, int wc, int fr, int fq, LAS unsigned char* lds, int wid, int lane) const {
#pragma unroll
        for (int ai = 0; ai < 2; ++ai)
#pragma unroll
            for (int m = 0; m < 4; ++m) {
                const int row = u.pm * 256 + ai * 128 + wr * 64 + m * 16 + fr; const float rs = rstd_row(ss, row);
                float hv[8];
#pragma unroll
                for (int n = 0; n < 2; ++n)
#pragma unroll
                    for (int e = 0; e < 4; ++e) { const float g = acc[ai][0][m][n][e] * rs, up = acc[ai][1][m][n][e] * rs; hv[n * 4 + e] = siluf_(g) * up; }
                u4 w; w.x = pk2(hv[0], hv[1]); w.y = pk2(hv[2], hv[3]); w.z = pk2(hv[4], hv[5]); w.w = pk2(hv[6], hv[7]);
                *(u4*)(H + (size_t)row * FF + u.pn * 128 + wc * 32 + 8 * fq) = w;
                asm volatile("" ::: "memory");
            }
    }
};
struct EpiProj {
    static constexpr bool PERM = true, AFTER_DRAIN = true;
    bf16* O; const float* ss;
    __device__ __forceinline__ void fused(f32x4 (&acc)[2][2][4][2], const pg8::Unit& u, int wr, int wc, int fr, int fq, LAS unsigned char* lds, int wid, int lane) const {
#pragma unroll
        for (int ai = 0; ai < 2; ++ai)
#pragma unroll
            for (int m = 0; m < 4; ++m) {
                const int row = u.pm * 256 + ai * 128 + wr * 64 + m * 16 + fr; const float rs = rstd_row(ss, row);
#pragma unroll
                for (int bj = 0; bj < 2; ++bj) { const f32x4 v0 = acc[ai][bj][m][0] * rs, v1 = acc[ai][bj][m][1] * rs;
                    u4 w; w.x = pk2(v0[0], v0[1]); w.y = pk2(v0[2], v0[3]); w.z = pk2(v1[0], v1[1]); w.w = pk2(v1[2], v1[3]);
                    *(u4*)(O + (size_t)row * NINP + u.pn * 256 + bj * 128 + wc * 32 + 8 * fq) = w; }
                asm volatile("" ::: "memory");
            }
    }
};
struct EpiResid {
    static constexpr bool PERM = true, AFTER_DRAIN = true;
    const float* xin; float* xout; bf16* xb; float* ss; float scale;
    __device__ __forceinline__ void fused(f32x4 (&acc)[2][2][4][2], const pg8::Unit& u, int wr, int wc, int fr, int fq, LAS unsigned char* lds, int wid, int lane) const {
        LAS float* P = (LAS float*)lds;
#pragma unroll
        for (int ai = 0; ai < 2; ++ai)
#pragma unroll
            for (int m = 0; m < 4; ++m) {
                const int rt = ai * 128 + wr * 64 + m * 16 + fr; const size_t row = (size_t)u.pm * 256 + rt; float sq = 0.f;
#pragma unroll
                for (int bj = 0; bj < 2; ++bj) { const size_t off = row * D + u.pn * 256 + bj * 128 + wc * 32 + 8 * fq;
                    f32x4 x0 = *(const f32x4*)(xin + off), x1 = *(const f32x4*)(xin + off + 4);
                    x0 += acc[ai][bj][m][0] * scale; x1 += acc[ai][bj][m][1] * scale;
                    *(f32x4*)(xout + off) = x0; *(f32x4*)(xout + off + 4) = x1;
                    u4 w; w.x = pk2(x0[0], x0[1]); w.y = pk2(x0[2], x0[3]); w.z = pk2(x1[0], x1[1]); w.w = pk2(x1[2], x1[3]);
                    *(u4*)(xb + off) = w;
                    sq += (x0[0] * x0[0] + x0[1] * x0[1]) + (x0[2] * x0[2] + x0[3] * x0[3]) + (x1[0] * x1[0] + x1[1] * x1[1]) + (x1[2] * x1[2] + x1[3] * x1[3]); }
                sq += __shfl_xor(sq, 16); sq += __shfl_xor(sq, 32);
                if (fq == 0) P[rt * 4 + wc] = sq;
            }
        __syncthreads();
        const int tid = wid * 64 + lane;
        if (tid < 256) ss[(size_t)(u.pm * 256 + tid) * 4 + u.pn] = (P[tid * 4 + 0] + P[tid * 4 + 1]) + (P[tid * 4 + 2] + P[tid * 4 + 3]);
        __syncthreads();
    }
};
struct OneUnit { pg8::StaticOrder b; int r;
    __device__ __forceinline__ bool next(int i, pg8::Unit& u) const { return i == 0 && b.next(r, u); }
    __device__ __forceinline__ void a_ready(const pg8::Unit&) const {}
    __device__ __forceinline__ void done(const pg8::Unit&) const {} };

__device__ __forceinline__ void tr_item(const float* W, int ldn, int nvalid, int col0, const float* sc, bf16* WT, int K, int row0, int k0, LAS float* scr, int lane) {
    const int c4 = col0 + (lane & 31) * 4; const bool ok = c4 < nvalid;
#pragma unroll 8
    for (int i = 0; i < 16; ++i) { const int kk = 2 * i + (lane >> 5); f4 v = (f4){0.f, 0.f, 0.f, 0.f}; if (ok) v = *(const f4*)(W + (size_t)(k0 + kk) * ldn + c4); if (sc) v = v * sc[k0 + kk]; *(LAS f4*)(scr + kk * 132 + (lane & 31) * 4) = v; }
    asm volatile("s_waitcnt lgkmcnt(0)" ::: "memory");
    const int kq = lane & 3;
#pragma unroll
    for (int j = 0; j < 8; ++j) { const int n = (lane >> 2) + 16 * j; const LAS float* s = scr + (8 * kq) * 132 + n;
        u4 o; o.x = pk2(s[0 * 132], s[1 * 132]); o.y = pk2(s[2 * 132], s[3 * 132]); o.z = pk2(s[4 * 132], s[5 * 132]); o.w = pk2(s[6 * 132], s[7 * 132]);
        *(u4*)(WT + (size_t)(row0 + n) * K + k0 + 8 * kq) = o; }
    asm volatile("s_waitcnt lgkmcnt(0)" ::: "memory");
}
__device__ __forceinline__ void tr_gu(const float* Wg, const float* Wu, const float* nw, bf16* WT, int it, LAS float* scr, int lane) {
    const int kb = it / 44, nb = it % 44, row0 = nb * 128, pn = row0 >> 8, half = (row0 >> 7) & 1;
    tr_item(half ? Wu : Wg, FF, FF, pn * 128, nw, WT, D, row0, kb * 32, scr, lane);
}
__device__ __forceinline__ void phase_convert(const float* const* in, unsigned char* ws, int l, int sets, LAS unsigned char* lds, int gw, int NGW, int wave, int lane) {
    LAS float* scr = (LAS float*)(lds + wave * 17408);
    constexpr int I_GU = 1408, I_D = 704, I_IN = 832, I_OUT = 256, NA = I_GU + I_D + I_IN, NB = I_OUT + I_GU + I_D;
    const int la = (sets & 4) ? l : l + 1; const bool doA = (sets & 4) || ((sets & 2) && l + 1 < NL), doB = (sets & 1) != 0;
    const int lo = doA ? 0 : NA, hi = doB ? NA + NB : NA;
    for (int it = lo + gw; it < hi; it += NGW) {
        int r = it;
        if (r < NA) { const size_t oFF = (size_t)la * D * FF;
            if (r < I_GU) { tr_gu(in[2] + oFF, in[3] + oFF, in[1] + la * D, (bf16*)(ws + WS_WGU1), r, scr, lane); continue; } r -= I_GU;
            if (r < I_D) { tr_item(in[4] + oFF, D, D, (r % 8) * 128, nullptr, (bf16*)(ws + WS_WD1), FF, (r % 8) * 128, (r / 8) * 32, scr, lane); continue; } r -= I_D;
            tr_item(in[6] + (size_t)la * D * NIN, NIN, NIN, (r % 26) * 128, in[5] + la * D, (bf16*)(ws + WS_WIN), D, (r % 26) * 128, (r / 26) * 32, scr, lane); continue; }
        r -= NA; const size_t oFF = (size_t)l * D * FF;
        if (r < I_OUT) { tr_item(in[7] + (size_t)l * D * D, D, D, (r % 8) * 128, nullptr, (bf16*)(ws + WS_WOUT), D, (r % 8) * 128, (r / 8) * 32, scr, lane); continue; } r -= I_OUT;
        if (r < I_GU) { tr_gu(in[39] + oFF, in[40] + oFF, in[38] + l * D, (bf16*)(ws + WS_WGU2), r, scr, lane); continue; } r -= I_GU;
        tr_item(in[41] + oFF, D, D, (r % 8) * 128, nullptr, (bf16*)(ws + WS_WD2), FF, (r % 8) * 128, (r / 8) * 32, scr, lane);
    }
}
__device__ __forceinline__ void phase_init_rows(const float* x, bf16* xb, float* ss, int gw, int NGW, int lane) {
    for (int m = gw; m < M; m += NGW) {
        const f4* xr = (const f4*)(x + (size_t)m * D) + lane; float s = 0.f; u2* o = (u2*)(xb + (size_t)m * D) + lane;
#pragma unroll
        for (int j = 0; j < 4; ++j) { const f4 v = xr[64 * j]; s += (v.x * v.x + v.y * v.y) + (v.z * v.z + v.w * v.w); u2 w; w.x = pk2(v.x, v.y); w.y = pk2(v.z, v.w); o[64 * j] = w; }
        s = wave_sum(s);
        if (lane < 4) ss[(size_t)m * 4 + lane] = lane == 0 ? s : 0.f;
    }
}
__device__ __forceinline__ void phase_final(float* x, const float* fw, int gw, int NGW, int lane) {
    for (int m = gw; m < M; m += NGW) {
        f4* xr = (f4*)(x + (size_t)m * D) + lane; f4 v[4]; float s = 0.f;
#pragma unroll
        for (int j = 0; j < 4; ++j) { v[j] = xr[64 * j]; s += (v[j].x * v[j].x + v[j].y * v[j].y) + (v[j].z * v[j].z + v[j].w * v[j].w); }
        const float rs = rsqrtf(wave_sum(s) * (1.f / 1024.f) + 1e-6f);
#pragma unroll
        for (int j = 0; j < 4; ++j) { const f4 w = ((const f4*)fw)[lane + 64 * j]; xr[64 * j] = v[j] * rs * w; }
    }
}
#define XB_TMO      128
#define XB_XCNT(j)  (256  + 64 * (j))
#define XB_XSUB(j)  (1280 + 64 * (j))
#define XB_XGEN(j)  (2304 + 64 * (j))
#define XB_TOP      3328
#define XB_TOPGEN   3392
#define XCD_BAR_WORDS 3456
#define XB_SPIN_CAP (1u << 18)

__device__ __forceinline__ unsigned xb_ld(unsigned* p)              { return __hip_atomic_load(p, __ATOMIC_RELAXED, __HIP_MEMORY_SCOPE_AGENT); }
__device__ __forceinline__ unsigned xb_add(unsigned* p, unsigned v) { return __hip_atomic_fetch_add(p, v, __ATOMIC_RELAXED, __HIP_MEMORY_SCOPE_AGENT); }
__device__ __forceinline__ unsigned xb_xcc_id() { return (unsigned)__builtin_amdgcn_s_getreg((3 << 11) | 20) & 0xFu; }
#define XB_SPIN(cond, bar) do { unsigned _sp = 0; while (cond) { __builtin_amdgcn_s_sleep(1); \
    if ((++_sp & 255u) == 0u) { if (xb_ld(&(bar)[XB_TMO])) break; if (_sp > XB_SPIN_CAP) { atomicAdd(&(bar)[XB_TMO], 1u); break; } } } } while (0)

struct XcdBarrier {
    unsigned* bar; unsigned x;
    volatile LAS unsigned* st;
};

__device__ __forceinline__ XcdBarrier xcd_barrier_post(unsigned* bar, volatile LAS unsigned* st) {
    XcdBarrier b; b.bar = bar; b.x = xb_xcc_id(); b.st = st;
    if (threadIdx.x == 0) (void)xb_add(&bar[XB_XCNT(b.x)], 1u);
    return b;
}
__device__ __forceinline__ void xcd_barrier_complete(unsigned* bar, unsigned x, unsigned& nloc, unsigned& nx) {
    const unsigned G = gridDim.x * gridDim.y * gridDim.z;
    unsigned sum, cnt, mine, sp = 0u;
    for (;;) {
        sum = 0u; cnt = 0u; mine = 0u;
#pragma unroll
        for (unsigned j = 0; j < 16; ++j) { const unsigned c = xb_ld(&bar[XB_XCNT(j)]); sum += c; cnt += (c > 0u) ? 1u : 0u; mine = (j == x) ? c : mine; }
        if (sum == G) break;
        __builtin_amdgcn_s_sleep(1);
        if ((++sp & 255u) == 0u) { if (xb_ld(&bar[XB_TMO])) break; if (sp > XB_SPIN_CAP) { atomicAdd(&bar[XB_TMO], 1u); break; } }
    }
    nloc = mine > 0u ? mine : 1u; nx = cnt > 0u ? cnt : 1u;
}

__device__ __forceinline__ void xcd_barrier(const XcdBarrier& b) {
    asm volatile("s_waitcnt vmcnt(0)" ::: "memory");
    __syncthreads();
    if (threadIdx.x == 0) {
        unsigned* bar = b.bar;
        __builtin_amdgcn_s_waitcnt(0);
        unsigned nloc = b.st[0], nx = b.st[1];
        if (nloc == 0u) { xcd_barrier_complete(bar, b.x, nloc, nx); b.st[0] = nloc; b.st[1] = nx; }
        const unsigned old = xb_add(&bar[XB_XSUB(b.x)], 1u);
        const unsigned gen = old / nloc;
        if (old + 1u == (gen + 1u) * nloc) {
            __builtin_amdgcn_fence(__ATOMIC_RELEASE, "agent");
            asm volatile("s_waitcnt vmcnt(0)" ::: "memory");
            const unsigned og = xb_add(&bar[XB_TOP], 1u);
            const unsigned tg = og / nx;
            if (og + 1u == (tg + 1u) * nx) xb_add(&bar[XB_TOPGEN], 1u);
            else XB_SPIN(xb_ld(&bar[XB_TOPGEN]) == tg, bar);
            __builtin_amdgcn_fence(__ATOMIC_ACQUIRE, "agent");
            xb_add(&bar[XB_XGEN(b.x)], 1u);
            asm volatile("s_waitcnt vmcnt(0)" ::: "memory");
        } else {
            XB_SPIN(xb_ld(&bar[XB_XGEN(b.x)]) == gen, bar);
            __builtin_amdgcn_fence(__ATOMIC_ACQUIRE, "agent");
            asm volatile("s_waitcnt vmcnt(0)" ::: "memory");
        }
    }
    __syncthreads();
}
__device__ __forceinline__ void prep_lru(const float* const* in, unsigned char* ws, int l, int item, LAS unsigned char* lds, int tid) {
    const bf16* PROJ = (const bf16*)(ws + WS_PROJ); LAS float* X = (LAS float*)lds; LAS float* G = X + 32 * 256;
    const int t0 = item * 32; const float* cw = in[11] + l * 4 * 256; const float* cb = in[12] + l * 256;
#pragma unroll
    for (int it = 0; it < 2; ++it) { const int idx = tid + it * 512, t = idx >> 5, cv = idx & 31, tok = t0 + t, pos = tok & (SEQ - 1);
        f4 a0 = *(const f4*)(cb + cv * 8), a1 = *(const f4*)(cb + cv * 8 + 4);
#pragma unroll
        for (int k = 0; k < 4; ++k) { u4 x = (u4){0u, 0u, 0u, 0u}; if (pos - 3 + k >= 0) x = *(const u4*)(PROJ + (size_t)(tok - 3 + k) * NINP + PC_LX + cv * 8);
            const f4 w0 = *(const f4*)(cw + k * 256 + cv * 8), w1 = *(const f4*)(cw + k * 256 + cv * 8 + 4);
            a0 += w0 * (f4){bflo(x.x), bfhi(x.x), bflo(x.y), bfhi(x.y)}; a1 += w1 * (f4){bflo(x.z), bfhi(x.z), bflo(x.w), bfhi(x.w)}; }
        *(LAS f4*)(X + t * 256 + cv * 8) = a0; *(LAS f4*)(X + t * 256 + cv * 8 + 4) = a1; }
    __syncthreads();
    const int gsel = tid >> 8, c = tid & 255, blk = c >> 6, j = c & 63;
    { const float* pw = (gsel ? in[15] : in[13]) + (size_t)l * 16384 + blk * 4096 + j; const float bias = (gsel ? in[16] : in[14])[l * 256 + c];
#pragma unroll 1
      for (int kh = 0; kh < 2; ++kh) { float wv[32];
#pragma unroll
          for (int k = 0; k < 32; ++k) wv[k] = pw[(kh * 32 + k) * 64];
#pragma unroll 1
          for (int t = 0; t < 32; ++t) { const LAS f4* xr = (const LAS f4*)(X + t * 256 + blk * 64 + kh * 32); float d0 = 0.f, d1 = 0.f;
#pragma unroll
              for (int k4 = 0; k4 < 8; k4 += 2) { const f4 v = xr[k4], w = xr[k4 + 1];
                  d0 += v.x * wv[4 * k4] + v.y * wv[4 * k4 + 1] + v.z * wv[4 * k4 + 2] + v.w * wv[4 * k4 + 3];
                  d1 += w.x * wv[4 * k4 + 4] + w.y * wv[4 * k4 + 5] + w.z * wv[4 * k4 + 6] + w.w * wv[4 * k4 + 7]; }
              LAS float* gp = G + (gsel * 32 + t) * 256 + c;
              if (kh == 0) *gp = d0 + d1; else *gp = sigmoidf_(*gp + d0 + d1 + bias); } } }
    __syncthreads();
    { const float sp = softplusf_(-in[17][l * 256 + c]);
#pragma unroll 4
      for (int tt = 0; tt < 16; ++tt) { const int t = gsel * 16 + tt; const float r = G[t * 256 + c], ig = G[(32 + t) * 256 + c], la = -8.f * r * sp, av = __expf(la), u = sqrtf(fmaxf(1.f - av * av, 0.f)) * (ig * X[t * 256 + c]);
          G[t * 256 + c] = av; G[(32 + t) * 256 + c] = u; } }
    __syncthreads();
    if (tid < 256) { float h = 0.f, A = 1.f; float* LRA = (float*)(ws + WS_LRA); float* LRH = (float*)(ws + WS_LRH);
#pragma unroll 4
        for (int t = 0; t < 32; ++t) { const float av = G[t * 256 + c], u = G[(32 + t) * 256 + c];
            h = av * h + u; A *= av; const size_t o = (size_t)(t0 + t) * 256 + c; LRA[o] = A; LRH[o] = h; }
        ((float*)(ws + WS_SEGA))[item * 256 + c] = A; ((float*)(ws + WS_SEGH))[item * 256 + c] = h; }
    __syncthreads();
}
__device__ __forceinline__ void prep_ssd(const float* const* in, unsigned char* ws, int l, int item, int tid) {
    const bf16* PROJ = (const bf16*)(ws + WS_PROJ);
    const int t0 = item * 32; const float* cw = in[32] + l * 4 * 768; const float* cb = in[33] + l * 768;
#pragma unroll 2
    for (int it = 0; it < 6; ++it) { const int idx = tid + it * 512, t = idx / 96, cv = idx - t * 96, tok = t0 + t, pos = tok & (SEQ - 1);
        f4 a0 = *(const f4*)(cb + cv * 8), a1 = *(const f4*)(cb + cv * 8 + 4);
#pragma unroll
        for (int k = 0; k < 4; ++k) { u4 x = (u4){0u, 0u, 0u, 0u}; if (pos - 3 + k >= 0) x = *(const u4*)(PROJ + (size_t)(tok - 3 + k) * NINP + PC_SXBC + cv * 8);
            const f4 w0 = *(const f4*)(cw + k * 768 + cv * 8), w1 = *(const f4*)(cw + k * 768 + cv * 8 + 4);
            a0 += w0 * (f4){bflo(x.x), bfhi(x.x), bflo(x.y), bfhi(x.y)}; a1 += w1 * (f4){bflo(x.z), bfhi(x.z), bflo(x.w), bfhi(x.w)}; }
        u4 o; o.x = pk2(siluf_(a0.x), siluf_(a0.y)); o.y = pk2(siluf_(a0.z), siluf_(a0.w)); o.z = pk2(siluf_(a1.x), siluf_(a1.y)); o.w = pk2(siluf_(a1.z), siluf_(a1.w));
        *(u4*)((bf16*)(ws + WS_XBC) + (size_t)tok * 768 + cv * 8) = o; }
    if (tid < 128) { const int t = tid >> 2, hh = tid & 3, tok = t0 + t; const float dt = softplusf_(bf2f(PROJ[(size_t)tok * NINP + PC_SDT + hh]) + in[34][l * 4 + hh]);
        ((float*)(ws + WS_DT))[tok * 4 + hh] = dt; ((float*)(ws + WS_DEC))[tok * 4 + hh] = -dt * __expf(in[35][l * 4 + hh]); }
}
__device__ __forceinline__ void prep_rw(const float* const* in, unsigned char* ws, int l, int item, LAS unsigned char* lds, int tid) {
    const bf16* PROJ = (const bf16*)(ws + WS_PROJ); LAS float* P = (LAS float*)lds; LAS float* VV = (LAS float*)(lds + 32 * 832 * 4);
    const int t0 = item * 32; const float* mu = in[18] + l * 832;
    LAS float* V1 = VV + 256;
#pragma unroll
    for (int it = 0; it < 7; ++it) { const int idx = tid + it * 512; if (idx < 3328) { const int t = idx / 104, cv = idx - t * 104, tok = t0 + t;
        const bf16* pc = PROJ + (size_t)tok * NINP + PC_RW + cv * 8; const u4 cur = *(const u4*)pc; u4 prv = (u4){0u, 0u, 0u, 0u}; if (tok & (SEQ - 1)) prv = *(const u4*)(pc - NINP);
        const f4 m0 = *(const f4*)(mu + cv * 8), m1 = *(const f4*)(mu + cv * 8 + 4);
        const f4 c0 = (f4){bflo(cur.x), bfhi(cur.x), bflo(cur.y), bfhi(cur.y)}, c1 = (f4){bflo(cur.z), bfhi(cur.z), bflo(cur.w), bfhi(cur.w)};
        const f4 p0 = (f4){bflo(prv.x), bfhi(prv.x), bflo(prv.y), bfhi(prv.y)}, p1 = (f4){bflo(prv.z), bfhi(prv.z), bflo(prv.w), bfhi(prv.w)};
        f4 v0 = c0 + (p0 - c0) * m0, v1 = c1 + (p1 - c1) * m1;
        if (cv == 96 || cv == 97) { v0 = (f4){tanhf_(v0.x), tanhf_(v0.y), tanhf_(v0.z), tanhf_(v0.w)}; v1 = (f4){tanhf_(v1.x), tanhf_(v1.y), tanhf_(v1.z), tanhf_(v1.w)}; }
        else if (cv >= 100) { v0 = (f4){sigmoidf_(v0.x), sigmoidf_(v0.y), sigmoidf_(v0.z), sigmoidf_(v0.w)}; v1 = (f4){sigmoidf_(v1.x), sigmoidf_(v1.y), sigmoidf_(v1.z), sigmoidf_(v1.w)}; }
        *(LAS f4*)(P + t * 832 + cv * 8) = v0; *(LAS f4*)(P + t * 832 + cv * 8 + 4) = v1; } }
    if (l > 0) *(LAS f4*)(V1 + tid * 4) = *(const f4*)(in[25] + (size_t)(l - 1) * 2048 + tid * 4);
    __syncthreads();
    if (l > 0 && tid < 256) { const int t = tid >> 3, j = tid & 7; float s = 0.f;
#pragma unroll 4
        for (int c4 = 0; c4 < 64; ++c4) { const f4 pv = *(const LAS f4*)(P + t * 832 + 512 + 4 * c4); s += pv.x * V1[(4 * c4) * 8 + j] + pv.y * V1[(4 * c4 + 1) * 8 + j] + pv.z * V1[(4 * c4 + 2) * 8 + j] + pv.w * V1[(4 * c4 + 3) * 8 + j]; }
        VV[t * 8 + j] = s; }
    __syncthreads();
    const int half = tid >> 8, c = tid & 255, hh = c >> 6, lane = tid & 63;
    float zw[16], za[16], gg[16], zv[16];
    { const float w0 = in[19][l * 256 + c], a0 = in[21][l * 256 + c], v0 = l > 0 ? in[24][(l - 1) * 256 + c] : 0.f;
#pragma unroll
      for (int tt = 0; tt < 16; ++tt) { zw[tt] = w0; za[tt] = a0; gg[tt] = 0.f; zv[tt] = v0; } }
    const LAS float* ph = P + half * 16 * 832;
    { const float* w2p = in[20] + (size_t)l * 4096 + c; const float* a2p = in[22] + (size_t)l * 4096 + c;
#pragma unroll 1
      for (int j4 = 0; j4 < 4; ++j4) { const float wa = w2p[(4 * j4) * 256], wb = w2p[(4 * j4 + 1) * 256], wc_ = w2p[(4 * j4 + 2) * 256], wd_ = w2p[(4 * j4 + 3) * 256];
          const float aa = a2p[(4 * j4) * 256], ab = a2p[(4 * j4 + 1) * 256], ac = a2p[(4 * j4 + 2) * 256], ad = a2p[(4 * j4 + 3) * 256];
#pragma unroll
          for (int tt = 0; tt < 16; ++tt) { const f4 sw = *(const LAS f4*)(ph + tt * 832 + 768 + 4 * j4), sa = *(const LAS f4*)(ph + tt * 832 + 784 + 4 * j4);
              zw[tt] += sw.x * wa + sw.y * wb + sw.z * wc_ + sw.w * wd_; za[tt] += sa.x * aa + sa.y * ab + sa.z * ac + sa.w * ad; } } }
    { const float* g2p = in[23] + (size_t)l * 8192 + c;
#pragma unroll 1
      for (int j4 = 0; j4 < 8; ++j4) { const float ga = g2p[(4 * j4) * 256], gb = g2p[(4 * j4 + 1) * 256], gc = g2p[(4 * j4 + 2) * 256], gd = g2p[(4 * j4 + 3) * 256];
#pragma unroll
          for (int tt = 0; tt < 16; ++tt) { const f4 sg = *(const LAS f4*)(ph + tt * 832 + 800 + 4 * j4); gg[tt] += sg.x * ga + sg.y * gb + sg.z * gc + sg.w * gd; } } }
    if (l > 0) { const float* v2p = in[26] + (size_t)(l - 1) * 2048 + c;
#pragma unroll 1
      for (int j4 = 0; j4 < 2; ++j4) { const float va = v2p[(4 * j4) * 256], vb = v2p[(4 * j4 + 1) * 256], vc = v2p[(4 * j4 + 2) * 256], vd = v2p[(4 * j4 + 3) * 256];
#pragma unroll
          for (int tt = 0; tt < 16; ++tt) { const f4 sv = *(const LAS f4*)(VV + (half * 16 + tt) * 8 + 4 * j4); zv[tt] += sv.x * va + sv.y * vb + sv.z * vc + sv.w * vd; } } }
    const float kkw = in[27][l * 256 + c], kaw = in[28][l * 256 + c], rkw = in[29][l * 256 + c];
    float* VF = (float*)(ws + WS_VFIRST);
#pragma unroll
    for (int tt = 0; tt < 16; ++tt) { const int t = half * 16 + tt; const size_t o = (size_t)(t0 + t) * 256 + c; const LAS float* pr = P + t * 832;
        const float r = pr[c], k = pr[256 + c]; float v = pr[512 + c];
        const float wd = __expf(-0.6065306597126334f * sigmoidf_(zw[tt])), av = sigmoidf_(za[tt]), g = gg[tt];
        if (l > 0) v = v + (VF[o] - v) * sigmoidf_(zv[tt]); else VF[o] = v;
        float kk = k * kkw; const float nrm = sqrtf(wave_sum(kk * kk)); kk = kk / fmaxf(nrm, 1e-12f);
        const float k2 = k * (1.f + (av - 1.f) * kaw);
        const float bon = wave_sum(r * k2 * rkw);
        ((bf16*)(ws + WS_RWR))[o] = (bf16)pk2(r, 0.f); ((bf16*)(ws + WS_RWK))[o] = (bf16)pk2(k2, 0.f); ((bf16*)(ws + WS_RWV))[o] = (bf16)pk2(v, 0.f);
        ((bf16*)(ws + WS_RWKK))[o] = (bf16)pk2(kk, 0.f); ((bf16*)(ws + WS_RWB))[o] = (bf16)pk2(kk * av, 0.f); ((bf16*)(ws + WS_RWG))[o] = (bf16)pk2(g, 0.f);
        ((float*)(ws + WS_RWW))[o] = wd;
        if (lane == 0) ((float*)(ws + WS_RWBON))[(t0 + t) * 4 + hh] = bon;
        asm volatile("" ::: "memory"); }
    __syncthreads();
}
__device__ __forceinline__ void phase_prep(const float* const* in, unsigned char* ws, int l, LAS unsigned char* lds, int tid) {
    constexpr int N_L = 512, N_R = 512, N_S = 512;
    for (int it = blockIdx.x; it < N_L + N_R + N_S; it += gridDim.x) {
        if (it < N_L) {
#ifndef SKIP_PL
            prep_lru(in, ws, l, it, lds, tid);
#endif
        } else if (it < N_L + N_R) {
#ifndef SKIP_PR
            prep_rw(in, ws, l, it - N_L, lds, tid);
#endif
        } else {
#ifndef SKIP_PS
            prep_ssd(in, ws, l, it - N_L - N_R, tid);
#endif
        }
    }
}

template <int MODE> __device__ __forceinline__ void scan_rw(unsigned char* ws, int item, LAS unsigned char* lds, int tid) {
    LAS float* LW = (LAS float*)lds; LAS float* LKK = LW + 2048; LAS float* LB = LW + 4096; LAS float* LK = LW + 6144; LAS float* LR = LW + 8192; LAS float* LV = LW + 10240; LAS float* LY = LW + 12288;
    const int bh = item / NCH, ch = item % NCH, hh = bh & 3, tokb = (bh >> 2) * SEQ + ch * CHL, nsub = CHL / 32;
    const int st = tid >> 4, sc4 = (tid & 15) * 4, row = tid >> 3, sl = tid & 7;
    const bf16* gR = (const bf16*)(ws + WS_RWR); const bf16* gK = (const bf16*)(ws + WS_RWK); const bf16* gV = (const bf16*)(ws + WS_RWV); const bf16* gKK = (const bf16*)(ws + WS_RWKK); const bf16* gB = (const bf16*)(ws + WS_RWB);
    const float* gW = (const float*)(ws + WS_RWW); bf16* gY = (bf16*)(ws + WS_YRW);
    float* gU = (float*)(ws + WS_RWU) + (size_t)item * 4096 + row * 64 + sl * 8; float* gP = (float*)(ws + WS_RWP) + (size_t)item * 4096 + row * 64 + sl * 8;
    f2 s[4], p[4];
    if (MODE == 1) { const f4 a = *(const f4*)gU, c = *(const f4*)(gU + 4); s[0] = LO2(a); s[1] = HI2(a); s[2] = LO2(c); s[3] = HI2(c); }
    else {
#pragma unroll
        for (int i = 0; i < 4; ++i) { s[i] = (f2){0.f, 0.f}; p[i] = (f2){(sl * 8 + 2 * i == row) ? 1.f : 0.f, (sl * 8 + 2 * i + 1 == row) ? 1.f : 0.f}; } }
    u2 pr, pk, pv, pkk, pb; f4 pw;
    { const size_t o = (size_t)(tokb + st) * 256 + hh * 64 + sc4; if (MODE == 1) pr = *(const u2*)(gR + o); pk = *(const u2*)(gK + o); pv = *(const u2*)(gV + o); pkk = *(const u2*)(gKK + o); pb = *(const u2*)(gB + o); pw = *(const f4*)(gW + o); }
    for (int sub = 0; sub < nsub; ++sub) {
        const int so = st * 64 + sc4;
        *(LAS f4*)(LW + so) = pw; if (MODE == 1) *(LAS f4*)(LR + so) = (f4){bflo(pr.x), bfhi(pr.x), bflo(pr.y), bfhi(pr.y)}; *(LAS f4*)(LK + so) = (f4){bflo(pk.x), bfhi(pk.x), bflo(pk.y), bfhi(pk.y)};
        *(LAS f4*)(LV + so) = (f4){bflo(pv.x), bfhi(pv.x), bflo(pv.y), bfhi(pv.y)}; *(LAS f4*)(LKK + so) = (f4){bflo(pkk.x), bfhi(pkk.x), bflo(pkk.y), bfhi(pkk.y)}; *(LAS f4*)(LB + so) = (f4){bflo(pb.x), bfhi(pb.x), bflo(pb.y), bfhi(pb.y)};
        lds_barrier();
        if (sub + 1 < nsub) { const size_t o = (size_t)(tokb + (sub + 1) * 32 + st) * 256 + hh * 64 + sc4; if (MODE == 1) pr = *(const u2*)(gR + o); pk = *(const u2*)(gK + o); pv = *(const u2*)(gV + o); pkk = *(const u2*)(gKK + o); pb = *(const u2*)(gB + o); pw = *(const f4*)(gW + o); }
        {
            const int ob = sl * 8; f4 w0, w1, a0, a1, b0, b1, k0, k1, r0 = (f4){0.f, 0.f, 0.f, 0.f}, r1 = r0; float vv;
#define RW_LOAD(T) { const int o_ = ((T) & 31) * 64 + ob; w0 = *(const LAS f4*)(LW + o_); w1 = *(const LAS f4*)(LW + o_ + 4); a0 = *(const LAS f4*)(LKK + o_); a1 = *(const LAS f4*)(LKK + o_ + 4); b0 = *(const LAS f4*)(LB + o_); b1 = *(const LAS f4*)(LB + o_ + 4); \
            k0 = *(const LAS f4*)(LK + o_); k1 = *(const LAS f4*)(LK + o_ + 4); if (MODE == 1) { r0 = *(const LAS f4*)(LR + o_); r1 = *(const LAS f4*)(LR + o_ + 4); } vv = LV[((T) & 31) * 64 + row]; }
            RW_LOAD(0)
#pragma unroll 2
            for (int t = 0; t < 32; ++t) {
                const f4 cw0 = w0, cw1 = w1, ca0 = a0, ca1 = a1, cb0 = b0, cb1 = b1, ck0 = k0, ck1 = k1, cr0 = r0, cr1 = r1; const float cv = vv;
                RW_LOAD(t + 1)
                f2 d2 = s[0] * LO2(ca0); d2 = s[1] * HI2(ca0) + d2; d2 = s[2] * LO2(ca1) + d2; d2 = s[3] * HI2(ca1) + d2;
                if (MODE == 0) { f2 e2 = p[0] * LO2(ca0); e2 = p[1] * HI2(ca0) + e2; e2 = p[2] * LO2(ca1) + e2; e2 = p[3] * HI2(ca1) + e2;
                    const float sp = -red8(e2.x + e2.y); const f2 sp2 = (f2){sp, sp};
                    p[0] = p[0] * LO2(cw0) + sp2 * LO2(cb0); p[1] = p[1] * HI2(cw0) + sp2 * HI2(cb0); p[2] = p[2] * LO2(cw1) + sp2 * LO2(cb1); p[3] = p[3] * HI2(cw1) + sp2 * HI2(cb1); }
                const float sa = -red8(d2.x + d2.y); const f2 sa2 = (f2){sa, sa}, cv2 = (f2){cv, cv};
                s[0] = s[0] * LO2(cw0) + sa2 * LO2(cb0) + cv2 * LO2(ck0); s[1] = s[1] * HI2(cw0) + sa2 * HI2(cb0) + cv2 * HI2(ck0);
                s[2] = s[2] * LO2(cw1) + sa2 * LO2(cb1) + cv2 * LO2(ck1); s[3] = s[3] * HI2(cw1) + sa2 * HI2(cb1) + cv2 * HI2(ck1);
                if (MODE == 1) { f2 y2 = s[0] * LO2(cr0); y2 = s[1] * HI2(cr0) + y2; y2 = s[2] * LO2(cr1) + y2; y2 = s[3] * HI2(cr1) + y2;
                    LY[t * 64 + row] = red8(y2.x + y2.y); } }
#undef RW_LOAD
        }
        lds_barrier();
        if (MODE == 1) { const f4 y = *(const LAS f4*)(LY + so); u2 w; w.x = pk2(y.x, y.y); w.y = pk2(y.z, y.w); *(u2*)(gY + (size_t)(tokb + sub * 32 + st) * 256 + hh * 64 + sc4) = w; }
    }
    if (MODE == 0) { *(f4*)gU = (f4){s[0].x, s[0].y, s[1].x, s[1].y}; *(f4*)(gU + 4) = (f4){s[2].x, s[2].y, s[3].x, s[3].y}; *(f4*)gP = (f4){p[0].x, p[0].y, p[1].x, p[1].y}; *(f4*)(gP + 4) = (f4){p[2].x, p[2].y, p[3].x, p[3].y}; }
    __syncthreads();
}
__device__ __forceinline__ void combine_rw(unsigned char* ws, int w, int lane) {
    const int bh = w >> 6, row = w & 63;
    const float* gP = (const float*)(ws + WS_RWP) + (size_t)bh * NCH * 4096 + lane; float* gU = (float*)(ws + WS_RWU) + (size_t)bh * NCH * 4096 + row * 64 + lane;
    float pc[64], s = 0.f, u = gU[0];
#pragma unroll
    for (int i = 0; i < 64; ++i) pc[i] = gP[i * 64];
#pragma unroll 1
    for (int c = 0; c < NCH; ++c) {
        float pn[64], un = 0.f; const int cn = (c + 1 < NCH) ? c + 1 : c;
#pragma unroll
        for (int i = 0; i < 64; ++i) pn[i] = gP[(size_t)cn * 4096 + i * 64];
        un = gU[(size_t)cn * 4096];
        gU[(size_t)c * 4096] = s;
        float n0 = u, n1 = 0.f; const int si = __builtin_bit_cast(int, s);
#pragma unroll
        for (int i = 0; i < 64; i += 2) { n0 += __builtin_bit_cast(float, __builtin_amdgcn_readlane(si, i)) * pc[i]; n1 += __builtin_bit_cast(float, __builtin_amdgcn_readlane(si, i + 1)) * pc[i + 1]; }
        s = n0 + n1; u = un;
#pragma unroll
        for (int i = 0; i < 64; ++i) pc[i] = pn[i];
    }
}
template <int MODE> __device__ __forceinline__ void scan_gla(const float* const* in, unsigned char* ws, int l, int item, LAS unsigned char* lds, int tid) {
    LAS float* LA = (LAS float*)lds; LAS float* LK = LA + 1024; LAS float* LQ = LA + 2048; LAS float* LV = LA + 3072; LAS float* LO = LA + 5120;
    const bf16* PROJ = (const bf16*)(ws + WS_PROJ); bf16* gO = (bf16*)(ws + WS_OGLA);
    const int bh = item / NCH, ch = item % NCH, hh = bh & 3, tokb = (bh >> 2) * SEQ + ch * CHL, nsub = CHL / 32;
    const int st = tid >> 4, si = tid & 15, vcol = tid >> 3, sl = tid & 7;
    float up0[16], up1[16];
#pragma unroll
    for (int r = 0; r < 16; ++r) { up0[r] = in[8][(l * 16 + r) * 128 + hh * 32 + 2 * si]; up1[r] = in[8][(l * 16 + r) * 128 + hh * 32 + 2 * si + 1]; }
    const float bi0 = in[9][l * 128 + hh * 32 + 2 * si], bi1 = in[9][l * 128 + hh * 32 + 2 * si + 1];
    float* gU = (float*)(ws + WS_GLU) + (size_t)item * 2048 + vcol * 32 + 4 * sl;
    float s[4] = {0.f, 0.f, 0.f, 0.f}, dp[4] = {1.f, 1.f, 1.f, 1.f};
    if (MODE == 1) { const f4 a = *(const f4*)gU; s[0] = a.x; s[1] = a.y; s[2] = a.z; s[3] = a.w; }
    u4 ps0, ps1; unsigned pq = 0, pk; u2 pv;
    { const bf16* p = PROJ + (size_t)(tokb + st) * NINP; ps0 = *(const u4*)(p + PC_GSTEM); ps1 = *(const u4*)(p + PC_GSTEM + 8); if (MODE == 1) pq = *(const unsigned*)(p + PC_GQ + hh * 32 + 2 * si); pk = *(const unsigned*)(p + PC_GK + hh * 32 + 2 * si); pv = *(const u2*)(p + PC_GV + hh * 64 + 4 * si); }
    for (int sub = 0; sub < nsub; ++sub) {
        { const unsigned sw[8] = {ps0.x, ps0.y, ps0.z, ps0.w, ps1.x, ps1.y, ps1.z, ps1.w}; float z0 = bi0, z1 = bi1;
#pragma unroll
          for (int r = 0; r < 8; ++r) { const float e0 = bflo(sw[r]), e1 = bfhi(sw[r]); z0 += e0 * up0[2 * r] + e1 * up0[2 * r + 1]; z1 += e0 * up1[2 * r] + e1 * up1[2 * r + 1]; }
          const float l0 = fminf(z0, 0.f) - log1pf(__expf(-fabsf(z0))), l1 = fminf(z1, 0.f) - log1pf(__expf(-fabsf(z1)));
          const int o = st * 32 + 2 * si; LA[o] = __expf(l0 * 0.0625f); LA[o + 1] = __expf(l1 * 0.0625f); LK[o] = bflo(pk); LK[o + 1] = bfhi(pk); if (MODE == 1) { LQ[o] = bflo(pq); LQ[o + 1] = bfhi(pq); }
          *(LAS f4*)(LV + st * 64 + 4 * si) = (f4){bflo(pv.x), bfhi(pv.x), bflo(pv.y), bfhi(pv.y)}; }
        lds_barrier();
        if (sub + 1 < nsub) { const bf16* p = PROJ + (size_t)(tokb + (sub + 1) * 32 + st) * NINP; ps0 = *(const u4*)(p + PC_GSTEM); ps1 = *(const u4*)(p + PC_GSTEM + 8); if (MODE == 1) pq = *(const unsigned*)(p + PC_GQ + hh * 32 + 2 * si); pk = *(const unsigned*)(p + PC_GK + hh * 32 + 2 * si); pv = *(const u2*)(p + PC_GV + hh * 64 + 4 * si); }
        {   f4 al, kk, qq = (f4){0.f, 0.f, 0.f, 0.f}; float vv;
#define GL_LOAD(T) { const int o_ = ((T) & 31) * 32 + 4 * sl; al = *(const LAS f4*)(LA + o_); kk = *(const LAS f4*)(LK + o_); if (MODE == 1) qq = *(const LAS f4*)(LQ + o_); vv = LV[((T) & 31) * 64 + vcol]; }
            GL_LOAD(0)
#pragma unroll 4
            for (int t = 0; t < 32; ++t) { const f4 ca = al, ck = kk, cq = qq; const float cv = vv;
                GL_LOAD(t + 1)
                s[0] = s[0] * ca.x + ck.x * cv; s[1] = s[1] * ca.y + ck.y * cv; s[2] = s[2] * ca.z + ck.z * cv; s[3] = s[3] * ca.w + ck.w * cv;
                if (MODE == 0) { dp[0] *= ca.x; dp[1] *= ca.y; dp[2] *= ca.z; dp[3] *= ca.w; }
                else { const float o = (s[0] * cq.x + s[1] * cq.y) + (s[2] * cq.z + s[3] * cq.w); LO[t * 64 + vcol] = red8(o) * 0.17677669529663687f; } }
#undef GL_LOAD
        }
        lds_barrier();
        if (MODE == 1) { const f4 y = *(const LAS f4*)(LO + st * 64 + 4 * si); u2 w; w.x = pk2(y.x, y.y); w.y = pk2(y.z, y.w); *(u2*)(gO + (size_t)(tokb + sub * 32 + st) * 256 + hh * 64 + 4 * si) = w; }
    }
    if (MODE == 0) { *(f4*)gU = (f4){s[0], s[1], s[2], s[3]}; if (vcol == 0) *(f4*)((float*)(ws + WS_GLD) + item * 32 + 4 * sl) = (f4){dp[0], dp[1], dp[2], dp[3]}; }
    __syncthreads();
}
template <int MODE> __device__ __forceinline__ void scan_ssd(unsigned char* ws, int item, LAS unsigned char* lds, int tid) {
    LAS float* LB = (LAS float*)lds; LAS float* LC = LB + 4096; LAS float* LX = LB + 8192; LAS float* LD = LB + 10240; LAS float* LY = LB + 10304;
    const bf16* XBC = (const bf16*)(ws + WS_XBC); const float* DT = (const float*)(ws + WS_DT); const float* DEC = (const float*)(ws + WS_DEC); bf16* gY = (bf16*)(ws + WS_YSSD);
    const int bh = item / NCH, ch = item % NCH, hh = bh & 3, tokb = (bh >> 2) * SEQ + ch * CHL, nsub = CHL / 32;
    const int st = tid >> 4, si = tid & 15, p = tid >> 3, sl = tid & 7, g = hh >> 1;
    float* gU = (float*)(ws + WS_SSU) + (size_t)item * 8192 + p * 128 + 16 * sl;
    f2 s[8]; float dprod = 1.f;
#pragma unroll
    for (int i = 0; i < 4; ++i) { f4 a = (f4){0.f, 0.f, 0.f, 0.f}; if (MODE == 1) a = *(const f4*)(gU + 4 * i); s[2 * i] = LO2(a); s[2 * i + 1] = HI2(a); }
    u4 pb, pc = (u4){0u, 0u, 0u, 0u}; u2 px; float pdt, pdec;
    { const size_t tok = tokb + st; const bf16* q = XBC + tok * 768; pb = *(const u4*)(q + 256 + g * 128 + 8 * si); if (MODE == 1) pc = *(const u4*)(q + 512 + g * 128 + 8 * si); px = *(const u2*)(q + hh * 64 + 4 * si); pdt = DT[tok * 4 + hh]; pdec = DEC[tok * 4 + hh]; }
    for (int sub = 0; sub < nsub; ++sub) {
        { const int o = st * 128 + 8 * si;
          *(LAS f4*)(LB + o) = (f4){bflo(pb.x), bfhi(pb.x), bflo(pb.y), bfhi(pb.y)}; *(LAS f4*)(LB + o + 4) = (f4){bflo(pb.z), bfhi(pb.z), bflo(pb.w), bfhi(pb.w)};
          if (MODE == 1) { *(LAS f4*)(LC + o) = (f4){bflo(pc.x), bfhi(pc.x), bflo(pc.y), bfhi(pc.y)}; *(LAS f4*)(LC + o + 4) = (f4){bflo(pc.z), bfhi(pc.z), bflo(pc.w), bfhi(pc.w)}; }
          *(LAS f4*)(LX + st * 64 + 4 * si) = (f4){bflo(px.x) * pdt, bfhi(px.x) * pdt, bflo(px.y) * pdt, bfhi(px.y) * pdt};
          if (si == 0) LD[st] = pdec; }
        lds_barrier();
        if (sub + 1 < nsub) { const size_t tok = tokb + (sub + 1) * 32 + st; const bf16* q = XBC + tok * 768; pb = *(const u4*)(q + 256 + g * 128 + 8 * si); if (MODE == 1) pc = *(const u4*)(q + 512 + g * 128 + 8 * si); px = *(const u2*)(q + hh * 64 + 4 * si); pdt = DT[tok * 4 + hh]; pdec = DEC[tok * 4 + hh]; }
        {   f4 bb[4], cc[4]; float xv, dc;
#pragma unroll
            for (int q4 = 0; q4 < 4; ++q4) cc[q4] = (f4){0.f, 0.f, 0.f, 0.f};
#define SS_LOAD(T) { const int o_ = ((T) & 31) * 128 + 16 * sl; _Pragma("unroll") for (int q4 = 0; q4 < 4; ++q4) { bb[q4] = *(const LAS f4*)(LB + o_ + 4 * q4); if (MODE == 1) cc[q4] = *(const LAS f4*)(LC + o_ + 4 * q4); } xv = LX[((T) & 31) * 64 + p]; dc = LD[(T) & 31]; }
            SS_LOAD(0)
#pragma unroll 2
            for (int t = 0; t < 32; ++t) { f4 cb_[4], cc_[4]; const float cx = xv, cd = dc;
#pragma unroll
                for (int q4 = 0; q4 < 4; ++q4) { cb_[q4] = bb[q4]; cc_[q4] = cc[q4]; }
                SS_LOAD(t + 1)
                if (MODE == 0) dprod *= cd;
                const f2 cd2 = (f2){cd, cd}, cx2 = (f2){cx, cx}; f2 y2 = (f2){0.f, 0.f};
#pragma unroll
                for (int q4 = 0; q4 < 4; ++q4) {
                    s[2 * q4] = s[2 * q4] * cd2 + LO2(cb_[q4]) * cx2; s[2 * q4 + 1] = s[2 * q4 + 1] * cd2 + HI2(cb_[q4]) * cx2;
                    if (MODE == 1) { y2 = s[2 * q4] * LO2(cc_[q4]) + y2; y2 = s[2 * q4 + 1] * HI2(cc_[q4]) + y2; } }
                if (MODE == 1) LY[t * 64 + p] = red8(y2.x + y2.y); }
#undef SS_LOAD
        }
        lds_barrier();
        if (MODE == 1) { const f4 y = *(const LAS f4*)(LY + st * 64 + 4 * si); u2 w; w.x = pk2(y.x, y.y); w.y = pk2(y.z, y.w); *(u2*)(gY + (size_t)(tokb + sub * 32 + st) * 256 + hh * 64 + 4 * si) = w; }
    }
    if (MODE == 0) {
#pragma unroll
        for (int i = 0; i < 4; ++i) *(f4*)(gU + 4 * i) = (f4){s[2 * i].x, s[2 * i].y, s[2 * i + 1].x, s[2 * i + 1].y};
        if (tid == 0) ((float*)(ws + WS_SSD))[item] = dprod; }
    __syncthreads();
}
typedef short s8v __attribute__((ext_vector_type(8)));
#define MFMA16(a, b, c) __builtin_amdgcn_mfma_f32_16x16x32_bf16(a, b, c, 0, 0, 0)
constexpr int SP = 136;
__device__ __forceinline__ bf16 u4_elem(const u4& w, int e) { const unsigned x = (e >> 1) == 0 ? w.x : (e >> 1) == 1 ? w.y : (e >> 1) == 2 ? w.z : w.w; return (bf16)((e & 1) ? (x >> 16) : (x & 0xffffu)); }
__device__ __forceinline__ void ssd_cumsum(unsigned char* ws, int tok0, int g, LAS float* CS, int tid) {
    const int wave = tid >> 6, lane = tid & 63;
    if (wave < 2) { const float* DA = (const float*)(ws + WS_DEC); const float a0 = DA[(size_t)(tok0 + 2 * lane) * 4 + 2 * g + wave], a1 = DA[(size_t)(tok0 + 2 * lane + 1) * 4 + 2 * g + wave]; float v = a0 + a1;
#pragma unroll
        for (int o = 1; o < 64; o <<= 1) { const float t = __shfl_up(v, o); if (lane >= o) v += t; }
        CS[wave * 128 + 2 * lane] = v - a1; CS[wave * 128 + 2 * lane + 1] = v; }
}
__device__ __forceinline__ void ssd_passA(unsigned char* ws, int item, LAS unsigned char* lds, int tid) {
    const int b = item >> 7, g = (item >> 6) & 1, ch = item & 63, tok0 = b * SEQ + ch * 128;
    LAS bf16* LB = (LAS bf16*)(lds + 34816); LAS bf16* LX = (LAS bf16*)(lds + 69632); LAS float* CS = (LAS float*)(lds + 139264);
    const bf16* XBC = (const bf16*)(ws + WS_XBC); const float* DT = (const float*)(ws + WS_DT);
    ssd_cumsum(ws, tok0, g, CS, tid);
    const int sr = tid >> 2, part = tid & 3;
    { const bf16* q = XBC + (size_t)(tok0 + sr) * 768 + 256 + g * 128 + part * 32;
#pragma unroll
      for (int v = 0; v < 4; ++v) { const u4 w = *(const u4*)(q + 8 * v);
#pragma unroll
          for (int e = 0; e < 8; ++e) LB[(part * 32 + 8 * v + e) * SP + sr] = u4_elem(w, e); } }
    lds_barrier();
    { const int hl = part >> 1, p0 = (part & 1) * 32, h = 2 * g + hl; const float sc = DT[(size_t)(tok0 + sr) * 4 + h] * __expf(CS[hl * 128 + 127] - CS[hl * 128 + sr]);
      const bf16* q = XBC + (size_t)(tok0 + sr) * 768 + h * 64 + p0;
#pragma unroll
      for (int v = 0; v < 4; ++v) { const u4 w = *(const u4*)(q + 8 * v);
#pragma unroll
          for (int e = 0; e < 8; ++e) LX[(hl * 64 + p0 + 8 * v + e) * SP + sr] = (bf16)pk2(bf2f(u4_elem(w, e)) * sc, 0.f); } }
    lds_barrier();
    const int wave = tid >> 6, lane = tid & 63, r16 = lane & 15, q4 = lane >> 4, hl = wave >> 2, pt = wave & 3;
    f32x4 acc[8];
#pragma unroll
    for (int nt = 0; nt < 8; ++nt) acc[nt] = (f32x4){0.f, 0.f, 0.f, 0.f};
#pragma unroll
    for (int ks = 0; ks < 4; ++ks) { const s8v af = *(const LAS s8v*)(LX + (hl * 64 + 16 * pt + r16) * SP + 32 * ks + 8 * q4);
#pragma unroll
        for (int nt = 0; nt < 8; ++nt) { const s8v bfr = *(const LAS s8v*)(LB + (16 * nt + r16) * SP + 32 * ks + 8 * q4); acc[nt] = MFMA16(af, bfr, acc[nt]); } }
    float* gU = (float*)(ws + WS_SSU) + ((size_t)(b * 4 + 2 * g + hl) * NCS + ch) * 8192;
#pragma unroll
    for (int nt = 0; nt < 8; ++nt)
#pragma unroll
        for (int i = 0; i < 4; ++i) gU[(16 * pt + 4 * q4 + i) * 128 + 16 * nt + r16] = acc[nt][i];
    if (tid < 2) ((float*)(ws + WS_SSD))[(b * 4 + 2 * g + tid) * NCS + ch] = __expf(CS[tid * 128 + 127]);
    __syncthreads();
}
__device__ __forceinline__ void ssd_passB(unsigned char* ws, int item, LAS unsigned char* lds, int tid) {
    const int b = item >> 7, g = (item >> 6) & 1, ch = item & 63, tok0 = b * SEQ + ch * 128;
    LAS bf16* LC = (LAS bf16*)lds; LAS bf16* LB = (LAS bf16*)(lds + 34816); LAS bf16* LX = (LAS bf16*)(lds + 69632); LAS bf16* LS = (LAS bf16*)(lds + 104448); LAS float* CS = (LAS float*)(lds + 139264);
    const bf16* XBC = (const bf16*)(ws + WS_XBC); const float* DT = (const float*)(ws + WS_DT); bf16* gY = (bf16*)(ws + WS_YSSD);
    ssd_cumsum(ws, tok0, g, CS, tid);
    const int sr = tid >> 2, part = tid & 3;
    { const bf16* q = XBC + (size_t)(tok0 + sr) * 768;
#pragma unroll
      for (int v = 0; v < 4; ++v) { *(LAS u4*)(LB + sr * SP + part * 32 + 8 * v) = *(const u4*)(q + 256 + g * 128 + part * 32 + 8 * v); *(LAS u4*)(LC + sr * SP + part * 32 + 8 * v) = *(const u4*)(q + 512 + g * 128 + part * 32 + 8 * v); } }
    { const int hl = part >> 1, p0 = (part & 1) * 32, h = 2 * g + hl; const float sc = DT[(size_t)(tok0 + sr) * 4 + h];
      const bf16* q = XBC + (size_t)(tok0 + sr) * 768 + h * 64 + p0;
#pragma unroll
      for (int v = 0; v < 4; ++v) { const u4 w = *(const u4*)(q + 8 * v);
#pragma unroll
          for (int e = 0; e < 8; ++e) LX[(hl * 64 + p0 + 8 * v + e) * SP + sr] = (bf16)pk2(bf2f(u4_elem(w, e)) * sc, 0.f); } }
    { const int hl = sr >> 6, p = sr & 63; const float* gS = (const float*)(ws + WS_SSU) + ((size_t)(b * 4 + 2 * g + hl) * NCS + ch) * 8192 + p * 128 + part * 32;
#pragma unroll
      for (int v = 0; v < 4; ++v) { const f4 x0 = *(const f4*)(gS + 8 * v), x1 = *(const f4*)(gS + 8 * v + 4); u4 w; w.x = pk2(x0.x, x0.y); w.y = pk2(x0.z, x0.w); w.z = pk2(x1.x, x1.y); w.w = pk2(x1.z, x1.w); *(LAS u4*)(LS + sr * SP + part * 32 + 8 * v) = w; } }
    lds_barrier();
    const int wave = tid >> 6, lane = tid & 63, r16 = lane & 15, q4 = lane >> 4, lt = wave;
    f32x4 cb[8];
#pragma unroll
    for (int st = 0; st < 8; ++st) cb[st] = (f32x4){0.f, 0.f, 0.f, 0.f};
#pragma unroll
    for (int ks = 0; ks < 4; ++ks) { const s8v af = *(const LAS s8v*)(LC + (16 * lt + r16) * SP + 32 * ks + 8 * q4);
#pragma unroll
        for (int st = 0; st < 8; ++st) { const s8v bfr = *(const LAS s8v*)(LB + (16 * st + r16) * SP + 32 * ks + 8 * q4); cb[st] = MFMA16(af, bfr, cb[st]); } }
#pragma unroll 1
    for (int hl = 0; hl < 2; ++hl) {
        lds_barrier();
#pragma unroll
        for (int st = 0; st < 8; ++st)
#pragma unroll
            for (int i = 0; i < 4; ++i) { const int l = 16 * lt + 4 * q4 + i, s2 = 16 * st + r16; const float m = (s2 <= l) ? cb[st][i] * __expf(CS[hl * 128 + l] - CS[hl * 128 + s2]) : 0.f; LB[l * SP + s2] = (bf16)pk2(m, 0.f); }
        lds_barrier();
        f32x4 yd[4], yo[4];
#pragma unroll
        for (int p4 = 0; p4 < 4; ++p4) { yd[p4] = (f32x4){0.f, 0.f, 0.f, 0.f}; yo[p4] = (f32x4){0.f, 0.f, 0.f, 0.f}; }
#pragma unroll
        for (int ks = 0; ks < 4; ++ks) { const s8v mf = *(const LAS s8v*)(LB + (16 * lt + r16) * SP + 32 * ks + 8 * q4), cf = *(const LAS s8v*)(LC + (16 * lt + r16) * SP + 32 * ks + 8 * q4);
#pragma unroll
            for (int p4 = 0; p4 < 4; ++p4) { const s8v xf = *(const LAS s8v*)(LX + (hl * 64 + 16 * p4 + r16) * SP + 32 * ks + 8 * q4), sf = *(const LAS s8v*)(LS + (hl * 64 + 16 * p4 + r16) * SP + 32 * ks + 8 * q4);
                yd[p4] = MFMA16(xf, mf, yd[p4]); yo[p4] = MFMA16(sf, cf, yo[p4]); } }
        const float el = __expf(CS[hl * 128 + 16 * lt + r16]);
#pragma unroll
        for (int p4 = 0; p4 < 4; ++p4) { const f32x4 y = yd[p4] + yo[p4] * el; u2 w; w.x = pk2(y[0], y[1]); w.y = pk2(y[2], y[3]);
            *(u2*)(gY + (size_t)(tok0 + 16 * lt + r16) * 256 + (2 * g + hl) * 64 + 16 * p4 + 4 * q4) = w; }
    }
    __syncthreads();
}
__device__ __forceinline__ void scan_lru_carry(unsigned char* ws, int tid) {
    const float* SA = (const float*)(ws + WS_SEGA); const float* SH = (const float*)(ws + WS_SEGH); float* CY = (float*)(ws + WS_CARRY);
    const int b = tid >> 8, c = tid & 255; float h = 0.f;
#pragma unroll 8
    for (int sg = 0; sg < 256; ++sg) { const int o = (b * 256 + sg) * 256 + c; CY[o] = h; h = SA[o] * h + SH[o]; }
}
__device__ __forceinline__ void combine_gla(unsigned char* ws, int bh, int tid) {
    float* gU = (float*)(ws + WS_GLU) + (size_t)bh * NCH * 2048 + tid * 4; const float* gD = (const float*)(ws + WS_GLD) + bh * NCH * 32 + (tid & 7) * 4; f4 s = (f4){0.f, 0.f, 0.f, 0.f};
#pragma unroll 4
    for (int c = 0; c < NCH; ++c) { const f4 u = *(const f4*)(gU + (size_t)c * 2048), d = *(const f4*)(gD + c * 32); *(f4*)(gU + (size_t)c * 2048) = s; s = s * d + u; }
}
__device__ __forceinline__ void combine_ssd(unsigned char* ws, int q, int tid) {
    const int bh = q >> 2; float* gU = (float*)(ws + WS_SSU) + (size_t)bh * NCS * 8192 + (q & 3) * 2048 + tid * 4; const float* gD = (const float*)(ws + WS_SSD) + bh * NCS; f4 s = (f4){0.f, 0.f, 0.f, 0.f};
#pragma unroll 4
    for (int c = 0; c < NCS; ++c) { const f4 u = *(const f4*)(gU + (size_t)c * 8192); const float d = gD[c]; *(f4*)(gU + (size_t)c * 8192) = s; s = s * d + u; }
}
template <int MODE> __device__ __forceinline__ void phase_scan(const float* const* in, unsigned char* ws, int l, LAS unsigned char* lds, int tid) {
    constexpr int NI = 8 * NCH;
    for (int it = blockIdx.x; it < 3 * NI; it += gridDim.x) {
        if (it < NI) scan_rw<MODE>(ws, it, lds, tid);
        else if (it < 2 * NI) { if (MODE == 0) ssd_passA(ws, it - NI, lds, tid); else ssd_passB(ws, it - NI, lds, tid); }
        else scan_gla<MODE>(in, ws, l, it - 2 * NI, lds, tid);
    }
}
__device__ __forceinline__ void phase_combine(const float* const* in, unsigned char* ws, int l, LAS unsigned char* lds, int tid) {
    const int wave = __builtin_amdgcn_readfirstlane(tid >> 6), lane = tid & 63; constexpr int NCW = 105;
    if ((int)gridDim.x > NCW + 8) {
        if ((int)blockIdx.x < 64) combine_rw(ws, blockIdx.x * 8 + wave, lane);
        else if ((int)blockIdx.x < 72) combine_gla(ws, blockIdx.x - 64, tid);
        else if ((int)blockIdx.x < 104) combine_ssd(ws, blockIdx.x - 72, tid);
        else if ((int)blockIdx.x == 104) scan_lru_carry(ws, tid);
        else phase_convert(in, ws, l, 3, lds, ((int)blockIdx.x - NCW) * 8 + wave, ((int)gridDim.x - NCW) * 8, wave, lane);
    } else {
        for (int it = blockIdx.x; it < NCW; it += gridDim.x) {
            if (it < 64) combine_rw(ws, it * 8 + wave, lane);
            else if (it < 72) combine_gla(ws, it - 64, tid);
            else if (it < 104) combine_ssd(ws, it - 72, tid);
            else scan_lru_carry(ws, tid);
        }
        phase_convert(in, ws, l, 3, lds, blockIdx.x * 8 + wave, gridDim.x * 8, wave, lane);
    }
}
__device__ __forceinline__ float red16(float x) { x += __shfl_xor(x, 1); x += __shfl_xor(x, 2); x += __shfl_xor(x, 4); x += __shfl_xor(x, 8); return x; }
__device__ __forceinline__ void phase_post(const float* const* in, unsigned char* ws, int l, int gw, int NGW, int lane) {
    const bf16* PROJ = (const bf16*)(ws + WS_PROJ); bf16* Y = (bf16*)(ws + WS_Y); const int c = 4 * lane, hh = lane >> 4;
    const f4 gnorm = *(const f4*)(in[10] + l * 64 + (c & 63)), gnw = *(const f4*)(in[30] + l * 256 + c), gnb = *(const f4*)(in[31] + l * 256 + c), snw = *(const f4*)(in[37] + l * 256 + c);
    const float dsk = in[36][l * 4 + hh];
    for (int tok = gw; tok < M; tok += NGW) { const bf16* pp = PROJ + (size_t)tok * NINP; const size_t o = (size_t)tok * 256 + c; bf16* yo = Y + (size_t)tok * D + c;
        { const u2 ov = *(const u2*)((const bf16*)(ws + WS_OGLA) + o), gv = *(const u2*)(pp + PC_GG + c);
          const float o0 = bflo(ov.x), o1 = bfhi(ov.x), o2 = bflo(ov.y), o3 = bfhi(ov.y);
          const float rs = rsqrtf(red16((o0 * o0 + o1 * o1) + (o2 * o2 + o3 * o3)) * (1.f / 64.f) + 1e-5f);
          u2 w; w.x = pk2(o0 * rs * gnorm.x * siluf_(bflo(gv.x)), o1 * rs * gnorm.y * siluf_(bfhi(gv.x))); w.y = pk2(o2 * rs * gnorm.z * siluf_(bflo(gv.y)), o3 * rs * gnorm.w * siluf_(bfhi(gv.y))); *(u2*)(yo) = w; }
        { const f4 A = *(const f4*)((const float*)(ws + WS_LRA) + o), H = *(const f4*)((const float*)(ws + WS_LRH) + o), cy = *(const f4*)((const float*)(ws + WS_CARRY) + (size_t)(tok >> 5) * 256 + c);
          const u2 gv = *(const u2*)(pp + PC_LG + c);
          u2 w; w.x = pk2((H.x + A.x * cy.x) * gelu_tanh(bflo(gv.x)), (H.y + A.y * cy.y) * gelu_tanh(bfhi(gv.x))); w.y = pk2((H.z + A.z * cy.z) * gelu_tanh(bflo(gv.y)), (H.w + A.w * cy.w) * gelu_tanh(bfhi(gv.y))); *(u2*)(yo + 256) = w; }
        { const u2 yv = *(const u2*)((const bf16*)(ws + WS_YRW) + o), vv = *(const u2*)((const bf16*)(ws + WS_RWV) + o), gv = *(const u2*)((const bf16*)(ws + WS_RWG) + o);
          const float bon = ((const float*)(ws + WS_RWBON))[tok * 4 + hh];
          float y0 = bflo(yv.x), y1 = bfhi(yv.x), y2 = bflo(yv.y), y3 = bfhi(yv.y);
          const float mean = red16((y0 + y1) + (y2 + y3)) * (1.f / 64.f); y0 -= mean; y1 -= mean; y2 -= mean; y3 -= mean;
          const float rs = rsqrtf(red16((y0 * y0 + y1 * y1) + (y2 * y2 + y3 * y3)) * (1.f / 64.f) + 64e-5f);
          u2 w; w.x = pk2((y0 * rs * gnw.x + gnb.x + bon * bflo(vv.x)) * bflo(gv.x), (y1 * rs * gnw.y + gnb.y + bon * bfhi(vv.x)) * bfhi(gv.x));
          w.y = pk2((y2 * rs * gnw.z + gnb.z + bon * bflo(vv.y)) * bflo(gv.y), (y3 * rs * gnw.w + gnb.w + bon * bfhi(vv.y)) * bfhi(gv.y)); *(u2*)(yo + 512) = w; }
        { const u2 yv = *(const u2*)((const bf16*)(ws + WS_YSSD) + o), xv = *(const u2*)((const bf16*)(ws + WS_XBC) + (size_t)tok * 768 + c), zv = *(const u2*)(pp + PC_SZ + c);
          const float y0 = (bflo(yv.x) + dsk * bflo(xv.x)) * siluf_(bflo(zv.x)), y1 = (bfhi(yv.x) + dsk * bfhi(xv.x)) * siluf_(bfhi(zv.x)), y2 = (bflo(yv.y) + dsk * bflo(xv.y)) * siluf_(bflo(zv.y)), y3 = (bfhi(yv.y) + dsk * bfhi(xv.y)) * siluf_(bfhi(zv.y));
          float q = red16((y0 * y0 + y1 * y1) + (y2 * y2 + y3 * y3)); q += __shfl_xor(q, 16);
          const float rs = rsqrtf(q * (1.f / 128.f) + 1e-5f);
          u2 w; w.x = pk2(y0 * rs * snw.x, y1 * rs * snw.y); w.y = pk2(y2 * rs * snw.z, y3 * rs * snw.w); *(u2*)(yo + 768) = w; }
    }
}
#ifndef PROBE_GEMM
#define PROBE_GEMM 1
#endif
#ifndef PROBE_SCAN
#define PROBE_SCAN 1
#endif
#ifndef PROBE_MISC
#define PROBE_MISC 1
#endif
struct Args { const float* in[43]; float* out; unsigned char* ws; };
template <class Epi> __device__ __forceinline__ void gemm_multi(LAS unsigned char* lds, const pg8::Gemm& g, const Epi& E) {
    pg8::StaticOrder S; S.init(g.M, g.N, (int)gridDim.x, (int)blockIdx.x);
    pg8::gemm_phase<Epi, pg8::StaticOrder, true, true>(lds, g, S, E);
}
template <class Epi> __device__ __forceinline__ void gemm_single(LAS unsigned char* lds, const pg8::Gemm& g, const Epi& E) {
    pg8::StaticOrder S; S.init(g.M, g.N, (int)gridDim.x, (int)blockIdx.x);
    for (int r = 0;; ++r) { pg8::Unit u; if (!S.next(r, u)) break; OneUnit O{S, r}; pg8::gemm_phase<Epi, OneUnit, false, true>(lds, g, O, E); }
}
__global__ void __launch_bounds__(512, 2) fwd(Args a) {
    extern __shared__ __attribute__((aligned(16))) unsigned char lds_raw[];
    LAS unsigned char* lds = (LAS unsigned char*)lds_raw;
    cg::grid_group grid = cg::this_grid();
    unsigned* ctl = (unsigned*)(a.ws + WS_CTL); volatile LAS unsigned* MISC = (volatile LAS unsigned*)(lds + LDS_BYTES - 64);
    if (blockIdx.x == 0) for (int i = threadIdx.x; i < XCD_BAR_WORDS; i += 512) __hip_atomic_store(ctl + i, 0u, __ATOMIC_RELAXED, __HIP_MEMORY_SCOPE_AGENT);
    if (threadIdx.x < 2) MISC[threadIdx.x] = 0u;
    __threadfence();
    grid.sync();
    const XcdBarrier bar = xcd_barrier_post(ctl, MISC);
#define TIDS int tid = threadIdx.x; asm volatile("" : "+v"(tid)); const int lane = tid & 63, wave = __builtin_amdgcn_readfirstlane(tid >> 6), gw = blockIdx.x * 8 + wave, NGW = gridDim.x * 8; (void)lane; (void)gw; (void)NGW;
    unsigned char* ws = a.ws; const float* const* in = a.in; float* X = a.out;
    bf16* XB = (bf16*)(ws + WS_XB); bf16* Y = (bf16*)(ws + WS_Y); bf16* H = (bf16*)(ws + WS_PROJ); bf16* PROJ = (bf16*)(ws + WS_PROJ); float* SS = (float*)(ws + WS_SS);
    { TIDS phase_convert(in, ws, 0, 4, lds, gw, NGW, wave, lane); phase_init_rows(in[0], XB, SS, gw, NGW, lane); }
    xcd_barrier(bar);
#pragma unroll 1
    for (int l = 0; l < NL; ++l) {
#ifndef SKIP_G1
        for (int rep = 0; rep < PROBE_GEMM; ++rep) { pg8::Gemm g{XB, (const bf16*)(ws + WS_WGU1), M, 2 * FF, D}; EpiGU E{H, SS}; gemm_single(lds, g, E); }
#endif
        xcd_barrier(bar);
#ifndef SKIP_G2
        { pg8::Gemm g{H, (const bf16*)(ws + WS_WD1), M, D, FF}; EpiResid E{l == 0 ? in[0] : X, X, XB, SS, 0.5f}; gemm_single(lds, g, E); }
#endif
        xcd_barrier(bar);
#ifndef SKIP_G3
        for (int rep = 0; rep < PROBE_GEMM; ++rep) { pg8::Gemm g{XB, (const bf16*)(ws + WS_WIN), M, NINP, D}; EpiProj E{PROJ, SS}; gemm_single(lds, g, E); }
#endif
        xcd_barrier(bar);
#ifndef SKIP_PREP
        for (int rep = 0; rep < PROBE_MISC; ++rep) { TIDS phase_prep(in, ws, l, lds, tid); }
#endif
        xcd_barrier(bar);
#ifndef SKIP_SCAN
        for (int rep = 0; rep < PROBE_SCAN; ++rep) { TIDS phase_scan<0>(in, ws, l, lds, tid); }
        xcd_barrier(bar);
        { TIDS phase_combine(in, ws, l, lds, tid); }
        xcd_barrier(bar);
        for (int rep = 0; rep < PROBE_SCAN; ++rep) { TIDS phase_scan<1>(in, ws, l, lds, tid); }
#endif
        xcd_barrier(bar);
#ifndef SKIP_POST
        for (int rep = 0; rep < PROBE_MISC; ++rep) { TIDS phase_post(in, ws, l, gw, NGW, lane); }
#endif
        xcd_barrier(bar);
#ifndef SKIP_G4
        { pg8::Gemm g{Y, (const bf16*)(ws + WS_WOUT), M, D, D}; EpiResid E{X, X, XB, SS, 1.0f}; gemm_single(lds, g, E); }
#endif
        xcd_barrier(bar);
#ifndef SKIP_G5
        for (int rep = 0; rep < PROBE_GEMM; ++rep) { pg8::Gemm g{XB, (const bf16*)(ws + WS_WGU2), M, 2 * FF, D}; EpiGU E{H, SS}; gemm_single(lds, g, E); }
#endif
        xcd_barrier(bar);
#ifndef SKIP_G6
        { pg8::Gemm g{H, (const bf16*)(ws + WS_WD2), M, D, FF}; EpiResid E{X, X, XB, SS, 0.5f}; gemm_single(lds, g, E); }
#endif
        xcd_barrier(bar);
    }
    { TIDS phase_final(X, in[42], gw, NGW, lane); }
}

extern "C" void kernel_launch(void* const* d_in, const int* in_sizes, int n_in, void* d_out, int out_size, void* d_ws, size_t ws_size, hipStream_t stream) {
    static int grid = 0;
    if (grid == 0) {
        int dev = 0, cus = 0, per_cu = 0;
        (void)hipGetDevice(&dev);
        (void)hipDeviceGetAttribute(&cus, hipDeviceAttributeMultiprocessorCount, dev);
        (void)hipFuncSetAttribute((const void*)fwd, hipFuncAttributeMaxDynamicSharedMemorySize, LDS_BYTES);
        (void)hipOccupancyMaxActiveBlocksPerMultiprocessor(&per_cu, (const void*)fwd, 512, LDS_BYTES);
        if (per_cu < 1) per_cu = 1;
        grid = cus * per_cu;
        if (n_in != 43 || out_size != M * D || ws_size < WS_END) fprintf(stderr, "kernel_launch: unexpected sizes n_in %d out %d ws %zu (need %zu)\n", n_in, out_size, ws_size, (size_t)WS_END);
    }
    Args a{};
    for (int i = 0; i < 43 && i < n_in; ++i) a.in[i] = (const float*)d_in[i];
    a.out = (float*)d_out; a.ws = (unsigned char*)d_ws;
    void* args[] = {&a};
    hipError_t e = hipLaunchCooperativeKernel((const void*)fwd, dim3(grid), dim3(512), args, LDS_BYTES, stream);
    if (e != hipSuccess) fprintf(stderr, "cooperative launch failed: %s (grid %d)\n", hipGetErrorString(e), grid);
}
```

```cpp
#include <hip/hip_runtime.h>
#include <hip/hip_cooperative_groups.h>
#include <cstdio>
#include <cstdint>
namespace cg = cooperative_groups;
namespace pg8 {
#define PG8_LAS __attribute__((address_space(3)))
typedef unsigned short bf16_t;
typedef short bf16x8 __attribute__((ext_vector_type(8)));
typedef float f32x4 __attribute__((ext_vector_type(4)));
typedef unsigned u32x4 __attribute__((ext_vector_type(4)));
constexpr int BM = 256, BK = 64, HALF = 128, HTB = HALF * BK * 2  , STAGE_BYTES = 8 * HTB, NXCD = 8, WGM = 8;

__host__ __device__ __forceinline__ int lds_byte(int r, int c) { const int st = (r >> 4) * 2 + (c >> 5), rr = r & 15, cc = c & 31, ob = rr * 64 + cc * 2; return st * 1024 + (ob ^ (((ob >> 9) & 1) << 5)); }
__host__ __device__ __forceinline__ void stage_rc(int b, int& R, int& C) { const int st = b / 1024, sb = b % 1024, swz = sb ^ (((sb >> 9) & 1) << 5); R = (st >> 1) * 16 + swz / 64; C = (st & 1) * 32 + (swz % 64) / 2; }
__host__ __device__ __forceinline__ int perm32(int rho) { const int n = rho >> 4, i = rho & 15; return 8 * (i >> 2) + 4 * n + (i & 3); }

struct Unit { int pm, pn; };
struct Gemm { const bf16_t* A; const bf16_t* Bt; int M, N, K; };

struct StaticOrder {
    int nM, nN, nwg, G, c;
    __host__ __device__ void init(int M, int N, int G_, int c_) { nM = M / BM; nN = N / BM; nwg = nM * nN; G = G_; c = c_; }
    __host__ __device__ bool next(int i, Unit& u) const {
        const long L = (long)i * G + c; if (L >= nwg) return false;
        int wgid = (int)L; { const int q = nwg / NXCD, r = nwg % NXCD, xcd = wgid % NXCD, off = wgid / NXCD; wgid = (xcd < r ? xcd * (q + 1) : r * (q + 1) + (xcd - r) * q) + off; }
        const int nig = WGM * nN, gid = wgid / nig, fm = gid * WGM, gsz = (nM - fm) < WGM ? (nM - fm) : WGM;
        u.pm = fm + ((wgid % nig) % gsz); u.pn = (wgid % nig) / gsz; return true;
    }
    __device__ __forceinline__ void a_ready(const Unit&) const {}
    __device__ __forceinline__ void done(const Unit&) const {}
};

__device__ __forceinline__ unsigned cvt_pk_bf16(float lo, float hi) { unsigned r; asm volatile("v_cvt_pk_bf16_f32 %0, %1, %2" : "=v"(r) : "v"(lo), "v"(hi)); return r; }
typedef float f32x2 __attribute__((ext_vector_type(2)));
template <class Epi, class Sched, bool ALIGN_EPI = false, bool SP2 = false>
__device__ __forceinline__ void gemm_phase(PG8_LAS unsigned char* lds, const Gemm g, const Sched& S, const Epi& E) {
    int tid_ = threadIdx.x; asm volatile("" : "+v"(tid_));
    const int tid = tid_, wid = __builtin_amdgcn_readfirstlane(tid >> 6), lane = tid & 63, wr = wid >> 2, wc = wid & 3, fr = lane & 15, fq = lane >> 4;
    const int K = g.K, nt = K / BK;
    unsigned voffA[2], voffB[2];
#pragma unroll
    for (int i = 0; i < 2; ++i) { int R, C; stage_rc(tid * 16 + i * 8192, R, C); const int Rb = Epi::PERM ? ((R & ~31) + perm32(R & 31)) : R;
        voffA[i] = (unsigned)(R * K + C) * 2u; voffB[i] = (unsigned)(Rb * K + C) * 2u; }
    const size_t kstep = (size_t)(BK * 2);
    const size_t hstep = (size_t)HALF * K * 2;
    const size_t tstep = 2 * hstep;
    const unsigned ldsw = (unsigned)wid * 1024u;
    const int aoff = lds_byte(wr * 64 + fr, fq * 8), boff = lds_byte(wc * 32 + fr, fq * 8);
#define PG8_SA(b, h) (((b) * 2 + (h)) * HTB)
#define PG8_SB(b, h) ((4 + (b) * 2 + (h)) * HTB)
#define PG8_STAGE(bufoff, gbase, voff) do { _Pragma("unroll") for (int _i = 0; _i < 2; ++_i) \
        __builtin_amdgcn_global_load_lds((const unsigned*)((const char*)(gbase) + (voff)[_i]), (PG8_LAS unsigned*)(lds + (bufoff) + ldsw + _i * 8192), 16, 0, 0); } while (0)
#define PG8_LDA(dst, b, h) do { _Pragma("unroll") for (int m = 0; m < 4; ++m) _Pragma("unroll") for (int k = 0; k < 2; ++k) dst[m][k] = *(const PG8_LAS bf16x8*)(lds + PG8_SA(b, h) + aoff + m * 2048 + k * 1024); } while (0)
#define PG8_LDB(dst, b, h) do { _Pragma("unroll") for (int n = 0; n < 2; ++n) _Pragma("unroll") for (int k = 0; k < 2; ++k) dst[n][k] = *(const PG8_LAS bf16x8*)(lds + PG8_SB(b, h) + boff + n * 2048 + k * 1024); } while (0)
#define PG8_MMA(ai, bj, At, Bt) do { __builtin_amdgcn_s_setprio(1); _Pragma("unroll") for (int m = 0; m < 4; ++m) _Pragma("unroll") for (int n = 0; n < 2; ++n) _Pragma("unroll") for (int k = 0; k < 2; ++k) \
        acc[ai][bj][m][n] = __builtin_amdgcn_mfma_f32_16x16x32_bf16(Bt[n][k], At[m][k], acc[ai][bj][m][n], 0, 0, 0); __builtin_amdgcn_s_setprio(0); } while (0)
#define PG8_WAIT_V(n) asm volatile("s_waitcnt vmcnt(" #n ")" ::: "memory")
#define PG8_WAIT_L(n) asm volatile("s_waitcnt lgkmcnt(" #n ")" ::: "memory")
#define PG8_BAR __builtin_amdgcn_s_barrier()
#define PG8_SCHED __builtin_amdgcn_sched_barrier(0)
    Unit cur, nxt; int ui = 0;
    if (!S.next(0, cur)) return;
    f32x4 acc[2][2][4][2];
#pragma unroll
    for (int a = 0; a < 2; ++a)
#pragma unroll
        for (int b = 0; b < 2; ++b)
#pragma unroll
            for (int m = 0; m < 4; ++m)
#pragma unroll
                for (int n = 0; n < 2; ++n) acc[a][b][m][n] = (f32x4){0.f, 0.f, 0.f, 0.f};
    bf16x8 At[4][2], B0[2][2], B1[2][2];
    const char* cA = (const char*)g.A + (size_t)cur.pm * tstep; const char* cB = (const char*)g.Bt + (size_t)cur.pn * tstep;
    S.a_ready(cur);
    if constexpr (SP2) {
        PG8_STAGE(PG8_SB(0, 0), cB, voffB); PG8_STAGE(PG8_SB(0, 1), cB + hstep, voffB); PG8_STAGE(PG8_SA(0, 0), cA, voffA); PG8_STAGE(PG8_SA(0, 1), cA + hstep, voffA);
        if (wr == 1) PG8_BAR;
        PG8_WAIT_V(2); PG8_BAR;
        PG8_STAGE(PG8_SB(1, 0), cB + kstep, voffB); PG8_STAGE(PG8_SA(1, 0), cA + kstep, voffA); PG8_STAGE(PG8_SB(1, 1), cB + hstep + kstep, voffB);
        PG8_WAIT_V(6); PG8_BAR;
    } else {
        PG8_STAGE(PG8_SB(0, 0), cB, voffB); PG8_STAGE(PG8_SA(0, 0), cA, voffA); PG8_STAGE(PG8_SB(0, 1), cB + hstep, voffB); PG8_STAGE(PG8_SA(0, 1), cA + hstep, voffA);
        if (wr == 1) PG8_BAR;
        PG8_WAIT_V(4); PG8_BAR;
        PG8_STAGE(PG8_SB(1, 0), cB + kstep, voffB); PG8_STAGE(PG8_SA(1, 0), cA + kstep, voffA); PG8_STAGE(PG8_SB(1, 1), cB + hstep + kstep, voffB);
        PG8_WAIT_V(6); PG8_BAR;
    }
    for (;;) {
        const bool has_next = S.next(ui + 1, nxt);
        const char* nA = has_next ? (const char*)g.A + (size_t)nxt.pm * tstep : cA; const char* nB = has_next ? (const char*)g.Bt + (size_t)nxt.pn * tstep : cB;
        for (int t = 0; t < nt; t += 2) {
            const bool last = (t == nt - 2);
            const char* a1 = cA + (size_t)(t + 1) * kstep;
            const char* a2 = last ? nA : cA + (size_t)(t + 2) * kstep; const char* b2 = last ? nB : cB + (size_t)(t + 2) * kstep;
            const char* a3 = a2 + kstep; const char* b3 = b2 + kstep;
            if (last && has_next) S.a_ready(nxt);
            if constexpr (SP2) {
            PG8_LDB(B0, 0, 0); PG8_LDB(B1, 0, 1); PG8_SCHED; PG8_LDA(At, 0, 0); PG8_STAGE(PG8_SA(1, 1), a1 + hstep, voffA);
            PG8_WAIT_V(8); PG8_WAIT_L(0); PG8_BAR; PG8_MMA(0, 0, At, B0); PG8_MMA(0, 1, At, B1); PG8_BAR; PG8_SCHED;
            PG8_LDA(At, 0, 1); PG8_STAGE(PG8_SB(0, 0), b2, voffB); PG8_STAGE(PG8_SB(0, 1), b2 + hstep, voffB); PG8_STAGE(PG8_SA(0, 0), a2, voffA);
            PG8_WAIT_V(8); PG8_WAIT_L(0); PG8_BAR; PG8_MMA(1, 0, At, B0); PG8_MMA(1, 1, At, B1); PG8_BAR; PG8_SCHED;
            PG8_LDB(B0, 1, 0); PG8_LDB(B1, 1, 1); PG8_SCHED; PG8_LDA(At, 1, 0); PG8_STAGE(PG8_SA(0, 1), a2 + hstep, voffA);
            PG8_WAIT_V(8); PG8_WAIT_L(0); PG8_BAR; PG8_MMA(0, 0, At, B0); PG8_MMA(0, 1, At, B1); PG8_BAR; PG8_SCHED;
            PG8_LDA(At, 1, 1); PG8_STAGE(PG8_SB(1, 0), b3, voffB); PG8_STAGE(PG8_SB(1, 1), b3 + hstep, voffB); PG8_STAGE(PG8_SA(1, 0), a3, voffA);
            PG8_WAIT_V(8); PG8_WAIT_L(0); PG8_BAR; PG8_MMA(1, 0, At, B0); PG8_MMA(1, 1, At, B1); PG8_BAR; PG8_SCHED;
            } else {
            PG8_LDB(B0, 0, 0); PG8_SCHED; PG8_LDA(At, 0, 0); PG8_STAGE(PG8_SA(1, 1), a1 + hstep, voffA);
            PG8_WAIT_L(8); PG8_BAR; PG8_WAIT_L(0); PG8_MMA(0, 0, At, B0); PG8_BAR; PG8_SCHED;
            PG8_LDB(B1, 0, 1); PG8_STAGE(PG8_SB(0, 0), b2, voffB);
            PG8_BAR; PG8_WAIT_L(0); PG8_MMA(0, 1, At, B1); PG8_BAR;
            PG8_LDA(At, 0, 1); PG8_STAGE(PG8_SA(0, 0), a2, voffA);
            PG8_BAR; PG8_WAIT_L(0); PG8_MMA(1, 0, At, B0); PG8_BAR; PG8_SCHED;
            PG8_STAGE(PG8_SB(0, 1), b2 + hstep, voffB);
            PG8_WAIT_V(6); PG8_BAR; PG8_MMA(1, 1, At, B1); PG8_BAR;
            PG8_LDB(B0, 1, 0); PG8_SCHED; PG8_LDA(At, 1, 0); PG8_STAGE(PG8_SA(0, 1), a2 + hstep, voffA);
            PG8_WAIT_L(8); PG8_BAR; PG8_WAIT_L(0); PG8_MMA(0, 0, At, B0); PG8_BAR; PG8_SCHED;
            PG8_LDB(B1, 1, 1); PG8_STAGE(PG8_SB(1, 0), b3, voffB);
            PG8_BAR; PG8_WAIT_L(0); PG8_MMA(0, 1, At, B1); PG8_BAR;
            PG8_LDA(At, 1, 1); PG8_STAGE(PG8_SA(1, 0), a3, voffA);
            PG8_BAR; PG8_WAIT_L(0); PG8_MMA(1, 0, At, B0); PG8_BAR; PG8_SCHED;
            PG8_STAGE(PG8_SB(1, 1), b3 + hstep, voffB);
            PG8_WAIT_V(6); PG8_BAR; PG8_MMA(1, 1, At, B1); PG8_BAR;
            }
        }
        if constexpr (ALIGN_EPI) { if (wr == 0) PG8_BAR; }
        if constexpr (!Epi::AFTER_DRAIN) { E(acc, cur, wr, wc, fr, fq); S.done(cur); }
        if (!has_next) break;
#pragma unroll
        for (int a = 0; a < 2; ++a)
#pragma unroll
            for (int b = 0; b < 2; ++b)
#pragma unroll
                for (int m = 0; m < 4; ++m)
#pragma unroll
                    for (int n = 0; n < 2; ++n) acc[a][b][m][n] = (f32x4){0.f, 0.f, 0.f, 0.f};
        cur = nxt; cA = nA; cB = nB; ++ui;
        if constexpr (ALIGN_EPI) { if (wr == 1) PG8_BAR; }
    }
    PG8_WAIT_V(0);
    if constexpr (!ALIGN_EPI) { if (wr == 0) PG8_BAR; }
    PG8_BAR;
    if constexpr (Epi::AFTER_DRAIN) { E.fused(acc, cur, wr, wc, fr, fq, lds, wid, lane); S.done(cur); }
#undef PG8_SA
#undef PG8_SB
#undef PG8_STAGE
#undef PG8_LDA
#undef PG8_LDB
#undef PG8_MMA
#undef PG8_WAIT_V
#undef PG8_WAIT_L
#undef PG8_BAR
#undef PG8_SCHED
}
}
#define LAS __attribute__((address_space(3)))
typedef unsigned short bf16;
typedef float f4 __attribute__((ext_vector_type(4)));
typedef float f2 __attribute__((ext_vector_type(2)));
#define LO2(v) __builtin_shufflevector(v, v, 0, 1)
#define HI2(v) __builtin_shufflevector(v, v, 2, 3)
typedef unsigned u2 __attribute__((ext_vector_type(2)));
typedef unsigned u4 __attribute__((ext_vector_type(4)));
using pg8::f32x4;

constexpr int M = 16384, D = 1024, FF = 2816, NIN = 3156, NINP = 3328, NL = 4, SEQ = 8192;
constexpr int LDS_BYTES = 147456;
constexpr size_t HM = 524288;
constexpr size_t WS_WGU1 = 0, WS_WD1 = 22 * HM, WS_WIN = 33 * HM, WS_WOUT = 46 * HM, WS_WGU2 = 50 * HM, WS_WD2 = 72 * HM;
constexpr size_t MiB = 1048576;
constexpr size_t WS_XB = 42 * MiB;
constexpr size_t WS_OGLA = WS_XB, WS_YRW = WS_XB + 8 * MiB, WS_YSSD = WS_XB + 16 * MiB;
constexpr size_t WS_Y = 74 * MiB;
constexpr size_t WS_PROJ = 106 * MiB;
constexpr size_t WS_VFIRST = 210 * MiB;
constexpr size_t WS_SS = 226 * MiB;
constexpr size_t WS_RWR = 227 * MiB, WS_RWK = 235 * MiB, WS_RWV = 243 * MiB, WS_RWKK = 251 * MiB, WS_RWB = 259 * MiB;
constexpr size_t WS_RWW = 267 * MiB;
constexpr size_t WS_RWG = 283 * MiB;
constexpr size_t WS_RWBON = 291 * MiB;
constexpr size_t WS_XBC = 292 * MiB;
constexpr size_t WS_DT = 316 * MiB, WS_DEC = 317 * MiB;
constexpr size_t WS_LRA = 318 * MiB, WS_LRH = 334 * MiB;
constexpr size_t WS_SEGA = 350 * MiB, WS_SEGH = 351 * MiB, WS_CARRY = 352 * MiB;
constexpr int NCH = 32, CHL = SEQ / NCH;
constexpr size_t WS_RWP = 353 * MiB, WS_RWU = 357 * MiB;
constexpr size_t WS_GLU = 361 * MiB, WS_GLD = 363 * MiB;
constexpr int NCS = 64;
constexpr size_t WS_SSU = 364 * MiB, WS_SSD = 380 * MiB;
constexpr size_t WS_CTL = 381 * MiB;
constexpr int CTL_WORDS = 3456 + 64 + 8 * 64 * 64;
constexpr size_t WS_END = 382 * MiB;

constexpr int PC_GQ = 0, PC_GK = 128, PC_GV = 256, PC_GG = 512, PC_GSTEM = 768, PC_LX = 784, PC_LG = 1040, PC_RW = 1296, PC_SZ = 2128, PC_SXBC = 2384, PC_SDT = 3152;

__device__ __forceinline__ float bf2f(bf16 v) { return __uint_as_float((unsigned)v << 16); }
__device__ __forceinline__ float bflo(unsigned w) { return __uint_as_float(w << 16); }
__device__ __forceinline__ float bfhi(unsigned w) { return __uint_as_float(w & 0xffff0000u); }
__device__ __forceinline__ unsigned pk2(float lo, float hi) { return pg8::cvt_pk_bf16(lo, hi); }
__device__ __forceinline__ float sigmoidf_(float x) { return 1.f / (1.f + __expf(-x)); }
__device__ __forceinline__ float siluf_(float x) { return x / (1.f + __expf(-x)); }
__device__ __forceinline__ float tanhf_(float x) { return 1.f - 2.f / (1.f + __expf(2.f * x)); }
__device__ __forceinline__ float softplusf_(float x) { return fmaxf(x, 0.f) + log1pf(__expf(-fabsf(x))); }
__device__ __forceinline__ float gelu_tanh(float x) { const float u = 0.7978845608028654f * (x + 0.044715f * x * x * x); return 0.5f * x * (1.f + tanhf_(u)); }

__device__ __forceinline__ float dpp_mov(float x, const int ctrl_sel) {
    const int v = __builtin_bit_cast(int, x); int r;
    if (ctrl_sel == 0) r = __builtin_amdgcn_update_dpp(0, v, 0xB1, 0xF, 0xF, true);
    else if (ctrl_sel == 1) r = __builtin_amdgcn_update_dpp(0, v, 0x4E, 0xF, 0xF, true);
    else r = __builtin_amdgcn_update_dpp(0, v, 0x141, 0xF, 0xF, true);
    return __builtin_bit_cast(float, r);
}
__device__ __forceinline__ float red8(float x) { x += dpp_mov(x, 0); x += dpp_mov(x, 1); x += dpp_mov(x, 2); return x; }
__device__ __forceinline__ float red16(float x) { x = red8(x); x += __builtin_bit_cast(float, __builtin_amdgcn_update_dpp(0, __builtin_bit_cast(int, x), 0x140, 0xF, 0xF, true)); return x; }
__device__ __forceinline__ float wave_sum(float v) { v = red16(v); v += __shfl_xor(v, 16); v += __shfl_xor(v, 32); return v; }
__device__ __forceinline__ float rstd_row(const float* ss, int row) { const f4 p = *(const f4*)(ss + (size_t)row * 4); return rsqrtf(((p.x + p.y) + (p.z + p.w)) * (1.f / 1024.f) + 1e-6f); }

__device__ __forceinline__ void lds_barrier() { asm volatile("s_waitcnt lgkmcnt(0)" ::: "memory"); __builtin_amdgcn_s_barrier(); asm volatile("" ::: "memory"); }
typedef short s8v __attribute__((ext_vector_type(8)));
#define MFMA16(a, b, c) __builtin_amdgcn_mfma_f32_16x16x32_bf16(a, b, c, 0, 0, 0)
struct EpiGU {
    static constexpr bool PERM = true, AFTER_DRAIN = true;
    bf16* H; const float* ss;
    __device__ __forceinline__ void fused(f32x4 (&acc)[2][2][4][2], const pg8::Unit& u, int wr, int wc, int fr, int fq, LAS unsigned char* lds, int wid, int lane) const {
        float rsv[8];
#pragma unroll
        for (int g = 0; g < 8; ++g) rsv[g] = rstd_row(ss, u.pm * 256 + (g >> 2) * 128 + wr * 64 + (g & 3) * 16 + fr);
#pragma unroll
        for (int ai = 0; ai < 2; ++ai)
#pragma unroll
            for (int m = 0; m < 4; ++m) {
                const int row = u.pm * 256 + ai * 128 + wr * 64 + m * 16 + fr; const float rs = rsv[ai * 4 + m];
                float hv[8];
#pragma unroll
                for (int n = 0; n < 2; ++n)
#pragma unroll
                    for (int e = 0; e < 4; ++e) { const float g = acc[ai][0][m][n][e] * rs, up = acc[ai][1][m][n][e] * rs; hv[n * 4 + e] = siluf_(g) * up; }
                u4 w; w.x = pk2(hv[0], hv[1]); w.y = pk2(hv[2], hv[3]); w.z = pk2(hv[4], hv[5]); w.w = pk2(hv[6], hv[7]);
                *(u4*)(H + (size_t)row * FF + u.pn * 128 + wc * 32 + 8 * fq) = w;
            }
    }
};
struct EpiProj {
    static constexpr bool PERM = true, AFTER_DRAIN = true;
    bf16* O; const float* ss;
    __device__ __forceinline__ void fused(f32x4 (&acc)[2][2][4][2], const pg8::Unit& u, int wr, int wc, int fr, int fq, LAS unsigned char* lds, int wid, int lane) const {
        float rsv[8];
#pragma unroll
        for (int g = 0; g < 8; ++g) rsv[g] = rstd_row(ss, u.pm * 256 + (g >> 2) * 128 + wr * 64 + (g & 3) * 16 + fr);
#pragma unroll
        for (int ai = 0; ai < 2; ++ai)
#pragma unroll
            for (int m = 0; m < 4; ++m) {
                const int row = u.pm * 256 + ai * 128 + wr * 64 + m * 16 + fr; const float rs = rsv[ai * 4 + m];
#pragma unroll
                for (int bj = 0; bj < 2; ++bj) { const f32x4 v0 = acc[ai][bj][m][0] * rs, v1 = acc[ai][bj][m][1] * rs;
                    u4 w; w.x = pk2(v0[0], v0[1]); w.y = pk2(v0[2], v0[3]); w.z = pk2(v1[0], v1[1]); w.w = pk2(v1[2], v1[3]);
                    *(u4*)(O + (size_t)row * NINP + u.pn * 256 + bj * 128 + wc * 32 + 8 * fq) = w; }
            }
    }
};
struct EpiGUm : EpiGU { static constexpr bool PERM = true, AFTER_DRAIN = false;
    __device__ __forceinline__ void operator()(const f32x4 (&acc)[2][2][4][2], const pg8::Unit& u, int wr, int wc, int fr, int fq) const { fused(const_cast<f32x4 (&)[2][2][4][2]>(acc), u, wr, wc, fr, fq, nullptr, 0, 0); } };
struct EpiProjm : EpiProj { static constexpr bool PERM = true, AFTER_DRAIN = false;
    __device__ __forceinline__ void operator()(const f32x4 (&acc)[2][2][4][2], const pg8::Unit& u, int wr, int wc, int fr, int fq) const { fused(const_cast<f32x4 (&)[2][2][4][2]>(acc), u, wr, wc, fr, fq, nullptr, 0, 0); } };
struct EpiResid {
    static constexpr bool PERM = true, AFTER_DRAIN = true;
    const float* xin; float* xout; bf16* xb; float* ss; float scale;
    __device__ __forceinline__ void fused(f32x4 (&acc)[2][2][4][2], const pg8::Unit& u, int wr, int wc, int fr, int fq, LAS unsigned char* lds, int wid, int lane) const {
        LAS float* P = (LAS float*)lds;
        const size_t base = ((size_t)u.pm * 256 + wr * 64 + fr) * D + u.pn * 256 + wc * 32 + 8 * fq;
        f32x4 nx[2][2], cx[2][2];
#pragma unroll
        for (int bj = 0; bj < 2; ++bj) { nx[bj][0] = *(const f32x4*)(xin + base + bj * 128); nx[bj][1] = *(const f32x4*)(xin + base + bj * 128 + 4); }
#pragma unroll
        for (int g = 0; g < 8; ++g) { const int ai = g >> 2, m = g & 3; const size_t go = base + (size_t)(ai * 128 + m * 16) * D;
#pragma unroll
            for (int bj = 0; bj < 2; ++bj) { cx[bj][0] = nx[bj][0]; cx[bj][1] = nx[bj][1]; }
            if (g < 7) { const size_t gn = base + (size_t)(((g + 1) >> 2) * 128 + ((g + 1) & 3) * 16) * D;
#pragma unroll
                for (int bj = 0; bj < 2; ++bj) { nx[bj][0] = *(const f32x4*)(xin + gn + bj * 128); nx[bj][1] = *(const f32x4*)(xin + gn + bj * 128 + 4); } }
            float sq = 0.f;
#pragma unroll
            for (int bj = 0; bj < 2; ++bj) { const size_t off = go + bj * 128;
                const f32x4 x0 = cx[bj][0] + acc[ai][bj][m][0] * scale, x1 = cx[bj][1] + acc[ai][bj][m][1] * scale;
                *(f32x4*)(xout + off) = x0; *(f32x4*)(xout + off + 4) = x1;
                u4 w; w.x = pk2(x0[0], x0[1]); w.y = pk2(x0[2], x0[3]); w.z = pk2(x1[0], x1[1]); w.w = pk2(x1[2], x1[3]);
                if (xb) *(u4*)(xb + off) = w;
                sq += (x0[0] * x0[0] + x0[1] * x0[1]) + (x0[2] * x0[2] + x0[3] * x0[3]) + (x1[0] * x1[0] + x1[1] * x1[1]) + (x1[2] * x1[2] + x1[3] * x1[3]); }
            sq += __shfl_xor(sq, 16); sq += __shfl_xor(sq, 32);
            if (fq == 0) P[(ai * 128 + wr * 64 + m * 16 + fr) * 4 + wc] = sq;
        }
        __syncthreads();
        const int tid = wid * 64 + lane;
        if (xb && tid < 256) ss[(size_t)(u.pm * 256 + tid) * 4 + u.pn] = (P[tid * 4 + 0] + P[tid * 4 + 1]) + (P[tid * 4 + 2] + P[tid * 4 + 3]);
        __syncthreads();
    }
};
struct OneUnit { pg8::StaticOrder b; int r; const unsigned* wait; unsigned need; unsigned* pub; unsigned* tmo; int prev;
    __device__ __forceinline__ bool next(int i, pg8::Unit& u) const { return i == 0 && b.next(r, u); }
    __device__ __forceinline__ void a_ready(const pg8::Unit& u) const {
        if (wait) {
            if (threadIdx.x < 64) { const unsigned long long t0 = __builtin_amdgcn_s_memrealtime(); unsigned polls = 0;
                while ((unsigned)__builtin_amdgcn_readfirstlane(__hip_atomic_load(wait + 64 * u.pm, __ATOMIC_RELAXED, __HIP_MEMORY_SCOPE_AGENT)) < need) {
                    if ((++polls & 255u) == 0u && __builtin_amdgcn_readfirstlane(__hip_atomic_load(tmo, __ATOMIC_RELAXED, __HIP_MEMORY_SCOPE_AGENT)) != 0u) break;
                    if (__builtin_amdgcn_s_memrealtime() - t0 > 2000000ull) { if (threadIdx.x == 0) __hip_atomic_store(tmo, 1u, __ATOMIC_RELAXED, __HIP_MEMORY_SCOPE_AGENT); break; }
                    __builtin_amdgcn_s_sleep(2); }
                __builtin_amdgcn_fence(__ATOMIC_ACQUIRE, "agent");
                asm volatile("s_waitcnt vmcnt(0)" ::: "memory"); }
            asm volatile("" ::: "memory"); __builtin_amdgcn_s_barrier(); asm volatile("" ::: "memory"); } }
    __device__ __forceinline__ void done(const pg8::Unit&) const { if (pub && prev >= 0 && threadIdx.x == 0) __hip_atomic_fetch_add(pub + 64 * prev, 1u, __ATOMIC_RELAXED, __HIP_MEMORY_SCOPE_AGENT); } };

__device__ __forceinline__ void tr_item(const float* W, int ldn, int nvalid, int col0, const float* sc, bf16* WT, int K, int row0, int k0, LAS float* scr, int lane) {
    const int c4 = col0 + (lane & 31) * 4; const bool ok = c4 < nvalid;
    f4 tv[16];
#pragma unroll
    for (int i = 0; i < 16; ++i) { const int kk = 2 * i + (lane >> 5); tv[i] = (f4){0.f, 0.f, 0.f, 0.f}; if (ok) tv[i] = __builtin_nontemporal_load((const f4*)(W + (size_t)(k0 + kk) * ldn + c4)); }
#pragma unroll
    for (int i = 0; i < 16; ++i) { const int kk = 2 * i + (lane >> 5); f4 v = tv[i]; if (sc) v = v * sc[k0 + kk]; *(LAS f4*)(scr + kk * 132 + (lane & 31) * 4) = v; }
    asm volatile("s_waitcnt lgkmcnt(0)" ::: "memory");
    const int kq = lane & 3;
#pragma unroll
    for (int j = 0; j < 8; ++j) { const int n = (lane >> 2) + 16 * j; const LAS float* s = scr + (8 * kq) * 132 + n;
        u4 o; o.x = pk2(s[0 * 132], s[1 * 132]); o.y = pk2(s[2 * 132], s[3 * 132]); o.z = pk2(s[4 * 132], s[5 * 132]); o.w = pk2(s[6 * 132], s[7 * 132]);
        *(u4*)(WT + (size_t)(row0 + n) * K + k0 + 8 * kq) = o; }
    asm volatile("s_waitcnt lgkmcnt(0)" ::: "memory");
}
__device__ __forceinline__ void tr_gu(const float* Wg, const float* Wu, const float* nw, bf16* WT, int it, LAS float* scr, int lane) {
    const int kb = it / 44, nb = it % 44, row0 = nb * 128, pn = row0 >> 8, half = (row0 >> 7) & 1;
    tr_item(half ? Wu : Wg, FF, FF, pn * 128, nw, WT, D, row0, kb * 32, scr, lane);
}
__device__ __forceinline__ void convert_mats(const float* const* in, unsigned char* ws, int mask, int lA, int lB, LAS unsigned char* lds, int gw, int NGW, int wave, int lane) {
    LAS float* scr = (LAS float*)(lds + wave * 17408);
    constexpr int I_GU = 1408, I_D = 704, I_IN = 832, I_OUT = 256;
    const int n0 = (mask & 1) ? I_GU : 0, n1 = (mask & 2) ? I_D : 0, n2 = (mask & 4) ? I_IN : 0, n3 = (mask & 8) ? I_OUT : 0, n4 = (mask & 16) ? I_GU : 0, n5 = (mask & 32) ? I_D : 0;
    const int total = n0 + n1 + n2 + n3 + n4 + n5; const size_t oA = (size_t)lA * D * FF, oB = (size_t)lB * D * FF;
    for (int it = gw; it < total; it += NGW) {
        int r = it;
        if (r < n0) { tr_gu(in[2] + oA, in[3] + oA, in[1] + lA * D, (bf16*)(ws + WS_WGU1), r, scr, lane); continue; } r -= n0;
        if (r < n1) { tr_item(in[4] + oA, D, D, (r % 8) * 128, nullptr, (bf16*)(ws + WS_WD1), FF, (r % 8) * 128, (r / 8) * 32, scr, lane); continue; } r -= n1;
        if (r < n2) { tr_item(in[6] + (size_t)lA * D * NIN, NIN, NIN, (r % 26) * 128, in[5] + lA * D, (bf16*)(ws + WS_WIN), D, (r % 26) * 128, (r / 26) * 32, scr, lane); continue; } r -= n2;
        if (r < n3) { tr_item(in[7] + (size_t)lB * D * D, D, D, (r % 8) * 128, nullptr, (bf16*)(ws + WS_WOUT), D, (r % 8) * 128, (r / 8) * 32, scr, lane); continue; } r -= n3;
        if (r < n4) { tr_gu(in[39] + oB, in[40] + oB, in[38] + lB * D, (bf16*)(ws + WS_WGU2), r, scr, lane); continue; } r -= n4;
        tr_item(in[41] + oB, D, D, (r % 8) * 128, nullptr, (bf16*)(ws + WS_WD2), FF, (r % 8) * 128, (r / 8) * 32, scr, lane);
    }
}
__device__ __forceinline__ void phase_init_rows(const float* x, bf16* xb, float* ss, int gw, int NGW, int lane) {
    for (int m = gw; m < M; m += NGW) {
        const f4* xr = (const f4*)(x + (size_t)m * D) + lane; float s = 0.f; u2* o = (u2*)(xb + (size_t)m * D) + lane;
#pragma unroll
        for (int j = 0; j < 4; ++j) { const f4 v = xr[64 * j]; s += (v.x * v.x + v.y * v.y) + (v.z * v.z + v.w * v.w); u2 w; w.x = pk2(v.x, v.y); w.y = pk2(v.z, v.w); o[64 * j] = w; }
        s = wave_sum(s);
        if (lane < 4) ss[(size_t)m * 4 + lane] = lane == 0 ? s : 0.f;
    }
}
__device__ __forceinline__ void phase_final(float* x, const float* fw, int gw, int NGW, int lane) {
    for (int m = gw; m < M; m += NGW) {
        f4* xr = (f4*)(x + (size_t)m * D) + lane; f4 v[4]; float s = 0.f;
#pragma unroll
        for (int j = 0; j < 4; ++j) { v[j] = xr[64 * j]; s += (v[j].x * v[j].x + v[j].y * v[j].y) + (v[j].z * v[j].z + v[j].w * v[j].w); }
        const float rs = rsqrtf(wave_sum(s) * (1.f / 1024.f) + 1e-6f);
#pragma unroll
        for (int j = 0; j < 4; ++j) { const f4 w = ((const f4*)fw)[lane + 64 * j]; xr[64 * j] = v[j] * rs * w; }
    }
}
#define XB_TMO      128
#define XB_XCNT(j)  (256  + 64 * (j))
#define XB_XSUB(j)  (1280 + 64 * (j))
#define XB_XGEN(j)  (2304 + 64 * (j))
#define XB_TOP      3328
#define XB_TOPGEN   3392
#define XCD_BAR_WORDS 3456
#define XB_SPIN_CAP (1u << 18)

__device__ __forceinline__ unsigned xb_ld(unsigned* p)              { return __hip_atomic_load(p, __ATOMIC_RELAXED, __HIP_MEMORY_SCOPE_AGENT); }
__device__ __forceinline__ unsigned xb_add(unsigned* p, unsigned v) { return __hip_atomic_fetch_add(p, v, __ATOMIC_RELAXED, __HIP_MEMORY_SCOPE_AGENT); }
__device__ __forceinline__ unsigned xb_xcc_id() { return (unsigned)__builtin_amdgcn_s_getreg((3 << 11) | 20) & 0xFu; }
#define XB_SPIN(cond, bar) do { unsigned _sp = 0; while (cond) { __builtin_amdgcn_s_sleep(1); \
    if ((++_sp & 255u) == 0u) { if (xb_ld(&(bar)[XB_TMO])) break; if (_sp > XB_SPIN_CAP) { atomicAdd(&(bar)[XB_TMO], 1u); break; } } } } while (0)

struct XcdBarrier {
    unsigned* bar; unsigned x;
    volatile LAS unsigned* st;
};

__device__ __forceinline__ XcdBarrier xcd_barrier_post(unsigned* bar, volatile LAS unsigned* st) {
    XcdBarrier b; b.bar = bar; b.x = xb_xcc_id(); b.st = st;
    if (threadIdx.x == 0) (void)xb_add(&bar[XB_XCNT(b.x)], 1u);
    return b;
}
__device__ __forceinline__ void xcd_barrier_complete(unsigned* bar, unsigned x, unsigned& nloc, unsigned& nx) {
    const unsigned G = gridDim.x * gridDim.y * gridDim.z;
    unsigned sum, cnt, mine, sp = 0u;
    for (;;) {
        sum = 0u; cnt = 0u; mine = 0u;
#pragma unroll
        for (unsigned j = 0; j < 16; ++j) { const unsigned c = xb_ld(&bar[XB_XCNT(j)]); sum += c; cnt += (c > 0u) ? 1u : 0u; mine = (j == x) ? c : mine; }
        if (sum == G) break;
        __builtin_amdgcn_s_sleep(1);
        if ((++sp & 255u) == 0u) { if (xb_ld(&bar[XB_TMO])) break; if (sp > XB_SPIN_CAP) { atomicAdd(&bar[XB_TMO], 1u); break; } }
    }
    nloc = mine > 0u ? mine : 1u; nx = cnt > 0u ? cnt : 1u;
}

__device__ __forceinline__ void xcd_barrier(const XcdBarrier& b) {
    asm volatile("s_waitcnt vmcnt(0)" ::: "memory");
    __syncthreads();
    if (threadIdx.x == 0) {
        unsigned* bar = b.bar;
        __builtin_amdgcn_s_waitcnt(0);
        unsigned nloc = b.st[0], nx = b.st[1];
        if (nloc == 0u) { xcd_barrier_complete(bar, b.x, nloc, nx); b.st[0] = nloc; b.st[1] = nx; }
        const unsigned old = xb_add(&bar[XB_XSUB(b.x)], 1u);
        const unsigned gen = old / nloc;
        if (old + 1u == (gen + 1u) * nloc) {
            __builtin_amdgcn_fence(__ATOMIC_RELEASE, "agent");
            asm volatile("s_waitcnt vmcnt(0)" ::: "memory");
            const unsigned og = xb_add(&bar[XB_TOP], 1u);
            const unsigned tg = og / nx;
            if (og + 1u == (tg + 1u) * nx) xb_add(&bar[XB_TOPGEN], 1u);
            else XB_SPIN(xb_ld(&bar[XB_TOPGEN]) == tg, bar);
            __builtin_amdgcn_fence(__ATOMIC_ACQUIRE, "agent");
            xb_add(&bar[XB_XGEN(b.x)], 1u);
            asm volatile("s_waitcnt vmcnt(0)" ::: "memory");
        } else {
            XB_SPIN(xb_ld(&bar[XB_XGEN(b.x)]) == gen, bar);
            __builtin_amdgcn_fence(__ATOMIC_ACQUIRE, "agent");
            asm volatile("s_waitcnt vmcnt(0)" ::: "memory");
        }
    }
    __syncthreads();
}
__device__ __forceinline__ void prep_lru(const float* const* in, unsigned char* ws, int l, int item, LAS unsigned char* lds, int tid) {
    const bf16* PROJ = (const bf16*)(ws + WS_PROJ); LAS float* X = (LAS float*)lds; LAS float* G = X + 32 * 256; LAS bf16* X16 = (LAS bf16*)(lds + 98304);
    const int t0 = item * 32; const float* cw = in[11] + l * 4 * 256; const float* cb = in[12] + l * 256;
#pragma unroll
    for (int it = 0; it < 2; ++it) { const int idx = tid + it * 512, t = idx >> 5, cv = idx & 31, tok = t0 + t, pos = tok & (SEQ - 1);
        f4 a0 = *(const f4*)(cb + cv * 8), a1 = *(const f4*)(cb + cv * 8 + 4);
#pragma unroll
        for (int k = 0; k < 4; ++k) { u4 x = (u4){0u, 0u, 0u, 0u}; if (pos - 3 + k >= 0) x = *(const u4*)(PROJ + (size_t)(tok - 3 + k) * NINP + PC_LX + cv * 8);
            const f4 w0 = *(const f4*)(cw + k * 256 + cv * 8), w1 = *(const f4*)(cw + k * 256 + cv * 8 + 4);
            a0 += w0 * (f4){bflo(x.x), bfhi(x.x), bflo(x.y), bfhi(x.y)}; a1 += w1 * (f4){bflo(x.z), bfhi(x.z), bflo(x.w), bfhi(x.w)}; }
        *(LAS f4*)(X + t * 256 + cv * 8) = a0; *(LAS f4*)(X + t * 256 + cv * 8 + 4) = a1;
        u4 xw; xw.x = pk2(a0.x, a0.y); xw.y = pk2(a0.z, a0.w); xw.z = pk2(a1.x, a1.y); xw.w = pk2(a1.z, a1.w); *(LAS u4*)(X16 + t * 264 + cv * 8) = xw; }
    const int gsel = tid >> 8, c = tid & 255;
    {
        const int wave = tid >> 6, lane = tid & 63, r16 = lane & 15, q4 = lane >> 4, gw_ = wave >> 2, blk = wave & 3;
        const float* W = (gw_ ? in[15] : in[13]) + (size_t)l * 16384 + blk * 4096; const float* bp = (gw_ ? in[16] : in[14]) + l * 256 + blk * 64;
        s8v bfr[4][2]; float bv[4];
#pragma unroll
        for (int nt = 0; nt < 4; ++nt) { bv[nt] = bp[16 * nt + r16];
#pragma unroll
            for (int ks = 0; ks < 2; ++ks) { const float* wp = W + (32 * ks + 8 * q4) * 64 + 16 * nt + r16;
                u4 w; w.x = pk2(wp[0], wp[64]); w.y = pk2(wp[128], wp[192]); w.z = pk2(wp[256], wp[320]); w.w = pk2(wp[384], wp[448]); bfr[nt][ks] = __builtin_bit_cast(s8v, w); } }
        __syncthreads();
        f32x4 acc[2][4];
#pragma unroll
        for (int mt = 0; mt < 2; ++mt)
#pragma unroll
            for (int nt = 0; nt < 4; ++nt) acc[mt][nt] = (f32x4){0.f, 0.f, 0.f, 0.f};
#pragma unroll
        for (int ks = 0; ks < 2; ++ks)
#pragma unroll
            for (int mt = 0; mt < 2; ++mt) { const s8v af = *(const LAS s8v*)(X16 + (16 * mt + r16) * 264 + blk * 64 + 32 * ks + 8 * q4);
#pragma unroll
                for (int nt = 0; nt < 4; ++nt) acc[mt][nt] = MFMA16(af, bfr[nt][ks], acc[mt][nt]); }
#pragma unroll
        for (int mt = 0; mt < 2; ++mt)
#pragma unroll
            for (int nt = 0; nt < 4; ++nt)
#pragma unroll
                for (int i = 0; i < 4; ++i) G[(gw_ * 32 + 16 * mt + 4 * q4 + i) * 256 + blk * 64 + 16 * nt + r16] = sigmoidf_(acc[mt][nt][i] + bv[nt]); }
    __syncthreads();
    { const float sp = softplusf_(-in[17][l * 256 + c]);
#pragma unroll 4
      for (int tt = 0; tt < 16; ++tt) { const int t = gsel * 16 + tt; const float r = G[t * 256 + c], ig = G[(32 + t) * 256 + c], la = -8.f * r * sp, av = __expf(la), u = sqrtf(fmaxf(1.f - av * av, 0.f)) * (ig * X[t * 256 + c]);
          G[t * 256 + c] = av; G[(32 + t) * 256 + c] = u; } }
    __syncthreads();
    if (tid < 256) { float h = 0.f, A = 1.f; float* LRA = (float*)(ws + WS_LRA); float* LRH = (float*)(ws + WS_LRH);
#pragma unroll 4
        for (int t = 0; t < 32; ++t) { const float av = G[t * 256 + c], u = G[(32 + t) * 256 + c];
            h = av * h + u; A *= av; const size_t o = (size_t)(t0 + t) * 256 + c; LRA[o] = A; LRH[o] = h; }
        ((float*)(ws + WS_SEGA))[item * 256 + c] = A; ((float*)(ws + WS_SEGH))[item * 256 + c] = h; }
    __syncthreads();
}
__device__ __forceinline__ void prep_ssd(const float* const* in, unsigned char* ws, int l, int item, int tid) {
    const bf16* PROJ = (const bf16*)(ws + WS_PROJ);
    const int t0 = item * 32; const float* cw = in[32] + l * 4 * 768; const float* cb = in[33] + l * 768;
#pragma unroll 2
    for (int it = 0; it < 6; ++it) { const int idx = tid + it * 512, t = idx / 96, cv = idx - t * 96, tok = t0 + t, pos = tok & (SEQ - 1);
        f4 a0 = *(const f4*)(cb + cv * 8), a1 = *(const f4*)(cb + cv * 8 + 4);
#pragma unroll
        for (int k = 0; k < 4; ++k) { u4 x = (u4){0u, 0u, 0u, 0u}; if (pos - 3 + k >= 0) x = *(const u4*)(PROJ + (size_t)(tok - 3 + k) * NINP + PC_SXBC + cv * 8);
            const f4 w0 = *(const f4*)(cw + k * 768 + cv * 8), w1 = *(const f4*)(cw + k * 768 + cv * 8 + 4);
            a0 += w0 * (f4){bflo(x.x), bfhi(x.x), bflo(x.y), bfhi(x.y)}; a1 += w1 * (f4){bflo(x.z), bfhi(x.z), bflo(x.w), bfhi(x.w)}; }
        u4 o; o.x = pk2(siluf_(a0.x), siluf_(a0.y)); o.y = pk2(siluf_(a0.z), siluf_(a0.w)); o.z = pk2(siluf_(a1.x), siluf_(a1.y)); o.w = pk2(siluf_(a1.z), siluf_(a1.w));
        *(u4*)((bf16*)(ws + WS_XBC) + (size_t)tok * 768 + cv * 8) = o; }
    if (tid < 128) { const int t = tid >> 2, hh = tid & 3, tok = t0 + t; const float dt = softplusf_(bf2f(PROJ[(size_t)tok * NINP + PC_SDT + hh]) + in[34][l * 4 + hh]);
        ((float*)(ws + WS_DT))[tok * 4 + hh] = dt; ((float*)(ws + WS_DEC))[tok * 4 + hh] = -dt * __expf(in[35][l * 4 + hh]); }
}
__device__ __forceinline__ void prep_rw(const float* const* in, unsigned char* ws, int l, int item, LAS unsigned char* lds, int tid) {
    const bf16* PROJ = (const bf16*)(ws + WS_PROJ); LAS float* P = (LAS float*)lds; LAS float* VV = (LAS float*)(lds + 32 * 832 * 4);
    const int t0 = item * 32; const float* mu = in[18] + l * 832;
    LAS float* V1 = VV + 256;
#pragma unroll
    for (int it = 0; it < 7; ++it) { const int idx = tid + it * 512; if (idx < 3328) { const int t = idx / 104, cv = idx - t * 104, tok = t0 + t;
        const bf16* pc = PROJ + (size_t)tok * NINP + PC_RW + cv * 8; const u4 cur = *(const u4*)pc; u4 prv = (u4){0u, 0u, 0u, 0u}; if (tok & (SEQ - 1)) prv = *(const u4*)(pc - NINP);
        const f4 m0 = *(const f4*)(mu + cv * 8), m1 = *(const f4*)(mu + cv * 8 + 4);
        const f4 c0 = (f4){bflo(cur.x), bfhi(cur.x), bflo(cur.y), bfhi(cur.y)}, c1 = (f4){bflo(cur.z), bfhi(cur.z), bflo(cur.w), bfhi(cur.w)};
        const f4 p0 = (f4){bflo(prv.x), bfhi(prv.x), bflo(prv.y), bfhi(prv.y)}, p1 = (f4){bflo(prv.z), bfhi(prv.z), bflo(prv.w), bfhi(prv.w)};
        f4 v0 = c0 + (p0 - c0) * m0, v1 = c1 + (p1 - c1) * m1;
        if (cv == 96 || cv == 97) { v0 = (f4){tanhf_(v0.x), tanhf_(v0.y), tanhf_(v0.z), tanhf_(v0.w)}; v1 = (f4){tanhf_(v1.x), tanhf_(v1.y), tanhf_(v1.z), tanhf_(v1.w)}; }
        else if (cv >= 100) { v0 = (f4){sigmoidf_(v0.x), sigmoidf_(v0.y), sigmoidf_(v0.z), sigmoidf_(v0.w)}; v1 = (f4){sigmoidf_(v1.x), sigmoidf_(v1.y), sigmoidf_(v1.z), sigmoidf_(v1.w)}; }
        *(LAS f4*)(P + t * 832 + cv * 8) = v0; *(LAS f4*)(P + t * 832 + cv * 8 + 4) = v1; } }
    if (l > 0) *(LAS f4*)(V1 + tid * 4) = *(const f4*)(in[25] + (size_t)(l - 1) * 2048 + tid * 4);
    __syncthreads();
    if (l > 0 && tid < 256) { const int t = tid >> 3, j = tid & 7; float s = 0.f;
#pragma unroll 4
        for (int c4 = 0; c4 < 64; ++c4) { const f4 pv = *(const LAS f4*)(P + t * 832 + 512 + 4 * c4); s += pv.x * V1[(4 * c4) * 8 + j] + pv.y * V1[(4 * c4 + 1) * 8 + j] + pv.z * V1[(4 * c4 + 2) * 8 + j] + pv.w * V1[(4 * c4 + 3) * 8 + j]; }
        VV[t * 8 + j] = s; }
    __syncthreads();
    const int half = tid >> 8, c = tid & 255, hh = c >> 6, lane = tid & 63;
    float zw[16], za[16], gg[16], zv[16];
    { const float w0 = in[19][l * 256 + c], a0 = in[21][l * 256 + c], v0 = l > 0 ? in[24][(l - 1) * 256 + c] : 0.f;
#pragma unroll
      for (int tt = 0; tt < 16; ++tt) { zw[tt] = w0; za[tt] = a0; gg[tt] = 0.f; zv[tt] = v0; } }
    const LAS float* ph = P + half * 16 * 832;
    {
        const float* w2p = in[20] + (size_t)l * 4096 + c; const float* a2p = in[22] + (size_t)l * 4096 + c;
        float wq[8];
#pragma unroll
        for (int q = 0; q < 4; ++q) { wq[q] = w2p[q * 256]; wq[4 + q] = a2p[q * 256]; }
#pragma unroll 1
        for (int j4 = 0; j4 < 4; ++j4) { float nq[8]; const int jn = j4 < 3 ? j4 + 1 : 3;
#pragma unroll
            for (int q = 0; q < 4; ++q) { nq[q] = w2p[(4 * jn + q) * 256]; nq[4 + q] = a2p[(4 * jn + q) * 256]; }
#pragma unroll
            for (int tt = 0; tt < 16; ++tt) { const f4 sw = *(const LAS f4*)(ph + tt * 832 + 768 + 4 * j4), sa = *(const LAS f4*)(ph + tt * 832 + 784 + 4 * j4);
                zw[tt] += sw.x * wq[0] + sw.y * wq[1] + sw.z * wq[2] + sw.w * wq[3]; za[tt] += sa.x * wq[4] + sa.y * wq[5] + sa.z * wq[6] + sa.w * wq[7]; }
#pragma unroll
            for (int q = 0; q < 8; ++q) wq[q] = nq[q]; }
        const float* g2p = in[23] + (size_t)l * 8192 + c; float gq[4];
#pragma unroll
        for (int q = 0; q < 4; ++q) gq[q] = g2p[q * 256];
#pragma unroll 1
        for (int j4 = 0; j4 < 8; ++j4) { float nq[4]; const int jn = j4 < 7 ? j4 + 1 : 7;
#pragma unroll
            for (int q = 0; q < 4; ++q) nq[q] = g2p[(4 * jn + q) * 256];
#pragma unroll
            for (int tt = 0; tt < 16; ++tt) { const f4 sg = *(const LAS f4*)(ph + tt * 832 + 800 + 4 * j4); gg[tt] += sg.x * gq[0] + sg.y * gq[1] + sg.z * gq[2] + sg.w * gq[3]; }
#pragma unroll
            for (int q = 0; q < 4; ++q) gq[q] = nq[q]; }
        if (l > 0) { const float* v2p = in[26] + (size_t)(l - 1) * 2048 + c; float vq[8];
#pragma unroll
            for (int q = 0; q < 8; ++q) vq[q] = v2p[q * 256];
#pragma unroll
            for (int tt = 0; tt < 16; ++tt) { const f4 s0 = *(const LAS f4*)(VV + (half * 16 + tt) * 8), s1 = *(const LAS f4*)(VV + (half * 16 + tt) * 8 + 4);
                zv[tt] += s0.x * vq[0] + s0.y * vq[1] + s0.z * vq[2] + s0.w * vq[3] + s1.x * vq[4] + s1.y * vq[5] + s1.z * vq[6] + s1.w * vq[7]; } }
    }
    const float kkw = in[27][l * 256 + c], kaw = in[28][l * 256 + c], rkw = in[29][l * 256 + c];
    float* VF = (float*)(ws + WS_VFIRST); float vf[16];
#pragma unroll
    for (int tt = 0; tt < 16; ++tt) vf[tt] = l > 0 ? VF[(size_t)(t0 + half * 16 + tt) * 256 + c] : 0.f;
#pragma unroll
    for (int tt = 0; tt < 16; ++tt) { const int t = half * 16 + tt; const size_t o = (size_t)(t0 + t) * 256 + c; const LAS float* pr = P + t * 832;
        const float r = pr[c], k = pr[256 + c]; float v = pr[512 + c];
        const float wd = __expf(-0.6065306597126334f * sigmoidf_(zw[tt])), av = sigmoidf_(za[tt]), g = gg[tt];
        if (l > 0) v = v + (vf[tt] - v) * sigmoidf_(zv[tt]); else VF[o] = v;
        float kk = k * kkw; const float nrm = sqrtf(wave_sum(kk * kk)); kk = kk / fmaxf(nrm, 1e-12f);
        const float k2 = k * (1.f + (av - 1.f) * kaw);
        const float bon = wave_sum(r * k2 * rkw);
        ((bf16*)(ws + WS_RWR))[o] = (bf16)pk2(r, 0.f); ((bf16*)(ws + WS_RWK))[o] = (bf16)pk2(k2, 0.f); ((bf16*)(ws + WS_RWV))[o] = (bf16)pk2(v, 0.f);
        ((bf16*)(ws + WS_RWKK))[o] = (bf16)pk2(-kk, 0.f); ((bf16*)(ws + WS_RWB))[o] = (bf16)pk2(kk * av, 0.f); ((bf16*)(ws + WS_RWG))[o] = (bf16)pk2(g, 0.f);
        ((float*)(ws + WS_RWW))[o] = wd;
        if (lane == 0) ((float*)(ws + WS_RWBON))[(t0 + t) * 4 + hh] = bon;
        asm volatile("" ::: "memory"); }
    __syncthreads();
}
__device__ __forceinline__ void phase_prep(const float* const* in, unsigned char* ws, int l, LAS unsigned char* lds, int tid) {
    const int N_L = (int)gridDim.x == 256 ? 256 : 512; constexpr int N_R = 512, N_S = 512;
    for (int it = blockIdx.x; it < N_L + N_R + N_S; it += gridDim.x) {
        if (it < N_L) {
#ifndef SKIP_PL
            prep_lru(in, ws, l, it, lds, tid);
#endif
        } else if (it < N_L + N_R) {
#ifndef SKIP_PR
            prep_rw(in, ws, l, it - N_L, lds, tid);
#endif
        } else {
#ifndef SKIP_PS
            prep_ssd(in, ws, l, it - N_L - N_R, tid);
#endif
        }
    }
}

template <int MODE> __device__ __forceinline__ void scan_rw(unsigned char* ws, int item, LAS unsigned char* lds, int tid) {
    LAS float* LW = (LAS float*)lds; LAS float* LKK = LW + 2048; LAS float* LB = LW + 4096; LAS float* LK = LW + 6144; LAS float* LR = LW + 8192; LAS float* LV = LW + 10240; LAS float* LY = LW + 12288;
    const int bh = item / NCH, ch = item % NCH, hh = bh & 3, tokb = (bh >> 2) * SEQ + ch * CHL, nsub = CHL / 32;
    const int st = tid >> 4, sc4 = (tid & 15) * 4, row = tid >> 3, sl = tid & 7;
    const bf16* gR = (const bf16*)(ws + WS_RWR); const bf16* gK = (const bf16*)(ws + WS_RWK); const bf16* gV = (const bf16*)(ws + WS_RWV); const bf16* gKK = (const bf16*)(ws + WS_RWKK); const bf16* gB = (const bf16*)(ws + WS_RWB);
    const float* gW = (const float*)(ws + WS_RWW); bf16* gY = (bf16*)(ws + WS_YRW);
    float* gU = (float*)(ws + WS_RWU) + (size_t)item * 4096 + row * 64 + sl * 8; float* gP = (float*)(ws + WS_RWP) + (size_t)item * 4096 + row * 64 + sl * 8;
    f2 s[4], p[4];
    if (MODE == 1) { const f4 a = *(const f4*)gU, c = *(const f4*)(gU + 4); s[0] = LO2(a); s[1] = HI2(a); s[2] = LO2(c); s[3] = HI2(c); }
    else {
#pragma unroll
        for (int i = 0; i < 4; ++i) { s[i] = (f2){0.f, 0.f}; p[i] = (f2){(sl * 8 + 2 * i == row) ? 1.f : 0.f, (sl * 8 + 2 * i + 1 == row) ? 1.f : 0.f}; } }
    u2 pr, pk, pv, pkk, pb; f4 pw;
    { const size_t o = (size_t)(tokb + st) * 256 + hh * 64 + sc4; if (MODE == 1) pr = *(const u2*)(gR + o); pk = *(const u2*)(gK + o); pv = *(const u2*)(gV + o); pkk = *(const u2*)(gKK + o); pb = *(const u2*)(gB + o); pw = *(const f4*)(gW + o); }
    for (int sub = 0; sub < nsub; ++sub) {
        const int so = st * 64 + sc4;
        *(LAS f4*)(LW + so) = pw; if (MODE == 1) *(LAS f4*)(LR + so) = (f4){bflo(pr.x), bfhi(pr.x), bflo(pr.y), bfhi(pr.y)}; *(LAS f4*)(LK + so) = (f4){bflo(pk.x), bfhi(pk.x), bflo(pk.y), bfhi(pk.y)};
        *(LAS f4*)(LV + so) = (f4){bflo(pv.x), bfhi(pv.x), bflo(pv.y), bfhi(pv.y)}; *(LAS f4*)(LKK + so) = (f4){bflo(pkk.x), bfhi(pkk.x), bflo(pkk.y), bfhi(pkk.y)}; *(LAS f4*)(LB + so) = (f4){bflo(pb.x), bfhi(pb.x), bflo(pb.y), bfhi(pb.y)};
        lds_barrier();
        if (sub + 1 < nsub) { const size_t o = (size_t)(tokb + (sub + 1) * 32 + st) * 256 + hh * 64 + sc4; if (MODE == 1) pr = *(const u2*)(gR + o); pk = *(const u2*)(gK + o); pv = *(const u2*)(gV + o); pkk = *(const u2*)(gKK + o); pb = *(const u2*)(gB + o); pw = *(const f4*)(gW + o); }
        {
            const int ob = sl * 8; f4 w0, w1, a0, a1, b0, b1, k0, k1, r0 = (f4){0.f, 0.f, 0.f, 0.f}, r1 = r0; float vv;
#define RW_LOAD(T) { const int o_ = ((T) & 31) * 64 + ob; w0 = *(const LAS f4*)(LW + o_); w1 = *(const LAS f4*)(LW + o_ + 4); a0 = *(const LAS f4*)(LKK + o_); a1 = *(const LAS f4*)(LKK + o_ + 4); b0 = *(const LAS f4*)(LB + o_); b1 = *(const LAS f4*)(LB + o_ + 4); \
            k0 = *(const LAS f4*)(LK + o_); k1 = *(const LAS f4*)(LK + o_ + 4); if (MODE == 1) { r0 = *(const LAS f4*)(LR + o_); r1 = *(const LAS f4*)(LR + o_ + 4); } vv = LV[((T) & 31) * 64 + row]; }
            RW_LOAD(0)
#pragma unroll 2
            for (int t = 0; t < 32; ++t) {
                const f4 cw0 = w0, cw1 = w1, ca0 = a0, ca1 = a1, cb0 = b0, cb1 = b1, ck0 = k0, ck1 = k1, cr0 = r0, cr1 = r1; const float cv = vv;
                RW_LOAD(t + 1)
                f2 d2 = s[0] * LO2(ca0); d2 = s[1] * HI2(ca0) + d2; d2 = s[2] * LO2(ca1) + d2; d2 = s[3] * HI2(ca1) + d2;
                if (MODE == 0) { f2 e2 = p[0] * LO2(ca0); e2 = p[1] * HI2(ca0) + e2; e2 = p[2] * LO2(ca1) + e2; e2 = p[3] * HI2(ca1) + e2;
                    const float sp = red8(e2.x + e2.y); const f2 sp2 = (f2){sp, sp};
                    p[0] = p[0] * LO2(cw0) + sp2 * LO2(cb0); p[1] = p[1] * HI2(cw0) + sp2 * HI2(cb0); p[2] = p[2] * LO2(cw1) + sp2 * LO2(cb1); p[3] = p[3] * HI2(cw1) + sp2 * HI2(cb1); }
                const float sa = red8(d2.x + d2.y); const f2 sa2 = (f2){sa, sa}, cv2 = (f2){cv, cv};
                s[0] = s[0] * LO2(cw0) + sa2 * LO2(cb0) + cv2 * LO2(ck0); s[1] = s[1] * HI2(cw0) + sa2 * HI2(cb0) + cv2 * HI2(ck0);
                s[2] = s[2] * LO2(cw1) + sa2 * LO2(cb1) + cv2 * LO2(ck1); s[3] = s[3] * HI2(cw1) + sa2 * HI2(cb1) + cv2 * HI2(ck1);
                if (MODE == 1) { f2 y2 = s[0] * LO2(cr0); y2 = s[1] * HI2(cr0) + y2; y2 = s[2] * LO2(cr1) + y2; y2 = s[3] * HI2(cr1) + y2;
                    LY[t * 64 + row] = red8(y2.x + y2.y); } }
#undef RW_LOAD
        }
        lds_barrier();
        if (MODE == 1) { const f4 y = *(const LAS f4*)(LY + so); u2 w; w.x = pk2(y.x, y.y); w.y = pk2(y.z, y.w); *(u2*)(gY + (size_t)(tokb + sub * 32 + st) * 256 + hh * 64 + sc4) = w; }
    }
    if (MODE == 0) { *(f4*)gU = (f4){s[0].x, s[0].y, s[1].x, s[1].y}; *(f4*)(gU + 4) = (f4){s[2].x, s[2].y, s[3].x, s[3].y}; *(f4*)gP = (f4){p[0].x, p[0].y, p[1].x, p[1].y}; *(f4*)(gP + 4) = (f4){p[2].x, p[2].y, p[3].x, p[3].y}; }
    __syncthreads();
}
template <int MODE> __device__ __forceinline__ void scan_rw2(unsigned char* ws, int pair, LAS unsigned char* lds, int tid) {
    const int hf = tid >> 8, ht = tid & 255, item = 2 * pair + hf;
    LAS float* LW = (LAS float*)(lds + hf * 57344); LAS float* LKK = LW + 2048; LAS float* LB = LW + 4096; LAS float* LK = LW + 6144; LAS float* LR = LW + 8192; LAS float* LV = LW + 10240; LAS float* LY = LW + 12288;
    const int bh = item / NCH, ch = item % NCH, hh = bh & 3, tokb = (bh >> 2) * SEQ + ch * CHL, nsub = CHL / 32;
    const int row0 = ht >> 3, sl = ht & 7;
    const bf16* gR = (const bf16*)(ws + WS_RWR); const bf16* gK = (const bf16*)(ws + WS_RWK); const bf16* gV = (const bf16*)(ws + WS_RWV); const bf16* gKK = (const bf16*)(ws + WS_RWKK); const bf16* gB = (const bf16*)(ws + WS_RWB);
    const float* gW = (const float*)(ws + WS_RWW); bf16* gY = (bf16*)(ws + WS_YRW);
    float* gU = (float*)(ws + WS_RWU) + (size_t)item * 4096 + row0 * 64 + sl * 8; float* gP = (float*)(ws + WS_RWP) + (size_t)item * 4096 + row0 * 64 + sl * 8;
    f2 s[2][4], p[2][4];
#pragma unroll
    for (int j = 0; j < 2; ++j) {
        if (MODE == 1) { const f4 a = *(const f4*)(gU + j * 2048), c = *(const f4*)(gU + j * 2048 + 4); s[j][0] = LO2(a); s[j][1] = HI2(a); s[j][2] = LO2(c); s[j][3] = HI2(c); }
        else {
#pragma unroll
            for (int i = 0; i < 4; ++i) { s[j][i] = (f2){0.f, 0.f}; p[j][i] = (f2){(sl * 8 + 2 * i == row0 + 32 * j) ? 1.f : 0.f, (sl * 8 + 2 * i + 1 == row0 + 32 * j) ? 1.f : 0.f}; } } }
    u2 pr[2], pk[2], pv[2], pkk[2], pb[2]; f4 pw[2];
#define RW2_FETCH(SUB) { _Pragma("unroll") for (int q = 0; q < 2; ++q) { const int pos = ht + 256 * q, st = pos >> 4, sc4 = (pos & 15) * 4; const size_t o = (size_t)(tokb + (SUB) * 32 + st) * 256 + hh * 64 + sc4; \
        if (MODE == 1) pr[q] = *(const u2*)(gR + o); pk[q] = *(const u2*)(gK + o); pv[q] = *(const u2*)(gV + o); pkk[q] = *(const u2*)(gKK + o); pb[q] = *(const u2*)(gB + o); pw[q] = *(const f4*)(gW + o); } }
    RW2_FETCH(0)
    for (int sub = 0; sub < nsub; ++sub) {
#pragma unroll
        for (int q = 0; q < 2; ++q) { const int pos = ht + 256 * q, so = (pos >> 4) * 64 + (pos & 15) * 4;
            *(LAS f4*)(LW + so) = pw[q]; if (MODE == 1) *(LAS f4*)(LR + so) = (f4){bflo(pr[q].x), bfhi(pr[q].x), bflo(pr[q].y), bfhi(pr[q].y)}; *(LAS f4*)(LK + so) = (f4){bflo(pk[q].x), bfhi(pk[q].x), bflo(pk[q].y), bfhi(pk[q].y)};
            *(LAS f4*)(LV + so) = (f4){bflo(pv[q].x), bfhi(pv[q].x), bflo(pv[q].y), bfhi(pv[q].y)}; *(LAS f4*)(LKK + so) = (f4){bflo(pkk[q].x), bfhi(pkk[q].x), bflo(pkk[q].y), bfhi(pkk[q].y)}; *(LAS f4*)(LB + so) = (f4){bflo(pb[q].x), bfhi(pb[q].x), bflo(pb[q].y), bfhi(pb[q].y)}; }
        lds_barrier();
        if (sub + 1 < nsub) RW2_FETCH(sub + 1)
        {   const int ob = sl * 8; f4 w0, w1, a0, a1, b0, b1, k0, k1, r0 = (f4){0.f, 0.f, 0.f, 0.f}, r1 = r0; float vv0, vv1;
#define RW_LOAD(T) { const int o_ = ((T) & 31) * 64 + ob; w0 = *(const LAS f4*)(LW + o_); w1 = *(const LAS f4*)(LW + o_ + 4); a0 = *(const LAS f4*)(LKK + o_); a1 = *(const LAS f4*)(LKK + o_ + 4); b0 = *(const LAS f4*)(LB + o_); b1 = *(const LAS f4*)(LB + o_ + 4); \
            k0 = *(const LAS f4*)(LK + o_); k1 = *(const LAS f4*)(LK + o_ + 4); if (MODE == 1) { r0 = *(const LAS f4*)(LR + o_); r1 = *(const LAS f4*)(LR + o_ + 4); } vv0 = LV[((T) & 31) * 64 + row0]; vv1 = LV[((T) & 31) * 64 + row0 + 32]; }
            RW_LOAD(0)
#pragma unroll 2
            for (int t = 0; t < 32; ++t) {
                const f4 cw0 = w0, cw1 = w1, ca0 = a0, ca1 = a1, cb0 = b0, cb1 = b1, ck0 = k0, ck1 = k1, cr0 = r0, cr1 = r1; const float cvv[2] = {vv0, vv1};
                RW_LOAD(t + 1)
#pragma unroll
                for (int j = 0; j < 2; ++j) {
                    f2 d2 = s[j][0] * LO2(ca0); d2 = s[j][1] * HI2(ca0) + d2; d2 = s[j][2] * LO2(ca1) + d2; d2 = s[j][3] * HI2(ca1) + d2;
                    if (MODE == 0) { f2 e2 = p[j][0] * LO2(ca0); e2 = p[j][1] * HI2(ca0) + e2; e2 = p[j][2] * LO2(ca1) + e2; e2 = p[j][3] * HI2(ca1) + e2;
                        const float sp = red8(e2.x + e2.y); const f2 sp2 = (f2){sp, sp};
                        p[j][0] = p[j][0] * LO2(cw0) + sp2 * LO2(cb0); p[j][1] = p[j][1] * HI2(cw0) + sp2 * HI2(cb0); p[j][2] = p[j][2] * LO2(cw1) + sp2 * LO2(cb1); p[j][3] = p[j][3] * HI2(cw1) + sp2 * HI2(cb1); }
                    const float sa = red8(d2.x + d2.y); const f2 sa2 = (f2){sa, sa}, cv2 = (f2){cvv[j], cvv[j]};
                    s[j][0] = s[j][0] * LO2(cw0) + sa2 * LO2(cb0) + cv2 * LO2(ck0); s[j][1] = s[j][1] * HI2(cw0) + sa2 * HI2(cb0) + cv2 * HI2(ck0);
                    s[j][2] = s[j][2] * LO2(cw1) + sa2 * LO2(cb1) + cv2 * LO2(ck1); s[j][3] = s[j][3] * HI2(cw1) + sa2 * HI2(cb1) + cv2 * HI2(ck1);
                    if (MODE == 1) { f2 y2 = s[j][0] * LO2(cr0); y2 = s[j][1] * HI2(cr0) + y2; y2 = s[j][2] * LO2(cr1) + y2; y2 = s[j][3] * HI2(cr1) + y2;
                        LY[t * 64 + row0 + 32 * j] = red8(y2.x + y2.y); } } }
#undef RW_LOAD
        }
        lds_barrier();
        if (MODE == 1) {
#pragma unroll
            for (int q = 0; q < 2; ++q) { const int pos = ht + 256 * q, st = pos >> 4, sc4 = (pos & 15) * 4; const f4 y = *(const LAS f4*)(LY + st * 64 + sc4); u2 w; w.x = pk2(y.x, y.y); w.y = pk2(y.z, y.w);
                *(u2*)(gY + (size_t)(tokb + sub * 32 + st) * 256 + hh * 64 + sc4) = w; } }
    }
#undef RW2_FETCH
    if (MODE == 0) {
#pragma unroll
        for (int j = 0; j < 2; ++j) { *(f4*)(gU + j * 2048) = (f4){s[j][0].x, s[j][0].y, s[j][1].x, s[j][1].y}; *(f4*)(gU + j * 2048 + 4) = (f4){s[j][2].x, s[j][2].y, s[j][3].x, s[j][3].y};
            *(f4*)(gP + j * 2048) = (f4){p[j][0].x, p[j][0].y, p[j][1].x, p[j][1].y}; *(f4*)(gP + j * 2048 + 4) = (f4){p[j][2].x, p[j][2].y, p[j][3].x, p[j][3].y}; } }
    __syncthreads();
}
__device__ __forceinline__ void combine_rw(unsigned char* ws, int it, LAS unsigned char* lds, int tid) {
    const int wave = tid >> 6, lane = tid & 63, bh = it >> 3, row = (it & 7) * 8 + wave;
    LAS float* LP = (LAS float*)lds;
    const float* gP = (const float*)(ws + WS_RWP) + (size_t)bh * NCH * 4096 + tid * 8; float* gU = (float*)(ws + WS_RWU) + (size_t)bh * NCH * 4096 + row * 64 + lane;
    f4 q[4][2]; float uq[4], s = 0.f;
#pragma unroll
    for (int d = 0; d < 4; ++d) { q[d][0] = *(const f4*)(gP + (size_t)d * 4096); q[d][1] = *(const f4*)(gP + (size_t)d * 4096 + 4); uq[d] = gU[(size_t)d * 4096]; }
    *(LAS f4*)(LP + tid * 8) = q[0][0]; *(LAS f4*)(LP + tid * 8 + 4) = q[0][1];
    lds_barrier();
#pragma unroll 1
    for (int c0 = 0; c0 < NCH; c0 += 4) {
#pragma unroll
        for (int d = 0; d < 4; ++d) { const int c = c0 + d; LAS float* cur = LP + (c & 1) * 4096; LAS float* nxt = LP + ((c + 1) & 1) * 4096;
            if (c + 1 < NCH) { *(LAS f4*)(nxt + tid * 8) = q[(d + 1) & 3][0]; *(LAS f4*)(nxt + tid * 8 + 4) = q[(d + 1) & 3][1]; }
            const float u = uq[d];
            if (c + 4 < NCH) { q[d][0] = *(const f4*)(gP + (size_t)(c + 4) * 4096); q[d][1] = *(const f4*)(gP + (size_t)(c + 4) * 4096 + 4); uq[d] = gU[(size_t)(c + 4) * 4096]; }
            gU[(size_t)c * 4096] = s;
            float n0 = u, n1 = 0.f; const int si = __builtin_bit_cast(int, s);
#pragma unroll
            for (int i = 0; i < 64; i += 2) { n0 += __builtin_bit_cast(float, __builtin_amdgcn_readlane(si, i)) * cur[i * 64 + lane]; n1 += __builtin_bit_cast(float, __builtin_amdgcn_readlane(si, i + 1)) * cur[(i + 1) * 64 + lane]; }
            s = n0 + n1;
            lds_barrier(); }
    }
    __syncthreads();
}
template <int MODE> __device__ __forceinline__ void scan_gla(const float* const* in, unsigned char* ws, int l, int item, LAS unsigned char* lds, int tid) {
    LAS float* LA = (LAS float*)lds; LAS float* LK = LA + 1024; LAS float* LQ = LA + 2048; LAS float* LV = LA + 3072; LAS float* LO = LA + 5120;
    const bf16* PROJ = (const bf16*)(ws + WS_PROJ); bf16* gO = (bf16*)(ws + WS_OGLA);
    const int bh = item / NCH, ch = item % NCH, hh = bh & 3, tokb = (bh >> 2) * SEQ + ch * CHL, nsub = CHL / 32;
    const int st = tid >> 4, si = tid & 15, vcol = tid >> 3, sl = tid & 7;
    float up0[16], up1[16];
#pragma unroll
    for (int r = 0; r < 16; ++r) { up0[r] = in[8][(l * 16 + r) * 128 + hh * 32 + 2 * si]; up1[r] = in[8][(l * 16 + r) * 128 + hh * 32 + 2 * si + 1]; }
    const float bi0 = in[9][l * 128 + hh * 32 + 2 * si], bi1 = in[9][l * 128 + hh * 32 + 2 * si + 1];
    float* gU = (float*)(ws + WS_GLU) + (size_t)item * 2048 + vcol * 32 + 4 * sl;
    float s[4] = {0.f, 0.f, 0.f, 0.f}, dp[4] = {1.f, 1.f, 1.f, 1.f};
    if (MODE == 1) { const f4 a = *(const f4*)gU; s[0] = a.x; s[1] = a.y; s[2] = a.z; s[3] = a.w; }
    u4 ps0, ps1; unsigned pq = 0, pk; u2 pv;
    { const bf16* p = PROJ + (size_t)(tokb + st) * NINP; ps0 = *(const u4*)(p + PC_GSTEM); ps1 = *(const u4*)(p + PC_GSTEM + 8); if (MODE == 1) pq = *(const unsigned*)(p + PC_GQ + hh * 32 + 2 * si); pk = *(const unsigned*)(p + PC_GK + hh * 32 + 2 * si); pv = *(const u2*)(p + PC_GV + hh * 64 + 4 * si); }
    for (int sub = 0; sub < nsub; ++sub) {
        { const unsigned sw[8] = {ps0.x, ps0.y, ps0.z, ps0.w, ps1.x, ps1.y, ps1.z, ps1.w}; float z0 = bi0, z1 = bi1;
#pragma unroll
          for (int r = 0; r < 8; ++r) { const float e0 = bflo(sw[r]), e1 = bfhi(sw[r]); z0 += e0 * up0[2 * r] + e1 * up0[2 * r + 1]; z1 += e0 * up1[2 * r] + e1 * up1[2 * r + 1]; }
          const float l0 = fminf(z0, 0.f) - log1pf(__expf(-fabsf(z0))), l1 = fminf(z1, 0.f) - log1pf(__expf(-fabsf(z1)));
          const int o = st * 32 + 2 * si; LA[o] = __expf(l0 * 0.0625f); LA[o + 1] = __expf(l1 * 0.0625f); LK[o] = bflo(pk); LK[o + 1] = bfhi(pk); if (MODE == 1) { LQ[o] = bflo(pq); LQ[o + 1] = bfhi(pq); }
          *(LAS f4*)(LV + st * 64 + 4 * si) = (f4){bflo(pv.x), bfhi(pv.x), bflo(pv.y), bfhi(pv.y)}; }
        lds_barrier();
        if (sub + 1 < nsub) { const bf16* p = PROJ + (size_t)(tokb + (sub + 1) * 32 + st) * NINP; ps0 = *(const u4*)(p + PC_GSTEM); ps1 = *(const u4*)(p + PC_GSTEM + 8); if (MODE == 1) pq = *(const unsigned*)(p + PC_GQ + hh * 32 + 2 * si); pk = *(const unsigned*)(p + PC_GK + hh * 32 + 2 * si); pv = *(const u2*)(p + PC_GV + hh * 64 + 4 * si); }
        {   f4 al, kk, qq = (f4){0.f, 0.f, 0.f, 0.f}; float vv;
#define GL_LOAD(T) { const int o_ = ((T) & 31) * 32 + 4 * sl; al = *(const LAS f4*)(LA + o_); kk = *(const LAS f4*)(LK + o_); if (MODE == 1) qq = *(const LAS f4*)(LQ + o_); vv = LV[((T) & 31) * 64 + vcol]; }
            GL_LOAD(0)
#pragma unroll 4
            for (int t = 0; t < 32; ++t) { const f4 ca = al, ck = kk, cq = qq; const float cv = vv;
                GL_LOAD(t + 1)
                s[0] = s[0] * ca.x + ck.x * cv; s[1] = s[1] * ca.y + ck.y * cv; s[2] = s[2] * ca.z + ck.z * cv; s[3] = s[3] * ca.w + ck.w * cv;
                if (MODE == 0) { dp[0] *= ca.x; dp[1] *= ca.y; dp[2] *= ca.z; dp[3] *= ca.w; }
                else { const float o = (s[0] * cq.x + s[1] * cq.y) + (s[2] * cq.z + s[3] * cq.w); LO[t * 64 + vcol] = red8(o) * 0.17677669529663687f; } }
#undef GL_LOAD
        }
        lds_barrier();
        if (MODE == 1) { const f4 y = *(const LAS f4*)(LO + st * 64 + 4 * si); u2 w; w.x = pk2(y.x, y.y); w.y = pk2(y.z, y.w); *(u2*)(gO + (size_t)(tokb + sub * 32 + st) * 256 + hh * 64 + 4 * si) = w; }
    }
    if (MODE == 0) { *(f4*)gU = (f4){s[0], s[1], s[2], s[3]}; if (vcol == 0) *(f4*)((float*)(ws + WS_GLD) + item * 32 + 4 * sl) = (f4){dp[0], dp[1], dp[2], dp[3]}; }
    __syncthreads();
}
template <int MODE> __device__ __forceinline__ void scan_ssd(unsigned char* ws, int item, LAS unsigned char* lds, int tid) {
    LAS float* LB = (LAS float*)lds; LAS float* LC = LB + 4096; LAS float* LX = LB + 8192; LAS float* LD = LB + 10240; LAS float* LY = LB + 10304;
    const bf16* XBC = (const bf16*)(ws + WS_XBC); const float* DT = (const float*)(ws + WS_DT); const float* DEC = (const float*)(ws + WS_DEC); bf16* gY = (bf16*)(ws + WS_YSSD);
    const int bh = item / NCH, ch = item % NCH, hh = bh & 3, tokb = (bh >> 2) * SEQ + ch * CHL, nsub = CHL / 32;
    const int st = tid >> 4, si = tid & 15, p = tid >> 3, sl = tid & 7, g = hh >> 1;
    float* gU = (float*)(ws + WS_SSU) + (size_t)item * 8192 + p * 128 + 16 * sl;
    f2 s[8]; float dprod = 1.f;
#pragma unroll
    for (int i = 0; i < 4; ++i) { f4 a = (f4){0.f, 0.f, 0.f, 0.f}; if (MODE == 1) a = *(const f4*)(gU + 4 * i); s[2 * i] = LO2(a); s[2 * i + 1] = HI2(a); }
    u4 pb, pc = (u4){0u, 0u, 0u, 0u}; u2 px; float pdt, pdec;
    { const size_t tok = tokb + st; const bf16* q = XBC + tok * 768; pb = *(const u4*)(q + 256 + g * 128 + 8 * si); if (MODE == 1) pc = *(const u4*)(q + 512 + g * 128 + 8 * si); px = *(const u2*)(q + hh * 64 + 4 * si); pdt = DT[tok * 4 + hh]; pdec = DEC[tok * 4 + hh]; }
    for (int sub = 0; sub < nsub; ++sub) {
        { const int o = st * 128 + 8 * si;
          *(LAS f4*)(LB + o) = (f4){bflo(pb.x), bfhi(pb.x), bflo(pb.y), bfhi(pb.y)}; *(LAS f4*)(LB + o + 4) = (f4){bflo(pb.z), bfhi(pb.z), bflo(pb.w), bfhi(pb.w)};
          if (MODE == 1) { *(LAS f4*)(LC + o) = (f4){bflo(pc.x), bfhi(pc.x), bflo(pc.y), bfhi(pc.y)}; *(LAS f4*)(LC + o + 4) = (f4){bflo(pc.z), bfhi(pc.z), bflo(pc.w), bfhi(pc.w)}; }
          *(LAS f4*)(LX + st * 64 + 4 * si) = (f4){bflo(px.x) * pdt, bfhi(px.x) * pdt, bflo(px.y) * pdt, bfhi(px.y) * pdt};
          if (si == 0) LD[st] = pdec; }
        lds_barrier();
        if (sub + 1 < nsub) { const size_t tok = tokb + (sub + 1) * 32 + st; const bf16* q = XBC + tok * 768; pb = *(const u4*)(q + 256 + g * 128 + 8 * si); if (MODE == 1) pc = *(const u4*)(q + 512 + g * 128 + 8 * si); px = *(const u2*)(q + hh * 64 + 4 * si); pdt = DT[tok * 4 + hh]; pdec = DEC[tok * 4 + hh]; }
        {   f4 bb[4], cc[4]; float xv, dc;
#pragma unroll
            for (int q4 = 0; q4 < 4; ++q4) cc[q4] = (f4){0.f, 0.f, 0.f, 0.f};
#define SS_LOAD(T) { const int o_ = ((T) & 31) * 128 + 16 * sl; _Pragma("unroll") for (int q4 = 0; q4 < 4; ++q4) { bb[q4] = *(const LAS f4*)(LB + o_ + 4 * q4); if (MODE == 1) cc[q4] = *(const LAS f4*)(LC + o_ + 4 * q4); } xv = LX[((T) & 31) * 64 + p]; dc = LD[(T) & 31]; }
            SS_LOAD(0)
#pragma unroll 2
            for (int t = 0; t < 32; ++t) { f4 cb_[4], cc_[4]; const float cx = xv, cd = dc;
#pragma unroll
                for (int q4 = 0; q4 < 4; ++q4) { cb_[q4] = bb[q4]; cc_[q4] = cc[q4]; }
                SS_LOAD(t + 1)
                if (MODE == 0) dprod *= cd;
                const f2 cd2 = (f2){cd, cd}, cx2 = (f2){cx, cx}; f2 y2 = (f2){0.f, 0.f};
#pragma unroll
                for (int q4 = 0; q4 < 4; ++q4) {
                    s[2 * q4] = s[2 * q4] * cd2 + LO2(cb_[q4]) * cx2; s[2 * q4 + 1] = s[2 * q4 + 1] * cd2 + HI2(cb_[q4]) * cx2;
                    if (MODE == 1) { y2 = s[2 * q4] * LO2(cc_[q4]) + y2; y2 = s[2 * q4 + 1] * HI2(cc_[q4]) + y2; } }
                if (MODE == 1) LY[t * 64 + p] = red8(y2.x + y2.y); }
#undef SS_LOAD
        }
        lds_barrier();
        if (MODE == 1) { const f4 y = *(const LAS f4*)(LY + st * 64 + 4 * si); u2 w; w.x = pk2(y.x, y.y); w.y = pk2(y.z, y.w); *(u2*)(gY + (size_t)(tokb + sub * 32 + st) * 256 + hh * 64 + 4 * si) = w; }
    }
    if (MODE == 0) {
#pragma unroll
        for (int i = 0; i < 4; ++i) *(f4*)(gU + 4 * i) = (f4){s[2 * i].x, s[2 * i].y, s[2 * i + 1].x, s[2 * i + 1].y};
        if (tid == 0) ((float*)(ws + WS_SSD))[item] = dprod; }
    __syncthreads();
}
constexpr int SP = 136;
__device__ __forceinline__ bf16 u4_elem(const u4& w, int e) { const unsigned x = (e >> 1) == 0 ? w.x : (e >> 1) == 1 ? w.y : (e >> 1) == 2 ? w.z : w.w; return (bf16)((e & 1) ? (x >> 16) : (x & 0xffffu)); }
__device__ __forceinline__ void ssd_cumsum(unsigned char* ws, int tok0, int g, LAS float* CS, int tid) {
    const int wave = tid >> 6, lane = tid & 63;
    if (wave < 2) { const float* DA = (const float*)(ws + WS_DEC); const float a0 = DA[(size_t)(tok0 + 2 * lane) * 4 + 2 * g + wave], a1 = DA[(size_t)(tok0 + 2 * lane + 1) * 4 + 2 * g + wave]; float v = a0 + a1;
#pragma unroll
        for (int o = 1; o < 64; o <<= 1) { const float t = __shfl_up(v, o); if (lane >= o) v += t; }
        CS[wave * 128 + 2 * lane] = v - a1; CS[wave * 128 + 2 * lane + 1] = v; }
}
__device__ __forceinline__ void ssd_passA(unsigned char* ws, int item, LAS unsigned char* lds, int tid) {
    const int b = item >> 7, g = (item >> 6) & 1, ch = item & 63, tok0 = b * SEQ + ch * 128;
    LAS bf16* LB = (LAS bf16*)(lds + 34816); LAS bf16* LX = (LAS bf16*)(lds + 69632); LAS float* CS = (LAS float*)(lds + 139264);
    const bf16* XBC = (const bf16*)(ws + WS_XBC); const float* DT = (const float*)(ws + WS_DT);
    ssd_cumsum(ws, tok0, g, CS, tid);
    const int sr = tid >> 2, part = tid & 3;
    { const bf16* q = XBC + (size_t)(tok0 + sr) * 768 + 256 + g * 128 + part * 32;
#pragma unroll
      for (int v = 0; v < 4; ++v) { const u4 w = *(const u4*)(q + 8 * v);
#pragma unroll
          for (int e = 0; e < 8; ++e) LB[(part * 32 + 8 * v + e) * SP + sr] = u4_elem(w, e); } }
    lds_barrier();
    { const int hl = part >> 1, p0 = (part & 1) * 32, h = 2 * g + hl; const float sc = DT[(size_t)(tok0 + sr) * 4 + h] * __expf(CS[hl * 128 + 127] - CS[hl * 128 + sr]);
      const bf16* q = XBC + (size_t)(tok0 + sr) * 768 + h * 64 + p0;
#pragma unroll
      for (int v = 0; v < 4; ++v) { const u4 w = *(const u4*)(q + 8 * v);
#pragma unroll
          for (int e = 0; e < 8; ++e) LX[(hl * 64 + p0 + 8 * v + e) * SP + sr] = (bf16)pk2(bf2f(u4_elem(w, e)) * sc, 0.f); } }
    lds_barrier();
    const int wave = tid >> 6, lane = tid & 63, r16 = lane & 15, q4 = lane >> 4, hl = wave >> 2, pt = wave & 3;
    f32x4 acc[8];
#pragma unroll
    for (int nt = 0; nt < 8; ++nt) acc[nt] = (f32x4){0.f, 0.f, 0.f, 0.f};
#pragma unroll
    for (int ks = 0; ks < 4; ++ks) { const s8v af = *(const LAS s8v*)(LX + (hl * 64 + 16 * pt + r16) * SP + 32 * ks + 8 * q4);
#pragma unroll
        for (int nt = 0; nt < 8; ++nt) { const s8v bfr = *(const LAS s8v*)(LB + (16 * nt + r16) * SP + 32 * ks + 8 * q4); acc[nt] = MFMA16(af, bfr, acc[nt]); } }
    float* gU = (float*)(ws + WS_SSU) + ((size_t)(b * 4 + 2 * g + hl) * NCS + ch) * 8192;
#pragma unroll
    for (int nt = 0; nt < 8; ++nt)
#pragma unroll
        for (int i = 0; i < 4; ++i) gU[(16 * pt + 4 * q4 + i) * 128 + 16 * nt + r16] = acc[nt][i];
    if (tid < 2) ((float*)(ws + WS_SSD))[(b * 4 + 2 * g + tid) * NCS + ch] = __expf(CS[tid * 128 + 127]);
    __syncthreads();
}
__device__ __forceinline__ void ssd_passB(unsigned char* ws, int item, LAS unsigned char* lds, int tid) {
    const int b = item >> 7, g = (item >> 6) & 1, ch = item & 63, tok0 = b * SEQ + ch * 128;
    LAS bf16* LC = (LAS bf16*)lds; LAS bf16* LB = (LAS bf16*)(lds + 34816); LAS bf16* LX = (LAS bf16*)(lds + 69632); LAS bf16* LS = (LAS bf16*)(lds + 104448); LAS float* CS = (LAS float*)(lds + 139264);
    const bf16* XBC = (const bf16*)(ws + WS_XBC); const float* DT = (const float*)(ws + WS_DT); bf16* gY = (bf16*)(ws + WS_YSSD);
    ssd_cumsum(ws, tok0, g, CS, tid);
    const int sr = tid >> 2, part = tid & 3;
    { const bf16* q = XBC + (size_t)(tok0 + sr) * 768;
#pragma unroll
      for (int v = 0; v < 4; ++v) { *(LAS u4*)(LB + sr * SP + part * 32 + 8 * v) = *(const u4*)(q + 256 + g * 128 + part * 32 + 8 * v); *(LAS u4*)(LC + sr * SP + part * 32 + 8 * v) = *(const u4*)(q + 512 + g * 128 + part * 32 + 8 * v); } }
    { const int hl = part >> 1, p0 = (part & 1) * 32, h = 2 * g + hl; const float sc = DT[(size_t)(tok0 + sr) * 4 + h];
      const bf16* q = XBC + (size_t)(tok0 + sr) * 768 + h * 64 + p0;
#pragma unroll
      for (int v = 0; v < 4; ++v) { const u4 w = *(const u4*)(q + 8 * v);
#pragma unroll
          for (int e = 0; e < 8; ++e) LX[(hl * 64 + p0 + 8 * v + e) * SP + sr] = (bf16)pk2(bf2f(u4_elem(w, e)) * sc, 0.f); } }
    { const int hl = sr >> 6, p = sr & 63; const float* gS = (const float*)(ws + WS_SSU) + ((size_t)(b * 4 + 2 * g + hl) * NCS + ch) * 8192 + p * 128 + part * 32;
#pragma unroll
      for (int v = 0; v < 4; ++v) { const f4 x0 = *(const f4*)(gS + 8 * v), x1 = *(const f4*)(gS + 8 * v + 4); u4 w; w.x = pk2(x0.x, x0.y); w.y = pk2(x0.z, x0.w); w.z = pk2(x1.x, x1.y); w.w = pk2(x1.z, x1.w); *(LAS u4*)(LS + sr * SP + part * 32 + 8 * v) = w; } }
    lds_barrier();
    const int wave = tid >> 6, lane = tid & 63, r16 = lane & 15, q4 = lane >> 4, lt = wave;
    f32x4 cb[8];
#pragma unroll
    for (int st = 0; st < 8; ++st) cb[st] = (f32x4){0.f, 0.f, 0.f, 0.f};
#pragma unroll
    for (int ks = 0; ks < 4; ++ks) { const s8v af = *(const LAS s8v*)(LC + (16 * lt + r16) * SP + 32 * ks + 8 * q4);
#pragma unroll
        for (int st = 0; st < 8; ++st) { const s8v bfr = *(const LAS s8v*)(LB + (16 * st + r16) * SP + 32 * ks + 8 * q4); cb[st] = MFMA16(af, bfr, cb[st]); } }
#pragma unroll 1
    for (int hl = 0; hl < 2; ++hl) {
        lds_barrier();
#pragma unroll
        for (int st = 0; st < 8; ++st)
#pragma unroll
            for (int i = 0; i < 4; ++i) { const int l = 16 * lt + 4 * q4 + i, s2 = 16 * st + r16; const float m = (s2 <= l) ? cb[st][i] * __expf(CS[hl * 128 + l] - CS[hl * 128 + s2]) : 0.f; LB[l * SP + s2] = (bf16)pk2(m, 0.f); }
        lds_barrier();
        f32x4 yd[4], yo[4];
#pragma unroll
        for (int p4 = 0; p4 < 4; ++p4) { yd[p4] = (f32x4){0.f, 0.f, 0.f, 0.f}; yo[p4] = (f32x4){0.f, 0.f, 0.f, 0.f}; }
#pragma unroll
        for (int ks = 0; ks < 4; ++ks) { const s8v mf = *(const LAS s8v*)(LB + (16 * lt + r16) * SP + 32 * ks + 8 * q4), cf = *(const LAS s8v*)(LC + (16 * lt + r16) * SP + 32 * ks + 8 * q4);
#pragma unroll
            for (int p4 = 0; p4 < 4; ++p4) { const s8v xf = *(const LAS s8v*)(LX + (hl * 64 + 16 * p4 + r16) * SP + 32 * ks + 8 * q4), sf = *(const LAS s8v*)(LS + (hl * 64 + 16 * p4 + r16) * SP + 32 * ks + 8 * q4);
                yd[p4] = MFMA16(xf, mf, yd[p4]); yo[p4] = MFMA16(sf, cf, yo[p4]); } }
        const float el = __expf(CS[hl * 128 + 16 * lt + r16]);
#pragma unroll
        for (int p4 = 0; p4 < 4; ++p4) { const f32x4 y = yd[p4] + yo[p4] * el; u2 w; w.x = pk2(y[0], y[1]); w.y = pk2(y[2], y[3]);
            *(u2*)(gY + (size_t)(tok0 + 16 * lt + r16) * 256 + (2 * g + hl) * 64 + 16 * p4 + 4 * q4) = w; }
    }
    __syncthreads();
}
__device__ __forceinline__ void scan_lru_carry(unsigned char* ws, int tid) {
    const float* SA = (const float*)(ws + WS_SEGA); const float* SH = (const float*)(ws + WS_SEGH); float* CY = (float*)(ws + WS_CARRY);
    const int b = tid >> 8, c = tid & 255; float h = 0.f;
#pragma unroll 1
    for (int g0 = 0; g0 < 256; g0 += 32) { float av[32], hv[32];
#pragma unroll
        for (int j = 0; j < 32; ++j) { const int o = (b * 256 + g0 + j) * 256 + c; av[j] = SA[o]; hv[j] = SH[o]; }
#pragma unroll
        for (int j = 0; j < 32; ++j) { CY[(b * 256 + g0 + j) * 256 + c] = h; h = av[j] * h + hv[j]; } }
}
__device__ __forceinline__ void combine_gla(unsigned char* ws, int bh, int tid) {
    float* gU = (float*)(ws + WS_GLU) + (size_t)bh * NCH * 2048 + tid * 4; const float* gD = (const float*)(ws + WS_GLD) + bh * NCH * 32 + (tid & 7) * 4; f4 s = (f4){0.f, 0.f, 0.f, 0.f};
#pragma unroll 1
    for (int c0 = 0; c0 < NCH; c0 += 16) { f4 u[16], d[16];
#pragma unroll
        for (int j = 0; j < 16; ++j) { u[j] = *(const f4*)(gU + (size_t)(c0 + j) * 2048); d[j] = *(const f4*)(gD + (c0 + j) * 32); }
#pragma unroll
        for (int j = 0; j < 16; ++j) { *(f4*)(gU + (size_t)(c0 + j) * 2048) = s; s = s * d[j] + u[j]; } }
}
__device__ __forceinline__ void combine_ssd(unsigned char* ws, int q, int tid) {
    const int bh = q >> 2; float* gU = (float*)(ws + WS_SSU) + (size_t)bh * NCS * 8192 + (q & 3) * 2048 + tid * 4; const float* gD = (const float*)(ws + WS_SSD) + bh * NCS; f4 s = (f4){0.f, 0.f, 0.f, 0.f};
#pragma unroll 1
    for (int c0 = 0; c0 < NCS; c0 += 16) { f4 u[16]; float d[16];
#pragma unroll
        for (int j = 0; j < 16; ++j) { u[j] = *(const f4*)(gU + (size_t)(c0 + j) * 8192); d[j] = gD[c0 + j]; }
#pragma unroll
        for (int j = 0; j < 16; ++j) { *(f4*)(gU + (size_t)(c0 + j) * 8192) = s; s = s * d[j] + u[j]; } }
}
template <int MODE> __device__ __forceinline__ void phase_scan(const float* const* in, unsigned char* ws, int l, LAS unsigned char* lds, int tid) {
    for (int t = blockIdx.x; t < 256; t += gridDim.x) {
        if (t < 128) scan_rw2<MODE>(ws, t, lds, tid);
        else { const int i0 = 2 * (t - 128);
            scan_gla<MODE>(in, ws, l, i0, lds, tid); scan_gla<MODE>(in, ws, l, i0 + 1, lds, tid);
            if (MODE == 0) { ssd_passA(ws, i0, lds, tid); ssd_passA(ws, i0 + 1, lds, tid); } else { ssd_passB(ws, i0, lds, tid); ssd_passB(ws, i0 + 1, lds, tid); }
            if (MODE == 0 && (int)gridDim.x == 256) { prep_lru(in, ws, l, 256 + i0, lds, tid); prep_lru(in, ws, l, 257 + i0, lds, tid); } }
    }
}
__device__ __forceinline__ void phase_combine(const float* const* in, unsigned char* ws, int l, LAS unsigned char* lds, int tid) {
    const int wave = __builtin_amdgcn_readfirstlane(tid >> 6), lane = tid & 63; constexpr int NCW = 105;
    const int mask = (l + 1 < NL ? (1 | 4) : 0) | 16;
    if ((int)gridDim.x > NCW + 8) {
        if ((int)blockIdx.x < 64) combine_rw(ws, blockIdx.x, lds, tid);
        else if ((int)blockIdx.x < 72) combine_gla(ws, blockIdx.x - 64, tid);
        else if ((int)blockIdx.x < 104) combine_ssd(ws, blockIdx.x - 72, tid);
        else if ((int)blockIdx.x == 104) scan_lru_carry(ws, tid);
        else convert_mats(in, ws, mask, l + 1, l, lds, ((int)blockIdx.x - NCW) * 8 + wave, ((int)gridDim.x - NCW) * 8, wave, lane);
    } else {
        for (int it = blockIdx.x; it < NCW; it += gridDim.x) {
            if (it < 64) combine_rw(ws, it, lds, tid);
            else if (it < 72) combine_gla(ws, it - 64, tid);
            else if (it < 104) combine_ssd(ws, it - 72, tid);
            else scan_lru_carry(ws, tid);
        }
        convert_mats(in, ws, mask, l + 1, l, lds, blockIdx.x * 8 + wave, gridDim.x * 8, wave, lane);
    }
}
__device__ __forceinline__ void phase_post(const float* const* in, unsigned char* ws, int l, int gw, int NGW, int lane) {
    const bf16* PROJ = (const bf16*)(ws + WS_PROJ); bf16* Y = (bf16*)(ws + WS_Y); const int c = 4 * lane, hh = lane >> 4;
    const f4 gnorm = *(const f4*)(in[10] + l * 64 + (c & 63)), gnw = *(const f4*)(in[30] + l * 256 + c), gnb = *(const f4*)(in[31] + l * 256 + c), snw = *(const f4*)(in[37] + l * 256 + c);
    const float dsk = in[36][l * 4 + hh];
    for (int tok = gw; tok < M; tok += NGW) { const bf16* pp = PROJ + (size_t)tok * NINP; const size_t o = (size_t)tok * 256 + c; bf16* yo = Y + (size_t)tok * D + c;
        const u2 g_ov = *(const u2*)((const bf16*)(ws + WS_OGLA) + o), g_gv = *(const u2*)(pp + PC_GG + c);
        const f4 l_A = *(const f4*)((const float*)(ws + WS_LRA) + o), l_H = *(const f4*)((const float*)(ws + WS_LRH) + o), l_cy = *(const f4*)((const float*)(ws + WS_CARRY) + (size_t)(tok >> 5) * 256 + c); const u2 l_gv = *(const u2*)(pp + PC_LG + c);
        const u2 r_yv = *(const u2*)((const bf16*)(ws + WS_YRW) + o), r_vv = *(const u2*)((const bf16*)(ws + WS_RWV) + o), r_gv = *(const u2*)((const bf16*)(ws + WS_RWG) + o); const float bon = ((const float*)(ws + WS_RWBON))[tok * 4 + hh];
        const u2 s_yv = *(const u2*)((const bf16*)(ws + WS_YSSD) + o), s_xv = *(const u2*)((const bf16*)(ws + WS_XBC) + (size_t)tok * 768 + c), s_zv = *(const u2*)(pp + PC_SZ + c);
        u2 w0, w1, w2, w3;
        { const float o0 = bflo(g_ov.x), o1 = bfhi(g_ov.x), o2 = bflo(g_ov.y), o3 = bfhi(g_ov.y);
          const float rs = rsqrtf(red16((o0 * o0 + o1 * o1) + (o2 * o2 + o3 * o3)) * (1.f / 64.f) + 1e-5f);
          w0.x = pk2(o0 * rs * gnorm.x * siluf_(bflo(g_gv.x)), o1 * rs * gnorm.y * siluf_(bfhi(g_gv.x))); w0.y = pk2(o2 * rs * gnorm.z * siluf_(bflo(g_gv.y)), o3 * rs * gnorm.w * siluf_(bfhi(g_gv.y))); }
        { w1.x = pk2((l_H.x + l_A.x * l_cy.x) * gelu_tanh(bflo(l_gv.x)), (l_H.y + l_A.y * l_cy.y) * gelu_tanh(bfhi(l_gv.x))); w1.y = pk2((l_H.z + l_A.z * l_cy.z) * gelu_tanh(bflo(l_gv.y)), (l_H.w + l_A.w * l_cy.w) * gelu_tanh(bfhi(l_gv.y))); }
        { float y0 = bflo(r_yv.x), y1 = bfhi(r_yv.x), y2 = bflo(r_yv.y), y3 = bfhi(r_yv.y);
          const float mean = red16((y0 + y1) + (y2 + y3)) * (1.f / 64.f); y0 -= mean; y1 -= mean; y2 -= mean; y3 -= mean;
          const float rs = rsqrtf(red16((y0 * y0 + y1 * y1) + (y2 * y2 + y3 * y3)) * (1.f / 64.f) + 64e-5f);
          w2.x = pk2((y0 * rs * gnw.x + gnb.x + bon * bflo(r_vv.x)) * bflo(r_gv.x), (y1 * rs * gnw.y + gnb.y + bon * bfhi(r_vv.x)) * bfhi(r_gv.x));
          w2.y = pk2((y2 * rs * gnw.z + gnb.z + bon * bflo(r_vv.y)) * bflo(r_gv.y), (y3 * rs * gnw.w + gnb.w + bon * bfhi(r_vv.y)) * bfhi(r_gv.y)); }
        { const float y0 = (bflo(s_yv.x) + dsk * bflo(s_xv.x)) * siluf_(bflo(s_zv.x)), y1 = (bfhi(s_yv.x) + dsk * bfhi(s_xv.x)) * siluf_(bfhi(s_zv.x)), y2 = (bflo(s_yv.y) + dsk * bflo(s_xv.y)) * siluf_(bflo(s_zv.y)), y3 = (bfhi(s_yv.y) + dsk * bfhi(s_xv.y)) * siluf_(bfhi(s_zv.y));
          float q = red16((y0 * y0 + y1 * y1) + (y2 * y2 + y3 * y3)); q += __shfl_xor(q, 16);
          const float rs = rsqrtf(q * (1.f / 128.f) + 1e-5f);
          w3.x = pk2(y0 * rs * snw.x, y1 * rs * snw.y); w3.y = pk2(y2 * rs * snw.z, y3 * rs * snw.w); }
        *(u2*)(yo) = w0; *(u2*)(yo + 256) = w1; *(u2*)(yo + 512) = w2; *(u2*)(yo + 768) = w3;
    }
}
#ifndef PROBE_GEMM
#define PROBE_GEMM 1
#endif
#ifndef PROBE_SCAN
#define PROBE_SCAN 1
#endif
#ifndef PROBE_MISC
#define PROBE_MISC 1
#endif
struct Args { const float* in[43]; float* out; unsigned char* ws; };
template <class Epi> __device__ __forceinline__ void gemm_multi(LAS unsigned char* lds, const pg8::Gemm& g, const Epi& E) {
    pg8::StaticOrder S; S.init(g.M, g.N, (int)gridDim.x, (int)blockIdx.x);
    pg8::gemm_phase<Epi, pg8::StaticOrder, true, true>(lds, g, S, E);
}
template <class Epi> __device__ __forceinline__ void gemm_single(LAS unsigned char* lds, const pg8::Gemm& g, const Epi& E, const unsigned* wait = nullptr, unsigned need = 0u, unsigned* pub = nullptr, unsigned* tmo = nullptr) {
    pg8::StaticOrder S; S.init(g.M, g.N, (int)gridDim.x, (int)blockIdx.x);
    int prev = -1;
    for (int r = 0;; ++r) { pg8::Unit u; if (!S.next(r, u)) break; OneUnit O{S, r, wait, need, pub, tmo, prev}; pg8::gemm_phase<Epi, OneUnit, false, true>(lds, g, O, E); prev = u.pm; }
    if (pub && prev >= 0) { asm volatile("s_waitcnt vmcnt(0)" ::: "memory"); __syncthreads(); if (threadIdx.x == 0) __hip_atomic_fetch_add(pub + 64 * prev, 1u, __ATOMIC_RELAXED, __HIP_MEMORY_SCOPE_AGENT); }
}
__device__ __forceinline__ void tail_convert(const float* const* in, unsigned char* ws, int units, int mask, int lA, int lB, LAS unsigned char* lds) {
    const int G = (int)gridDim.x, rem = units % G; if (rem == 0 || (int)blockIdx.x < rem) return;
    int tid = threadIdx.x; asm volatile("" : "+v"(tid)); const int lane = tid & 63, wave = __builtin_amdgcn_readfirstlane(tid >> 6);
    convert_mats(in, ws, mask, lA, lB, lds, ((int)blockIdx.x - rem) * 8 + wave, (G - rem) * 8, wave, lane);
}
__global__ void __launch_bounds__(512, 2) fwd(Args a) {
    extern __shared__ __attribute__((aligned(16))) unsigned char lds_raw[];
    LAS unsigned char* lds = (LAS unsigned char*)lds_raw;
    cg::grid_group grid = cg::this_grid();
    unsigned* ctl = (unsigned*)(a.ws + WS_CTL); volatile LAS unsigned* MISC = (volatile LAS unsigned*)(lds + LDS_BYTES - 64);
    if (threadIdx.x < 2) MISC[threadIdx.x] = 0u;
    __syncthreads();
    if (a.ws == nullptr) grid.sync();
    const XcdBarrier bar = xcd_barrier_post(ctl, MISC);
#define GSYNC() do { XcdBarrier bb_ = bar; asm volatile("" : "+s"(bb_.bar), "+s"(bb_.x)); xcd_barrier(bb_); } while (0)
#define TIDS int tid = threadIdx.x; asm volatile("" : "+v"(tid)); const int lane = tid & 63, wave = __builtin_amdgcn_readfirstlane(tid >> 6), gw = blockIdx.x * 8 + wave, NGW = gridDim.x * 8; (void)lane; (void)gw; (void)NGW;
    unsigned char* ws = a.ws; const float* const* in = a.in; float* X = a.out;
    bf16* XB = (bf16*)(ws + WS_XB); bf16* Y = (bf16*)(ws + WS_Y); bf16* H = (bf16*)(ws + WS_PROJ); bf16* PROJ = (bf16*)(ws + WS_PROJ); float* SS = (float*)(ws + WS_SS);
    { TIDS convert_mats(in, ws, 7, 0, 0, lds, gw, NGW, wave, lane); phase_init_rows(in[0], XB, SS, gw, NGW, lane); }
    GSYNC();
#pragma unroll 1
    for (int l = 0; l < NL; ++l) {
#ifndef SKIP_G1
        { pg8::Gemm g{XB, (const bf16*)(ws + WS_WGU1), M, 2 * FF, D}; EpiGU E{H, SS}; gemm_single(lds, g, E); tail_convert(in, ws, 64 * 22, 8, l, l, lds); }
#endif
        GSYNC();
#ifndef SKIP_G2
        { pg8::Gemm g{H, (const bf16*)(ws + WS_WD1), M, D, FF}; EpiResid E{l == 0 ? in[0] : X, X, XB, SS, 0.5f}; gemm_single(lds, g, E); }
#endif
        GSYNC();
#ifndef SKIP_G3
        for (int rep = 0; rep < PROBE_GEMM; ++rep) { pg8::Gemm g{XB, (const bf16*)(ws + WS_WIN), M, NINP, D}; EpiProj E{PROJ, SS}; gemm_single(lds, g, E); if (l + 1 < NL) tail_convert(in, ws, 64 * 13, 2, l + 1, l, lds); }
#endif
        GSYNC();
#ifndef SKIP_PREP
        for (int rep = 0; rep < PROBE_MISC; ++rep) { TIDS phase_prep(in, ws, l, lds, tid); }
#endif
        GSYNC();
#ifndef SKIP_SCAN
        for (int rep = 0; rep < PROBE_SCAN; ++rep) { TIDS phase_scan<0>(in, ws, l, lds, tid); }
        GSYNC();
        { TIDS phase_combine(in, ws, l, lds, tid); }
        GSYNC();
        for (int rep = 0; rep < PROBE_SCAN; ++rep) { TIDS phase_scan<1>(in, ws, l, lds, tid); }
#endif
        GSYNC();
#ifndef SKIP_POST
        for (int rep = 0; rep < PROBE_MISC; ++rep) { TIDS phase_post(in, ws, l, gw, NGW, lane); }
#endif
        GSYNC();
#ifndef SKIP_G4
        { pg8::Gemm g{Y, (const bf16*)(ws + WS_WOUT), M, D, D}; EpiResid E{X, X, XB, SS, 1.0f}; gemm_single(lds, g, E); }
#endif
        GSYNC();
#ifndef SKIP_G5
        { pg8::Gemm g{XB, (const bf16*)(ws + WS_WGU2), M, 2 * FF, D}; EpiGU E{H, SS}; gemm_single(lds, g, E); tail_convert(in, ws, 64 * 22, 32, l + 1, l, lds); }
#endif
        GSYNC();
#ifndef SKIP_G6
        { pg8::Gemm g{H, (const bf16*)(ws + WS_WD2), M, D, FF}; EpiResid E{X, X, l + 1 < NL ? XB : nullptr, SS, 0.5f}; gemm_single(lds, g, E); }
#endif
        GSYNC();
    }
    { TIDS phase_final(X, in[42], gw, NGW, lane); }
}

extern "C" void kernel_launch(void* const* d_in, const int* in_sizes, int n_in, void* d_out, int out_size, void* d_ws, size_t ws_size, hipStream_t stream) {
    static int grid = 0;
    if (grid == 0) {
        int dev = 0, cus = 0, per_cu = 0;
        (void)hipGetDevice(&dev);
        (void)hipDeviceGetAttribute(&cus, hipDeviceAttributeMultiprocessorCount, dev);
        (void)hipFuncSetAttribute((const void*)fwd, hipFuncAttributeMaxDynamicSharedMemorySize, LDS_BYTES);
        (void)hipOccupancyMaxActiveBlocksPerMultiprocessor(&per_cu, (const void*)fwd, 512, LDS_BYTES);
        if (per_cu < 1) per_cu = 1;
        grid = cus * per_cu;
        if (n_in != 43 || out_size != M * D || ws_size < WS_END) fprintf(stderr, "kernel_launch: unexpected sizes n_in %d out %d ws %zu (need %zu)\n", n_in, out_size, ws_size, (size_t)WS_END);
    }
    Args a{};
    for (int i = 0; i < 43 && i < n_in; ++i) a.in[i] = (const float*)d_in[i];
    a.out = (float*)d_out; a.ws = (unsigned char*)d_ws;
    (void)hipMemsetAsync((unsigned char*)d_ws + WS_CTL, 0, (size_t)(XCD_BAR_WORDS + 64) * 4, stream);
    void* args[] = {&a};
    hipError_t e = hipLaunchCooperativeKernel((const void*)fwd, dim3(grid), dim3(512), args, LDS_BYTES, stream);
    if (e != hipSuccess) fprintf(stderr, "cooperative launch failed: %s (grid %d)\n", hipGetErrorString(e), grid);
}
```

```cpp
#include <hip/hip_runtime.h>
#include <hip/hip_cooperative_groups.h>
#include <cstdio>
#include <cstdint>
namespace cg = cooperative_groups;
namespace pg8 {
#define PG8_LAS __attribute__((address_space(3)))
typedef unsigned short bf16_t;
typedef short bf16x8 __attribute__((ext_vector_type(8)));
typedef float f32x4 __attribute__((ext_vector_type(4)));
typedef unsigned u32x4 __attribute__((ext_vector_type(4)));
constexpr int BM = 256, BK = 64, HALF = 128, HTB = HALF * BK * 2  , STAGE_BYTES = 8 * HTB, NXCD = 8, WGM = 8;

__host__ __device__ __forceinline__ int lds_byte(int r, int c) { const int st = (r >> 4) * 2 + (c >> 5), rr = r & 15, cc = c & 31, ob = rr * 64 + cc * 2; return st * 1024 + (ob ^ (((ob >> 9) & 1) << 5)); }
__host__ __device__ __forceinline__ void stage_rc(int b, int& R, int& C) { const int st = b / 1024, sb = b % 1024, swz = sb ^ (((sb >> 9) & 1) << 5); R = (st >> 1) * 16 + swz / 64; C = (st & 1) * 32 + (swz % 64) / 2; }
__host__ __device__ __forceinline__ int perm32(int rho) { const int n = rho >> 4, i = rho & 15; return 8 * (i >> 2) + 4 * n + (i & 3); }

struct Unit { int pm, pn; };
struct Gemm { const bf16_t* A; const bf16_t* Bt; int M, N, K; };

struct StaticOrder {
    int nM, nN, nwg, G, c;
    __host__ __device__ void init(int M, int N, int G_, int c_) { nM = M / BM; nN = N / BM; nwg = nM * nN; G = G_; c = c_; }
    __host__ __device__ bool next(int i, Unit& u) const {
        const long L = (long)i * G + c; if (L >= nwg) return false;
        int wgid = (int)L; { const int q = nwg / NXCD, r = nwg % NXCD, xcd = wgid % NXCD, off = wgid / NXCD; wgid = (xcd < r ? xcd * (q + 1) : r * (q + 1) + (xcd - r) * q) + off; }
        const int nig = WGM * nN, gid = wgid / nig, fm = gid * WGM, gsz = (nM - fm) < WGM ? (nM - fm) : WGM;
        u.pm = fm + ((wgid % nig) % gsz); u.pn = (wgid % nig) / gsz; return true;
    }
    __device__ __forceinline__ void a_ready(const Unit&) const {}
    __device__ __forceinline__ void done(const Unit&) const {}
};

__device__ __forceinline__ unsigned cvt_pk_bf16(float lo, float hi) { unsigned r; asm volatile("v_cvt_pk_bf16_f32 %0, %1, %2" : "=v"(r) : "v"(lo), "v"(hi)); return r; }
typedef float f32x2 __attribute__((ext_vector_type(2)));
template <class Epi, class Sched, bool ALIGN_EPI = false, bool SP2 = false>
__device__ __forceinline__ void gemm_phase(PG8_LAS unsigned char* lds, const Gemm g, const Sched& S, const Epi& E) {
    int tid_ = threadIdx.x; asm volatile("" : "+v"(tid_));
    const int tid = tid_, wid = __builtin_amdgcn_readfirstlane(tid >> 6), lane = tid & 63, wr = wid >> 2, wc = wid & 3, fr = lane & 15, fq = lane >> 4;
    const int K = g.K, nt = K / BK;
    unsigned voffA[2], voffB[2];
#pragma unroll
    for (int i = 0; i < 2; ++i) { int R, C; stage_rc(tid * 16 + i * 8192, R, C); const int Rb = Epi::PERM ? ((R & ~31) + perm32(R & 31)) : R;
        voffA[i] = (unsigned)(R * K + C) * 2u; voffB[i] = (unsigned)(Rb * K + C) * 2u; }
    const size_t kstep = (size_t)(BK * 2);
    const size_t hstep = (size_t)HALF * K * 2;
    const size_t tstep = 2 * hstep;
    const unsigned ldsw = (unsigned)wid * 1024u;
    const int aoff = lds_byte(wr * 64 + fr, fq * 8), boff = lds_byte(wc * 32 + fr, fq * 8);
#define PG8_SA(b, h) (((b) * 2 + (h)) * HTB)
#define PG8_SB(b, h) ((4 + (b) * 2 + (h)) * HTB)
#define PG8_STAGE(bufoff, gbase, voff) do { _Pragma("unroll") for (int _i = 0; _i < 2; ++_i) \
        __builtin_amdgcn_global_load_lds((const unsigned*)((const char*)(gbase) + (voff)[_i]), (PG8_LAS unsigned*)(lds + (bufoff) + ldsw + _i * 8192), 16, 0, 0); } while (0)
#define PG8_LDA(dst, b, h) do { _Pragma("unroll") for (int m = 0; m < 4; ++m) _Pragma("unroll") for (int k = 0; k < 2; ++k) dst[m][k] = *(const PG8_LAS bf16x8*)(lds + PG8_SA(b, h) + aoff + m * 2048 + k * 1024); } while (0)
#define PG8_LDB(dst, b, h) do { _Pragma("unroll") for (int n = 0; n < 2; ++n) _Pragma("unroll") for (int k = 0; k < 2; ++k) dst[n][k] = *(const PG8_LAS bf16x8*)(lds + PG8_SB(b, h) + boff + n * 2048 + k * 1024); } while (0)
#define PG8_MMA(ai, bj, At, Bt) do { __builtin_amdgcn_s_setprio(1); _Pragma("unroll") for (int m = 0; m < 4; ++m) _Pragma("unroll") for (int n = 0; n < 2; ++n) _Pragma("unroll") for (int k = 0; k < 2; ++k) \
        acc[ai][bj][m][n] = __builtin_amdgcn_mfma_f32_16x16x32_bf16(Bt[n][k], At[m][k], acc[ai][bj][m][n], 0, 0, 0); __builtin_amdgcn_s_setprio(0); } while (0)
#define PG8_WAIT_V(n) asm volatile("s_waitcnt vmcnt(" #n ")" ::: "memory")
#define PG8_WAIT_L(n) asm volatile("s_waitcnt lgkmcnt(" #n ")" ::: "memory")
#define PG8_BAR __builtin_amdgcn_s_barrier()
#define PG8_SCHED __builtin_amdgcn_sched_barrier(0)
    Unit cur, nxt; int ui = 0;
    if (!S.next(0, cur)) return;
    f32x4 acc[2][2][4][2];
#pragma unroll
    for (int a = 0; a < 2; ++a)
#pragma unroll
        for (int b = 0; b < 2; ++b)
#pragma unroll
            for (int m = 0; m < 4; ++m)
#pragma unroll
                for (int n = 0; n < 2; ++n) acc[a][b][m][n] = (f32x4){0.f, 0.f, 0.f, 0.f};
    bf16x8 At[4][2], B0[2][2], B1[2][2];
    const char* cA = (const char*)g.A + (size_t)cur.pm * tstep; const char* cB = (const char*)g.Bt + (size_t)cur.pn * tstep;
    S.a_ready(cur);
    if constexpr (SP2) {
        PG8_STAGE(PG8_SB(0, 0), cB, voffB); PG8_STAGE(PG8_SB(0, 1), cB + hstep, voffB); PG8_STAGE(PG8_SA(0, 0), cA, voffA); PG8_STAGE(PG8_SA(0, 1), cA + hstep, voffA);
        if (wr == 1) PG8_BAR;
        PG8_WAIT_V(2); PG8_BAR;
        PG8_STAGE(PG8_SB(1, 0), cB + kstep, voffB); PG8_STAGE(PG8_SA(1, 0), cA + kstep, voffA); PG8_STAGE(PG8_SB(1, 1), cB + hstep + kstep, voffB);
        PG8_WAIT_V(6); PG8_BAR;
    } else {
        PG8_STAGE(PG8_SB(0, 0), cB, voffB); PG8_STAGE(PG8_SA(0, 0), cA, voffA); PG8_STAGE(PG8_SB(0, 1), cB + hstep, voffB); PG8_STAGE(PG8_SA(0, 1), cA + hstep, voffA);
        if (wr == 1) PG8_BAR;
        PG8_WAIT_V(4); PG8_BAR;
        PG8_STAGE(PG8_SB(1, 0), cB + kstep, voffB); PG8_STAGE(PG8_SA(1, 0), cA + kstep, voffA); PG8_STAGE(PG8_SB(1, 1), cB + hstep + kstep, voffB);
        PG8_WAIT_V(6); PG8_BAR;
    }
    for (;;) {
        const bool has_next = S.next(ui + 1, nxt);
        const char* nA = has_next ? (const char*)g.A + (size_t)nxt.pm * tstep : cA; const char* nB = has_next ? (const char*)g.Bt + (size_t)nxt.pn * tstep : cB;
        for (int t = 0; t < nt; t += 2) {
            const bool last = (t == nt - 2);
            const char* a1 = cA + (size_t)(t + 1) * kstep;
            const char* a2 = last ? nA : cA + (size_t)(t + 2) * kstep; const char* b2 = last ? nB : cB + (size_t)(t + 2) * kstep;
            const char* a3 = a2 + kstep; const char* b3 = b2 + kstep;
            if (last && has_next) S.a_ready(nxt);
            if constexpr (SP2) {
            PG8_LDB(B0, 0, 0); PG8_LDB(B1, 0, 1); PG8_SCHED; PG8_LDA(At, 0, 0); PG8_STAGE(PG8_SA(1, 1), a1 + hstep, voffA);
            PG8_WAIT_V(8); PG8_WAIT_L(0); PG8_BAR; PG8_MMA(0, 0, At, B0); PG8_MMA(0, 1, At, B1); PG8_BAR; PG8_SCHED;
            PG8_LDA(At, 0, 1); PG8_STAGE(PG8_SB(0, 0), b2, voffB); PG8_STAGE(PG8_SB(0, 1), b2 + hstep, voffB); PG8_STAGE(PG8_SA(0, 0), a2, voffA);
            PG8_WAIT_V(8); PG8_WAIT_L(0); PG8_BAR; PG8_MMA(1, 0, At, B0); PG8_MMA(1, 1, At, B1); PG8_BAR; PG8_SCHED;
            PG8_LDB(B0, 1, 0); PG8_LDB(B1, 1, 1); PG8_SCHED; PG8_LDA(At, 1, 0); PG8_STAGE(PG8_SA(0, 1), a2 + hstep, voffA);
            PG8_WAIT_V(8); PG8_WAIT_L(0); PG8_BAR; PG8_MMA(0, 0, At, B0); PG8_MMA(0, 1, At, B1); PG8_BAR; PG8_SCHED;
            PG8_LDA(At, 1, 1); PG8_STAGE(PG8_SB(1, 0), b3, voffB); PG8_STAGE(PG8_SB(1, 1), b3 + hstep, voffB); PG8_STAGE(PG8_SA(1, 0), a3, voffA);
            PG8_WAIT_V(8); PG8_WAIT_L(0); PG8_BAR; PG8_MMA(1, 0, At, B0); PG8_MMA(1, 1, At, B1); PG8_BAR; PG8_SCHED;
            } else {
            PG8_LDB(B0, 0, 0); PG8_SCHED; PG8_LDA(At, 0, 0); PG8_STAGE(PG8_SA(1, 1), a1 + hstep, voffA);
            PG8_WAIT_L(8); PG8_BAR; PG8_WAIT_L(0); PG8_MMA(0, 0, At, B0); PG8_BAR; PG8_SCHED;
            PG8_LDB(B1, 0, 1); PG8_STAGE(PG8_SB(0, 0), b2, voffB);
            PG8_BAR; PG8_WAIT_L(0); PG8_MMA(0, 1, At, B1); PG8_BAR;
            PG8_LDA(At, 0, 1); PG8_STAGE(PG8_SA(0, 0), a2, voffA);
            PG8_BAR; PG8_WAIT_L(0); PG8_MMA(1, 0, At, B0); PG8_BAR; PG8_SCHED;
            PG8_STAGE(PG8_SB(0, 1), b2 + hstep, voffB);
            PG8_WAIT_V(6); PG8_BAR; PG8_MMA(1, 1, At, B1); PG8_BAR;
            PG8_LDB(B0, 1, 0); PG8_SCHED; PG8_LDA(At, 1, 0); PG8_STAGE(PG8_SA(0, 1), a2 + hstep, voffA);
            PG8_WAIT_L(8); PG8_BAR; PG8_WAIT_L(0); PG8_MMA(0, 0, At, B0); PG8_BAR; PG8_SCHED;
            PG8_LDB(B1, 1, 1); PG8_STAGE(PG8_SB(1, 0), b3, voffB);
            PG8_BAR; PG8_WAIT_L(0); PG8_MMA(0, 1, At, B1); PG8_BAR;
            PG8_LDA(At, 1, 1); PG8_STAGE(PG8_SA(1, 0), a3, voffA);
            PG8_BAR; PG8_WAIT_L(0); PG8_MMA(1, 0, At, B0); PG8_BAR; PG8_SCHED;
            PG8_STAGE(PG8_SB(1, 1), b3 + hstep, voffB);
            PG8_WAIT_V(6); PG8_BAR; PG8_MMA(1, 1, At, B1); PG8_BAR;
            }
        }
        if constexpr (ALIGN_EPI) { if (wr == 0) PG8_BAR; }
        if constexpr (!Epi::AFTER_DRAIN) { E(acc, cur, wr, wc, fr, fq); S.done(cur); }
        if (!has_next) break;
#pragma unroll
        for (int a = 0; a < 2; ++a)
#pragma unroll
            for (int b = 0; b < 2; ++b)
#pragma unroll
                for (int m = 0; m < 4; ++m)
#pragma unroll
                    for (int n = 0; n < 2; ++n) acc[a][b][m][n] = (f32x4){0.f, 0.f, 0.f, 0.f};
        cur = nxt; cA = nA; cB = nB; ++ui;
        if constexpr (ALIGN_EPI) { if (wr == 1) PG8_BAR; }
    }
    PG8_WAIT_V(0);
    if constexpr (!ALIGN_EPI) { if (wr == 0) PG8_BAR; }
    PG8_BAR;
    if constexpr (Epi::AFTER_DRAIN) { E.fused(acc, cur, wr, wc, fr, fq, lds, wid, lane); S.done(cur); }
#undef PG8_SA
#undef PG8_SB
#undef PG8_STAGE
#undef PG8_LDA
#undef PG8_LDB
#undef PG8_MMA
#undef PG8_WAIT_V
#undef PG8_WAIT_L
#undef PG8_BAR
#undef PG8_SCHED
}
}
#define LAS __attribute__((address_space(3)))
typedef unsigned short bf16;
typedef float f4 __attribute__((ext_vector_type(4)));
typedef float f2 __attribute__((ext_vector_type(2)));
#define LO2(v) __builtin_shufflevector(v, v, 0, 1)
#define HI2(v) __builtin_shufflevector(v, v, 2, 3)
typedef unsigned u2 __attribute__((ext_vector_type(2)));
typedef unsigned u4 __attribute__((ext_vector_type(4)));
using pg8::f32x4;

constexpr int M = 16384, D = 1024, FF = 2816, NIN = 3156, NINP = 3328, NL = 4, SEQ = 8192;
constexpr int LDS_BYTES = 147456;
constexpr size_t HM = 524288;
constexpr size_t WS_WGU1 = 0, WS_WD1 = 22 * HM, WS_WIN = 33 * HM, WS_WOUT = 46 * HM, WS_WGU2 = 50 * HM, WS_WD2 = 72 * HM;
constexpr size_t MiB = 1048576;
constexpr size_t WS_XB = 42 * MiB;
constexpr size_t WS_Y = 74 * MiB;
constexpr size_t WS_PROJ = 106 * MiB;
constexpr size_t WS_VFIRST = 210 * MiB;
constexpr size_t WS_SS = 226 * MiB;
constexpr size_t WS_RWR = 227 * MiB, WS_RWK = 235 * MiB, WS_RWV = 243 * MiB, WS_RWKK = 251 * MiB, WS_RWB = 259 * MiB;
constexpr size_t WS_RWW = 267 * MiB;
constexpr size_t WS_RWG = 283 * MiB;
constexpr size_t WS_RWBON = 291 * MiB;
constexpr size_t WS_XBC = 292 * MiB;
constexpr size_t WS_DT = 316 * MiB, WS_DEC = 317 * MiB;
constexpr size_t WS_LRA = 318 * MiB, WS_LRH = 334 * MiB;
constexpr size_t WS_SEGA = 350 * MiB, WS_SEGH = 351 * MiB, WS_CARRY = 352 * MiB;
constexpr int NCH = 32, CHL = SEQ / NCH;
constexpr size_t WS_RWP = 353 * MiB, WS_RWU = 357 * MiB;
constexpr size_t WS_GLU = 361 * MiB, WS_GLD = 363 * MiB;
constexpr int NCS = 64;
constexpr size_t WS_SSU = 364 * MiB, WS_SSD = 380 * MiB;
constexpr size_t WS_CTL = 381 * MiB;
constexpr int CTL_WORDS = 3456 + 64 + 8 * 64 * 64;
constexpr size_t WS_END = 382 * MiB;

constexpr int PC_GQ = 0, PC_GK = 128, PC_GV = 256, PC_GG = 512, PC_GSTEM = 768, PC_LX = 784, PC_LG = 1040, PC_RW = 1296, PC_SZ = 2128, PC_SXBC = 2384, PC_SDT = 3152;

__device__ __forceinline__ float bf2f(bf16 v) { return __uint_as_float((unsigned)v << 16); }
__device__ __forceinline__ float bflo(unsigned w) { return __uint_as_float(w << 16); }
__device__ __forceinline__ float bfhi(unsigned w) { return __uint_as_float(w & 0xffff0000u); }
__device__ __forceinline__ unsigned pk2(float lo, float hi) { return pg8::cvt_pk_bf16(lo, hi); }
__device__ __forceinline__ float sigmoidf_(float x) { return 1.f / (1.f + __expf(-x)); }
__device__ __forceinline__ float siluf_(float x) { return x / (1.f + __expf(-x)); }
__device__ __forceinline__ float tanhf_(float x) { return 1.f - 2.f / (1.f + __expf(2.f * x)); }
__device__ __forceinline__ float softplusf_(float x) { return fmaxf(x, 0.f) + log1pf(__expf(-fabsf(x))); }
__device__ __forceinline__ float gelu_tanh(float x) { const float u = 0.7978845608028654f * (x + 0.044715f * x * x * x); return 0.5f * x * (1.f + tanhf_(u)); }

__device__ __forceinline__ float dpp_mov(float x, const int ctrl_sel) {
    const int v = __builtin_bit_cast(int, x); int r;
    if (ctrl_sel == 0) r = __builtin_amdgcn_update_dpp(0, v, 0xB1, 0xF, 0xF, true);
    else if (ctrl_sel == 1) r = __builtin_amdgcn_update_dpp(0, v, 0x4E, 0xF, 0xF, true);
    else r = __builtin_amdgcn_update_dpp(0, v, 0x141, 0xF, 0xF, true);
    return __builtin_bit_cast(float, r);
}
__device__ __forceinline__ float red8(float x) { x += dpp_mov(x, 0); x += dpp_mov(x, 1); x += dpp_mov(x, 2); return x; }
__device__ __forceinline__ float red16(float x) { x = red8(x); x += __builtin_bit_cast(float, __builtin_amdgcn_update_dpp(0, __builtin_bit_cast(int, x), 0x140, 0xF, 0xF, true)); return x; }
__device__ __forceinline__ float wave_sum(float v) { v = red16(v); v += __shfl_xor(v, 16); v += __shfl_xor(v, 32); return v; }
__device__ __forceinline__ float rstd_row(const float* ss, int row) { const f4 p = *(const f4*)(ss + (size_t)row * 4); return rsqrtf(((p.x + p.y) + (p.z + p.w)) * (1.f / 1024.f) + 1e-6f); }

__device__ __forceinline__ void lds_barrier() { asm volatile("s_waitcnt lgkmcnt(0)" ::: "memory"); __builtin_amdgcn_s_barrier(); asm volatile("" ::: "memory"); }
typedef short s8v __attribute__((ext_vector_type(8)));
#define MFMA16(a, b, c) __builtin_amdgcn_mfma_f32_16x16x32_bf16(a, b, c, 0, 0, 0)
struct EpiGU {
    static constexpr bool PERM = true, AFTER_DRAIN = true;
    bf16* H; const float* ss;
    __device__ __forceinline__ void fused(f32x4 (&acc)[2][2][4][2], const pg8::Unit& u, int wr, int wc, int fr, int fq, LAS unsigned char* lds, int wid, int lane) const {
        float rsv[8];
#pragma unroll
        for (int g = 0; g < 8; ++g) rsv[g] = rstd_row(ss, u.pm * 256 + (g >> 2) * 128 + wr * 64 + (g & 3) * 16 + fr);
#pragma unroll
        for (int ai = 0; ai < 2; ++ai)
#pragma unroll
            for (int m = 0; m < 4; ++m) {
                const int row = u.pm * 256 + ai * 128 + wr * 64 + m * 16 + fr; const float rs = rsv[ai * 4 + m];
                float hv[8];
#pragma unroll
                for (int n = 0; n < 2; ++n)
#pragma unroll
                    for (int e = 0; e < 4; ++e) { const float g = acc[ai][0][m][n][e] * rs, up = acc[ai][1][m][n][e] * rs; hv[n * 4 + e] = siluf_(g) * up; }
                u4 w; w.x = pk2(hv[0], hv[1]); w.y = pk2(hv[2], hv[3]); w.z = pk2(hv[4], hv[5]); w.w = pk2(hv[6], hv[7]);
                *(u4*)(H + (size_t)row * FF + u.pn * 128 + wc * 32 + 8 * fq) = w;
            }
    }
};
struct EpiProj {
    static constexpr bool PERM = true, AFTER_DRAIN = true;
    bf16* O; const float* ss;
    __device__ __forceinline__ void fused(f32x4 (&acc)[2][2][4][2], const pg8::Unit& u, int wr, int wc, int fr, int fq, LAS unsigned char* lds, int wid, int lane) const {
        float rsv[8];
#pragma unroll
        for (int g = 0; g < 8; ++g) rsv[g] = rstd_row(ss, u.pm * 256 + (g >> 2) * 128 + wr * 64 + (g & 3) * 16 + fr);
#pragma unroll
        for (int ai = 0; ai < 2; ++ai)
#pragma unroll
            for (int m = 0; m < 4; ++m) {
                const int row = u.pm * 256 + ai * 128 + wr * 64 + m * 16 + fr; const float rs = rsv[ai * 4 + m];
#pragma unroll
                for (int bj = 0; bj < 2; ++bj) { const f32x4 v0 = acc[ai][bj][m][0] * rs, v1 = acc[ai][bj][m][1] * rs;
                    u4 w; w.x = pk2(v0[0], v0[1]); w.y = pk2(v0[2], v0[3]); w.z = pk2(v1[0], v1[1]); w.w = pk2(v1[2], v1[3]);
                    *(u4*)(O + (size_t)row * NINP + u.pn * 256 + bj * 128 + wc * 32 + 8 * fq) = w; }
            }
    }
};
struct EpiGUm : EpiGU { static constexpr bool PERM = true, AFTER_DRAIN = false;
    __device__ __forceinline__ void operator()(const f32x4 (&acc)[2][2][4][2], const pg8::Unit& u, int wr, int wc, int fr, int fq) const { fused(const_cast<f32x4 (&)[2][2][4][2]>(acc), u, wr, wc, fr, fq, nullptr, 0, 0); } };
struct EpiProjm : EpiProj { static constexpr bool PERM = true, AFTER_DRAIN = false;
    __device__ __forceinline__ void operator()(const f32x4 (&acc)[2][2][4][2], const pg8::Unit& u, int wr, int wc, int fr, int fq) const { fused(const_cast<f32x4 (&)[2][2][4][2]>(acc), u, wr, wc, fr, fq, nullptr, 0, 0); } };
struct EpiResid {
    static constexpr bool PERM = true, AFTER_DRAIN = true;
    const float* xin; bf16* xb; float* ss; float scale; int keep;
    __device__ __forceinline__ void fused(f32x4 (&acc)[2][2][4][2], const pg8::Unit& u, int wr, int wc, int fr, int fq, LAS unsigned char* lds, int wid, int lane) const {
        LAS float* P = (LAS float*)lds;
        const size_t base = ((size_t)u.pm * 256 + wr * 64 + fr) * D + u.pn * 256 + wc * 32 + 8 * fq;
        f32x4 nx[2][2], cx[2][2];
#define RES_LOAD(OFF) { _Pragma("unroll") for (int bj = 0; bj < 2; ++bj) { if (xin) { nx[bj][0] = *(const f32x4*)(xin + (OFF) + bj * 128); nx[bj][1] = *(const f32x4*)(xin + (OFF) + bj * 128 + 4); } \
            else { const u4 q = *(const u4*)(xb + (OFF) + bj * 128); nx[bj][0] = (f32x4){bflo(q.x), bfhi(q.x), bflo(q.y), bfhi(q.y)}; nx[bj][1] = (f32x4){bflo(q.z), bfhi(q.z), bflo(q.w), bfhi(q.w)}; } } }
        RES_LOAD(base)
#pragma unroll
        for (int g = 0; g < 8; ++g) { const int ai = g >> 2, m = g & 3; const size_t go = base + (size_t)(ai * 128 + m * 16) * D;
#pragma unroll
            for (int bj = 0; bj < 2; ++bj) { cx[bj][0] = nx[bj][0]; cx[bj][1] = nx[bj][1]; }
            if (g < 7) { const size_t gn = base + (size_t)(((g + 1) >> 2) * 128 + ((g + 1) & 3) * 16) * D; RES_LOAD(gn) }
            float sq = 0.f;
#pragma unroll
            for (int bj = 0; bj < 2; ++bj) { const size_t off = go + bj * 128;
                const f32x4 x0 = cx[bj][0] + acc[ai][bj][m][0] * scale, x1 = cx[bj][1] + acc[ai][bj][m][1] * scale;
                u4 w; w.x = pk2(x0[0], x0[1]); w.y = pk2(x0[2], x0[3]); w.z = pk2(x1[0], x1[1]); w.w = pk2(x1[2], x1[3]);
                *(u4*)(xb + off) = w;
                sq += (x0[0] * x0[0] + x0[1] * x0[1]) + (x0[2] * x0[2] + x0[3] * x0[3]) + (x1[0] * x1[0] + x1[1] * x1[1]) + (x1[2] * x1[2] + x1[3] * x1[3]); }
            sq += __shfl_xor(sq, 16); sq += __shfl_xor(sq, 32);
            if (fq == 0) P[(ai * 128 + wr * 64 + m * 16 + fr) * 4 + wc] = sq;
        }
#undef RES_LOAD
        __syncthreads();
        const int tid = wid * 64 + lane;
        if (keep && tid < 256) ss[(size_t)(u.pm * 256 + tid) * 4 + u.pn] = (P[tid * 4 + 0] + P[tid * 4 + 1]) + (P[tid * 4 + 2] + P[tid * 4 + 3]);
        __syncthreads();
    }
};
struct OneUnit { pg8::StaticOrder b; int r; const unsigned* wait; unsigned need; unsigned* pub; unsigned* tmo; int prev;
    __device__ __forceinline__ bool next(int i, pg8::Unit& u) const { return i == 0 && b.next(r, u); }
    __device__ __forceinline__ void a_ready(const pg8::Unit& u) const {
        if (wait) {
            if (threadIdx.x < 64) { const unsigned long long t0 = __builtin_amdgcn_s_memrealtime(); unsigned polls = 0;
                while ((unsigned)__builtin_amdgcn_readfirstlane(__hip_atomic_load(wait + 64 * u.pm, __ATOMIC_RELAXED, __HIP_MEMORY_SCOPE_AGENT)) < need) {
                    if ((++polls & 255u) == 0u && __builtin_amdgcn_readfirstlane(__hip_atomic_load(tmo, __ATOMIC_RELAXED, __HIP_MEMORY_SCOPE_AGENT)) != 0u) break;
                    if (__builtin_amdgcn_s_memrealtime() - t0 > 2000000ull) { if (threadIdx.x == 0) __hip_atomic_store(tmo, 1u, __ATOMIC_RELAXED, __HIP_MEMORY_SCOPE_AGENT); break; }
                    __builtin_amdgcn_s_sleep(2); }
                __builtin_amdgcn_fence(__ATOMIC_ACQUIRE, "agent");
                asm volatile("s_waitcnt vmcnt(0)" ::: "memory"); }
            asm volatile("" ::: "memory"); __builtin_amdgcn_s_barrier(); asm volatile("" ::: "memory"); } }
    __device__ __forceinline__ void done(const pg8::Unit&) const { if (pub && prev >= 0 && threadIdx.x == 0) __hip_atomic_fetch_add(pub + 64 * prev, 1u, __ATOMIC_RELAXED, __HIP_MEMORY_SCOPE_AGENT); } };

__device__ __forceinline__ void tr_item(const float* W, int ldn, int nvalid, int col0, const float* sc, bf16* WT, int K, int row0, int k0, LAS float* scr, int lane) {
    const int c4 = col0 + (lane & 31) * 4; const bool ok = c4 < nvalid;
    f4 tv[16];
#pragma unroll
    for (int i = 0; i < 16; ++i) { const int kk = 2 * i + (lane >> 5); tv[i] = (f4){0.f, 0.f, 0.f, 0.f}; if (ok) tv[i] = __builtin_nontemporal_load((const f4*)(W + (size_t)(k0 + kk) * ldn + c4)); }
#pragma unroll
    for (int i = 0; i < 16; ++i) { const int kk = 2 * i + (lane >> 5); f4 v = tv[i]; if (sc) v = v * sc[k0 + kk]; *(LAS f4*)(scr + kk * 132 + (lane & 31) * 4) = v; }
    asm volatile("s_waitcnt lgkmcnt(0)" ::: "memory");
    const int kq = lane & 3;
#pragma unroll
    for (int j = 0; j < 8; ++j) { const int n = (lane >> 2) + 16 * j; const LAS float* s = scr + (8 * kq) * 132 + n;
        u4 o; o.x = pk2(s[0 * 132], s[1 * 132]); o.y = pk2(s[2 * 132], s[3 * 132]); o.z = pk2(s[4 * 132], s[5 * 132]); o.w = pk2(s[6 * 132], s[7 * 132]);
        *(u4*)(WT + (size_t)(row0 + n) * K + k0 + 8 * kq) = o; }
    asm volatile("s_waitcnt lgkmcnt(0)" ::: "memory");
}
__device__ __forceinline__ void tr_gu(const float* Wg, const float* Wu, const float* nw, bf16* WT, int it, LAS float* scr, int lane) {
    const int kb = it / 44, nb = it % 44, row0 = nb * 128, pn = row0 >> 8, half = (row0 >> 7) & 1;
    tr_item(half ? Wu : Wg, FF, FF, pn * 128, nw, WT, D, row0, kb * 32, scr, lane);
}
__device__ __forceinline__ void convert_mats(const float* const* in, unsigned char* ws, int mask, int lA, int lB, LAS unsigned char* lds, int gw, int NGW, int wave, int lane) {
    LAS float* scr = (LAS float*)(lds + wave * 17408);
    constexpr int I_GU = 1408, I_D = 704, I_IN = 832, I_OUT = 256;
    const int n0 = (mask & 1) ? I_GU : 0, n1 = (mask & 2) ? I_D : 0, n2 = (mask & 4) ? I_IN : 0, n3 = (mask & 8) ? I_OUT : 0, n4 = (mask & 16) ? I_GU : 0, n5 = (mask & 32) ? I_D : 0;
    const int total = n0 + n1 + n2 + n3 + n4 + n5; const size_t oA = (size_t)lA * D * FF, oB = (size_t)lB * D * FF;
    for (int it = gw; it < total; it += NGW) {
        int r = it;
        if (r < n0) { tr_gu(in[2] + oA, in[3] + oA, in[1] + lA * D, (bf16*)(ws + WS_WGU1), r, scr, lane); continue; } r -= n0;
        if (r < n1) { tr_item(in[4] + oA, D, D, (r % 8) * 128, nullptr, (bf16*)(ws + WS_WD1), FF, (r % 8) * 128, (r / 8) * 32, scr, lane); continue; } r -= n1;
        if (r < n2) { tr_item(in[6] + (size_t)lA * D * NIN, NIN, NIN, (r % 26) * 128, in[5] + lA * D, (bf16*)(ws + WS_WIN), D, (r % 26) * 128, (r / 26) * 32, scr, lane); continue; } r -= n2;
        if (r < n3) { tr_item(in[7] + (size_t)lB * D * D, D, D, (r % 8) * 128, nullptr, (bf16*)(ws + WS_WOUT), D, (r % 8) * 128, (r / 8) * 32, scr, lane); continue; } r -= n3;
        if (r < n4) { tr_gu(in[39] + oB, in[40] + oB, in[38] + lB * D, (bf16*)(ws + WS_WGU2), r, scr, lane); continue; } r -= n4;
        tr_item(in[41] + oB, D, D, (r % 8) * 128, nullptr, (bf16*)(ws + WS_WD2), FF, (r % 8) * 128, (r / 8) * 32, scr, lane);
    }
}
__device__ __forceinline__ void phase_init_rows(const float* x, bf16* xb, float* ss, int gw, int NGW, int lane) {
    for (int m = gw; m < M; m += NGW) {
        const f4* xr = (const f4*)(x + (size_t)m * D) + lane; float s = 0.f; u2* o = (u2*)(xb + (size_t)m * D) + lane;
#pragma unroll
        for (int j = 0; j < 4; ++j) { const f4 v = xr[64 * j]; s += (v.x * v.x + v.y * v.y) + (v.z * v.z + v.w * v.w); u2 w; w.x = pk2(v.x, v.y); w.y = pk2(v.z, v.w); o[64 * j] = w; }
        s = wave_sum(s);
        if (lane < 4) ss[(size_t)m * 4 + lane] = lane == 0 ? s : 0.f;
    }
}
__device__ __forceinline__ void phase_final(const bf16* xb, float* out, const float* fw, int gw, int NGW, int lane) {
    for (int m = gw; m < M; m += NGW) {
        const u2* xr = (const u2*)(xb + (size_t)m * D) + lane; f4* orow = (f4*)(out + (size_t)m * D) + lane; f4 v[4]; float s = 0.f;
#pragma unroll
        for (int j = 0; j < 4; ++j) { const u2 q = xr[64 * j]; v[j] = (f4){bflo(q.x), bfhi(q.x), bflo(q.y), bfhi(q.y)}; s += (v[j].x * v[j].x + v[j].y * v[j].y) + (v[j].z * v[j].z + v[j].w * v[j].w); }
        const float rs = rsqrtf(wave_sum(s) * (1.f / 1024.f) + 1e-6f);
#pragma unroll
        for (int j = 0; j < 4; ++j) { const f4 w = ((const f4*)fw)[lane + 64 * j]; orow[64 * j] = v[j] * rs * w; }
    }
}
#define XB_TMO      128
#define XB_XCNT(j)  (256  + 64 * (j))
#define XB_XSUB(j)  (1280 + 64 * (j))
#define XB_XGEN(j)  (2304 + 64 * (j))
#define XB_TOP      3328
#define XB_TOPGEN   3392
#define XCD_BAR_WORDS 3456
#define XB_SPIN_CAP (1u << 18)

__device__ __forceinline__ unsigned xb_ld(unsigned* p)              { return __hip_atomic_load(p, __ATOMIC_RELAXED, __HIP_MEMORY_SCOPE_AGENT); }
__device__ __forceinline__ unsigned xb_add(unsigned* p, unsigned v) { return __hip_atomic_fetch_add(p, v, __ATOMIC_RELAXED, __HIP_MEMORY_SCOPE_AGENT); }
__device__ __forceinline__ unsigned xb_xcc_id() { return (unsigned)__builtin_amdgcn_s_getreg((3 << 11) | 20) & 0xFu; }
#define XB_SPIN(cond, bar) do { unsigned _sp = 0; while (cond) { __builtin_amdgcn_s_sleep(1); \
    if ((++_sp & 255u) == 0u) { if (xb_ld(&(bar)[XB_TMO])) break; if (_sp > XB_SPIN_CAP) { atomicAdd(&(bar)[XB_TMO], 1u); break; } } } } while (0)

struct XcdBarrier {
    unsigned* bar; unsigned x;
    volatile LAS unsigned* st;
};

__device__ __forceinline__ XcdBarrier xcd_barrier_post(unsigned* bar, volatile LAS unsigned* st) {
    XcdBarrier b; b.bar = bar; b.x = xb_xcc_id(); b.st = st;
    if (threadIdx.x == 0) (void)xb_add(&bar[XB_XCNT(b.x)], 1u);
    return b;
}
__device__ __forceinline__ void xcd_barrier_complete(unsigned* bar, unsigned x, unsigned& nloc, unsigned& nx) {
    const unsigned G = gridDim.x * gridDim.y * gridDim.z;
    unsigned sum, cnt, mine, sp = 0u;
    for (;;) {
        sum = 0u; cnt = 0u; mine = 0u;
#pragma unroll
        for (unsigned j = 0; j < 16; ++j) { const unsigned c = xb_ld(&bar[XB_XCNT(j)]); sum += c; cnt += (c > 0u) ? 1u : 0u; mine = (j == x) ? c : mine; }
        if (sum == G) break;
        __builtin_amdgcn_s_sleep(1);
        if ((++sp & 255u) == 0u) { if (xb_ld(&bar[XB_TMO])) break; if (sp > XB_SPIN_CAP) { atomicAdd(&bar[XB_TMO], 1u); break; } }
    }
    nloc = mine > 0u ? mine : 1u; nx = cnt > 0u ? cnt : 1u;
}

__device__ __forceinline__ void xcd_barrier(const XcdBarrier& b) {
    asm volatile("s_waitcnt vmcnt(0)" ::: "memory");
    __syncthreads();
    if (threadIdx.x == 0) {
        unsigned* bar = b.bar;
        __builtin_amdgcn_s_waitcnt(0);
        unsigned nloc = b.st[0], nx = b.st[1];
        if (nloc == 0u) { xcd_barrier_complete(bar, b.x, nloc, nx); b.st[0] = nloc; b.st[1] = nx; }
        const unsigned old = xb_add(&bar[XB_XSUB(b.x)], 1u);
        const unsigned gen = old / nloc;
        if (old + 1u == (gen + 1u) * nloc) {
            __builtin_amdgcn_fence(__ATOMIC_RELEASE, "agent");
            asm volatile("s_waitcnt vmcnt(0)" ::: "memory");
            const unsigned og = xb_add(&bar[XB_TOP], 1u);
            const unsigned tg = og / nx;
            if (og + 1u == (tg + 1u) * nx) xb_add(&bar[XB_TOPGEN], 1u);
            else XB_SPIN(xb_ld(&bar[XB_TOPGEN]) == tg, bar);
            __builtin_amdgcn_fence(__ATOMIC_ACQUIRE, "agent");
            xb_add(&bar[XB_XGEN(b.x)], 1u);
            asm volatile("s_waitcnt vmcnt(0)" ::: "memory");
        } else {
            XB_SPIN(xb_ld(&bar[XB_XGEN(b.x)]) == gen, bar);
            __builtin_amdgcn_fence(__ATOMIC_ACQUIRE, "agent");
            asm volatile("s_waitcnt vmcnt(0)" ::: "memory");
        }
    }
    __syncthreads();
}
__device__ __forceinline__ void prep_lru(const float* const* in, unsigned char* ws, int l, int item, LAS unsigned char* lds, int tid) {
    const bf16* PROJ = (const bf16*)(ws + WS_PROJ); LAS float* X = (LAS float*)lds; LAS float* G = X + 32 * 256; LAS bf16* X16 = (LAS bf16*)(lds + 98304);
    const int t0 = item * 32; const float* cw = in[11] + l * 4 * 256; const float* cb = in[12] + l * 256;
#pragma unroll
    for (int it = 0; it < 2; ++it) { const int idx = tid + it * 512, t = idx >> 5, cv = idx & 31, tok = t0 + t, pos = tok & (SEQ - 1);
        f4 a0 = *(const f4*)(cb + cv * 8), a1 = *(const f4*)(cb + cv * 8 + 4);
#pragma unroll
        for (int k = 0; k < 4; ++k) { u4 x = (u4){0u, 0u, 0u, 0u}; if (pos - 3 + k >= 0) x = *(const u4*)(PROJ + (size_t)(tok - 3 + k) * NINP + PC_LX + cv * 8);
            const f4 w0 = *(const f4*)(cw + k * 256 + cv * 8), w1 = *(const f4*)(cw + k * 256 + cv * 8 + 4);
            a0 += w0 * (f4){bflo(x.x), bfhi(x.x), bflo(x.y), bfhi(x.y)}; a1 += w1 * (f4){bflo(x.z), bfhi(x.z), bflo(x.w), bfhi(x.w)}; }
        *(LAS f4*)(X + t * 256 + cv * 8) = a0; *(LAS f4*)(X + t * 256 + cv * 8 + 4) = a1;
        u4 xw; xw.x = pk2(a0.x, a0.y); xw.y = pk2(a0.z, a0.w); xw.z = pk2(a1.x, a1.y); xw.w = pk2(a1.z, a1.w); *(LAS u4*)(X16 + t * 264 + cv * 8) = xw; }
    const int gsel = tid >> 8, c = tid & 255;
    {
        const int wave = tid >> 6, lane = tid & 63, r16 = lane & 15, q4 = lane >> 4, gw_ = wave >> 2, blk = wave & 3;
        const float* W = (gw_ ? in[15] : in[13]) + (size_t)l * 16384 + blk * 4096; const float* bp = (gw_ ? in[16] : in[14]) + l * 256 + blk * 64;
        s8v bfr[4][2]; float bv[4];
#pragma unroll
        for (int nt = 0; nt < 4; ++nt) { bv[nt] = bp[16 * nt + r16];
#pragma unroll
            for (int ks = 0; ks < 2; ++ks) { const float* wp = W + (32 * ks + 8 * q4) * 64 + 16 * nt + r16;
                u4 w; w.x = pk2(wp[0], wp[64]); w.y = pk2(wp[128], wp[192]); w.z = pk2(wp[256], wp[320]); w.w = pk2(wp[384], wp[448]); bfr[nt][ks] = __builtin_bit_cast(s8v, w); } }
        __syncthreads();
        f32x4 acc[2][4];
#pragma unroll
        for (int mt = 0; mt < 2; ++mt)
#pragma unroll
            for (int nt = 0; nt < 4; ++nt) acc[mt][nt] = (f32x4){0.f, 0.f, 0.f, 0.f};
#pragma unroll
        for (int ks = 0; ks < 2; ++ks)
#pragma unroll
            for (int mt = 0; mt < 2; ++mt) { const s8v af = *(const LAS s8v*)(X16 + (16 * mt + r16) * 264 + blk * 64 + 32 * ks + 8 * q4);
#pragma unroll
                for (int nt = 0; nt < 4; ++nt) acc[mt][nt] = MFMA16(af, bfr[nt][ks], acc[mt][nt]); }
#pragma unroll
        for (int mt = 0; mt < 2; ++mt)
#pragma unroll
            for (int nt = 0; nt < 4; ++nt)
#pragma unroll
                for (int i = 0; i < 4; ++i) G[(gw_ * 32 + 16 * mt + 4 * q4 + i) * 256 + blk * 64 + 16 * nt + r16] = sigmoidf_(acc[mt][nt][i] + bv[nt]); }
    __syncthreads();
    { const float sp = softplusf_(-in[17][l * 256 + c]);
#pragma unroll 4
      for (int tt = 0; tt < 16; ++tt) { const int t = gsel * 16 + tt; const float r = G[t * 256 + c], ig = G[(32 + t) * 256 + c], la = -8.f * r * sp, av = __expf(la), u = sqrtf(fmaxf(1.f - av * av, 0.f)) * (ig * X[t * 256 + c]);
          G[t * 256 + c] = av; G[(32 + t) * 256 + c] = u; } }
    __syncthreads();
    if (tid < 256) { float h = 0.f, A = 1.f; float* LRA = (float*)(ws + WS_LRA); float* LRH = (float*)(ws + WS_LRH);
#pragma unroll 4
        for (int t = 0; t < 32; ++t) { const float av = G[t * 256 + c], u = G[(32 + t) * 256 + c];
            h = av * h + u; A *= av; const size_t o = (size_t)(t0 + t) * 256 + c; LRA[o] = A; LRH[o] = h; }
        ((float*)(ws + WS_SEGA))[item * 256 + c] = A; ((float*)(ws + WS_SEGH))[item * 256 + c] = h; }
    __syncthreads();
}
__device__ __forceinline__ void prep_ssd(const float* const* in, unsigned char* ws, int l, int item, int tid) {
    const bf16* PROJ = (const bf16*)(ws + WS_PROJ);
    const int t0 = item * 32; const float* cw = in[32] + l * 4 * 768; const float* cb = in[33] + l * 768;
#pragma unroll 2
    for (int it = 0; it < 6; ++it) { const int idx = tid + it * 512, t = idx / 96, cv = idx - t * 96, tok = t0 + t, pos = tok & (SEQ - 1);
        f4 a0 = *(const f4*)(cb + cv * 8), a1 = *(const f4*)(cb + cv * 8 + 4);
#pragma unroll
        for (int k = 0; k < 4; ++k) { u4 x = (u4){0u, 0u, 0u, 0u}; if (pos - 3 + k >= 0) x = *(const u4*)(PROJ + (size_t)(tok - 3 + k) * NINP + PC_SXBC + cv * 8);
            const f4 w0 = *(const f4*)(cw + k * 768 + cv * 8), w1 = *(const f4*)(cw + k * 768 + cv * 8 + 4);
            a0 += w0 * (f4){bflo(x.x), bfhi(x.x), bflo(x.y), bfhi(x.y)}; a1 += w1 * (f4){bflo(x.z), bfhi(x.z), bflo(x.w), bfhi(x.w)}; }
        u4 o; o.x = pk2(siluf_(a0.x), siluf_(a0.y)); o.y = pk2(siluf_(a0.z), siluf_(a0.w)); o.z = pk2(siluf_(a1.x), siluf_(a1.y)); o.w = pk2(siluf_(a1.z), siluf_(a1.w));
        *(u4*)((bf16*)(ws + WS_XBC) + (size_t)tok * 768 + cv * 8) = o; }
    if (tid < 128) { const int t = tid >> 2, hh = tid & 3, tok = t0 + t; const float dt = softplusf_(bf2f(PROJ[(size_t)tok * NINP + PC_SDT + hh]) + in[34][l * 4 + hh]);
        ((float*)(ws + WS_DT))[tok * 4 + hh] = dt; ((float*)(ws + WS_DEC))[tok * 4 + hh] = -dt * __expf(in[35][l * 4 + hh]); }
}
__device__ __forceinline__ void prep_rw(const float* const* in, unsigned char* ws, int l, int item, LAS unsigned char* lds, int tid) {
    const bf16* PROJ = (const bf16*)(ws + WS_PROJ); LAS float* P = (LAS float*)lds; LAS float* VV = (LAS float*)(lds + 32 * 832 * 4);
    const int t0 = item * 32; const float* mu = in[18] + l * 832;
    LAS float* V1 = VV + 256;
#pragma unroll
    for (int it = 0; it < 7; ++it) { const int idx = tid + it * 512; if (idx < 3328) { const int t = idx / 104, cv = idx - t * 104, tok = t0 + t;
        const bf16* pc = PROJ + (size_t)tok * NINP + PC_RW + cv * 8; const u4 cur = *(const u4*)pc; u4 prv = (u4){0u, 0u, 0u, 0u}; if (tok & (SEQ - 1)) prv = *(const u4*)(pc - NINP);
        const f4 m0 = *(const f4*)(mu + cv * 8), m1 = *(const f4*)(mu + cv * 8 + 4);
        const f4 c0 = (f4){bflo(cur.x), bfhi(cur.x), bflo(cur.y), bfhi(cur.y)}, c1 = (f4){bflo(cur.z), bfhi(cur.z), bflo(cur.w), bfhi(cur.w)};
        const f4 p0 = (f4){bflo(prv.x), bfhi(prv.x), bflo(prv.y), bfhi(prv.y)}, p1 = (f4){bflo(prv.z), bfhi(prv.z), bflo(prv.w), bfhi(prv.w)};
        f4 v0 = c0 + (p0 - c0) * m0, v1 = c1 + (p1 - c1) * m1;
        if (cv == 96 || cv == 97) { v0 = (f4){tanhf_(v0.x), tanhf_(v0.y), tanhf_(v0.z), tanhf_(v0.w)}; v1 = (f4){tanhf_(v1.x), tanhf_(v1.y), tanhf_(v1.z), tanhf_(v1.w)}; }
        else if (cv >= 100) { v0 = (f4){sigmoidf_(v0.x), sigmoidf_(v0.y), sigmoidf_(v0.z), sigmoidf_(v0.w)}; v1 = (f4){sigmoidf_(v1.x), sigmoidf_(v1.y), sigmoidf_(v1.z), sigmoidf_(v1.w)}; }
        *(LAS f4*)(P + t * 832 + cv * 8) = v0; *(LAS f4*)(P + t * 832 + cv * 8 + 4) = v1; } }
    if (l > 0) *(LAS f4*)(V1 + tid * 4) = *(const f4*)(in[25] + (size_t)(l - 1) * 2048 + tid * 4);
    __syncthreads();
    if (l > 0 && tid < 256) { const int t = tid >> 3, j = tid & 7; float s = 0.f;
#pragma unroll 4
        for (int c4 = 0; c4 < 64; ++c4) { const f4 pv = *(const LAS f4*)(P + t * 832 + 512 + 4 * c4); s += pv.x * V1[(4 * c4) * 8 + j] + pv.y * V1[(4 * c4 + 1) * 8 + j] + pv.z * V1[(4 * c4 + 2) * 8 + j] + pv.w * V1[(4 * c4 + 3) * 8 + j]; }
        VV[t * 8 + j] = s; }
    __syncthreads();
    const int half = tid >> 8, c = tid & 255, hh = c >> 6, lane = tid & 63;
    float zw[16], za[16], gg[16], zv[16];
    { const float w0 = in[19][l * 256 + c], a0 = in[21][l * 256 + c], v0 = l > 0 ? in[24][(l - 1) * 256 + c] : 0.f;
#pragma unroll
      for (int tt = 0; tt < 16; ++tt) { zw[tt] = w0; za[tt] = a0; gg[tt] = 0.f; zv[tt] = v0; } }
    const LAS float* ph = P + half * 16 * 832;
    {
        const float* w2p = in[20] + (size_t)l * 4096 + c; const float* a2p = in[22] + (size_t)l * 4096 + c;
        float wq[8];
#pragma unroll
        for (int q = 0; q < 4; ++q) { wq[q] = w2p[q * 256]; wq[4 + q] = a2p[q * 256]; }
#pragma unroll 1
        for (int j4 = 0; j4 < 4; ++j4) { float nq[8]; const int jn = j4 < 3 ? j4 + 1 : 3;
#pragma unroll
            for (int q = 0; q < 4; ++q) { nq[q] = w2p[(4 * jn + q) * 256]; nq[4 + q] = a2p[(4 * jn + q) * 256]; }
#pragma unroll
            for (int tt = 0; tt < 16; ++tt) { const f4 sw = *(const LAS f4*)(ph + tt * 832 + 768 + 4 * j4), sa = *(const LAS f4*)(ph + tt * 832 + 784 + 4 * j4);
                zw[tt] += sw.x * wq[0] + sw.y * wq[1] + sw.z * wq[2] + sw.w * wq[3]; za[tt] += sa.x * wq[4] + sa.y * wq[5] + sa.z * wq[6] + sa.w * wq[7]; }
#pragma unroll
            for (int q = 0; q < 8; ++q) wq[q] = nq[q]; }
        const float* g2p = in[23] + (size_t)l * 8192 + c; float gq[4];
#pragma unroll
        for (int q = 0; q < 4; ++q) gq[q] = g2p[q * 256];
#pragma unroll 1
        for (int j4 = 0; j4 < 8; ++j4) { float nq[4]; const int jn = j4 < 7 ? j4 + 1 : 7;
#pragma unroll
            for (int q = 0; q < 4; ++q) nq[q] = g2p[(4 * jn + q) * 256];
#pragma unroll
            for (int tt = 0; tt < 16; ++tt) { const f4 sg = *(const LAS f4*)(ph + tt * 832 + 800 + 4 * j4); gg[tt] += sg.x * gq[0] + sg.y * gq[1] + sg.z * gq[2] + sg.w * gq[3]; }
#pragma unroll
            for (int q = 0; q < 4; ++q) gq[q] = nq[q]; }
        if (l > 0) { const float* v2p = in[26] + (size_t)(l - 1) * 2048 + c; float vq[8];
#pragma unroll
            for (int q = 0; q < 8; ++q) vq[q] = v2p[q * 256];
#pragma unroll
            for (int tt = 0; tt < 16; ++tt) { const f4 s0 = *(const LAS f4*)(VV + (half * 16 + tt) * 8), s1 = *(const LAS f4*)(VV + (half * 16 + tt) * 8 + 4);
                zv[tt] += s0.x * vq[0] + s0.y * vq[1] + s0.z * vq[2] + s0.w * vq[3] + s1.x * vq[4] + s1.y * vq[5] + s1.z * vq[6] + s1.w * vq[7]; } }
    }
    const float kkw = in[27][l * 256 + c], kaw = in[28][l * 256 + c], rkw = in[29][l * 256 + c];
    float* VF = (float*)(ws + WS_VFIRST); float vf[16];
#pragma unroll
    for (int tt = 0; tt < 16; ++tt) vf[tt] = l > 0 ? VF[(size_t)(t0 + half * 16 + tt) * 256 + c] : 0.f;
#pragma unroll
    for (int tt = 0; tt < 16; ++tt) { const int t = half * 16 + tt; const size_t o = (size_t)(t0 + t) * 256 + c; const LAS float* pr = P + t * 832;
        const float r = pr[c], k = pr[256 + c]; float v = pr[512 + c];
        const float wd = __expf(-0.6065306597126334f * sigmoidf_(zw[tt])), av = sigmoidf_(za[tt]), g = gg[tt];
        if (l > 0) v = v + (vf[tt] - v) * sigmoidf_(zv[tt]); else VF[o] = v;
        float kk = k * kkw; const float nrm = sqrtf(wave_sum(kk * kk)); kk = kk / fmaxf(nrm, 1e-12f);
        const float k2 = k * (1.f + (av - 1.f) * kaw);
        const float bon = wave_sum(r * k2 * rkw);
        ((bf16*)(ws + WS_RWR))[o] = (bf16)pk2(r, 0.f); ((bf16*)(ws + WS_RWK))[o] = (bf16)pk2(k2, 0.f); ((bf16*)(ws + WS_RWV))[o] = (bf16)pk2(v, 0.f);
        ((bf16*)(ws + WS_RWKK))[o] = (bf16)pk2(-kk, 0.f); ((bf16*)(ws + WS_RWB))[o] = (bf16)pk2(kk * av, 0.f); ((bf16*)(ws + WS_RWG))[o] = (bf16)pk2(g, 0.f);
        ((float*)(ws + WS_RWW))[o] = wd;
        if (lane == 0) ((float*)(ws + WS_RWBON))[(t0 + t) * 4 + hh] = bon;
        asm volatile("" ::: "memory"); }
    __syncthreads();
}
__device__ __forceinline__ void phase_prep(const float* const* in, unsigned char* ws, int l, LAS unsigned char* lds, int tid) {
    const int N_L = (int)gridDim.x == 256 ? 256 : 512; constexpr int N_R = 512, N_S = 512;
    for (int it = blockIdx.x; it < N_L + N_R + N_S; it += gridDim.x) {
        if (it < N_L) {
#ifndef SKIP_PL
            prep_lru(in, ws, l, it, lds, tid);
#endif
        } else if (it < N_L + N_R) {
#ifndef SKIP_PR
            prep_rw(in, ws, l, it - N_L, lds, tid);
#endif
        } else {
#ifndef SKIP_PS
            prep_ssd(in, ws, l, it - N_L - N_R, tid);
#endif
        }
    }
}

template <int MODE> __device__ __forceinline__ void scan_rw(unsigned char* ws, int item, LAS unsigned char* lds, int tid) {
    LAS float* LW = (LAS float*)lds; LAS float* LKK = LW + 2048; LAS float* LB = LW + 4096; LAS float* LK = LW + 6144; LAS float* LR = LW + 8192; LAS float* LV = LW + 10240; LAS float* LY = LW + 12288;
    const int bh = item / NCH, ch = item % NCH, hh = bh & 3, tokb = (bh >> 2) * SEQ + ch * CHL, nsub = CHL / 32;
    const int st = tid >> 4, sc4 = (tid & 15) * 4, row = tid >> 3, sl = tid & 7;
    const bf16* gR = (const bf16*)(ws + WS_RWR); const bf16* gK = (const bf16*)(ws + WS_RWK); const bf16* gV = (const bf16*)(ws + WS_RWV); const bf16* gKK = (const bf16*)(ws + WS_RWKK); const bf16* gB = (const bf16*)(ws + WS_RWB);
    const float* gW = (const float*)(ws + WS_RWW); bf16* gY = (bf16*)(ws + WS_Y) + 512;
    float* gU = (float*)(ws + WS_RWU) + (size_t)item * 4096 + row * 64 + sl * 8; float* gP = (float*)(ws + WS_RWP) + (size_t)item * 4096 + row * 64 + sl * 8;
    f2 s[4], p[4];
    if (MODE == 1) { const f4 a = *(const f4*)gU, c = *(const f4*)(gU + 4); s[0] = LO2(a); s[1] = HI2(a); s[2] = LO2(c); s[3] = HI2(c); }
    else {
#pragma unroll
        for (int i = 0; i < 4; ++i) { s[i] = (f2){0.f, 0.f}; p[i] = (f2){(sl * 8 + 2 * i == row) ? 1.f : 0.f, (sl * 8 + 2 * i + 1 == row) ? 1.f : 0.f}; } }
    u2 pr, pk, pv, pkk, pb; f4 pw;
    { const size_t o = (size_t)(tokb + st) * 256 + hh * 64 + sc4; if (MODE == 1) pr = *(const u2*)(gR + o); pk = *(const u2*)(gK + o); pv = *(const u2*)(gV + o); pkk = *(const u2*)(gKK + o); pb = *(const u2*)(gB + o); pw = *(const f4*)(gW + o); }
    for (int sub = 0; sub < nsub; ++sub) {
        const int so = st * 64 + sc4;
        *(LAS f4*)(LW + so) = pw; if (MODE == 1) *(LAS f4*)(LR + so) = (f4){bflo(pr.x), bfhi(pr.x), bflo(pr.y), bfhi(pr.y)}; *(LAS f4*)(LK + so) = (f4){bflo(pk.x), bfhi(pk.x), bflo(pk.y), bfhi(pk.y)};
        *(LAS f4*)(LV + so) = (f4){bflo(pv.x), bfhi(pv.x), bflo(pv.y), bfhi(pv.y)}; *(LAS f4*)(LKK + so) = (f4){bflo(pkk.x), bfhi(pkk.x), bflo(pkk.y), bfhi(pkk.y)}; *(LAS f4*)(LB + so) = (f4){bflo(pb.x), bfhi(pb.x), bflo(pb.y), bfhi(pb.y)};
        lds_barrier();
        if (sub + 1 < nsub) { const size_t o = (size_t)(tokb + (sub + 1) * 32 + st) * 256 + hh * 64 + sc4; if (MODE == 1) pr = *(const u2*)(gR + o); pk = *(const u2*)(gK + o); pv = *(const u2*)(gV + o); pkk = *(const u2*)(gKK + o); pb = *(const u2*)(gB + o); pw = *(const f4*)(gW + o); }
        {
            const int ob = sl * 8; f4 w0, w1, a0, a1, b0, b1, k0, k1, r0 = (f4){0.f, 0.f, 0.f, 0.f}, r1 = r0; float vv;
#define RW_LOAD(T) { const int o_ = ((T) & 31) * 64 + ob; w0 = *(const LAS f4*)(LW + o_); w1 = *(const LAS f4*)(LW + o_ + 4); a0 = *(const LAS f4*)(LKK + o_); a1 = *(const LAS f4*)(LKK + o_ + 4); b0 = *(const LAS f4*)(LB + o_); b1 = *(const LAS f4*)(LB + o_ + 4); \
            k0 = *(const LAS f4*)(LK + o_); k1 = *(const LAS f4*)(LK + o_ + 4); if (MODE == 1) { r0 = *(const LAS f4*)(LR + o_); r1 = *(const LAS f4*)(LR + o_ + 4); } vv = LV[((T) & 31) * 64 + row]; }
            RW_LOAD(0)
#pragma unroll 2
            for (int t = 0; t < 32; ++t) {
                const f4 cw0 = w0, cw1 = w1, ca0 = a0, ca1 = a1, cb0 = b0, cb1 = b1, ck0 = k0, ck1 = k1, cr0 = r0, cr1 = r1; const float cv = vv;
                RW_LOAD(t + 1)
                f2 d2 = s[0] * LO2(ca0); d2 = s[1] * HI2(ca0) + d2; d2 = s[2] * LO2(ca1) + d2; d2 = s[3] * HI2(ca1) + d2;
                if (MODE == 0) { f2 e2 = p[0] * LO2(ca0); e2 = p[1] * HI2(ca0) + e2; e2 = p[2] * LO2(ca1) + e2; e2 = p[3] * HI2(ca1) + e2;
                    const float sp = red8(e2.x + e2.y); const f2 sp2 = (f2){sp, sp};
                    p[0] = p[0] * LO2(cw0) + sp2 * LO2(cb0); p[1] = p[1] * HI2(cw0) + sp2 * HI2(cb0); p[2] = p[2] * LO2(cw1) + sp2 * LO2(cb1); p[3] = p[3] * HI2(cw1) + sp2 * HI2(cb1); }
                const float sa = red8(d2.x + d2.y); const f2 sa2 = (f2){sa, sa}, cv2 = (f2){cv, cv};
                s[0] = s[0] * LO2(cw0) + sa2 * LO2(cb0) + cv2 * LO2(ck0); s[1] = s[1] * HI2(cw0) + sa2 * HI2(cb0) + cv2 * HI2(ck0);
                s[2] = s[2] * LO2(cw1) + sa2 * LO2(cb1) + cv2 * LO2(ck1); s[3] = s[3] * HI2(cw1) + sa2 * HI2(cb1) + cv2 * HI2(ck1);
                if (MODE == 1) { f2 y2 = s[0] * LO2(cr0); y2 = s[1] * HI2(cr0) + y2; y2 = s[2] * LO2(cr1) + y2; y2 = s[3] * HI2(cr1) + y2;
                    LY[t * 64 + row] = red8(y2.x + y2.y); } }
#undef RW_LOAD
        }
        lds_barrier();
        if (MODE == 1) { const f4 y = *(const LAS f4*)(LY + so); u2 w; w.x = pk2(y.x, y.y); w.y = pk2(y.z, y.w); *(u2*)(gY + (size_t)(tokb + sub * 32 + st) * D + hh * 64 + sc4) = w; }
    }
    if (MODE == 0) { *(f4*)gU = (f4){s[0].x, s[0].y, s[1].x, s[1].y}; *(f4*)(gU + 4) = (f4){s[2].x, s[2].y, s[3].x, s[3].y}; *(f4*)gP = (f4){p[0].x, p[0].y, p[1].x, p[1].y}; *(f4*)(gP + 4) = (f4){p[2].x, p[2].y, p[3].x, p[3].y}; }
    __syncthreads();
}
template <int MODE> __device__ __forceinline__ void scan_rw2(unsigned char* ws, int pair, LAS unsigned char* lds, int tid) {
    const int hf = tid >> 8, ht = tid & 255, item = 2 * pair + hf;
    LAS float* LW = (LAS float*)(lds + hf * 57344); LAS float* LKK = LW + 2048; LAS float* LB = LW + 4096; LAS float* LK = LW + 6144; LAS float* LR = LW + 8192; LAS float* LV = LW + 10240; LAS float* LY = LW + 12288;
    const int bh = item / NCH, ch = item % NCH, hh = bh & 3, tokb = (bh >> 2) * SEQ + ch * CHL, nsub = CHL / 32;
    const int row0 = ht >> 3, sl = ht & 7;
    const bf16* gR = (const bf16*)(ws + WS_RWR); const bf16* gK = (const bf16*)(ws + WS_RWK); const bf16* gV = (const bf16*)(ws + WS_RWV); const bf16* gKK = (const bf16*)(ws + WS_RWKK); const bf16* gB = (const bf16*)(ws + WS_RWB);
    const float* gW = (const float*)(ws + WS_RWW); bf16* gY = (bf16*)(ws + WS_Y) + 512;
    float* gU = (float*)(ws + WS_RWU) + (size_t)item * 4096 + row0 * 64 + sl * 8; float* gP = (float*)(ws + WS_RWP) + (size_t)item * 4096 + row0 * 64 + sl * 8;
    f2 s[2][4], p[2][4];
#pragma unroll
    for (int j = 0; j < 2; ++j) {
        if (MODE == 1) { const f4 a = *(const f4*)(gU + j * 2048), c = *(const f4*)(gU + j * 2048 + 4); s[j][0] = LO2(a); s[j][1] = HI2(a); s[j][2] = LO2(c); s[j][3] = HI2(c); }
        else {
#pragma unroll
            for (int i = 0; i < 4; ++i) { s[j][i] = (f2){0.f, 0.f}; p[j][i] = (f2){(sl * 8 + 2 * i == row0 + 32 * j) ? 1.f : 0.f, (sl * 8 + 2 * i + 1 == row0 + 32 * j) ? 1.f : 0.f}; } } }
    u2 pr[2], pk[2], pv[2], pkk[2], pb[2]; f4 pw[2];
#define RW2_FETCH(SUB) { _Pragma("unroll") for (int q = 0; q < 2; ++q) { const int pos = ht + 256 * q, st = pos >> 4, sc4 = (pos & 15) * 4; const size_t o = (size_t)(tokb + (SUB) * 32 + st) * 256 + hh * 64 + sc4; \
        if (MODE == 1) pr[q] = *(const u2*)(gR + o); pk[q] = *(const u2*)(gK + o); pv[q] = *(const u2*)(gV + o); pkk[q] = *(const u2*)(gKK + o); pb[q] = *(const u2*)(gB + o); pw[q] = *(const f4*)(gW + o); } }
    RW2_FETCH(0)
    for (int sub = 0; sub < nsub; ++sub) {
#pragma unroll
        for (int q = 0; q < 2; ++q) { const int pos = ht + 256 * q, so = (pos >> 4) * 64 + (pos & 15) * 4;
            *(LAS f4*)(LW + so) = pw[q]; if (MODE == 1) *(LAS f4*)(LR + so) = (f4){bflo(pr[q].x), bfhi(pr[q].x), bflo(pr[q].y), bfhi(pr[q].y)}; *(LAS f4*)(LK + so) = (f4){bflo(pk[q].x), bfhi(pk[q].x), bflo(pk[q].y), bfhi(pk[q].y)};
            *(LAS f4*)(LV + so) = (f4){bflo(pv[q].x), bfhi(pv[q].x), bflo(pv[q].y), bfhi(pv[q].y)}; *(LAS f4*)(LKK + so) = (f4){bflo(pkk[q].x), bfhi(pkk[q].x), bflo(pkk[q].y), bfhi(pkk[q].y)}; *(LAS f4*)(LB + so) = (f4){bflo(pb[q].x), bfhi(pb[q].x), bflo(pb[q].y), bfhi(pb[q].y)}; }
        lds_barrier();
        if (sub + 1 < nsub) RW2_FETCH(sub + 1)
        {   const int ob = sl * 8; f4 w0, w1, a0, a1, b0, b1, k0, k1, r0 = (f4){0.f, 0.f, 0.f, 0.f}, r1 = r0; float vv0, vv1;
#define RW_LOAD(T) { const int o_ = ((T) & 31) * 64 + ob; w0 = *(const LAS f4*)(LW + o_); w1 = *(const LAS f4*)(LW + o_ + 4); a0 = *(const LAS f4*)(LKK + o_); a1 = *(const LAS f4*)(LKK + o_ + 4); b0 = *(const LAS f4*)(LB + o_); b1 = *(const LAS f4*)(LB + o_ + 4); \
            k0 = *(const LAS f4*)(LK + o_); k1 = *(const LAS f4*)(LK + o_ + 4); if (MODE == 1) { r0 = *(const LAS f4*)(LR + o_); r1 = *(const LAS f4*)(LR + o_ + 4); } vv0 = LV[((T) & 31) * 64 + row0]; vv1 = LV[((T) & 31) * 64 + row0 + 32]; }
            RW_LOAD(0)
#pragma unroll 2
            for (int t = 0; t < 32; ++t) {
                const f4 cw0 = w0, cw1 = w1, ca0 = a0, ca1 = a1, cb0 = b0, cb1 = b1, ck0 = k0, ck1 = k1, cr0 = r0, cr1 = r1; const float cvv[2] = {vv0, vv1};
                RW_LOAD(t + 1)
#pragma unroll
                for (int j = 0; j < 2; ++j) {
                    f2 d2 = s[j][0] * LO2(ca0); d2 = s[j][1] * HI2(ca0) + d2; d2 = s[j][2] * LO2(ca1) + d2; d2 = s[j][3] * HI2(ca1) + d2;
                    if (MODE == 0) { f2 e2 = p[j][0] * LO2(ca0); e2 = p[j][1] * HI2(ca0) + e2; e2 = p[j][2] * LO2(ca1) + e2; e2 = p[j][3] * HI2(ca1) + e2;
                        const float sp = red8(e2.x + e2.y); const f2 sp2 = (f2){sp, sp};
                        p[j][0] = p[j][0] * LO2(cw0) + sp2 * LO2(cb0); p[j][1] = p[j][1] * HI2(cw0) + sp2 * HI2(cb0); p[j][2] = p[j][2] * LO2(cw1) + sp2 * LO2(cb1); p[j][3] = p[j][3] * HI2(cw1) + sp2 * HI2(cb1); }
                    const float sa = red8(d2.x + d2.y); const f2 sa2 = (f2){sa, sa}, cv2 = (f2){cvv[j], cvv[j]};
                    s[j][0] = s[j][0] * LO2(cw0) + sa2 * LO2(cb0) + cv2 * LO2(ck0); s[j][1] = s[j][1] * HI2(cw0) + sa2 * HI2(cb0) + cv2 * HI2(ck0);
                    s[j][2] = s[j][2] * LO2(cw1) + sa2 * LO2(cb1) + cv2 * LO2(ck1); s[j][3] = s[j][3] * HI2(cw1) + sa2 * HI2(cb1) + cv2 * HI2(ck1);
                    if (MODE == 1) { f2 y2 = s[j][0] * LO2(cr0); y2 = s[j][1] * HI2(cr0) + y2; y2 = s[j][2] * LO2(cr1) + y2; y2 = s[j][3] * HI2(cr1) + y2;
                        LY[t * 64 + row0 + 32 * j] = red8(y2.x + y2.y); } } }
#undef RW_LOAD
        }
        lds_barrier();
        if (MODE == 1) {
#pragma unroll
            for (int q = 0; q < 2; ++q) { const int pos = ht + 256 * q, st = pos >> 4, sc4 = (pos & 15) * 4; const f4 y = *(const LAS f4*)(LY + st * 64 + sc4); u2 w; w.x = pk2(y.x, y.y); w.y = pk2(y.z, y.w);
                *(u2*)(gY + (size_t)(tokb + sub * 32 + st) * D + hh * 64 + sc4) = w; } }
    }
#undef RW2_FETCH
    if (MODE == 0) {
#pragma unroll
        for (int j = 0; j < 2; ++j) { *(f4*)(gU + j * 2048) = (f4){s[j][0].x, s[j][0].y, s[j][1].x, s[j][1].y}; *(f4*)(gU + j * 2048 + 4) = (f4){s[j][2].x, s[j][2].y, s[j][3].x, s[j][3].y};
            *(f4*)(gP + j * 2048) = (f4){p[j][0].x, p[j][0].y, p[j][1].x, p[j][1].y}; *(f4*)(gP + j * 2048 + 4) = (f4){p[j][2].x, p[j][2].y, p[j][3].x, p[j][3].y}; } }
    __syncthreads();
}
__device__ __forceinline__ void combine_rw(unsigned char* ws, int it, LAS unsigned char* lds, int tid) {
    const int wave = tid >> 6, lane = tid & 63, bh = it >> 3, row = (it & 7) * 8 + wave;
    LAS float* LP = (LAS float*)lds;
    const float* gP = (const float*)(ws + WS_RWP) + (size_t)bh * NCH * 4096 + tid * 8; float* gU = (float*)(ws + WS_RWU) + (size_t)bh * NCH * 4096 + row * 64 + lane;
    f4 q[4][2]; float uq[4], s = 0.f;
#pragma unroll
    for (int d = 0; d < 4; ++d) { q[d][0] = *(const f4*)(gP + (size_t)d * 4096); q[d][1] = *(const f4*)(gP + (size_t)d * 4096 + 4); uq[d] = gU[(size_t)d * 4096]; }
    *(LAS f4*)(LP + tid * 8) = q[0][0]; *(LAS f4*)(LP + tid * 8 + 4) = q[0][1];
    lds_barrier();
#pragma unroll 1
    for (int c0 = 0; c0 < NCH; c0 += 4) {
#pragma unroll
        for (int d = 0; d < 4; ++d) { const int c = c0 + d; LAS float* cur = LP + (c & 1) * 4096; LAS float* nxt = LP + ((c + 1) & 1) * 4096;
            if (c + 1 < NCH) { *(LAS f4*)(nxt + tid * 8) = q[(d + 1) & 3][0]; *(LAS f4*)(nxt + tid * 8 + 4) = q[(d + 1) & 3][1]; }
            const float u = uq[d];
            if (c + 4 < NCH) { q[d][0] = *(const f4*)(gP + (size_t)(c + 4) * 4096); q[d][1] = *(const f4*)(gP + (size_t)(c + 4) * 4096 + 4); uq[d] = gU[(size_t)(c + 4) * 4096]; }
            gU[(size_t)c * 4096] = s;
            float n0 = u, n1 = 0.f; const int si = __builtin_bit_cast(int, s);
#pragma unroll
            for (int i = 0; i < 64; i += 2) { n0 += __builtin_bit_cast(float, __builtin_amdgcn_readlane(si, i)) * cur[i * 64 + lane]; n1 += __builtin_bit_cast(float, __builtin_amdgcn_readlane(si, i + 1)) * cur[(i + 1) * 64 + lane]; }
            s = n0 + n1;
            lds_barrier(); }
    }
    __syncthreads();
}
template <int MODE> __device__ __forceinline__ void scan_gla(const float* const* in, unsigned char* ws, int l, int item, LAS unsigned char* lds, int tid) {
    LAS float* LA = (LAS float*)lds; LAS float* LK = LA + 1024; LAS float* LQ = LA + 2048; LAS float* LV = LA + 3072; LAS float* LO = LA + 5120;
    const bf16* PROJ = (const bf16*)(ws + WS_PROJ); bf16* gO = (bf16*)(ws + WS_Y);
    const int bh = item / NCH, ch = item % NCH, hh = bh & 3, tokb = (bh >> 2) * SEQ + ch * CHL, nsub = CHL / 32;
    const int st = tid >> 4, si = tid & 15, vcol = tid >> 3, sl = tid & 7;
    float up0[16], up1[16];
#pragma unroll
    for (int r = 0; r < 16; ++r) { up0[r] = in[8][(l * 16 + r) * 128 + hh * 32 + 2 * si]; up1[r] = in[8][(l * 16 + r) * 128 + hh * 32 + 2 * si + 1]; }
    const float bi0 = in[9][l * 128 + hh * 32 + 2 * si], bi1 = in[9][l * 128 + hh * 32 + 2 * si + 1];
    float* gU = (float*)(ws + WS_GLU) + (size_t)item * 2048 + vcol * 32 + 4 * sl;
    float s[4] = {0.f, 0.f, 0.f, 0.f}, dp[4] = {1.f, 1.f, 1.f, 1.f};
    if (MODE == 1) { const f4 a = *(const f4*)gU; s[0] = a.x; s[1] = a.y; s[2] = a.z; s[3] = a.w; }
    u4 ps0, ps1; unsigned pq = 0, pk; u2 pv;
    { const bf16* p = PROJ + (size_t)(tokb + st) * NINP; ps0 = *(const u4*)(p + PC_GSTEM); ps1 = *(const u4*)(p + PC_GSTEM + 8); if (MODE == 1) pq = *(const unsigned*)(p + PC_GQ + hh * 32 + 2 * si); pk = *(const unsigned*)(p + PC_GK + hh * 32 + 2 * si); pv = *(const u2*)(p + PC_GV + hh * 64 + 4 * si); }
    for (int sub = 0; sub < nsub; ++sub) {
        { const unsigned sw[8] = {ps0.x, ps0.y, ps0.z, ps0.w, ps1.x, ps1.y, ps1.z, ps1.w}; float z0 = bi0, z1 = bi1;
#pragma unroll
          for (int r = 0; r < 8; ++r) { const float e0 = bflo(sw[r]), e1 = bfhi(sw[r]); z0 += e0 * up0[2 * r] + e1 * up0[2 * r + 1]; z1 += e0 * up1[2 * r] + e1 * up1[2 * r + 1]; }
          const float l0 = fminf(z0, 0.f) - log1pf(__expf(-fabsf(z0))), l1 = fminf(z1, 0.f) - log1pf(__expf(-fabsf(z1)));
          const int o = st * 32 + 2 * si; LA[o] = __expf(l0 * 0.0625f); LA[o + 1] = __expf(l1 * 0.0625f); LK[o] = bflo(pk); LK[o + 1] = bfhi(pk); if (MODE == 1) { LQ[o] = bflo(pq); LQ[o + 1] = bfhi(pq); }
          *(LAS f4*)(LV + st * 64 + 4 * si) = (f4){bflo(pv.x), bfhi(pv.x), bflo(pv.y), bfhi(pv.y)}; }
        lds_barrier();
        if (sub + 1 < nsub) { const bf16* p = PROJ + (size_t)(tokb + (sub + 1) * 32 + st) * NINP; ps0 = *(const u4*)(p + PC_GSTEM); ps1 = *(const u4*)(p + PC_GSTEM + 8); if (MODE == 1) pq = *(const unsigned*)(p + PC_GQ + hh * 32 + 2 * si); pk = *(const unsigned*)(p + PC_GK + hh * 32 + 2 * si); pv = *(const u2*)(p + PC_GV + hh * 64 + 4 * si); }
        {   f4 al, kk, qq = (f4){0.f, 0.f, 0.f, 0.f}; float vv;
#define GL_LOAD(T) { const int o_ = ((T) & 31) * 32 + 4 * sl; al = *(const LAS f4*)(LA + o_); kk = *(const LAS f4*)(LK + o_); if (MODE == 1) qq = *(const LAS f4*)(LQ + o_); vv = LV[((T) & 31) * 64 + vcol]; }
            GL_LOAD(0)
#pragma unroll 4
            for (int t = 0; t < 32; ++t) { const f4 ca = al, ck = kk, cq = qq; const float cv = vv;
                GL_LOAD(t + 1)
                s[0] = s[0] * ca.x + ck.x * cv; s[1] = s[1] * ca.y + ck.y * cv; s[2] = s[2] * ca.z + ck.z * cv; s[3] = s[3] * ca.w + ck.w * cv;
                if (MODE == 0) { dp[0] *= ca.x; dp[1] *= ca.y; dp[2] *= ca.z; dp[3] *= ca.w; }
                else { const float o = (s[0] * cq.x + s[1] * cq.y) + (s[2] * cq.z + s[3] * cq.w); LO[t * 64 + vcol] = red8(o) * 0.17677669529663687f; } }
#undef GL_LOAD
        }
        lds_barrier();
        if (MODE == 1) { const f4 y = *(const LAS f4*)(LO + st * 64 + 4 * si); u2 w; w.x = pk2(y.x, y.y); w.y = pk2(y.z, y.w); *(u2*)(gO + (size_t)(tokb + sub * 32 + st) * D + hh * 64 + 4 * si) = w; }
    }
    if (MODE == 0) { *(f4*)gU = (f4){s[0], s[1], s[2], s[3]}; if (vcol == 0) *(f4*)((float*)(ws + WS_GLD) + item * 32 + 4 * sl) = (f4){dp[0], dp[1], dp[2], dp[3]}; }
    __syncthreads();
}
template <int MODE> __device__ __forceinline__ void scan_ssd(unsigned char* ws, int item, LAS unsigned char* lds, int tid) {
    LAS float* LB = (LAS float*)lds; LAS float* LC = LB + 4096; LAS float* LX = LB + 8192; LAS float* LD = LB + 10240; LAS float* LY = LB + 10304;
    const bf16* XBC = (const bf16*)(ws + WS_XBC); const float* DT = (const float*)(ws + WS_DT); const float* DEC = (const float*)(ws + WS_DEC); bf16* gY = (bf16*)(ws + WS_Y) + 768;
    const int bh = item / NCH, ch = item % NCH, hh = bh & 3, tokb = (bh >> 2) * SEQ + ch * CHL, nsub = CHL / 32;
    const int st = tid >> 4, si = tid & 15, p = tid >> 3, sl = tid & 7, g = hh >> 1;
    float* gU = (float*)(ws + WS_SSU) + (size_t)item * 8192 + p * 128 + 16 * sl;
    f2 s[8]; float dprod = 1.f;
#pragma unroll
    for (int i = 0; i < 4; ++i) { f4 a = (f4){0.f, 0.f, 0.f, 0.f}; if (MODE == 1) a = *(const f4*)(gU + 4 * i); s[2 * i] = LO2(a); s[2 * i + 1] = HI2(a); }
    u4 pb, pc = (u4){0u, 0u, 0u, 0u}; u2 px; float pdt, pdec;
    { const size_t tok = tokb + st; const bf16* q = XBC + tok * 768; pb = *(const u4*)(q + 256 + g * 128 + 8 * si); if (MODE == 1) pc = *(const u4*)(q + 512 + g * 128 + 8 * si); px = *(const u2*)(q + hh * 64 + 4 * si); pdt = DT[tok * 4 + hh]; pdec = DEC[tok * 4 + hh]; }
    for (int sub = 0; sub < nsub; ++sub) {
        { const int o = st * 128 + 8 * si;
          *(LAS f4*)(LB + o) = (f4){bflo(pb.x), bfhi(pb.x), bflo(pb.y), bfhi(pb.y)}; *(LAS f4*)(LB + o + 4) = (f4){bflo(pb.z), bfhi(pb.z), bflo(pb.w), bfhi(pb.w)};
          if (MODE == 1) { *(LAS f4*)(LC + o) = (f4){bflo(pc.x), bfhi(pc.x), bflo(pc.y), bfhi(pc.y)}; *(LAS f4*)(LC + o + 4) = (f4){bflo(pc.z), bfhi(pc.z), bflo(pc.w), bfhi(pc.w)}; }
          *(LAS f4*)(LX + st * 64 + 4 * si) = (f4){bflo(px.x) * pdt, bfhi(px.x) * pdt, bflo(px.y) * pdt, bfhi(px.y) * pdt};
          if (si == 0) LD[st] = pdec; }
        lds_barrier();
        if (sub + 1 < nsub) { const size_t tok = tokb + (sub + 1) * 32 + st; const bf16* q = XBC + tok * 768; pb = *(const u4*)(q + 256 + g * 128 + 8 * si); if (MODE == 1) pc = *(const u4*)(q + 512 + g * 128 + 8 * si); px = *(const u2*)(q + hh * 64 + 4 * si); pdt = DT[tok * 4 + hh]; pdec = DEC[tok * 4 + hh]; }
        {   f4 bb[4], cc[4]; float xv, dc;
#pragma unroll
            for (int q4 = 0; q4 < 4; ++q4) cc[q4] = (f4){0.f, 0.f, 0.f, 0.f};
#define SS_LOAD(T) { const int o_ = ((T) & 31) * 128 + 16 * sl; _Pragma("unroll") for (int q4 = 0; q4 < 4; ++q4) { bb[q4] = *(const LAS f4*)(LB + o_ + 4 * q4); if (MODE == 1) cc[q4] = *(const LAS f4*)(LC + o_ + 4 * q4); } xv = LX[((T) & 31) * 64 + p]; dc = LD[(T) & 31]; }
            SS_LOAD(0)
#pragma unroll 2
            for (int t = 0; t < 32; ++t) { f4 cb_[4], cc_[4]; const float cx = xv, cd = dc;
#pragma unroll
                for (int q4 = 0; q4 < 4; ++q4) { cb_[q4] = bb[q4]; cc_[q4] = cc[q4]; }
                SS_LOAD(t + 1)
                if (MODE == 0) dprod *= cd;
                const f2 cd2 = (f2){cd, cd}, cx2 = (f2){cx, cx}; f2 y2 = (f2){0.f, 0.f};
#pragma unroll
                for (int q4 = 0; q4 < 4; ++q4) {
                    s[2 * q4] = s[2 * q4] * cd2 + LO2(cb_[q4]) * cx2; s[2 * q4 + 1] = s[2 * q4 + 1] * cd2 + HI2(cb_[q4]) * cx2;
                    if (MODE == 1) { y2 = s[2 * q4] * LO2(cc_[q4]) + y2; y2 = s[2 * q4 + 1] * HI2(cc_[q4]) + y2; } }
                if (MODE == 1) LY[t * 64 + p] = red8(y2.x + y2.y); }
#undef SS_LOAD
        }
        lds_barrier();
        if (MODE == 1) { const f4 y = *(const LAS f4*)(LY + st * 64 + 4 * si); u2 w; w.x = pk2(y.x, y.y); w.y = pk2(y.z, y.w); *(u2*)(gY + (size_t)(tokb + sub * 32 + st) * D + hh * 64 + 4 * si) = w; }
    }
    if (MODE == 0) {
#pragma unroll
        for (int i = 0; i < 4; ++i) *(f4*)(gU + 4 * i) = (f4){s[2 * i].x, s[2 * i].y, s[2 * i + 1].x, s[2 * i + 1].y};
        if (tid == 0) ((float*)(ws + WS_SSD))[item] = dprod; }
    __syncthreads();
}
constexpr int SP = 136;
__device__ __forceinline__ bf16 u4_elem(const u4& w, int e) { const unsigned x = (e >> 1) == 0 ? w.x : (e >> 1) == 1 ? w.y : (e >> 1) == 2 ? w.z : w.w; return (bf16)((e & 1) ? (x >> 16) : (x & 0xffffu)); }
__device__ __forceinline__ void ssd_cumsum(unsigned char* ws, int tok0, int g, LAS float* CS, int tid) {
    const int wave = tid >> 6, lane = tid & 63;
    if (wave < 2) { const float* DA = (const float*)(ws + WS_DEC); const float a0 = DA[(size_t)(tok0 + 2 * lane) * 4 + 2 * g + wave], a1 = DA[(size_t)(tok0 + 2 * lane + 1) * 4 + 2 * g + wave]; float v = a0 + a1;
#pragma unroll
        for (int o = 1; o < 64; o <<= 1) { const float t = __shfl_up(v, o); if (lane >= o) v += t; }
        CS[wave * 128 + 2 * lane] = v - a1; CS[wave * 128 + 2 * lane + 1] = v; }
}
__device__ __forceinline__ void ssd_passA(unsigned char* ws, int item, LAS unsigned char* lds, int tid) {
    const int b = item >> 7, g = (item >> 6) & 1, ch = item & 63, tok0 = b * SEQ + ch * 128;
    LAS bf16* LB = (LAS bf16*)(lds + 34816); LAS bf16* LX = (LAS bf16*)(lds + 69632); LAS float* CS = (LAS float*)(lds + 139264);
    const bf16* XBC = (const bf16*)(ws + WS_XBC); const float* DT = (const float*)(ws + WS_DT);
    ssd_cumsum(ws, tok0, g, CS, tid);
    const int sr = tid >> 2, part = tid & 3;
    { const bf16* q = XBC + (size_t)(tok0 + sr) * 768 + 256 + g * 128 + part * 32;
#pragma unroll
      for (int v = 0; v < 4; ++v) { const u4 w = *(const u4*)(q + 8 * v);
#pragma unroll
          for (int e = 0; e < 8; ++e) LB[(part * 32 + 8 * v + e) * SP + sr] = u4_elem(w, e); } }
    lds_barrier();
    { const int hl = part >> 1, p0 = (part & 1) * 32, h = 2 * g + hl; const float sc = DT[(size_t)(tok0 + sr) * 4 + h] * __expf(CS[hl * 128 + 127] - CS[hl * 128 + sr]);
      const bf16* q = XBC + (size_t)(tok0 + sr) * 768 + h * 64 + p0;
#pragma unroll
      for (int v = 0; v < 4; ++v) { const u4 w = *(const u4*)(q + 8 * v);
#pragma unroll
          for (int e = 0; e < 8; ++e) LX[(hl * 64 + p0 + 8 * v + e) * SP + sr] = (bf16)pk2(bf2f(u4_elem(w, e)) * sc, 0.f); } }
    lds_barrier();
    const int wave = tid >> 6, lane = tid & 63, r16 = lane & 15, q4 = lane >> 4, hl = wave >> 2, pt = wave & 3;
    f32x4 acc[8];
#pragma unroll
    for (int nt = 0; nt < 8; ++nt) acc[nt] = (f32x4){0.f, 0.f, 0.f, 0.f};
#pragma unroll
    for (int ks = 0; ks < 4; ++ks) { const s8v af = *(const LAS s8v*)(LX + (hl * 64 + 16 * pt + r16) * SP + 32 * ks + 8 * q4);
#pragma unroll
        for (int nt = 0; nt < 8; ++nt) { const s8v bfr = *(const LAS s8v*)(LB + (16 * nt + r16) * SP + 32 * ks + 8 * q4); acc[nt] = MFMA16(af, bfr, acc[nt]); } }
    float* gU = (float*)(ws + WS_SSU) + ((size_t)(b * 4 + 2 * g + hl) * NCS + ch) * 8192;
#pragma unroll
    for (int nt = 0; nt < 8; ++nt)
#pragma unroll
        for (int i = 0; i < 4; ++i) gU[(16 * pt + 4 * q4 + i) * 128 + 16 * nt + r16] = acc[nt][i];
    if (tid < 2) ((float*)(ws + WS_SSD))[(b * 4 + 2 * g + tid) * NCS + ch] = __expf(CS[tid * 128 + 127]);
    __syncthreads();
}
__device__ __forceinline__ void ssd_passB(unsigned char* ws, int item, LAS unsigned char* lds, int tid) {
    const int b = item >> 7, g = (item >> 6) & 1, ch = item & 63, tok0 = b * SEQ + ch * 128;
    LAS bf16* LC = (LAS bf16*)lds; LAS bf16* LB = (LAS bf16*)(lds + 34816); LAS bf16* LX = (LAS bf16*)(lds + 69632); LAS bf16* LS = (LAS bf16*)(lds + 104448); LAS float* CS = (LAS float*)(lds + 139264);
    const bf16* XBC = (const bf16*)(ws + WS_XBC); const float* DT = (const float*)(ws + WS_DT); bf16* gY = (bf16*)(ws + WS_Y) + 768;
    ssd_cumsum(ws, tok0, g, CS, tid);
    const int sr = tid >> 2, part = tid & 3;
    { const bf16* q = XBC + (size_t)(tok0 + sr) * 768;
#pragma unroll
      for (int v = 0; v < 4; ++v) { *(LAS u4*)(LB + sr * SP + part * 32 + 8 * v) = *(const u4*)(q + 256 + g * 128 + part * 32 + 8 * v); *(LAS u4*)(LC + sr * SP + part * 32 + 8 * v) = *(const u4*)(q + 512 + g * 128 + part * 32 + 8 * v); } }
    { const int hl = part >> 1, p0 = (part & 1) * 32, h = 2 * g + hl; const float sc = DT[(size_t)(tok0 + sr) * 4 + h];
      const bf16* q = XBC + (size_t)(tok0 + sr) * 768 + h * 64 + p0;
#pragma unroll
      for (int v = 0; v < 4; ++v) { const u4 w = *(const u4*)(q + 8 * v);
#pragma unroll
          for (int e = 0; e < 8; ++e) LX[(hl * 64 + p0 + 8 * v + e) * SP + sr] = (bf16)pk2(bf2f(u4_elem(w, e)) * sc, 0.f); } }
    { const int hl = sr >> 6, p = sr & 63; const float* gS = (const float*)(ws + WS_SSU) + ((size_t)(b * 4 + 2 * g + hl) * NCS + ch) * 8192 + p * 128 + part * 32;
#pragma unroll
      for (int v = 0; v < 4; ++v) { const f4 x0 = *(const f4*)(gS + 8 * v), x1 = *(const f4*)(gS + 8 * v + 4); u4 w; w.x = pk2(x0.x, x0.y); w.y = pk2(x0.z, x0.w); w.z = pk2(x1.x, x1.y); w.w = pk2(x1.z, x1.w); *(LAS u4*)(LS + sr * SP + part * 32 + 8 * v) = w; } }
    lds_barrier();
    const int wave = tid >> 6, lane = tid & 63, r16 = lane & 15, q4 = lane >> 4, lt = wave;
    f32x4 cb[8];
#pragma unroll
    for (int st = 0; st < 8; ++st) cb[st] = (f32x4){0.f, 0.f, 0.f, 0.f};
#pragma unroll
    for (int ks = 0; ks < 4; ++ks) { const s8v af = *(const LAS s8v*)(LC + (16 * lt + r16) * SP + 32 * ks + 8 * q4);
#pragma unroll
        for (int st = 0; st < 8; ++st) { const s8v bfr = *(const LAS s8v*)(LB + (16 * st + r16) * SP + 32 * ks + 8 * q4); cb[st] = MFMA16(af, bfr, cb[st]); } }
#pragma unroll 1
    for (int hl = 0; hl < 2; ++hl) {
        lds_barrier();
#pragma unroll
        for (int st = 0; st < 8; ++st)
#pragma unroll
            for (int i = 0; i < 4; ++i) { const int l = 16 * lt + 4 * q4 + i, s2 = 16 * st + r16; const float m = (s2 <= l) ? cb[st][i] * __expf(CS[hl * 128 + l] - CS[hl * 128 + s2]) : 0.f; LB[l * SP + s2] = (bf16)pk2(m, 0.f); }
        lds_barrier();
        f32x4 yd[4], yo[4];
#pragma unroll
        for (int p4 = 0; p4 < 4; ++p4) { yd[p4] = (f32x4){0.f, 0.f, 0.f, 0.f}; yo[p4] = (f32x4){0.f, 0.f, 0.f, 0.f}; }
#pragma unroll
        for (int ks = 0; ks < 4; ++ks) { const s8v mf = *(const LAS s8v*)(LB + (16 * lt + r16) * SP + 32 * ks + 8 * q4), cf = *(const LAS s8v*)(LC + (16 * lt + r16) * SP + 32 * ks + 8 * q4);
#pragma unroll
            for (int p4 = 0; p4 < 4; ++p4) { const s8v xf = *(const LAS s8v*)(LX + (hl * 64 + 16 * p4 + r16) * SP + 32 * ks + 8 * q4), sf = *(const LAS s8v*)(LS + (hl * 64 + 16 * p4 + r16) * SP + 32 * ks + 8 * q4);
                yd[p4] = MFMA16(xf, mf, yd[p4]); yo[p4] = MFMA16(sf, cf, yo[p4]); } }
        const float el = __expf(CS[hl * 128 + 16 * lt + r16]);
#pragma unroll
        for (int p4 = 0; p4 < 4; ++p4) { const f32x4 y = yd[p4] + yo[p4] * el; u2 w; w.x = pk2(y[0], y[1]); w.y = pk2(y[2], y[3]);
            *(u2*)(gY + (size_t)(tok0 + 16 * lt + r16) * D + (2 * g + hl) * 64 + 16 * p4 + 4 * q4) = w; }
    }
    __syncthreads();
}
__device__ __forceinline__ void scan_lru_carry(unsigned char* ws, int tid) {
    const float* SA = (const float*)(ws + WS_SEGA); const float* SH = (const float*)(ws + WS_SEGH); float* CY = (float*)(ws + WS_CARRY);
    const int b = tid >> 8, c = tid & 255; float h = 0.f;
#pragma unroll 1
    for (int g0 = 0; g0 < 256; g0 += 32) { float av[32], hv[32];
#pragma unroll
        for (int j = 0; j < 32; ++j) { const int o = (b * 256 + g0 + j) * 256 + c; av[j] = SA[o]; hv[j] = SH[o]; }
#pragma unroll
        for (int j = 0; j < 32; ++j) { CY[(b * 256 + g0 + j) * 256 + c] = h; h = av[j] * h + hv[j]; } }
}
__device__ __forceinline__ void combine_gla(unsigned char* ws, int bh, int tid) {
    float* gU = (float*)(ws + WS_GLU) + (size_t)bh * NCH * 2048 + tid * 4; const float* gD = (const float*)(ws + WS_GLD) + bh * NCH * 32 + (tid & 7) * 4; f4 s = (f4){0.f, 0.f, 0.f, 0.f};
#pragma unroll 1
    for (int c0 = 0; c0 < NCH; c0 += 16) { f4 u[16], d[16];
#pragma unroll
        for (int j = 0; j < 16; ++j) { u[j] = *(const f4*)(gU + (size_t)(c0 + j) * 2048); d[j] = *(const f4*)(gD + (c0 + j) * 32); }
#pragma unroll
        for (int j = 0; j < 16; ++j) { *(f4*)(gU + (size_t)(c0 + j) * 2048) = s; s = s * d[j] + u[j]; } }
}
__device__ __forceinline__ void combine_ssd(unsigned char* ws, int q, int tid) {
    const int bh = q >> 2; float* gU = (float*)(ws + WS_SSU) + (size_t)bh * NCS * 8192 + (q & 3) * 2048 + tid * 4; const float* gD = (const float*)(ws + WS_SSD) + bh * NCS; f4 s = (f4){0.f, 0.f, 0.f, 0.f};
#pragma unroll 1
    for (int c0 = 0; c0 < NCS; c0 += 16) { f4 u[16]; float d[16];
#pragma unroll
        for (int j = 0; j < 16; ++j) { u[j] = *(const f4*)(gU + (size_t)(c0 + j) * 8192); d[j] = gD[c0 + j]; }
#pragma unroll
        for (int j = 0; j < 16; ++j) { *(f4*)(gU + (size_t)(c0 + j) * 8192) = s; s = s * d[j] + u[j]; } }
}
template <int MODE> __device__ __forceinline__ void phase_scan(const float* const* in, unsigned char* ws, int l, LAS unsigned char* lds, int tid) {
    for (int t = blockIdx.x; t < 256; t += gridDim.x) {
        if (t < 128) scan_rw2<MODE>(ws, t, lds, tid);
        else { const int i0 = 2 * (t - 128);
            scan_gla<MODE>(in, ws, l, i0, lds, tid); scan_gla<MODE>(in, ws, l, i0 + 1, lds, tid);
            if (MODE == 0) { ssd_passA(ws, i0, lds, tid); ssd_passA(ws, i0 + 1, lds, tid); } else { ssd_passB(ws, i0, lds, tid); ssd_passB(ws, i0 + 1, lds, tid); }
            if (MODE == 0 && (int)gridDim.x == 256) { prep_lru(in, ws, l, 256 + i0, lds, tid); prep_lru(in, ws, l, 257 + i0, lds, tid); } }
    }
}
__device__ __forceinline__ void phase_combine(const float* const* in, unsigned char* ws, int l, LAS unsigned char* lds, int tid) {
    const int wave = __builtin_amdgcn_readfirstlane(tid >> 6), lane = tid & 63; constexpr int NCW = 105;
    const int mask = (l + 1 < NL ? (1 | 4) : 0) | 16;
    if ((int)gridDim.x > NCW + 8) {
        if ((int)blockIdx.x < 64) combine_rw(ws, blockIdx.x, lds, tid);
        else if ((int)blockIdx.x < 72) combine_gla(ws, blockIdx.x - 64, tid);
        else if ((int)blockIdx.x < 104) combine_ssd(ws, blockIdx.x - 72, tid);
        else if ((int)blockIdx.x == 104) scan_lru_carry(ws, tid);
        else convert_mats(in, ws, mask, l + 1, l, lds, ((int)blockIdx.x - NCW) * 8 + wave, ((int)gridDim.x - NCW) * 8, wave, lane);
    } else {
        for (int it = blockIdx.x; it < NCW; it += gridDim.x) {
            if (it < 64) combine_rw(ws, it, lds, tid);
            else if (it < 72) combine_gla(ws, it - 64, tid);
            else if (it < 104) combine_ssd(ws, it - 72, tid);
            else scan_lru_carry(ws, tid);
        }
        convert_mats(in, ws, mask, l + 1, l, lds, blockIdx.x * 8 + wave, gridDim.x * 8, wave, lane);
    }
}
__device__ __forceinline__ void phase_post(const float* const* in, unsigned char* ws, int l, int gw, int NGW, int lane) {
    const bf16* PROJ = (const bf16*)(ws + WS_PROJ); bf16* Y = (bf16*)(ws + WS_Y); const int c = 4 * lane, hh = lane >> 4;
    const f4 gnorm = *(const f4*)(in[10] + l * 64 + (c & 63)), gnw = *(const f4*)(in[30] + l * 256 + c), gnb = *(const f4*)(in[31] + l * 256 + c), snw = *(const f4*)(in[37] + l * 256 + c);
    const float dsk = in[36][l * 4 + hh];
    for (int tok = gw; tok < M; tok += NGW) { const bf16* pp = PROJ + (size_t)tok * NINP; const size_t o = (size_t)tok * 256 + c; bf16* yo = Y + (size_t)tok * D + c;
        const u2 g_ov = *(const u2*)(yo), g_gv = *(const u2*)(pp + PC_GG + c);
        const f4 l_A = *(const f4*)((const float*)(ws + WS_LRA) + o), l_H = *(const f4*)((const float*)(ws + WS_LRH) + o), l_cy = *(const f4*)((const float*)(ws + WS_CARRY) + (size_t)(tok >> 5) * 256 + c); const u2 l_gv = *(const u2*)(pp + PC_LG + c);
        const u2 r_yv = *(const u2*)(yo + 512), r_vv = *(const u2*)((const bf16*)(ws + WS_RWV) + o), r_gv = *(const u2*)((const bf16*)(ws + WS_RWG) + o); const float bon = ((const float*)(ws + WS_RWBON))[tok * 4 + hh];
        const u2 s_yv = *(const u2*)(yo + 768), s_xv = *(const u2*)((const bf16*)(ws + WS_XBC) + (size_t)tok * 768 + c), s_zv = *(const u2*)(pp + PC_SZ + c);
        u2 w0, w1, w2, w3;
        { const float o0 = bflo(g_ov.x), o1 = bfhi(g_ov.x), o2 = bflo(g_ov.y), o3 = bfhi(g_ov.y);
          const float rs = rsqrtf(red16((o0 * o0 + o1 * o1) + (o2 * o2 + o3 * o3)) * (1.f / 64.f) + 1e-5f);
          w0.x = pk2(o0 * rs * gnorm.x * siluf_(bflo(g_gv.x)), o1 * rs * gnorm.y * siluf_(bfhi(g_gv.x))); w0.y = pk2(o2 * rs * gnorm.z * siluf_(bflo(g_gv.y)), o3 * rs * gnorm.w * siluf_(bfhi(g_gv.y))); }
        { w1.x = pk2((l_H.x + l_A.x * l_cy.x) * gelu_tanh(bflo(l_gv.x)), (l_H.y + l_A.y * l_cy.y) * gelu_tanh(bfhi(l_gv.x))); w1.y = pk2((l_H.z + l_A.z * l_cy.z) * gelu_tanh(bflo(l_gv.y)), (l_H.w + l_A.w * l_cy.w) * gelu_tanh(bfhi(l_gv.y))); }
        { float y0 = bflo(r_yv.x), y1 = bfhi(r_yv.x), y2 = bflo(r_yv.y), y3 = bfhi(r_yv.y);
          const float mean = red16((y0 + y1) + (y2 + y3)) * (1.f / 64.f); y0 -= mean; y1 -= mean; y2 -= mean; y3 -= mean;
          const float rs = rsqrtf(red16((y0 * y0 + y1 * y1) + (y2 * y2 + y3 * y3)) * (1.f / 64.f) + 64e-5f);
          w2.x = pk2((y0 * rs * gnw.x + gnb.x + bon * bflo(r_vv.x)) * bflo(r_gv.x), (y1 * rs * gnw.y + gnb.y + bon * bfhi(r_vv.x)) * bfhi(r_gv.x));
          w2.y = pk2((y2 * rs * gnw.z + gnb.z + bon * bflo(r_vv.y)) * bflo(r_gv.y), (y3 * rs * gnw.w + gnb.w + bon * bfhi(r_vv.y)) * bfhi(r_gv.y)); }
        { const float y0 = (bflo(s_yv.x) + dsk * bflo(s_xv.x)) * siluf_(bflo(s_zv.x)), y1 = (bfhi(s_yv.x) + dsk * bfhi(s_xv.x)) * siluf_(bfhi(s_zv.x)), y2 = (bflo(s_yv.y) + dsk * bflo(s_xv.y)) * siluf_(bflo(s_zv.y)), y3 = (bfhi(s_yv.y) + dsk * bfhi(s_xv.y)) * siluf_(bfhi(s_zv.y));
          float q = red16((y0 * y0 + y1 * y1) + (y2 * y2 + y3 * y3)); q += __shfl_xor(q, 16);
          const float rs = rsqrtf(q * (1.f / 128.f) + 1e-5f);
          w3.x = pk2(y0 * rs * snw.x, y1 * rs * snw.y); w3.y = pk2(y2 * rs * snw.z, y3 * rs * snw.w); }
        *(u2*)(yo) = w0; *(u2*)(yo + 256) = w1; *(u2*)(yo + 512) = w2; *(u2*)(yo + 768) = w3;
    }
}
#ifndef PROBE_GEMM
#define PROBE_GEMM 1
#endif
#ifndef PROBE_SCAN
#define PROBE_SCAN 1
#endif
#ifndef PROBE_MISC
#define PROBE_MISC 1
#endif
struct Args { const float* in[43]; float* out; unsigned char* ws; };
template <class Epi> __device__ __forceinline__ void gemm_multi(LAS unsigned char* lds, const pg8::Gemm& g, const Epi& E) {
    pg8::StaticOrder S; S.init(g.M, g.N, (int)gridDim.x, (int)blockIdx.x);
    pg8::gemm_phase<Epi, pg8::StaticOrder, true, true>(lds, g, S, E);
}
template <class Epi> __device__ __forceinline__ void gemm_single(LAS unsigned char* lds, const pg8::Gemm& g, const Epi& E, const unsigned* wait = nullptr, unsigned need = 0u, unsigned* pub = nullptr, unsigned* tmo = nullptr) {
    pg8::StaticOrder S; S.init(g.M, g.N, (int)gridDim.x, (int)blockIdx.x);
    int prev = -1;
    for (int r = 0;; ++r) { pg8::Unit u; if (!S.next(r, u)) break; OneUnit O{S, r, wait, need, pub, tmo, prev}; pg8::gemm_phase<Epi, OneUnit, false, true>(lds, g, O, E); prev = u.pm; }
    if (pub && prev >= 0) { asm volatile("s_waitcnt vmcnt(0)" ::: "memory"); __syncthreads(); if (threadIdx.x == 0) __hip_atomic_fetch_add(pub + 64 * prev, 1u, __ATOMIC_RELAXED, __HIP_MEMORY_SCOPE_AGENT); }
}
__device__ __forceinline__ void tail_convert(const float* const* in, unsigned char* ws, int units, int mask, int lA, int lB, LAS unsigned char* lds) {
    const int G = (int)gridDim.x, rem = units % G; if (rem == 0 || (int)blockIdx.x < rem) return;
    int tid = threadIdx.x; asm volatile("" : "+v"(tid)); const int lane = tid & 63, wave = __builtin_amdgcn_readfirstlane(tid >> 6);
    convert_mats(in, ws, mask, lA, lB, lds, ((int)blockIdx.x - rem) * 8 + wave, (G - rem) * 8, wave, lane);
}
__global__ void __launch_bounds__(512, 2) fwd(Args a) {
    extern __shared__ __attribute__((aligned(16))) unsigned char lds_raw[];
    LAS unsigned char* lds = (LAS unsigned char*)lds_raw;
    cg::grid_group grid = cg::this_grid();
    unsigned* ctl = (unsigned*)(a.ws + WS_CTL); volatile LAS unsigned* MISC = (volatile LAS unsigned*)(lds + LDS_BYTES - 64);
    if (threadIdx.x < 2) MISC[threadIdx.x] = 0u;
    __syncthreads();
    if (a.ws == nullptr) grid.sync();
    const XcdBarrier bar = xcd_barrier_post(ctl, MISC);
#define GSYNC() do { XcdBarrier bb_ = bar; asm volatile("" : "+s"(bb_.bar), "+s"(bb_.x)); xcd_barrier(bb_); } while (0)
#define TIDS int tid = threadIdx.x; asm volatile("" : "+v"(tid)); const int lane = tid & 63, wave = __builtin_amdgcn_readfirstlane(tid >> 6), gw = blockIdx.x * 8 + wave, NGW = gridDim.x * 8; (void)lane; (void)gw; (void)NGW;
    unsigned char* ws = a.ws; const float* const* in = a.in; float* X = a.out;
    bf16* XB = (bf16*)(ws + WS_XB); bf16* Y = (bf16*)(ws + WS_Y); bf16* H = (bf16*)(ws + WS_PROJ); bf16* PROJ = (bf16*)(ws + WS_PROJ); float* SS = (float*)(ws + WS_SS);
    { TIDS convert_mats(in, ws, 7, 0, 0, lds, gw, NGW, wave, lane); phase_init_rows(in[0], XB, SS, gw, NGW, lane); }
    GSYNC();
#pragma unroll 1
    for (int l = 0; l < NL; ++l) {
#ifndef SKIP_G1
        { pg8::Gemm g{XB, (const bf16*)(ws + WS_WGU1), M, 2 * FF, D}; EpiGU E{H, SS}; gemm_single(lds, g, E); tail_convert(in, ws, 64 * 22, 8, l, l, lds); }
#endif
        GSYNC();
#ifndef SKIP_G2
        { pg8::Gemm g{H, (const bf16*)(ws + WS_WD1), M, D, FF}; EpiResid E{l == 0 ? in[0] : nullptr, XB, SS, 0.5f, 1}; gemm_single(lds, g, E); }
#endif
        GSYNC();
#ifndef SKIP_G3
        for (int rep = 0; rep < PROBE_GEMM; ++rep) { pg8::Gemm g{XB, (const bf16*)(ws + WS_WIN), M, NINP, D}; EpiProj E{PROJ, SS}; gemm_single(lds, g, E); if (l + 1 < NL) tail_convert(in, ws, 64 * 13, 2, l + 1, l, lds); }
#endif
        GSYNC();
#ifndef SKIP_PREP
        for (int rep = 0; rep < PROBE_MISC; ++rep) { TIDS phase_prep(in, ws, l, lds, tid); }
#endif
        GSYNC();
#ifndef SKIP_SCAN
        for (int rep = 0; rep < PROBE_SCAN; ++rep) { TIDS phase_scan<0>(in, ws, l, lds, tid); }
        GSYNC();
        { TIDS phase_combine(in, ws, l, lds, tid); }
        GSYNC();
        for (int rep = 0; rep < PROBE_SCAN; ++rep) { TIDS phase_scan<1>(in, ws, l, lds, tid); }
#endif
        GSYNC();
#ifndef SKIP_POST
        for (int rep = 0; rep < PROBE_MISC; ++rep) { TIDS phase_post(in, ws, l, gw, NGW, lane); }
#endif
        GSYNC();
#ifndef SKIP_G4
        { pg8::Gemm g{Y, (const bf16*)(ws + WS_WOUT), M, D, D}; EpiResid E{nullptr, XB, SS, 1.0f, 1}; gemm_single(lds, g, E); }
#endif
        GSYNC();
#ifndef SKIP_G5
        { pg8::Gemm g{XB, (const bf16*)(ws + WS_WGU2), M, 2 * FF, D}; EpiGU E{H, SS}; gemm_single(lds, g, E); tail_convert(in, ws, 64 * 22, 32, l + 1, l, lds); }
#endif
        GSYNC();
#ifndef SKIP_G6
        { pg8::Gemm g{H, (const bf16*)(ws + WS_WD2), M, D, FF}; EpiResid E{nullptr, XB, SS, 0.5f, l + 1 < NL ? 1 : 0}; gemm_single(lds, g, E); }
#endif
        GSYNC();
    }
    { TIDS phase_final(XB, X, in[42], gw, NGW, lane); }
}

extern "C" void kernel_launch(void* const* d_in, const int* in_sizes, int n_in, void* d_out, int out_size, void* d_ws, size_t ws_size, hipStream_t stream) {
    static int grid = 0;
    if (grid == 0) {
        int dev = 0, cus = 0, per_cu = 0;
        (void)hipGetDevice(&dev);
        (void)hipDeviceGetAttribute(&cus, hipDeviceAttributeMultiprocessorCount, dev);
        (void)hipFuncSetAttribute((const void*)fwd, hipFuncAttributeMaxDynamicSharedMemorySize, LDS_BYTES);
        (void)hipOccupancyMaxActiveBlocksPerMultiprocessor(&per_cu, (const void*)fwd, 512, LDS_BYTES);
        if (per_cu < 1) per_cu = 1;
        grid = cus * per_cu;
        if (n_in != 43 || out_size != M * D || ws_size < WS_END) fprintf(stderr, "kernel_launch: unexpected sizes n_in %d out %d ws %zu (need %zu)\n", n_in, out_size, ws_size, (size_t)WS_END);
    }
    Args a{};
    for (int i = 0; i < 43 && i < n_in; ++i) a.in[i] = (const float*)d_in[i];
    a.out = (float*)d_out; a.ws = (unsigned char*)d_ws;
    (void)hipMemsetAsync((unsigned char*)d_ws + WS_CTL, 0, (size_t)CTL_WORDS * 4, stream);
    void* args[] = {&a};
    hipError_t e = hipLaunchCooperativeKernel((const void*)fwd, dim3(grid), dim3(512), args, LDS_BYTES, stream);
    if (e != hipSuccess) fprintf(stderr, "cooperative launch failed: %s (grid %d)\n", hipGetErrorString(e), grid);
}
```
